# Optimizing an MI355X kernel written in HIP

```python
import math
import jax, jax.numpy as jnp
from jax import lax
import numpy as np

D_MODEL = 2048
BATCH = 8
SEQ = 4096
DEPTH = 4

N_MIXERS = 2
Q_BLOCK = 128
D_FF = 4 * D_MODEL
RMS_EPS = 1e-6

A_HEADS = 32
A_QK_DIM = 128
A_V_DIM = 128
A_Q_RANK = 512
A_KV_RANK = 256
IDX_HEADS = 16
IDX_DIM = 128
IDX_TOPK = 256

B_HEADS = 16
B_HEAD_DIM = D_MODEL // B_HEADS

REL_BUCKETS = 32
REL_MAX_DIST = 128

N_A_LAYERS = (DEPTH + 1) // 2
N_B_LAYERS = DEPTH // 2
A_IN_COLS = A_Q_RANK + A_KV_RANK + IDX_DIM + IDX_HEADS
B_IN_COLS = 3 * B_HEADS * B_HEAD_DIM

kernel_name = "hybrid_dsa_stickbreaking_adaln_trunk"


def rmsnorm(x, g):
    xf = x.astype(jnp.float32)
    y = xf * lax.rsqrt(jnp.mean(xf * xf, axis=-1, keepdims=True) + RMS_EPS)
    return (y * g.astype(jnp.float32)).astype(x.dtype)


def layernorm(x, g):
    xf = x.astype(jnp.float32)
    mu = jnp.mean(xf, axis=-1, keepdims=True)
    var = jnp.mean(jnp.square(xf - mu), axis=-1, keepdims=True)
    return ((xf - mu) * lax.rsqrt(var + RMS_EPS) * g.astype(jnp.float32)).astype(x.dtype)


def modulate(h, shift, scale):
    return h * (1 + scale[:, None, :]) + shift[:, None, :]


def t5_bucket(dist):
    max_exact = REL_BUCKETS // 2
    d = jnp.maximum(dist, 1).astype(jnp.float32)
    large = max_exact + (jnp.log(d / max_exact) / math.log(REL_MAX_DIST / max_exact)
                         * (REL_BUCKETS - max_exact)).astype(jnp.int32)
    large = jnp.minimum(large, REL_BUCKETS - 1)
    return jnp.where(dist < max_exact, dist, large)


def dsa_attention(h, w_in, q_norm, kv_norm, idx_k_norm, w_qb, w_idx_qb, w_uk, w_uv, w_out, rel_bias):
    B, S, _ = h.shape
    k_top = min(IDX_TOPK, S // 4)
    proj = h @ w_in
    c1 = A_Q_RANK
    c2 = c1 + A_KV_RANK
    c3 = c2 + IDX_DIM
    q_lat, c_kv, k_idx, w_idx = jnp.split(proj, [c1, c2, c3], axis=-1)
    q_lat = rmsnorm(q_lat, q_norm)
    c_kv = rmsnorm(c_kv, kv_norm)
    k_idx = layernorm(k_idx, idx_k_norm)
    q = (q_lat @ w_qb).reshape(B, S, A_HEADS, A_QK_DIM)
    q_idx = (q_lat @ w_idx_qb).reshape(B, S, IDX_HEADS, IDX_DIM)
    w_idx = w_idx * (IDX_HEADS ** -0.5 * IDX_DIM ** -0.5)
    scale = A_QK_DIM ** -0.5
    key_pos = jnp.arange(S)

    def block(i):
        q0 = i * Q_BLOCK
        t = q0 + jnp.arange(Q_BLOCK)
        qb = lax.dynamic_slice_in_dim(q, q0, Q_BLOCK, axis=1)
        qib = lax.dynamic_slice_in_dim(q_idx, q0, Q_BLOCK, axis=1)
        wb = lax.dynamic_slice_in_dim(w_idx, q0, Q_BLOCK, axis=1)
        dots = jnp.einsum('bqhd,bsd->bqsh', qib, k_idx)
        score = jnp.einsum('bqsh,bqh->bqs', jax.nn.relu(dots), wb).astype(jnp.float32)
        score = jnp.where(key_pos[None, None, :] <= t[None, :, None], score, -jnp.inf)
        _, idx = lax.top_k(score, k_top)
        valid = idx <= t[None, :, None]
        kv_sel = jax.vmap(lambda kv, ix: kv[ix])(c_kv, idx)
        q_abs = jnp.einsum('bqhd,hcd->bqhc', qb, w_uk)
        logits = jnp.einsum('bqhc,bqkc->bqhk', q_abs, kv_sel).astype(jnp.float32) * scale
        bucket = t5_bucket(jnp.maximum(t[None, :, None] - idx, 0))
        logits = logits + jnp.moveaxis(rel_bias[bucket], -1, 2).astype(jnp.float32)
        logits = jnp.where(valid[:, :, None, :], logits, -jnp.inf)
        probs = jax.nn.softmax(logits, axis=-1).astype(h.dtype)
        o_lat = jnp.einsum('bqhk,bqkc->bqhc', probs, kv_sel)
        return jnp.einsum('bqhc,hcv->bqhv', o_lat, w_uv)

    out = lax.map(block, jnp.arange(S // Q_BLOCK))
    out = jnp.moveaxis(out, 0, 1).reshape(B, S, A_HEADS * A_V_DIM)
    return out @ w_out


def stick_breaking_attention(h, w_in, w_out):
    B, S, _ = h.shape
    q, k, v = jnp.split(h @ w_in, 3, axis=-1)
    q = q.reshape(B, S, B_HEADS, B_HEAD_DIM)
    k = k.reshape(B, S, B_HEADS, B_HEAD_DIM)
    v = v.reshape(B, S, B_HEADS, B_HEAD_DIM)
    scale = B_HEAD_DIM ** -0.5
    key_pos = jnp.arange(S)

    def block(i):
        q0 = i * Q_BLOCK
        t = q0 + jnp.arange(Q_BLOCK)
        qb = lax.dynamic_slice_in_dim(q, q0, Q_BLOCK, axis=1)
        z = jnp.einsum('bqhd,bshd->bhqs', qb, k).astype(jnp.float32) * scale
        strict = key_pos[None, :] < t[:, None]
        log_beta = jax.nn.log_sigmoid(z)
        log_rest = jnp.where(strict, log_beta - z, 0.0)
        later = lax.cumsum(log_rest, axis=3, reverse=True) - log_rest
        weights = jnp.where(strict, jnp.exp(log_beta + later), 0.0).astype(h.dtype)
        return jnp.einsum('bhqs,bshd->bqhd', weights, v)

    out = lax.map(block, jnp.arange(S // Q_BLOCK))
    out = jnp.moveaxis(out, 0, 1).reshape(B, S, B_HEADS * B_HEAD_DIM)
    return out @ w_out


def setup_inputs(seed: int = 0) -> dict:
    key = jax.random.key(seed)
    ks = jax.random.split(key, 20)

    def w(k, shape, fan_in):
        return jax.random.normal(k, shape, jnp.float32) * (fan_in ** -0.5)

    def gain(k, shape):
        return 1.0 + 0.05 * jax.random.normal(k, shape, jnp.float32)

    D = D_MODEL
    return {
        "x": jax.random.normal(ks[0], (BATCH, SEQ, D), jnp.float32),
        "c": jax.random.normal(ks[1], (BATCH, D), jnp.float32),
        "rel_bias": 0.5 * jax.random.normal(ks[2], (REL_BUCKETS, A_HEADS), jnp.float32),
        "ada_w": w(ks[3], (DEPTH, D, 6 * D), D),
        "ada_b": 0.01 * jax.random.normal(ks[4], (DEPTH, 6 * D), jnp.float32),
        "norm_g": gain(ks[5], (DEPTH, 4, D)),
        "a_w_in": w(ks[6], (N_A_LAYERS, D, A_IN_COLS), D),
        "a_q_norm": gain(ks[7], (N_A_LAYERS, A_Q_RANK)),
        "a_kv_norm": gain(ks[8], (N_A_LAYERS, A_KV_RANK)),
        "a_idx_k_norm": gain(ks[9], (N_A_LAYERS, IDX_DIM)),
        "a_w_qb": w(ks[10], (N_A_LAYERS, A_Q_RANK, A_HEADS * A_QK_DIM), A_Q_RANK),
        "a_w_idx_qb": w(ks[11], (N_A_LAYERS, A_Q_RANK, IDX_HEADS * IDX_DIM), A_Q_RANK),
        "a_w_uk": w(ks[12], (N_A_LAYERS, A_HEADS, A_KV_RANK, A_QK_DIM), A_KV_RANK),
        "a_w_uv": w(ks[13], (N_A_LAYERS, A_HEADS, A_KV_RANK, A_V_DIM), A_KV_RANK),
        "a_w_out": w(ks[14], (N_A_LAYERS, A_HEADS * A_V_DIM, D), A_HEADS * A_V_DIM),
        "b_w_in": w(ks[15], (N_B_LAYERS, D, B_IN_COLS), D),
        "b_w_out": w(ks[16], (N_B_LAYERS, B_HEADS * B_HEAD_DIM, D), B_HEADS * B_HEAD_DIM),
        "mlp_w1": w(ks[17], (DEPTH, D, D_FF), D),
        "mlp_w2": w(ks[18], (DEPTH, D_FF, D), D_FF),
    }


def reference(x, c, rel_bias, ada_w, ada_b, norm_g, a_w_in, a_q_norm, a_kv_norm, a_idx_k_norm,
              a_w_qb, a_w_idx_qb, a_w_uk, a_w_uv, a_w_out, b_w_in, b_w_out, mlp_w1, mlp_w2):
    mod = jnp.einsum('bd,lde->lbe', jax.nn.silu(c), ada_w) + ada_b[:, None, :]
    for layer in range(DEPTH):
        shift_m, scale_m, gate_m, shift_f, scale_f, gate_f = jnp.split(mod[layer], 6, axis=-1)
        j = layer // N_MIXERS
        h = modulate(rmsnorm(x, norm_g[layer, 0]), shift_m, scale_m)
        if layer % N_MIXERS == 0:
            y = dsa_attention(h, a_w_in[j], a_q_norm[j], a_kv_norm[j], a_idx_k_norm[j],
                              a_w_qb[j], a_w_idx_qb[j], a_w_uk[j], a_w_uv[j], a_w_out[j], rel_bias)
        else:
            y = stick_breaking_attention(h, b_w_in[j], b_w_out[j])
        x = x + gate_m[:, None, :] * rmsnorm(y, norm_g[layer, 1])
        h = modulate(rmsnorm(x, norm_g[layer, 2]), shift_f, scale_f)
        y = jnp.square(jax.nn.relu(h @ mlp_w1[layer])) @ mlp_w2[layer]
        x = x + gate_f[:, None, :] * rmsnorm(y, norm_g[layer, 3])
    return x
```

```cpp
#include <hip/hip_runtime.h>
#include <cstdio>
#include <cstdint>
#ifndef ONE_LAUNCH
#define ONE_LAUNCH 1
#endif
namespace pg8 {
#define PG8_LAS __attribute__((address_space(3)))
typedef unsigned short bf16_t;
typedef short bf16x8 __attribute__((ext_vector_type(8)));
typedef float f32x4 __attribute__((ext_vector_type(4)));
typedef unsigned u32x4 __attribute__((ext_vector_type(4)));
constexpr int BM = 256, BK = 64, HALF = 128, HTB = HALF * BK * 2  , STAGE_BYTES = 8 * HTB, NXCD = 8, WGM = 4;

__host__ __device__ __forceinline__ int lds_byte(int r, int c) { const int st = (r >> 4) * 2 + (c >> 5), rr = r & 15, cc = c & 31, ob = rr * 64 + cc * 2; return st * 1024 + (ob ^ (((ob >> 9) & 1) << 5)); }
__host__ __device__ __forceinline__ void stage_rc(int b, int& R, int& C) { const int st = b / 1024, sb = b % 1024, swz = sb ^ (((sb >> 9) & 1) << 5); R = (st >> 1) * 16 + swz / 64; C = (st & 1) * 32 + (swz % 64) / 2; }
__host__ __device__ __forceinline__ int perm32(int rho) { const int n = rho >> 4, i = rho & 15; return 8 * (i >> 2) + 4 * n + (i & 3); }

struct Unit { int pm, pn; };
struct Gemm { const bf16_t* A; const bf16_t* Bt; int M, N, K, lda, ldb, acs; };

struct StaticOrder {
    int nM, nN, nwg, G, c;
    __host__ __device__ void init(int M, int N, int G_, int c_) { nM = M / BM; nN = N / BM; nwg = nM * nN; G = G_; c = c_; }
    __host__ __device__ bool next(int i, Unit& u) const {
        const long L = (long)i * G + c; if (L >= nwg) return false;
        int wgid = (int)L; { const int q = nwg / NXCD, r = nwg % NXCD, xcd = wgid % NXCD, off = wgid / NXCD; wgid = (xcd < r ? xcd * (q + 1) : r * (q + 1) + (xcd - r) * q) + off; }
        const int nig = WGM * nN, gid = wgid / nig, fm = gid * WGM, gsz = (nM - fm) < WGM ? (nM - fm) : WGM;
        u.pm = fm + ((wgid % nig) % gsz); u.pn = (wgid % nig) / gsz; return true;
    }
    __device__ __forceinline__ void a_ready(const Unit&) const {}
    __device__ __forceinline__ void done(const Unit&) const {}
};


__device__ __forceinline__ unsigned cvt_pk_bf16(float lo, float hi) { unsigned r; asm volatile("v_cvt_pk_bf16_f32 %0, %1, %2" : "=v"(r) : "v"(lo), "v"(hi)); return r; }
struct EpiF32 {
    static constexpr bool PERM = false, AFTER_DRAIN = false;
    float* C; int ldc;
    __device__ __forceinline__ void operator()(const f32x4 (&acc)[2][2][4][2], const Unit& u, int wr, int wc, int fr, int fq) const {
        const int row0 = u.pm * BM + wr * 64 + fr, col0 = u.pn * BM + wc * 32 + 4 * fq;
#pragma unroll
        for (int ai = 0; ai < 2; ++ai)
#pragma unroll
            for (int m = 0; m < 4; ++m) { float* rowp = C + (size_t)(row0 + ai * HALF + m * 16) * ldc + col0;
#pragma unroll
                for (int bj = 0; bj < 2; ++bj)
#pragma unroll
                    for (int n = 0; n < 2; ++n) *(f32x4*)(rowp + bj * HALF + n * 16) = acc[ai][bj][m][n]; }
    }
};
template <int ACT> struct EpiBf16 {
    static constexpr bool PERM = true, AFTER_DRAIN = false;
    bf16_t* O0; int ld0; bf16_t* O1; int ld1; int split_col;
    __device__ __forceinline__ void operator()(const f32x4 (&acc)[2][2][4][2], const Unit& u, int wr, int wc, int fr, int fq) const {
        const int row0 = u.pm * BM + wr * 64 + fr; int colt = u.pn * BM; bf16_t* base = O0; int ldc = ld0;
        if (colt >= split_col) { base = O1; ldc = ld1; colt -= split_col; }
        const int col0 = colt + wc * 32 + 8 * fq;
#pragma unroll
        for (int ai = 0; ai < 2; ++ai)
#pragma unroll
            for (int m = 0; m < 4; ++m) { bf16_t* rowp = base + (size_t)(row0 + ai * HALF + m * 16) * ldc + col0;
#pragma unroll
                for (int bj = 0; bj < 2; ++bj) { f32x4 v0 = acc[ai][bj][m][0], v1 = acc[ai][bj][m][1];
                    if (ACT == 1) {
#pragma unroll
                        for (int j = 0; j < 4; ++j) { const float a = fmaxf(v0[j], 0.f), b = fmaxf(v1[j], 0.f); v0[j] = a * a; v1[j] = b * b; } }
                    u32x4 w; w.x = cvt_pk_bf16(v0[0], v0[1]); w.y = cvt_pk_bf16(v0[2], v0[3]); w.z = cvt_pk_bf16(v1[0], v1[1]); w.w = cvt_pk_bf16(v1[2], v1[3]);
                    *(u32x4*)(rowp + bj * HALF) = w; } }
    }
};

template <class Epi, class Sched, bool ALIGN_EPI = false, bool SP2 = false>
__device__ __forceinline__ void gemm_phase(PG8_LAS unsigned char* lds, const Gemm g, const Sched& S, const Epi& E, int tid_in) {
    int tid_l = tid_in; asm volatile("" : "+v"(tid_l));
    const int tid = tid_l, wid = __builtin_amdgcn_readfirstlane(tid >> 6), lane = tid & 63, wr = wid >> 2, wc = wid & 3, fr = lane & 15, fq = lane >> 4;
    const int K = g.K, nt = K / BK;
    unsigned voffA[2], voffB[2];
#pragma unroll
    for (int i = 0; i < 2; ++i) { int R, C; stage_rc(tid * 16 + i * 8192, R, C); const int Rb = Epi::PERM ? ((R & ~31) + perm32(R & 31)) : R;
        voffA[i] = (unsigned)(R * g.lda + C) * 2u; voffB[i] = (unsigned)(Rb * g.ldb + C) * 2u; }
    const size_t kstep = (size_t)(BK * 2);
    const size_t hstepA = (size_t)HALF * g.lda * 2, hstepB = (size_t)HALF * g.ldb * 2;
    const size_t tstepA = 2 * hstepA, tstepB = 2 * hstepB, cstepA = (size_t)g.acs * 2;
    const unsigned ldsw = (unsigned)wid * 1024u;
    const int aoff = lds_byte(wr * 64 + fr, fq * 8), boff = lds_byte(wc * 32 + fr, fq * 8);
#define PG8_SA(b, h) (((b) * 2 + (h)) * HTB)
#define PG8_SB(b, h) ((4 + (b) * 2 + (h)) * HTB)
#define PG8_STAGE(bufoff, gbase, voff) do { _Pragma("unroll") for (int _i = 0; _i < 2; ++_i) \
        __builtin_amdgcn_global_load_lds((const unsigned*)((const char*)(gbase) + (voff)[_i]), (PG8_LAS unsigned*)(lds + (bufoff) + ldsw + _i * 8192), 16, 0, 0); } while (0)
#define PG8_LDA(dst, b, h) do { _Pragma("unroll") for (int m = 0; m < 4; ++m) _Pragma("unroll") for (int k = 0; k < 2; ++k) dst[m][k] = *(const PG8_LAS bf16x8*)(lds + PG8_SA(b, h) + aoff + m * 2048 + k * 1024); } while (0)
#define PG8_LDB(dst, b, h) do { _Pragma("unroll") for (int n = 0; n < 2; ++n) _Pragma("unroll") for (int k = 0; k < 2; ++k) dst[n][k] = *(const PG8_LAS bf16x8*)(lds + PG8_SB(b, h) + boff + n * 2048 + k * 1024); } while (0)
#define PG8_MMA(ai, bj, At, Bt) do { __builtin_amdgcn_s_setprio(1); _Pragma("unroll") for (int m = 0; m < 4; ++m) _Pragma("unroll") for (int n = 0; n < 2; ++n) _Pragma("unroll") for (int k = 0; k < 2; ++k) \
        acc[ai][bj][m][n] = __builtin_amdgcn_mfma_f32_16x16x32_bf16(Bt[n][k], At[m][k], acc[ai][bj][m][n], 0, 0, 0); __builtin_amdgcn_s_setprio(0); } while (0)
#define PG8_WAIT_V(n) asm volatile("s_waitcnt vmcnt(" #n ")" ::: "memory")
#define PG8_WAIT_L(n) asm volatile("s_waitcnt lgkmcnt(" #n ")" ::: "memory")
#define PG8_BAR __builtin_amdgcn_s_barrier()
#define PG8_SCHED __builtin_amdgcn_sched_barrier(0)
    Unit cur, nxt; int ui = 0;
    if (!S.next(0, cur)) return;
    f32x4 acc[2][2][4][2];
#pragma unroll
    for (int a = 0; a < 2; ++a)
#pragma unroll
        for (int b = 0; b < 2; ++b)
#pragma unroll
            for (int m = 0; m < 4; ++m)
#pragma unroll
                for (int n = 0; n < 2; ++n) acc[a][b][m][n] = (f32x4){0.f, 0.f, 0.f, 0.f};
    bf16x8 At[4][2], B0[2][2], B1[2][2];
    const char* cA = (const char*)g.A + (size_t)cur.pm * tstepA + (size_t)cur.pn * cstepA; const char* cB = (const char*)g.Bt + (size_t)cur.pn * tstepB;
    S.a_ready(cur);
    if constexpr (SP2) {
        PG8_STAGE(PG8_SB(0, 0), cB, voffB); PG8_STAGE(PG8_SB(0, 1), cB + hstepB, voffB); PG8_STAGE(PG8_SA(0, 0), cA, voffA); PG8_STAGE(PG8_SA(0, 1), cA + hstepA, voffA);
        if (wr == 1) PG8_BAR;
        PG8_WAIT_V(2); PG8_BAR;
        PG8_STAGE(PG8_SB(1, 0), cB + kstep, voffB); PG8_STAGE(PG8_SA(1, 0), cA + kstep, voffA); PG8_STAGE(PG8_SB(1, 1), cB + hstepB + kstep, voffB);
        PG8_WAIT_V(6); PG8_BAR;
    } else {
        PG8_STAGE(PG8_SB(0, 0), cB, voffB); PG8_STAGE(PG8_SA(0, 0), cA, voffA); PG8_STAGE(PG8_SB(0, 1), cB + hstepB, voffB); PG8_STAGE(PG8_SA(0, 1), cA + hstepA, voffA);
        if (wr == 1) PG8_BAR;
        PG8_WAIT_V(4); PG8_BAR;
        PG8_STAGE(PG8_SB(1, 0), cB + kstep, voffB); PG8_STAGE(PG8_SA(1, 0), cA + kstep, voffA); PG8_STAGE(PG8_SB(1, 1), cB + hstepB + kstep, voffB);
        PG8_WAIT_V(6); PG8_BAR;
    }
    for (;;) {
        const bool has_next = S.next(ui + 1, nxt);
        const char* nA = has_next ? (const char*)g.A + (size_t)nxt.pm * tstepA + (size_t)nxt.pn * cstepA : cA; const char* nB = has_next ? (const char*)g.Bt + (size_t)nxt.pn * tstepB : cB;
        for (int t = 0; t < nt; t += 2) {
            const bool last = (t == nt - 2);
            const char* a1 = cA + (size_t)(t + 1) * kstep;
            const char* a2 = last ? nA : cA + (size_t)(t + 2) * kstep; const char* b2 = last ? nB : cB + (size_t)(t + 2) * kstep;
            const char* a3 = a2 + kstep; const char* b3 = b2 + kstep;
            if (last && has_next) S.a_ready(nxt);
            if constexpr (SP2) {
            PG8_LDB(B0, 0, 0); PG8_LDB(B1, 0, 1); PG8_SCHED; PG8_LDA(At, 0, 0); PG8_STAGE(PG8_SA(1, 1), a1 + hstepA, voffA);
            PG8_WAIT_V(8); PG8_WAIT_L(0); PG8_BAR; PG8_MMA(0, 0, At, B0); PG8_MMA(0, 1, At, B1); PG8_BAR; PG8_SCHED;
            PG8_LDA(At, 0, 1); PG8_STAGE(PG8_SB(0, 0), b2, voffB); PG8_STAGE(PG8_SB(0, 1), b2 + hstepB, voffB); PG8_STAGE(PG8_SA(0, 0), a2, voffA);
            PG8_WAIT_V(8); PG8_WAIT_L(0); PG8_BAR; PG8_MMA(1, 0, At, B0); PG8_MMA(1, 1, At, B1); PG8_BAR; PG8_SCHED;
            PG8_LDB(B0, 1, 0); PG8_LDB(B1, 1, 1); PG8_SCHED; PG8_LDA(At, 1, 0); PG8_STAGE(PG8_SA(0, 1), a2 + hstepA, voffA);
            PG8_WAIT_V(8); PG8_WAIT_L(0); PG8_BAR; PG8_MMA(0, 0, At, B0); PG8_MMA(0, 1, At, B1); PG8_BAR; PG8_SCHED;
            PG8_LDA(At, 1, 1); PG8_STAGE(PG8_SB(1, 0), b3, voffB); PG8_STAGE(PG8_SB(1, 1), b3 + hstepB, voffB); PG8_STAGE(PG8_SA(1, 0), a3, voffA);
            PG8_WAIT_V(8); PG8_WAIT_L(0); PG8_BAR; PG8_MMA(1, 0, At, B0); PG8_MMA(1, 1, At, B1); PG8_BAR; PG8_SCHED;
            } else {
            PG8_LDB(B0, 0, 0); PG8_SCHED; PG8_LDA(At, 0, 0); PG8_STAGE(PG8_SA(1, 1), a1 + hstepA, voffA);
            PG8_WAIT_L(8); PG8_BAR; PG8_WAIT_L(0); PG8_MMA(0, 0, At, B0); PG8_BAR; PG8_SCHED;
            PG8_LDB(B1, 0, 1); PG8_STAGE(PG8_SB(0, 0), b2, voffB);
            PG8_BAR; PG8_WAIT_L(0); PG8_MMA(0, 1, At, B1); PG8_BAR;
            PG8_LDA(At, 0, 1); PG8_STAGE(PG8_SA(0, 0), a2, voffA);
            PG8_BAR; PG8_WAIT_L(0); PG8_MMA(1, 0, At, B0); PG8_BAR; PG8_SCHED;
            PG8_STAGE(PG8_SB(0, 1), b2 + hstepB, voffB);
            PG8_WAIT_V(6); PG8_BAR; PG8_MMA(1, 1, At, B1); PG8_BAR;
            PG8_LDB(B0, 1, 0); PG8_SCHED; PG8_LDA(At, 1, 0); PG8_STAGE(PG8_SA(0, 1), a2 + hstepA, voffA);
            PG8_WAIT_L(8); PG8_BAR; PG8_WAIT_L(0); PG8_MMA(0, 0, At, B0); PG8_BAR; PG8_SCHED;
            PG8_LDB(B1, 1, 1); PG8_STAGE(PG8_SB(1, 0), b3, voffB);
            PG8_BAR; PG8_WAIT_L(0); PG8_MMA(0, 1, At, B1); PG8_BAR;
            PG8_LDA(At, 1, 1); PG8_STAGE(PG8_SA(1, 0), a3, voffA);
            PG8_BAR; PG8_WAIT_L(0); PG8_MMA(1, 0, At, B0); PG8_BAR; PG8_SCHED;
            PG8_STAGE(PG8_SB(1, 1), b3 + hstepB, voffB);
            PG8_WAIT_V(6); PG8_BAR; PG8_MMA(1, 1, At, B1); PG8_BAR;
            }
        }
        if constexpr (ALIGN_EPI) { if (wr == 0) PG8_BAR; }
        if constexpr (!Epi::AFTER_DRAIN) { E(acc, cur, wr, wc, fr, fq); S.done(cur); }
        if (!has_next) break;
#pragma unroll
        for (int a = 0; a < 2; ++a)
#pragma unroll
            for (int b = 0; b < 2; ++b)
#pragma unroll
                for (int m = 0; m < 4; ++m)
#pragma unroll
                    for (int n = 0; n < 2; ++n) acc[a][b][m][n] = (f32x4){0.f, 0.f, 0.f, 0.f};
        cur = nxt; cA = nA; cB = nB; ++ui;
        if constexpr (ALIGN_EPI) { if (wr == 1) PG8_BAR; }
    }
    PG8_WAIT_V(0);
    if constexpr (!ALIGN_EPI) { if (wr == 0) PG8_BAR; }
    PG8_BAR;
    if constexpr (Epi::AFTER_DRAIN) { E.fused(acc, cur, wr, wc, fr, fq, lds, wid, lane); S.done(cur); }
#undef PG8_SA
#undef PG8_SB
#undef PG8_STAGE
#undef PG8_LDA
#undef PG8_LDB
#undef PG8_MMA
#undef PG8_WAIT_V
#undef PG8_WAIT_L
#undef PG8_BAR
#undef PG8_SCHED
}
}

constexpr int NWAVES = 8;
constexpr int BATCH = 8, SEQ = 4096, DM = 2048, DEPTH = 4, DFF = 8192, T = BATCH * SEQ;
constexpr int A_HEADS = 32, A_QR = 512, A_KVR = 256, IDX_H = 16, IDX_D = 128, TOPK = 256, A_IN = 912, A_INP = 1024;
constexpr int B_HEADS = 16, B_HD = 128, B_INC = 3 * DM;
constexpr int MODW = 6 * DM;
constexpr float RMS_EPS = 1e-6f;
enum { IN_X = 0, IN_C, IN_RELB, IN_ADAW, IN_ADAB, IN_NORMG, IN_AWIN, IN_AQN, IN_AKVN, IN_AIKN, IN_AWQB, IN_AWIQB, IN_AWUK, IN_AWUV, IN_AWOUT, IN_BWIN, IN_BWOUT, IN_W1, IN_W2, N_IN };

constexpr size_t MiB = 1u << 20;
constexpr size_t WS_CTL = 0, CTL_ZERO_BYTES = 1 * MiB;
constexpr size_t WS_MOD = 1 * MiB;
constexpr size_t WS_MODP = 3 * MiB;
constexpr size_t WS_WAIN = 16 * MiB;
constexpr size_t WS_WQC = 24 * MiB;
constexpr size_t WS_WUV = 44 * MiB;
constexpr size_t WS_WAOUT = 52 * MiB;
constexpr size_t WS_WBIN = 84 * MiB;
constexpr size_t WS_WBOUT = 132 * MiB;
constexpr size_t WS_WM1 = 148 * MiB;
constexpr size_t WS_WM2 = 276 * MiB;
constexpr size_t WS_H = 404 * MiB;
constexpr size_t WS_P = 532 * MiB;
constexpr size_t WS_BIG = 788 * MiB;
constexpr size_t WS_QLAT = 1300 * MiB;
constexpr size_t WS_CKV = 1332 * MiB;
constexpr size_t WS_KIDX = 1348 * MiB;
constexpr size_t WS_WIDX = 1356 * MiB;
constexpr size_t WS_IDX = 1358 * MiB;
constexpr size_t WS_END = 1390 * MiB;
constexpr int CW_BAR = 4096;
constexpr int CW_SBQ = 8192;

constexpr int LDS_BYTES = 163840;
constexpr int MISC_OFF = LDS_BYTES - 256;

#define GAS __attribute__((address_space(1)))
#define LAS __attribute__((address_space(3)))
typedef unsigned short bf16;
typedef unsigned v4u __attribute__((ext_vector_type(4)));
typedef unsigned v2u __attribute__((ext_vector_type(2)));
typedef float f32x4 __attribute__((ext_vector_type(4)));
typedef float f32x2 __attribute__((ext_vector_type(2)));
typedef __bf16 bf16x2_t __attribute__((ext_vector_type(2)));
#define LDS_WAIT() asm volatile("s_waitcnt lgkmcnt(0)" ::: "memory")
#define VM_WAIT() asm volatile("s_waitcnt vmcnt(0)" ::: "memory")
__device__ __forceinline__ unsigned f2bf(float f) { unsigned u = __builtin_bit_cast(unsigned, f); return (u + 0x7fffu + ((u >> 16) & 1u)) >> 16; }
__device__ __forceinline__ unsigned pk2(float lo, float hi) { return f2bf(lo) | (f2bf(hi) << 16); }
__device__ __forceinline__ float bflo(unsigned u) { return __builtin_bit_cast(float, u << 16); }
__device__ __forceinline__ float bfhi(unsigned u) { return __builtin_bit_cast(float, u & 0xffff0000u); }
__device__ __forceinline__ float dot2bf(unsigned a, unsigned b, float c) { return __builtin_amdgcn_fdot2_f32_bf16(__builtin_bit_cast(bf16x2_t, a), __builtin_bit_cast(bf16x2_t, b), c, false); }
#define DPP_F(v, ctrl) __builtin_bit_cast(float, __builtin_amdgcn_update_dpp(0, __builtin_bit_cast(int, (v)), (ctrl), 0xf, 0xf, true))
#define RDL_F(v, l) __builtin_bit_cast(float, __builtin_amdgcn_readlane(__builtin_bit_cast(int, (v)), (l)))
__device__ __forceinline__ float wave_sum(float v, int) {
    v += DPP_F(v, 0xB1); v += DPP_F(v, 0x4E); v += DPP_F(v, 0x124); v += DPP_F(v, 0x128);
    return (RDL_F(v, 0) + RDL_F(v, 16)) + (RDL_F(v, 32) + RDL_F(v, 48));
}
__device__ __forceinline__ float wave_max(float v, int) {
    v = fmaxf(v, DPP_F(v, 0xB1)); v = fmaxf(v, DPP_F(v, 0x4E)); v = fmaxf(v, DPP_F(v, 0x124)); v = fmaxf(v, DPP_F(v, 0x128));
    return fmaxf(fmaxf(RDL_F(v, 0), RDL_F(v, 16)), fmaxf(RDL_F(v, 32), RDL_F(v, 48)));
}
__device__ __forceinline__ float shx(float v, int, int lane) {
    const unsigned u = __builtin_bit_cast(unsigned, v);
    auto r = __builtin_amdgcn_permlane32_swap(u, u, false, false);
    return __builtin_bit_cast(float, (lane & 32) ? r[0] : r[1]);
}

#define XB_TMO      128
#define XB_XCNT(j)  (256  + 64 * (j))
#define XB_XSUB(j)  (1280 + 64 * (j))
#define XB_XGEN(j)  (2304 + 64 * (j))
#define XB_TOP      3328
#define XB_TOPGEN   3392
#define XCD_BAR_WORDS 3456
#define XB_SPIN_CAP (1u << 22)

__device__ __forceinline__ unsigned xb_ld(unsigned* p)              { return __hip_atomic_load(p, __ATOMIC_RELAXED, __HIP_MEMORY_SCOPE_AGENT); }
__device__ __forceinline__ unsigned xb_add(unsigned* p, unsigned v) { return __hip_atomic_fetch_add(p, v, __ATOMIC_RELAXED, __HIP_MEMORY_SCOPE_AGENT); }
__device__ __forceinline__ unsigned xb_xcc_id() { return (unsigned)__builtin_amdgcn_s_getreg((3 << 11) | 20) & 0xFu; }
#define XB_SPIN(cond, bar) do { unsigned _sp = 0; while (cond) { __builtin_amdgcn_s_sleep(1); \
    if ((++_sp & 255u) == 0u) { if (xb_ld(&(bar)[XB_TMO])) break; if (_sp > XB_SPIN_CAP) { atomicAdd(&(bar)[XB_TMO], 1u); break; } } } } while (0)

struct XcdBarrier {
    unsigned* bar; unsigned x;
    volatile LAS unsigned* st;
};

__device__ __forceinline__ XcdBarrier xcd_barrier_post(unsigned* bar, volatile LAS unsigned* st) {
    XcdBarrier b; b.bar = bar; b.x = xb_xcc_id(); b.st = st;
    if (threadIdx.x == 0) (void)xb_add(&bar[XB_XCNT(b.x)], 1u);
    return b;
}
__device__ __forceinline__ void xcd_barrier_complete(unsigned* bar, unsigned x, unsigned& nloc, unsigned& nx) {
    const unsigned G = gridDim.x * gridDim.y * gridDim.z;
    unsigned sum, cnt, mine, sp = 0u;
    for (;;) {
        sum = 0u; cnt = 0u; mine = 0u;
#pragma unroll
        for (unsigned j = 0; j < 16; ++j) { const unsigned c = xb_ld(&bar[XB_XCNT(j)]); sum += c; cnt += (c > 0u) ? 1u : 0u; mine = (j == x) ? c : mine; }
        if (sum == G) break;
        __builtin_amdgcn_s_sleep(1);
        if ((++sp & 255u) == 0u) { if (xb_ld(&bar[XB_TMO])) break; if (sp > XB_SPIN_CAP) { atomicAdd(&bar[XB_TMO], 1u); break; } }
    }
    nloc = mine > 0u ? mine : 1u; nx = cnt > 0u ? cnt : 1u;
}

template <bool CENSUS> __device__ __forceinline__ void xcd_barrier(const XcdBarrier& b) {
    asm volatile("s_waitcnt vmcnt(0)" ::: "memory");
    __syncthreads();
    if (threadIdx.x == 0) {
        unsigned* bar = b.bar;
        __builtin_amdgcn_s_waitcnt(0);
        unsigned nloc = b.st[0], nx = b.st[1];
        if (CENSUS) { if (nloc == 0u) { xcd_barrier_complete(bar, b.x, nloc, nx); b.st[0] = nloc; b.st[1] = nx; } }
        const unsigned old = xb_add(&bar[XB_XSUB(b.x)], 1u);
        const unsigned gen = old / nloc;
        if (old + 1u == (gen + 1u) * nloc) {
            __builtin_amdgcn_fence(__ATOMIC_RELEASE, "agent");
            asm volatile("s_waitcnt vmcnt(0)" ::: "memory");
            const unsigned og = xb_add(&bar[XB_TOP], 1u);
            const unsigned tg = og / nx;
            if (og + 1u == (tg + 1u) * nx) xb_add(&bar[XB_TOPGEN], 1u);
            else XB_SPIN(xb_ld(&bar[XB_TOPGEN]) == tg, bar);
            __builtin_amdgcn_fence(__ATOMIC_ACQUIRE, "agent");
            xb_add(&bar[XB_XGEN(b.x)], 1u);
            asm volatile("s_waitcnt vmcnt(0)" ::: "memory");
        } else {
            XB_SPIN(xb_ld(&bar[XB_XGEN(b.x)]) == gen, bar);
            __builtin_amdgcn_fence(__ATOMIC_ACQUIRE, "agent");
            asm volatile("s_waitcnt vmcnt(0)" ::: "memory");
        }
    }
    __syncthreads();
}

struct Args { const float* in[N_IN]; float* out; unsigned char* ws; int ph_lo, ph_hi; };
#define CAS __attribute__((address_space(4)))
struct Frame {
    LAS unsigned char* lds;
    int tid, lane, wave, G;
    const CAS Args* ap;
    float* out; unsigned char* ws;
    __device__ __forceinline__ const float* inp(int i) const { return ap->in[i]; }
};
#define WSP(type, off) ((type*)(F.ws + (off)))

__device__ __forceinline__ void p0_transpose_item(const float* W, int Nsrc, bf16* dst, int ldo, LAS float* scr, int kb, int nb, int lane) {
    const int k0 = 64 * kb, n0 = 32 * nb, rsub = lane >> 3, c4 = lane & 7, nn = n0 + 4 * c4;
    f32x4 v[8];
#pragma unroll
    for (int i = 0; i < 8; ++i) v[i] = (nn < Nsrc) ? *(const f32x4*)(W + (size_t)(k0 + 8 * i + rsub) * Nsrc + nn) : (f32x4){0.f, 0.f, 0.f, 0.f};
#pragma unroll
    for (int i = 0; i < 8; ++i) { LAS float* d = scr + (8 * i + rsub) * 33 + 4 * c4; d[0] = v[i].x; d[1] = v[i].y; d[2] = v[i].z; d[3] = v[i].w; }
    LDS_WAIT(); asm volatile("" ::: "memory");
    const int c = lane & 7;
#pragma unroll
    for (int j = 0; j < 4; ++j) { const int n = (lane >> 3) + 8 * j; const LAS float* s = scr + (8 * c) * 33 + n;
        v4u o; o.x = pk2(s[0 * 33], s[1 * 33]); o.y = pk2(s[2 * 33], s[3 * 33]); o.z = pk2(s[4 * 33], s[5 * 33]); o.w = pk2(s[6 * 33], s[7 * 33]);
        *(v4u*)(dst + (size_t)(n0 + n) * ldo + k0 + 8 * c) = o; }
    LDS_WAIT(); asm volatile("" ::: "memory");
}
__device__ __forceinline__ void p0_tr_load(f32x4 (&v)[8], const float* W, int Nsrc, int kb, int nb, int lane) {
    const int k0 = 64 * kb, rsub = lane >> 3, nn = 32 * nb + 4 * (lane & 7);
#pragma unroll
    for (int i = 0; i < 8; ++i) v[i] = (nn < Nsrc) ? *(const f32x4*)(W + (size_t)(k0 + 8 * i + rsub) * Nsrc + nn) : (f32x4){0.f, 0.f, 0.f, 0.f};
}
__device__ __forceinline__ void p0_tr_store(const f32x4 (&v)[8], bf16* dst, int ldo, LAS float* scr, int kb, int nb, int lane) {
    const int k0 = 64 * kb, n0 = 32 * nb, rsub = lane >> 3, c4 = lane & 7;
#pragma unroll
    for (int i = 0; i < 8; ++i) { LAS float* d = scr + (8 * i + rsub) * 33 + 4 * c4; d[0] = v[i].x; d[1] = v[i].y; d[2] = v[i].z; d[3] = v[i].w; }
    LDS_WAIT(); asm volatile("" ::: "memory");
    const int c = lane & 7;
#pragma unroll
    for (int j = 0; j < 4; ++j) { const int n = (lane >> 3) + 8 * j; const LAS float* s = scr + (8 * c) * 33 + n;
        v4u o; o.x = pk2(s[0 * 33], s[1 * 33]); o.y = pk2(s[2 * 33], s[3 * 33]); o.z = pk2(s[4 * 33], s[5 * 33]); o.w = pk2(s[6 * 33], s[7 * 33]);
        *(v4u*)(dst + (size_t)(n0 + n) * ldo + k0 + 8 * c) = o; }
    LDS_WAIT(); asm volatile("" ::: "memory");
}
__device__ __forceinline__ void p0_transpose_job(Frame& F, const float* src, size_t sstride, int nmat, int K, int Nsrc, int Npad, bf16* dst, size_t dstride, int ldo) {
    LAS float* scr = (LAS float*)(F.lds + F.wave * 16384);
    const int gw = blockIdx.x * NWAVES + F.wave, NGW = F.G * NWAVES;
    const int nkb = K / 64, nnb = Npad / 32, per = nkb * nnb, tot = nmat * per;
    int it = gw;
    f32x4 v[8], vn[8];
    if (it < tot) { const int m = it / per, r = it % per; p0_tr_load(v, src + (size_t)m * sstride, Nsrc, r / nnb, r % nnb, F.lane); }
    while (it < tot) {
        const int nx = it + NGW;
        if (nx < tot) { const int m = nx / per, r = nx % per; p0_tr_load(vn, src + (size_t)m * sstride, Nsrc, r / nnb, r % nnb, F.lane); }
        { const int m = it / per, r = it % per; p0_tr_store(v, dst + (size_t)m * dstride, ldo, scr, r / nnb, r % nnb, F.lane); }
#pragma unroll
        for (int i = 0; i < 8; ++i) v[i] = vn[i];
        it = nx;
    }
}
__device__ __forceinline__ void ph_prologue(Frame& F) {
    {
        LAS float* sl = (LAS float*)(F.lds);
        LAS float* red = (LAS float*)(F.lds + 8192);
        const float* cin = F.inp(IN_C); const float* ada_w = F.inp(IN_ADAW); float* modp = WSP(float, WS_MODP);
        for (int u = blockIdx.x; u < 768; u += F.G) {
            const int l = u / 192, r = u % 192, ec = r >> 3, dc = r & 7;
            __syncthreads();
            for (int i = F.tid; i < 2048; i += 512) { const int rr = i >> 3, b = i & 7; const float v = cin[b * DM + dc * 256 + rr]; sl[rr * 8 + b] = v / (1.f + __expf(-v)); }
            __syncthreads();
            const int cq = F.tid & 127, dq = F.tid >> 7;
            f32x4 acc[8];
#pragma unroll
            for (int b = 0; b < 8; ++b) acc[b] = (f32x4){0.f, 0.f, 0.f, 0.f};
            const float* wp = ada_w + ((size_t)l * DM + dc * 256 + dq * 64) * MODW + ec * 512 + cq * 4;
#pragma unroll 8
            for (int i = 0; i < 64; ++i) {
                const f32x4 w = *(const f32x4*)(wp + (size_t)i * MODW);
                const f32x4 s0 = *(const LAS f32x4*)(sl + (dq * 64 + i) * 8), s1 = *(const LAS f32x4*)(sl + (dq * 64 + i) * 8 + 4);
                acc[0] += w * s0.x; acc[1] += w * s0.y; acc[2] += w * s0.z; acc[3] += w * s0.w;
                acc[4] += w * s1.x; acc[5] += w * s1.y; acc[6] += w * s1.z; acc[7] += w * s1.w;
            }
#pragma unroll
            for (int b = 0; b < 8; ++b) *(LAS f32x4*)(red + (dq * 8 + b) * 512 + cq * 4) = acc[b];
            __syncthreads();
            { const int b = F.tid >> 6, c0 = (F.tid & 63) * 8;
#pragma unroll
              for (int k = 0; k < 2; ++k) {
                  const f32x4 s = (*(const LAS f32x4*)(red + (0 * 8 + b) * 512 + c0 + 4 * k) + *(const LAS f32x4*)(red + (1 * 8 + b) * 512 + c0 + 4 * k))
                                + (*(const LAS f32x4*)(red + (2 * 8 + b) * 512 + c0 + 4 * k) + *(const LAS f32x4*)(red + (3 * 8 + b) * 512 + c0 + 4 * k));
                  *(f32x4*)(modp + (((size_t)dc * 4 + l) * 8 + b) * MODW + ec * 512 + c0 + 4 * k) = s; } }
        }
        __syncthreads();
    }
    {
        LAS float* Bs = (LAS float*)(F.lds);
        LAS float* As = (LAS float*)(F.lds + 256 * 132 * 4);
        const float* wqb = F.inp(IN_AWQB); const float* wuk = F.inp(IN_AWUK); bf16* wqc = WSP(bf16, WS_WQC);
        for (int u = blockIdx.x; u < 1024; u += F.G) {
            const int j = u >> 9, h = (u & 511) >> 4, rb = u & 15, r0 = rb * 32;
            __syncthreads();
            const float* bsrc = wuk + ((size_t)j * A_HEADS + h) * 256 * 128;
            for (int i = F.tid; i < 256 * 32; i += 512) { const int row = i >> 5, c4 = i & 31; *(LAS f32x4*)(Bs + row * 132 + c4 * 4) = *(const f32x4*)(bsrc + row * 128 + c4 * 4); }
            for (int i = F.tid; i < 32 * 32; i += 512) { const int row = i >> 5, c4 = i & 31; *(LAS f32x4*)(As + row * 128 + c4 * 4) = *(const f32x4*)(wqb + ((size_t)j * A_QR + r0 + row) * 4096 + h * 128 + c4 * 4); }
            __syncthreads();
            const int c = F.tid & 255, rh = F.tid >> 8;
            float acc[16];
#pragma unroll
            for (int q = 0; q < 16; ++q) acc[q] = 0.f;
            for (int d4 = 0; d4 < 32; ++d4) {
                const f32x4 bv = *(const LAS f32x4*)(Bs + c * 132 + d4 * 4);
#pragma unroll
                for (int q = 0; q < 16; ++q) { const f32x4 av = *(const LAS f32x4*)(As + (rh * 16 + q) * 128 + d4 * 4); acc[q] += (av.x * bv.x + av.y * bv.y) + (av.z * bv.z + av.w * bv.w); }
            }
            bf16* orow = wqc + ((size_t)j * 10240 + h * 256 + c) * 512 + r0 + rh * 16;
            v4u o0, o1;
            o0.x = pk2(acc[0], acc[1]); o0.y = pk2(acc[2], acc[3]); o0.z = pk2(acc[4], acc[5]); o0.w = pk2(acc[6], acc[7]);
            o1.x = pk2(acc[8], acc[9]); o1.y = pk2(acc[10], acc[11]); o1.z = pk2(acc[12], acc[13]); o1.w = pk2(acc[14], acc[15]);
            *(v4u*)(orow) = o0; *(v4u*)(orow + 8) = o1;
        }
        __syncthreads();
    }
    p0_transpose_job(F, F.inp(IN_AWIN), (size_t)DM * A_IN, 2, DM, A_IN, A_INP, WSP(bf16, WS_WAIN), (size_t)A_INP * DM, DM);
    p0_transpose_job(F, F.inp(IN_AWIQB), (size_t)A_QR * 2048, 2, A_QR, 2048, 2048, WSP(bf16, WS_WQC) + (size_t)8192 * 512, (size_t)10240 * 512, 512);
    p0_transpose_job(F, F.inp(IN_AWOUT), (size_t)4096 * DM, 2, 4096, DM, DM, WSP(bf16, WS_WAOUT), (size_t)DM * 4096, 4096);
    p0_transpose_job(F, F.inp(IN_BWIN), (size_t)DM * B_INC, 2, DM, B_INC, B_INC, WSP(bf16, WS_WBIN), (size_t)B_INC * DM, DM);
    p0_transpose_job(F, F.inp(IN_BWOUT), (size_t)DM * DM, 2, DM, DM, DM, WSP(bf16, WS_WBOUT), (size_t)DM * DM, DM);
    p0_transpose_job(F, F.inp(IN_W1), (size_t)DM * DFF, 4, DM, DFF, DFF, WSP(bf16, WS_WM1), (size_t)DFF * DM, DM);
    p0_transpose_job(F, F.inp(IN_W2), (size_t)DFF * DM, 4, DFF, DM, DM, WSP(bf16, WS_WM2), (size_t)DM * DFF, DFF);
    {
        LAS float* scr = (LAS float*)(F.lds + F.wave * 16384);
        const int gw = blockIdx.x * NWAVES + F.wave, NGW = F.G * NWAVES;
        const float* wuv = F.inp(IN_AWUV); bf16* d0 = WSP(bf16, WS_WUV);
        for (int it = gw; it < 64 * 16; it += NGW) {
            const int m = it >> 4, r = it & 15, j = m >> 5, h = m & 31;
            bf16* dst = d0 + (size_t)j * 4096 * 512 + (size_t)((h >> 1) * 256 + (h & 1) * 128) * 512 + (h & 1) * 256;
            p0_transpose_item(wuv + (size_t)m * 256 * 128, 128, dst, 512, scr, r >> 2, r & 3, F.lane);
        }
        const int gt = blockIdx.x * 512 + F.tid, NT = F.G * 512;
        for (int i = gt; i < 2 * 4096 * 32; i += NT) {
            const int row = i >> 5, ch = i & 31, hh = (row >> 7) & 1;
            *(v4u*)(d0 + (size_t)row * 512 + (1 - hh) * 256 + ch * 8) = (v4u){0u, 0u, 0u, 0u};
        }
    }
}
__device__ __forceinline__ void ph_modreduce(Frame& F) {
    const float* modp = WSP(float, WS_MODP); float* mod = WSP(float, WS_MOD); const float* ada_b = F.inp(IN_ADAB);
    const int gt = blockIdx.x * 512 + F.tid, NT = F.G * 512;
    for (int i = gt; i < DEPTH * BATCH * MODW / 4; i += NT) {
        const int e4 = i % (MODW / 4), lb = i / (MODW / 4), l = lb >> 3;
        f32x4 s = *(const f32x4*)(ada_b + (size_t)l * MODW + e4 * 4);
#pragma unroll
        for (int dc = 0; dc < 8; ++dc) s += *(const f32x4*)(modp + ((size_t)dc * 32 + lb) * MODW + e4 * 4);
        *(f32x4*)(mod + (size_t)lb * MODW + e4 * 4) = s;
    }
}

__device__ __forceinline__ void ph_post(Frame& F, const bf16* y, const void* xin_, bool xin_f32, void* xout_, bool xout_f32, const float* gate, const float* gy, bf16* hout, const float* gh, const float* shift, const float* scale) {
    LAS float* vec = (LAS float*)F.lds;
    const int rlo = (int)(((long long)blockIdx.x * T) / F.G), rhi = (int)(((long long)(blockIdx.x + 1) * T) / F.G);
    for (int seg = rlo; seg < rhi; ) {
        const int b = seg / SEQ; const int send = ((b + 1) * SEQ < rhi) ? (b + 1) * SEQ : rhi;
        __syncthreads();
        for (int i = F.tid; i < 5 * (DM / 4); i += NWAVES * 64) { const int v = i / (DM / 4), c4 = i % (DM / 4);
            const float* src = (v == 0) ? (y ? gate + (size_t)b * MODW : nullptr) : (v == 1) ? (y ? gy : nullptr) : (v == 2) ? (hout ? gh : nullptr) : (v == 3) ? (hout ? shift + (size_t)b * MODW : nullptr) : (hout ? scale + (size_t)b * MODW : nullptr);
            *(LAS f32x4*)(vec + v * DM + 4 * c4) = src ? *(const f32x4*)(src + 4 * c4) : (f32x4){0.f, 0.f, 0.f, 0.f}; }
        __syncthreads();
        constexpr int NR = 2;
        for (int r0 = seg + 2 * F.wave; r0 < send; r0 += NR * NWAVES) {
            const int r1 = (r0 + 1 < send) ? r0 + 1 : r0;
            int e0 = 4 * F.lane; asm volatile("" : "+v"(e0));
            f32x4 x[NR][8]; v2u yp[NR][8];
            if (xin_f32) { const float* xin = (const float*)xin_;
#pragma unroll
                for (int q = 0; q < NR; ++q) { const int row = q ? r1 : r0;
#pragma unroll
                    for (int j = 0; j < 8; ++j) x[q][j] = *(const f32x4*)(xin + (size_t)row * DM + e0 + 256 * j); }
                if (y) {
#pragma unroll
                    for (int q = 0; q < NR; ++q) { const int row = q ? r1 : r0;
#pragma unroll
                        for (int j = 0; j < 8; ++j) yp[q][j] = *(const v2u*)(y + (size_t)row * DM + e0 + 256 * j); } }
            } else { const bf16* xin = (const bf16*)xin_; v2u xp[NR][8];
#pragma unroll
                for (int q = 0; q < NR; ++q) { const int row = q ? r1 : r0;
#pragma unroll
                    for (int j = 0; j < 8; ++j) xp[q][j] = *(const v2u*)(xin + (size_t)row * DM + e0 + 256 * j); }
                if (y) {
#pragma unroll
                    for (int q = 0; q < NR; ++q) { const int row = q ? r1 : r0;
#pragma unroll
                        for (int j = 0; j < 8; ++j) yp[q][j] = *(const v2u*)(y + (size_t)row * DM + e0 + 256 * j); } }
#pragma unroll
                for (int q = 0; q < NR; ++q) {
#pragma unroll
                    for (int j = 0; j < 8; ++j) { const v2u p = xp[q][j]; x[q][j] = (f32x4){bflo(p.x), bfhi(p.x), bflo(p.y), bfhi(p.y)}; } }
            }
#pragma unroll
            for (int q = 0; q < NR; ++q) { const int row = q ? r1 : r0;
                if (y) {
                    f32x4 yv[8]; float ss = 0.f;
#pragma unroll
                    for (int j = 0; j < 8; ++j) { const v2u p = yp[q][j]; yv[j] = (f32x4){bflo(p.x), bfhi(p.x), bflo(p.y), bfhi(p.y)};
                        ss += (yv[j].x * yv[j].x + yv[j].y * yv[j].y) + (yv[j].z * yv[j].z + yv[j].w * yv[j].w); }
                    const float ry = 1.0f / sqrtf(wave_sum(ss, F.lane) * (1.f / DM) + RMS_EPS);
#pragma unroll
                    for (int j = 0; j < 8; ++j) { const f32x4 g = *(const LAS f32x4*)(vec + 1 * DM + e0 + 256 * j), gt = *(const LAS f32x4*)(vec + 0 * DM + e0 + 256 * j);
                        x[q][j] += gt * (yv[j] * ry * g); }
                    if (xout_f32) { float* xout = (float*)xout_;
#pragma unroll
                        for (int j = 0; j < 8; ++j) *(f32x4*)(xout + (size_t)row * DM + e0 + 256 * j) = x[q][j];
                    } else { bf16* xout = (bf16*)xout_;
#pragma unroll
                        for (int j = 0; j < 8; ++j) { v2u o; o.x = pk2(x[q][j].x, x[q][j].y); o.y = pk2(x[q][j].z, x[q][j].w); *(v2u*)(xout + (size_t)row * DM + e0 + 256 * j) = o; } }
                }
                if (hout) {
                    float ss = 0.f;
#pragma unroll
                    for (int j = 0; j < 8; ++j) ss += (x[q][j].x * x[q][j].x + x[q][j].y * x[q][j].y) + (x[q][j].z * x[q][j].z + x[q][j].w * x[q][j].w);
                    const float rx = 1.0f / sqrtf(wave_sum(ss, F.lane) * (1.f / DM) + RMS_EPS);
#pragma unroll
                    for (int j = 0; j < 8; ++j) { const f32x4 g = *(const LAS f32x4*)(vec + 2 * DM + e0 + 256 * j), sh = *(const LAS f32x4*)(vec + 3 * DM + e0 + 256 * j), sc = *(const LAS f32x4*)(vec + 4 * DM + e0 + 256 * j);
                        const f32x4 hv = (x[q][j] * rx * g) * (sc + 1.0f) + sh;
                        v2u o; o.x = pk2(hv.x, hv.y); o.y = pk2(hv.z, hv.w);
                        *(v2u*)(hout + (size_t)row * DM + e0 + 256 * j) = o; }
                }
            }
        }
        seg = send;
    }
}
__device__ __forceinline__ void ph_dsa_norm(Frame& F, const float* proj, const float* qn, const float* kvn, const float* ikn, bf16* qlat, bf16* ckv, bf16* kidx, float* widx) {
    const int gw = blockIdx.x * NWAVES + F.wave, NGW = F.G * NWAVES; const int e0 = 4 * F.lane;
    for (int row = gw; row < T; row += NGW) {
        f32x4 v[4];
#pragma unroll
        for (int j = 0; j < 4; ++j) v[j] = *(const f32x4*)(proj + (size_t)row * A_INP + e0 + 256 * j);
        float sq = 0.f;
#pragma unroll
        for (int j = 0; j < 2; ++j) sq += (v[j].x * v[j].x + v[j].y * v[j].y) + (v[j].z * v[j].z + v[j].w * v[j].w);
        const float rq = 1.0f / sqrtf(wave_sum(sq, F.lane) * (1.f / A_QR) + RMS_EPS);
#pragma unroll
        for (int j = 0; j < 2; ++j) { const f32x4 g = *(const f32x4*)(qn + e0 + 256 * j); const f32x4 o = v[j] * rq * g; v2u w; w.x = pk2(o.x, o.y); w.y = pk2(o.z, o.w);
            *(v2u*)(qlat + (size_t)row * A_QR + e0 + 256 * j) = w; }
        const float skv = (v[2].x * v[2].x + v[2].y * v[2].y) + (v[2].z * v[2].z + v[2].w * v[2].w);
        const float rkv = 1.0f / sqrtf(wave_sum(skv, F.lane) * (1.f / A_KVR) + RMS_EPS);
        { const f32x4 g = *(const f32x4*)(kvn + e0); const f32x4 o = v[2] * rkv * g; v2u w; w.x = pk2(o.x, o.y); w.y = pk2(o.z, o.w); *(v2u*)(ckv + (size_t)row * A_KVR + e0) = w; }
        const bool isk = F.lane < 32;
        const float s1 = isk ? (v[3].x + v[3].y) + (v[3].z + v[3].w) : 0.f;
        const float mean = wave_sum(s1, F.lane) * (1.f / IDX_D);
        const f32x4 dv = v[3] - mean;
        const float s2 = isk ? (dv.x * dv.x + dv.y * dv.y) + (dv.z * dv.z + dv.w * dv.w) : 0.f;
        const float rk = 1.0f / sqrtf(wave_sum(s2, F.lane) * (1.f / IDX_D) + RMS_EPS);
        if (isk) { const f32x4 g = *(const f32x4*)(ikn + e0); const f32x4 o = dv * rk * g; v2u w; w.x = pk2(o.x, o.y); w.y = pk2(o.z, o.w); *(v2u*)(kidx + (size_t)row * IDX_D + e0) = w; }
        else if (F.lane < 36) { *(f32x4*)(widx + (size_t)row * IDX_H + (e0 - 128)) = v[3] * 0.02209708691207961f; }
    }
}

__device__ __forceinline__ int wave_scan_incl(int v, int lane, int& total) {
    v += __builtin_amdgcn_update_dpp(0, v, 0x111, 0xf, 0xf, true); v += __builtin_amdgcn_update_dpp(0, v, 0x112, 0xf, 0xf, true);
    v += __builtin_amdgcn_update_dpp(0, v, 0x114, 0xf, 0xf, true); v += __builtin_amdgcn_update_dpp(0, v, 0x118, 0xf, 0xf, true);
    const int t0 = __builtin_amdgcn_readlane(v, 15), t1 = __builtin_amdgcn_readlane(v, 31), t2 = __builtin_amdgcn_readlane(v, 47), t3 = __builtin_amdgcn_readlane(v, 63);
    v += (lane >= 16 ? t0 : 0) + (lane >= 32 ? t1 : 0) + (lane >= 48 ? t2 : 0);
    total = (t0 + t1) + (t2 + t3);
    return v;
}
template <bool G, class SP> __device__ __forceinline__ void topk_select_row(SP sc, int t, int* out, int lane, LAS int* lst) {
    const int n = t + 1;
    if (n <= TOPK) { for (int i = lane; i < TOPK; i += 64) out[i] = (i < n) ? i : 0; return; }
    const int ni = G ? 2 * ((n + 127) >> 7) : (n + 63) >> 6;
#define TOPK_KEYIDX(i) (G ? 128 * ((i) >> 1) + 2 * lane + ((i) & 1) : 64 * (i) + lane)
    unsigned key[64];
#pragma unroll
    for (int g = 0; g < 8; ++g) {
        if (8 * g < ni) {
            if constexpr (G) {
#pragma unroll
                for (int j = 4 * g; j < 4 * g + 4; ++j) { const unsigned d = __hip_atomic_load((const unsigned*)sc + 64 * j + lane, __ATOMIC_RELAXED, __HIP_MEMORY_SCOPE_AGENT);
#pragma unroll
                    for (int e = 0; e < 2; ++e) { const int s = 128 * j + 2 * lane + e; const unsigned h = e ? (d >> 16) : (d & 0xffffu); const unsigned k = (h & 0x8000u) ? (~h & 0xffffu) : (h | 0x8000u); key[2 * j + e] = (s < n) ? k : 0u; } }
            } else {
#pragma unroll
                for (int i = 8 * g; i < 8 * g + 8; ++i) { const int s = 64 * i + lane; const unsigned h = sc[s < n ? s : n - 1]; const unsigned k = (h & 0x8000u) ? (~h & 0xffffu) : (h | 0x8000u); key[i] = (s < n) ? k : 0u; }
            }
        } else {
#pragma unroll
            for (int i = 8 * g; i < 8 * g + 8; ++i) key[i] = 0u;
        }
    }
    unsigned prefix = 0u;
    for (int bit = 15; bit >= 0; --bit) {
        const unsigned cand = prefix | (1u << bit); int cl = 0;
#pragma unroll
        for (int g = 0; g < 8; ++g) if (8 * g < ni) {
#pragma unroll
            for (int i = 8 * g; i < 8 * g + 8; ++i) cl += (key[i] >= cand) ? 1 : 0; }
        cl += __builtin_amdgcn_update_dpp(0, cl, 0xB1, 0xf, 0xf, true); cl += __builtin_amdgcn_update_dpp(0, cl, 0x4E, 0xf, 0xf, true);
        cl += __builtin_amdgcn_update_dpp(0, cl, 0x124, 0xf, 0xf, true); cl += __builtin_amdgcn_update_dpp(0, cl, 0x128, 0xf, 0xf, true);
        const int cnt = (__builtin_amdgcn_readlane(cl, 0) + __builtin_amdgcn_readlane(cl, 16)) + (__builtin_amdgcn_readlane(cl, 32) + __builtin_amdgcn_readlane(cl, 48));
        if (cnt >= TOPK) prefix = cand;
    }
    int cg = 0, ce = 0;
#pragma unroll
    for (int g = 0; g < 8; ++g) if (8 * g < ni) {
#pragma unroll
        for (int i = 8 * g; i < 8 * g + 8; ++i) { cg += (key[i] > prefix) ? 1 : 0; ce += (key[i] == prefix) ? 1 : 0; } }
    int tg, te;
    const int bg = wave_scan_incl(cg, lane, tg) - cg, be = wave_scan_incl(ce, lane, te) - ce;
    int quota = (TOPK - tg) - be; quota = quota < 0 ? 0 : (quota > ce ? ce : quota);
    int pg = bg, pe = tg + (be < TOPK - tg ? be : TOPK - tg);
    const int dummy = TOPK + lane;
#pragma unroll
    for (int g = 0; g < 8; ++g) if (8 * g < ni) {
#pragma unroll
        for (int i = 8 * g; i < 8 * g + 8; ++i) {
            const bool gt = key[i] > prefix, eq = (key[i] == prefix) && (quota > 0);
            const int pos = gt ? pg : (eq ? pe : dummy);
            lst[pos] = TOPK_KEYIDX(i);
            pg += gt ? 1 : 0; pe += eq ? 1 : 0; quota -= eq ? 1 : 0;
        } }
    asm volatile("s_waitcnt lgkmcnt(0)" ::: "memory");
    *(v4u*)(out + 4 * lane) = *(const LAS v4u*)(lst + 4 * lane);
#undef TOPK_KEYIDX
}
__device__ __forceinline__ int t5_bucket(int d) {
    if (d < 16) return d;
    int bkt = 16;
    bkt += (d >= 19) + (d >= 21) + (d >= 24) + (d >= 27) + (d >= 31) + (d >= 35) + (d >= 40) + (d >= 46) + (d >= 52) + (d >= 59) + (d >= 67) + (d >= 77) + (d >= 87) + (d >= 99) + (d >= 113);
    return bkt;
}

typedef short bf16x8 __attribute__((ext_vector_type(8)));
typedef short s16x4 __attribute__((ext_vector_type(4)));
typedef float f32x16 __attribute__((ext_vector_type(16)));
__device__ __forceinline__ unsigned offb(unsigned row, unsigned ch) { return 256u * row + 16u * (ch ^ (((row & 3u) << 2) | ((row >> 2) & 3u))); }
__device__ __forceinline__ unsigned tr_base_perm(unsigned lane, unsigned c, unsigned t) {
    const unsigned h = lane >> 5, blk = (lane >> 4) & 1u, q = (lane & 15u) >> 2, p = lane & 3u;
    return offb(8u * t + 4u * h + q, 4u * c + 2u * blk + (p >> 1)) + 8u * (p & 1u);
}
__device__ __forceinline__ bf16x8 tr_frag_at(LAS unsigned char* img, unsigned b0, unsigned b1, unsigned ks) {
    const s16x4 lo = __builtin_amdgcn_ds_read_tr16_b64_v4i16((LAS s16x4*)(img + b0 + 4096u * ks));
    const s16x4 hi = __builtin_amdgcn_ds_read_tr16_b64_v4i16((LAS s16x4*)(img + b1 + 4096u * ks));
    return __builtin_shufflevector(lo, hi, 0, 1, 2, 3, 4, 5, 6, 7);
}

__device__ __forceinline__ void ph_indexer(Frame& F, const bf16* qidx, const bf16* kidx, const float* widx, int* idxo) {
    constexpr int NQ = 8;
    LAS unsigned short* sc = (LAS unsigned short*)(F.lds);
    LAS float* wsh = (LAS float*)(F.lds + 65536);
    LAS unsigned char* ring = F.lds + 66560;
    const int r = F.lane & 31, hf = F.lane >> 5, rp = F.wave & 1, kq = F.wave >> 1;
    const int drow = 4 * F.wave + (F.lane >> 4), dch = (F.lane & 15) ^ (((F.lane >> 4) << 2) | (F.wave & 3));
    for (int u = blockIdx.x; u < BATCH * (SEQ / NQ); u += F.G) {
        const int b = u & 7, t0 = (u >> 3) * NQ;
        const int nt = (t0 + NQ + 31) >> 5, ns = (nt + 3) >> 2;
        const bf16* kbase = kidx + (size_t)(b * SEQ + drow) * IDX_D + dch * 8;
        __syncthreads();
#pragma unroll
        for (int j = 0; j < 4; ++j) __builtin_amdgcn_global_load_lds((const unsigned*)(kbase + (size_t)(j * 32) * IDX_D), (LAS unsigned*)(ring + j * 8192 + F.wave * 1024), 16, 0, 0);
        if (F.tid < NQ * 16) wsh[F.tid] = widx[(size_t)(b * SEQ + t0 + (F.tid >> 4)) * IDX_H + (F.tid & 15)];
        bf16x8 Af[2][8];
#pragma unroll
        for (int rt = 0; rt < 2; ++rt) { const int query = t0 + 4 * rp + 2 * rt + ((r >> 2) & 1), head = 4 * (r >> 3) + (r & 3);
            const bf16* ap = qidx + (size_t)(b * SEQ + query) * 2048 + head * 128 + 8 * hf;
#pragma unroll
            for (int ks = 0; ks < 8; ++ks) Af[rt][ks] = *(const bf16x8*)(ap + 16 * ks); }
        for (int s = 0; s < ns; ++s) {
            asm volatile("s_waitcnt vmcnt(0) lgkmcnt(0)" ::: "memory"); __builtin_amdgcn_s_barrier(); asm volatile("" ::: "memory");
            if (s + 1 < ns) {
#pragma unroll
                for (int j = 0; j < 4; ++j) __builtin_amdgcn_global_load_lds((const unsigned*)(kbase + (size_t)((4 * (s + 1) + j) * 32) * IDX_D), (LAS unsigned*)(ring + ((s + 1) & 1) * 32768 + j * 8192 + F.wave * 1024), 16, 0, 0);
            }
            const int kt = 4 * s + kq;
            if (kt < nt) {
                LAS unsigned char* tile = ring + (s & 1) * 32768 + kq * 8192;
                bf16x8 Bf[8];
#pragma unroll
                for (int ks = 0; ks < 8; ++ks) Bf[ks] = *(const LAS bf16x8*)(tile + offb((unsigned)r, (unsigned)(2 * ks + hf)));
#pragma unroll
                for (int rt = 0; rt < 2; ++rt) {
                    f32x16 acc;
#pragma unroll
                    for (int i = 0; i < 16; ++i) acc[i] = 0.f;
#pragma unroll
                    for (int ks = 0; ks < 8; ++ks) acc = __builtin_amdgcn_mfma_f32_32x32x16_bf16(Af[rt][ks], Bf[ks], acc, 0, 0, 0);
                    float s0 = 0.f, s1 = 0.f;
#pragma unroll
                    for (int i4 = 0; i4 < 4; ++i4) { const f32x4 w4 = *(const LAS f32x4*)(wsh + (4 * rp + 2 * rt + hf) * 16 + 4 * i4);
                        s0 += w4.x * fmaxf(acc[4 * i4], 0.f) + w4.z * fmaxf(acc[4 * i4 + 2], 0.f); s1 += w4.y * fmaxf(acc[4 * i4 + 1], 0.f) + w4.w * fmaxf(acc[4 * i4 + 3], 0.f); }
                    sc[(4 * rp + 2 * rt + hf) * 4096 + kt * 32 + r] = __builtin_bit_cast(unsigned short, (_Float16)(s0 + s1));
                }
            }
        }
        __syncthreads();
        for (int q = F.wave; q < NQ; q += NWAVES) topk_select_row<false>(sc + q * 4096, t0 + q, idxo + (size_t)(b * SEQ + t0 + q) * TOPK, F.lane, (LAS int*)(F.lds + 132096) + F.wave * 320);
    }
}

#define LDS_BARRIER() do { asm volatile("s_waitcnt lgkmcnt(0)" ::: "memory"); __builtin_amdgcn_s_barrier(); asm volatile("" ::: "memory"); } while (0)
__device__ __forceinline__ int relane(int lane) { asm volatile("" : "+v"(lane)); return lane; }
__device__ __forceinline__ void ph_sparse_attn(Frame& F, bf16* qa_olat, const bf16* ckv, const int* idxi, const float* relb) {
    LAS unsigned char* KV = F.lds;
    LAS unsigned char* PF = F.lds + 131072;
    LAS float* wmax = (LAS float*)(F.lds + 147456);
    LAS float* wsum = wmax + 256;
    LAS unsigned char* bks = F.lds + 147456 + 2048;
    LAS float* relbs = (LAS float*)(F.lds + 147456 + 2048 + 512);
    LAS float* invw = (LAS float*)(F.lds + 147456 + 2048 + 512 + 4224);
    LAS unsigned char* blut = F.lds + 147456 + 2048 + 512 + 4224 + 1024;
    const float scale = 0.08838834764831845f;
    const int w = F.wave;
    __syncthreads();
    for (int i = F.tid; i < 1024; i += 512) relbs[i] = relb[i];
    if (F.tid < 32) relbs[1024 + F.tid] = -INFINITY;
    if (F.tid < 128) blut[F.tid] = (unsigned char)t5_bucket(F.tid);
    int u = blockIdx.x;
    if (u >= T) return;
    int idc[16]; int bid; v4u R[16]; v4u Qr[2];
    {
        const int cc = F.lane & 31, r = F.lane & 31, hf = F.lane >> 5;
        const int t = u % SEQ, b = u / SEQ;
        const int* ip = idxi + (size_t)u * TOPK + 32 * w + hf;
#pragma unroll
        for (int k = 0; k < 16; ++k) idc[k] = ip[2 * k];
        const bf16* kb = ckv + (size_t)b * SEQ * A_KVR + cc * 8;
#pragma unroll
        for (int k = 0; k < 16; ++k) R[k] = *(const v4u*)(kb + (size_t)idc[k] * A_KVR);
        if (F.tid < 256) { const int id = idxi[(size_t)u * TOPK + F.tid]; const int d = t - id; bks[F.tid] = (F.tid <= t) ? (unsigned char)t5_bucket(d > 0 ? d : 0) : (unsigned char)32; }
        const int u2 = (u + F.G < T) ? u + F.G : u;
        const int* ip2 = idxi + (size_t)u2 * TOPK + 32 * w + hf;
#pragma unroll
        for (int k = 0; k < 16; ++k) idc[k] = ip2[2 * k];
        bid = (F.tid < 256) ? idxi[(size_t)u2 * TOPK + F.tid] : -1;
        { const v4u* qp = (const v4u*)(qa_olat + (size_t)u * A_HEADS * A_KVR);
#pragma unroll
          for (int j = 0; j < 2; ++j) { const int id = 2 * w + j, head = 8 * (id & 3) + (F.lane & 7), pos = 8 * (id >> 2) + (F.lane >> 3); Qr[j] = qp[head * 32 + pos]; } }
    }
    unsigned wro[16], qwo[2], trb[2];
    { const unsigned r0 = F.lane & 31, hf0 = F.lane >> 5; const unsigned c0 = (r0 & 15u) ^ (4u * hf0);
#pragma unroll
      for (int k = 0; k < 16; ++k) wro[k] = (r0 >> 4) * 65536u + 256u * (32u * w + hf0) + 512u * k + 16u * (c0 ^ (unsigned)(8 * (k & 1) + ((k >> 1) & 3)));
#pragma unroll
      for (int j = 0; j < 2; ++j) { const int id = 2 * w + j, head = 8 * (id & 3) + (F.lane & 7), pos = 8 * (id >> 2) + (F.lane >> 3); qwo[j] = (pos >> 1) * 1024 + ((pos & 1) * 32 + head) * 16; }
      trb[0] = tr_base_perm((unsigned)F.lane, (unsigned)(w & 3), 0u); trb[1] = tr_base_perm((unsigned)F.lane, (unsigned)(w & 3), 1u); }
    unsigned rdo[16];
    { const unsigned r0 = F.lane & 31, hf0 = F.lane >> 5, row = 32u * w + r0, xr = ((row & 3u) << 2) | ((row >> 2) & 3u);
#pragma unroll
      for (int ks = 0; ks < 16; ++ks) rdo[ks] = 256u * row + (ks >> 3) * 65536u + 16u * ((unsigned)(2 * (ks & 7) + hf0) ^ xr); }
    for (int it = 0; u < T; u += F.G, ++it) {
        const int un = u + F.G, unn = u + 2 * F.G, par = it & 1;
        LDS_BARRIER();
        const int l2 = relane(F.lane), r = l2 & 31, hf = l2 >> 5;
        {
#pragma unroll
          for (int k = 0; k < 16; ++k) *(LAS v4u*)(KV + wro[k]) = R[k]; }
        *(LAS v4u*)(PF + qwo[0]) = Qr[0]; *(LAS v4u*)(PF + qwo[1]) = Qr[1];
        LDS_BARRIER();
        const int tid1 = w * 64 + l2;
        const int unb = (un < T) ? un : u; const int bn = unb / SEQ, tn = unb % SEQ;
        const bf16* kbn = ckv + (size_t)bn * SEQ * A_KVR + r * 8;
        f32x16 acc;
#pragma unroll
        for (int i = 0; i < 16; ++i) acc[i] = 0.f;
        {
#pragma unroll
          for (int ks = 0; ks < 16; ++ks) { const bf16x8 a = *(const LAS bf16x8*)(KV + rdo[ks]);
              acc = __builtin_amdgcn_mfma_f32_32x32x16_bf16(a, *(const LAS bf16x8*)(PF + ks * 1024 + l2 * 16), acc, 0, 0, 0);
              R[ks] = *(const v4u*)(kbn + (size_t)idc[ks] * A_KVR); } }
        if (tid1 < 256) { int d = tn - bid; d = d < 0 ? 0 : (d > 127 ? 127 : d); bks[(par ^ 1) * 256 + tid1] = (tid1 <= tn) ? blut[d] : (unsigned char)32; }
        { const v4u* qp = (const v4u*)(qa_olat + (size_t)unb * A_HEADS * A_KVR);
#pragma unroll
          for (int j = 0; j < 2; ++j) { const int id = 2 * w + j, head = 8 * (id & 3) + (l2 & 7), pos = 8 * (id >> 2) + (l2 >> 3); Qr[j] = qp[head * 32 + pos]; } }
        float lg[16]; float m = -INFINITY;
#pragma unroll
        for (int g = 0; g < 4; ++g) { const unsigned b4 = *(const LAS unsigned*)(bks + par * 256 + 32 * w + 8 * g + 4 * hf);
#pragma unroll
            for (int j = 0; j < 4; ++j) { const unsigned bk = (b4 >> (8 * j)) & 255u; const int i = 4 * g + j;
                lg[i] = acc[i] * scale + relbs[bk * 32 + r]; m = fmaxf(m, lg[i]); } }
        m = fmaxf(m, shx(m, 32, l2));
        if (hf == 0) wmax[r * 8 + w] = m;
        LDS_BARRIER();
        { const f32x4 m0 = *(const LAS f32x4*)(wmax + r * 8), m1 = *(const LAS f32x4*)(wmax + r * 8 + 4);
          m = fmaxf(fmaxf(fmaxf(m0.x, m0.y), fmaxf(m0.z, m0.w)), fmaxf(fmaxf(m1.x, m1.y), fmaxf(m1.z, m1.w))); }
        float s = 0.f;
#pragma unroll
        for (int i = 0; i < 16; ++i) { lg[i] = __expf(lg[i] - m); s += lg[i]; }
        s += shx(s, 32, l2);
        if (hf == 0) wsum[r * 8 + w] = s;
#pragma unroll
        for (int s2 = 0; s2 < 2; ++s2) { v4u pk; pk.x = pk2(lg[8 * s2 + 0], lg[8 * s2 + 1]); pk.y = pk2(lg[8 * s2 + 2], lg[8 * s2 + 3]); pk.z = pk2(lg[8 * s2 + 4], lg[8 * s2 + 5]); pk.w = pk2(lg[8 * s2 + 6], lg[8 * s2 + 7]);
            *(LAS v4u*)(PF + (2 * w + s2) * 1024 + l2 * 16) = pk; }
        LDS_BARRIER();
        const int l3 = relane(F.lane), r3 = l3 & 31, hf3 = l3 >> 5;
        if (hf3 == 0) { const f32x4 s0 = *(const LAS f32x4*)(wsum + r3 * 8), s1 = *(const LAS f32x4*)(wsum + r3 * 8 + 4);
            invw[w * 32 + r3] = 1.0f / (((s0.x + s0.y) + (s0.z + s0.w)) + ((s1.x + s1.y) + (s1.z + s1.w))); }
        f32x16 o;
#pragma unroll
        for (int i = 0; i < 16; ++i) o[i] = 0.f;
        LAS unsigned char* img = KV + (w >> 2) * 65536;
        const int unc = (unn < T) ? unn : u;
        const int* ip2 = idxi + (size_t)unc * TOPK + 32 * w + hf3;
        const unsigned tb0 = trb[0], tb1 = trb[1];
#pragma unroll
        for (int ks = 0; ks < 16; ++ks) { const bf16x8 a = *(const LAS bf16x8*)(PF + ks * 1024 + l3 * 16);
            const bf16x8 bb = tr_frag_at(img, tb0, tb1, (unsigned)ks);
            o = __builtin_amdgcn_mfma_f32_32x32x16_bf16(a, bb, o, 0, 0, 0);
            idc[ks] = ip2[2 * ks]; }
        if (w * 64 + l3 < 256) bid = idxi[(size_t)unc * TOPK + w * 64 + l3];
        bf16* op = qa_olat + ((size_t)u * A_HEADS + 4 * hf3) * A_KVR + 32 * w + r3;
#pragma unroll
        for (int g = 0; g < 4; ++g) { const f32x4 iv = *(const LAS f32x4*)(invw + w * 32 + 8 * g + 4 * hf3);
            op[(8 * g + 0) * A_KVR] = (bf16)f2bf(o[4 * g + 0] * iv.x); op[(8 * g + 1) * A_KVR] = (bf16)f2bf(o[4 * g + 1] * iv.y);
            op[(8 * g + 2) * A_KVR] = (bf16)f2bf(o[4 * g + 2] * iv.z); op[(8 * g + 3) * A_KVR] = (bf16)f2bf(o[4 * g + 3] * iv.w); }
    }
}

__device__ __forceinline__ void ph_sb_attn(Frame& F, const bf16* qkv, bf16* o_out, unsigned* qctr) {
    LAS unsigned char* img = F.lds + F.wave * 8192;
    LAS unsigned char* qimg = F.lds + 65536 + F.wave * 8192;
    const int r = F.lane & 31, hf = F.lane >> 5;
    const float scale = 0.08838834764831845f;
    constexpr int NTASK8 = BATCH * B_HEADS * (SEQ / 32) / 8;
    const int myx = (int)(xb_xcc_id() & 7u);
    for (int qi = 0; qi < 8; ++qi) { const int qsel = (myx + qi) & 7;
    for (;;) {
        int task = 0;
        if (F.lane == 0) task = (int)__hip_atomic_fetch_add(qctr + 64 * qsel, 1u, __ATOMIC_RELAXED, __HIP_MEMORY_SCOPE_AGENT);
        task = __builtin_amdgcn_readfirstlane(task);
        if (task >= NTASK8) break;
        task += qsel * NTASK8;
        const int qt = task & 127, bh = task >> 7, h = bh & 15, b = bh >> 4, t0 = qt * 32;
        v4u Kr[8], Vr[8];
#pragma unroll
        for (int k = 0; k < 8; ++k) { const int n = F.lane + 64 * k; *(LAS v4u*)(qimg + offb(n >> 4, n & 15)) = *(const v4u*)(qkv + (size_t)(b * SEQ + t0 + (n >> 4)) * B_INC + h * B_HD + (n & 15) * 8); }
        {
#pragma unroll
          for (int k = 0; k < 8; ++k) { const int n = F.lane + 64 * k; const bf16* rp = qkv + (size_t)(b * SEQ + qt * 32 + (n >> 4)) * B_INC + h * B_HD + (n & 15) * 8; Kr[k] = *(const v4u*)(rp + DM); Vr[k] = *(const v4u*)(rp + 2 * DM); } }
        f32x16 o[4];
#pragma unroll
        for (int dt = 0; dt < 4; ++dt)
#pragma unroll
            for (int i = 0; i < 16; ++i) o[dt][i] = 0.f;
        float Rc = 1.f;
        for (int kt = qt; kt >= 0; --kt) {
            const int ll = relane(F.lane), r = ll & 31, hf = ll >> 5;
#pragma unroll
            for (int k = 0; k < 8; ++k) { const int n = ll + 64 * k; *(LAS v4u*)(img + offb(n >> 4, n & 15)) = Kr[k]; }
            f32x16 acc;
#pragma unroll
            for (int i = 0; i < 16; ++i) acc[i] = 0.f;
#pragma unroll
            for (int ks = 0; ks < 8; ++ks) acc = __builtin_amdgcn_mfma_f32_32x32x16_bf16(*(const LAS bf16x8*)(img + offb(r, 2 * ks + hf)), *(const LAS bf16x8*)(qimg + offb(r, 2 * ks + hf)), acc, 0, 0, 0);
            asm volatile("s_waitcnt lgkmcnt(0)" ::: "memory");
#pragma unroll
            for (int k = 0; k < 8; ++k) { const int n = ll + 64 * k; *(LAS v4u*)(img + offb(n >> 4, n & 15)) = Vr[k]; }
            float be[16], om[16];
            const bool diag = (kt == qt);
#pragma unroll
            for (int i = 0; i < 16; ++i) { const float z = fminf(acc[i] * scale, 80.f);
                const float e = __expf(z), rr = __builtin_amdgcn_rcpf(1.0f + e);
                be[i] = e * rr; om[i] = rr; }
            if (diag) {
#pragma unroll
                for (int i = 0; i < 16; ++i) { const int kap = 8 * (i >> 2) + 4 * hf + (i & 3); if (kap >= r) { be[i] = 0.f; om[i] = 1.f; } } }
            float sfx[16], Gt[4], Go[4];
#pragma unroll
            for (int g = 0; g < 4; ++g) { sfx[4 * g + 3] = 1.f; sfx[4 * g + 2] = om[4 * g + 3]; sfx[4 * g + 1] = sfx[4 * g + 2] * om[4 * g + 2]; sfx[4 * g + 0] = sfx[4 * g + 1] * om[4 * g + 1]; Gt[g] = sfx[4 * g + 0] * om[4 * g + 0]; }
#pragma unroll
            for (int g = 0; g < 4; ++g) Go[g] = shx(Gt[g], 32, ll);
            float SP[4]; SP[3] = 1.f; SP[2] = Gt[3] * Go[3]; SP[1] = SP[2] * (Gt[2] * Go[2]); SP[0] = SP[1] * (Gt[1] * Go[1]);
            float wgt[16];
#pragma unroll
            for (int g = 0; g < 4; ++g) { const float Rg = Rc * SP[g] * (hf == 0 ? Go[g] : 1.f);
#pragma unroll
                for (int j = 0; j < 4; ++j) wgt[4 * g + j] = be[4 * g + j] * (Rg * sfx[4 * g + j]); }
            Rc = Rc * (SP[0] * (Gt[0] * Go[0]));
            if (kt > 0) {
#pragma unroll
                for (int k = 0; k < 8; ++k) { const int n = F.lane + 64 * k; const bf16* rp = qkv + (size_t)(b * SEQ + (kt - 1) * 32 + (n >> 4)) * B_INC + h * B_HD + (n & 15) * 8; Kr[k] = *(const v4u*)(rp + DM); Vr[k] = *(const v4u*)(rp + 2 * DM); }
            }
            asm volatile("s_waitcnt lgkmcnt(0)" ::: "memory");
#pragma unroll
            for (int s2 = 0; s2 < 2; ++s2) {
                v4u pk; pk.x = pk2(wgt[8 * s2 + 0], wgt[8 * s2 + 1]); pk.y = pk2(wgt[8 * s2 + 2], wgt[8 * s2 + 3]); pk.z = pk2(wgt[8 * s2 + 4], wgt[8 * s2 + 5]); pk.w = pk2(wgt[8 * s2 + 6], wgt[8 * s2 + 7]);
                const bf16x8 pa = __builtin_bit_cast(bf16x8, pk);
#pragma unroll
                for (int dt = 0; dt < 4; ++dt) { const bf16x8 vb = tr_frag_at(img, tr_base_perm((unsigned)ll, (unsigned)dt, 0u), tr_base_perm((unsigned)ll, (unsigned)dt, 1u), (unsigned)s2);
                    o[dt] = __builtin_amdgcn_mfma_f32_32x32x16_bf16(pa, vb, o[dt], 0, 0, 0); }
            }
            if (__ballot(Rc >= 0x1p-40f) == 0ull) break;
        }
#pragma unroll
        for (int dt = 0; dt < 4; ++dt)
#pragma unroll
            for (int i = 0; i < 16; ++i) { const int qrow = 8 * (i >> 2) + 4 * hf + (i & 3);
                o_out[(size_t)(b * SEQ + t0 + qrow) * DM + h * B_HD + 32 * dt + r] = (bf16)f2bf(o[dt][i]); }
    }
    }
}

constexpr int PH_LAYER0 = 3, PH_PER_LAYER = 16, PH_END = PH_LAYER0 + DEPTH * PH_PER_LAYER;
typedef pg8::bf16_t gb16;
__device__ __forceinline__ bool relaunder(Frame& F) { int l_; asm volatile("v_mbcnt_lo_u32_b32 %0, -1, 0\n\tv_mbcnt_hi_u32_b32 %0, -1, %0" : "=v"(l_)); F.lane = l_; F.tid = F.wave * 64 + l_; return true; }
template <class Epi> __device__ __forceinline__ void run_gemm(Frame& F, const bf16* A, const bf16* Bt, int N, int K, int lda, int ldb, int acs, const Epi& E) {
    pg8::Gemm g{(const gb16*)A, (const gb16*)Bt, T, N, K, lda, ldb, acs}; pg8::StaticOrder S; S.init(T, N, F.G, (F.G == 256) ? (int)((blockIdx.x & 31) * 8 + (blockIdx.x >> 5)) : (int)blockIdx.x);
    pg8::gemm_phase<Epi, pg8::StaticOrder, true, true>(F.lds, g, S, E, F.tid);
}
__global__ void __launch_bounds__(NWAVES * 64, 2) fwd_kernel(Args args) {
    extern __shared__ __attribute__((aligned(16))) unsigned char lds_raw[];
    Frame F;
    F.lds = (LAS unsigned char*)lds_raw;
    F.tid = threadIdx.x; F.lane = F.tid & 63; F.wave = __builtin_amdgcn_readfirstlane(F.tid >> 6); F.G = gridDim.x;
    F.ap = (const CAS Args*)__builtin_amdgcn_kernarg_segment_ptr();
    F.out = args.out; F.ws = args.ws;
    volatile LAS unsigned* MISC = (volatile LAS unsigned*)(F.lds + MISC_OFF);
    if (F.tid < 64) MISC[F.tid] = 0u;
    __syncthreads();
    const int lo = args.ph_lo, hi = args.ph_hi;
    XcdBarrier bar; bar.bar = (unsigned*)(F.ws + WS_CTL) + CW_BAR; bar.x = 0; bar.st = nullptr;
    if (hi - lo > 1) { bar = xcd_barrier_post((unsigned*)(F.ws + WS_CTL) + CW_BAR, MISC + 8); xcd_barrier<true>(bar); }
#define IN(k) (lo <= (k) && (k) < hi && relaunder(F))
#define INR(k) (lo <= (k) && (k) < hi)
#define GRID_BAR() do { XcdBarrier b2_ = bar; b2_.x = (unsigned)__builtin_amdgcn_readfirstlane((int)bar.x); asm volatile("" : "+s"(b2_.bar), "+s"(b2_.x)); xcd_barrier<false>(b2_); } while (0)
#define SEAM(k) do { if (INR((k) + 1)) GRID_BAR(); } while (0)

    float* mod = WSP(float, WS_MOD);
    const float* normg = F.inp(IN_NORMG);
    bf16* Hb = WSP(bf16, WS_H);
    if (IN(0)) { ph_prologue(F); SEAM(0); }
    if (IN(1)) { ph_modreduce(F); SEAM(1); }
    if (IN(2)) { ph_post(F, nullptr, F.inp(IN_X), true, nullptr, false, nullptr, nullptr, Hb, normg + 0 * DM, mod + 0 * DM, mod + 1 * DM); SEAM(2); }

    for (int L = 0; L < DEPTH; ++L) {
        const int pb = PH_LAYER0 + PH_PER_LAYER * L, j = L >> 1;
        const float* modL = mod + (size_t)L * BATCH * MODW;
        const float* ng = normg + (size_t)L * 4 * DM;
        const bool lastL = (L == DEPTH - 1);
        bf16* XB = (bf16*)((unsigned char*)F.out + 128 * MiB); bf16* XL = WSP(bf16, WS_P + 128 * MiB);
        if ((L & 1) == 0) {
            float* proj = WSP(float, WS_P); bf16* qidx = WSP(bf16, WS_P + 128 * MiB); bf16* ob = WSP(bf16, WS_P);
            bf16* big = WSP(bf16, WS_BIG);
            bf16* qlat = WSP(bf16, WS_QLAT); bf16* ckv = WSP(bf16, WS_CKV); bf16* kidx = WSP(bf16, WS_KIDX); float* widx = WSP(float, WS_WIDX); int* idxb = WSP(int, WS_IDX);
            if (IN(pb + 0)) { pg8::EpiF32 E{proj, A_INP}; run_gemm(F, Hb, WSP(bf16, WS_WAIN) + (size_t)j * A_INP * DM, A_INP, DM, DM, DM, 0, E); SEAM(pb + 0); }
            if (IN(pb + 1)) { ph_dsa_norm(F, proj, F.inp(IN_AQN) + j * A_QR, F.inp(IN_AKVN) + j * A_KVR, F.inp(IN_AIKN) + j * IDX_D, qlat, ckv, kidx, widx); SEAM(pb + 1); }
            if (IN(pb + 2)) { pg8::EpiBf16<0> E{(gb16*)big, 8192, (gb16*)qidx, 2048, 8192}; run_gemm(F, qlat, WSP(bf16, WS_WQC) + (size_t)j * 10240 * 512, 10240, A_QR, A_QR, A_QR, 0, E); SEAM(pb + 2); }
            if (IN(pb + 3)) { ph_indexer(F, qidx, kidx, widx, idxb); SEAM(pb + 3); }
            if (IN(pb + 4)) { ph_sparse_attn(F, big, ckv, idxb, F.inp(IN_RELB)); SEAM(pb + 4); }
            if (IN(pb + 5)) { pg8::EpiBf16<0> E{(gb16*)ob, 4096, (gb16*)ob, 4096, 1 << 30}; run_gemm(F, big, WSP(bf16, WS_WUV) + (size_t)j * 4096 * 512, 4096, 512, 8192, 512, 512, E); SEAM(pb + 5); }
            if (IN(pb + 6)) { pg8::EpiBf16<0> E{(gb16*)big, DM, (gb16*)big, DM, 1 << 30}; run_gemm(F, ob, WSP(bf16, WS_WAOUT) + (size_t)j * DM * 4096, DM, 4096, 4096, 4096, 0, E); SEAM(pb + 6); }
        } else {
            bf16* qkv = WSP(bf16, WS_BIG); bf16* ob = WSP(bf16, WS_P); bf16* big = WSP(bf16, WS_BIG);
            if (IN(pb + 0)) { pg8::EpiBf16<0> E{(gb16*)qkv, B_INC, (gb16*)qkv, B_INC, 1 << 30}; run_gemm(F, Hb, WSP(bf16, WS_WBIN) + (size_t)j * B_INC * DM, B_INC, DM, DM, DM, 0, E); SEAM(pb + 0); }
            if (IN(pb + 1)) { ph_sb_attn(F, qkv, ob, (unsigned*)(F.ws + WS_CTL) + CW_SBQ + 512 * j); SEAM(pb + 1); }
            if (IN(pb + 2)) { pg8::EpiBf16<0> E{(gb16*)big, DM, (gb16*)big, DM, 1 << 30}; run_gemm(F, ob, WSP(bf16, WS_WBOUT) + (size_t)j * DM * DM, DM, DM, DM, DM, 0, E); if (INR(pb + 7)) GRID_BAR(); }
        }
        if (IN(pb + 7)) { ph_post(F, WSP(bf16, WS_BIG), (L == 0) ? (const void*)F.inp(IN_X) : (const void*)XB, L == 0, lastL ? (void*)XL : (void*)XB, false, modL + 2 * DM, ng + 1 * DM, Hb, ng + 2 * DM, modL + 3 * DM, modL + 4 * DM); SEAM(pb + 7); }
        if (IN(pb + 8)) { pg8::EpiBf16<1> E{(gb16*)WSP(bf16, WS_BIG), DFF, (gb16*)WSP(bf16, WS_BIG), DFF, 1 << 30}; run_gemm(F, Hb, WSP(bf16, WS_WM1) + (size_t)L * DFF * DM, DFF, DM, DM, DM, 0, E); SEAM(pb + 8); }
        if (IN(pb + 9)) { pg8::EpiBf16<0> E{(gb16*)WSP(bf16, WS_P), DM, (gb16*)WSP(bf16, WS_P), DM, 1 << 30}; run_gemm(F, WSP(bf16, WS_BIG), WSP(bf16, WS_WM2) + (size_t)L * DM * DFF, DM, DFF, DFF, DFF, 0, E); SEAM(pb + 9); }
        if (IN(pb + 10)) {
            const float* modN = mod + (size_t)(L + 1) * BATCH * MODW; const float* ngN = normg + (size_t)(L + 1) * 4 * DM;
            ph_post(F, WSP(bf16, WS_P), lastL ? (const void*)XL : (const void*)XB, false, lastL ? (void*)F.out : (void*)XB, lastL, modL + 5 * DM, ng + 3 * DM, lastL ? nullptr : Hb, ngN, modN + 0 * DM, modN + 1 * DM);
            if (!lastL && INR(pb + PH_PER_LAYER)) GRID_BAR();
        }
    }
#undef IN
#undef INR
#undef GRID_BAR
#undef SEAM
}

extern "C" void kernel_launch(void* const* d_in, const int* in_sizes, int n_in, void* d_out, int out_size, void* d_ws, size_t ws_size, hipStream_t stream) {
    static int grid = 0;
    if (grid == 0) {
        if (n_in != N_IN || out_size != T * DM || ws_size < WS_END) { fprintf(stderr, "kernel_launch: unexpected problem: n_in %d out %d ws %zu (need %zu); nothing launched\n", n_in, out_size, ws_size, (size_t)WS_END); grid = -1; return; }
        int dev = 0, cus = 0, per_cu = 0;
        if (hipGetDevice(&dev) != hipSuccess || hipDeviceGetAttribute(&cus, hipDeviceAttributeMultiprocessorCount, dev) != hipSuccess) { grid = -1; return; }
        if (hipFuncSetAttribute((const void*)fwd_kernel, hipFuncAttributeMaxDynamicSharedMemorySize, LDS_BYTES) != hipSuccess) { fprintf(stderr, "kernel_launch: hipFuncSetAttribute(%d B LDS) failed\n", LDS_BYTES); grid = -1; return; }
        if (hipOccupancyMaxActiveBlocksPerMultiprocessor(&per_cu, (const void*)fwd_kernel, NWAVES * 64, LDS_BYTES) != hipSuccess || per_cu < 1) { fprintf(stderr, "kernel_launch: occupancy query says %d workgroups per CU; nothing launched\n", per_cu); (void)hipGetLastError(); grid = -1; return; }
        grid = cus * (per_cu < 1 ? per_cu : 1);
    }
    if (grid < 0) return;
    (void)hipMemsetAsync((char*)d_ws + WS_CTL, 0, CTL_ZERO_BYTES, stream);
    Args a{};
    for (int i = 0; i < N_IN; ++i) a.in[i] = (const float*)d_in[i];
    a.out = (float*)d_out; a.ws = (unsigned char*)d_ws;
#if ONE_LAUNCH
    a.ph_lo = 0; a.ph_hi = PH_END;
    hipLaunchKernelGGL(fwd_kernel, dim3(grid), dim3(NWAVES * 64), LDS_BYTES, stream, a);
#else
    for (int p = 0; p < PH_END; ++p) {
        if (p >= PH_LAYER0) { const int L = (p - PH_LAYER0) / PH_PER_LAYER, r = (p - PH_LAYER0) % PH_PER_LAYER;
            if (r > 10) continue; if ((L & 1) && r >= 3 && r <= 6) continue; }
        a.ph_lo = p; a.ph_hi = p + 1;
        hipLaunchKernelGGL(fwd_kernel, dim3(grid), dim3(NWAVES * 64), LDS_BYTES, stream, a);
    }
#endif
}
```

```cpp
#include <hip/hip_runtime.h>
#include <cstdio>
#include <cstdint>
#ifndef ONE_LAUNCH
#define ONE_LAUNCH 1
#endif
namespace pg8 {
#define PG8_LAS __attribute__((address_space(3)))
typedef unsigned short bf16_t;
typedef short bf16x8 __attribute__((ext_vector_type(8)));
typedef float f32x4 __attribute__((ext_vector_type(4)));
typedef unsigned u32x4 __attribute__((ext_vector_type(4)));
constexpr int BM = 256, BK = 64, HALF = 128, HTB = HALF * BK * 2  , STAGE_BYTES = 8 * HTB, NXCD = 8, WGM = 4;

__host__ __device__ __forceinline__ int lds_byte(int r, int c) { const int st = (r >> 4) * 2 + (c >> 5), rr = r & 15, cc = c & 31, ob = rr * 64 + cc * 2; return st * 1024 + (ob ^ (((ob >> 9) & 1) << 5)); }
__host__ __device__ __forceinline__ void stage_rc(int b, int& R, int& C) { const int st = b / 1024, sb = b % 1024, swz = sb ^ (((sb >> 9) & 1) << 5); R = (st >> 1) * 16 + swz / 64; C = (st & 1) * 32 + (swz % 64) / 2; }
__host__ __device__ __forceinline__ int perm32(int rho) { const int n = rho >> 4, i = rho & 15; return 8 * (i >> 2) + 4 * n + (i & 3); }

struct Unit { int pm, pn; };
struct Gemm { const bf16_t* A; const bf16_t* Bt; int M, N, K, lda, ldb, acs; };

struct StaticOrder {
    int nM, nN, nwg, G, c;
    __host__ __device__ void init(int M, int N, int G_, int c_) { nM = M / BM; nN = N / BM; nwg = nM * nN; G = G_; c = c_; }
    __host__ __device__ bool next(int i, Unit& u) const {
        const long L = (long)i * G + c; if (L >= nwg) return false;
        int wgid = (int)L; { const int q = nwg / NXCD, r = nwg % NXCD, xcd = wgid % NXCD, off = wgid / NXCD; wgid = (xcd < r ? xcd * (q + 1) : r * (q + 1) + (xcd - r) * q) + off; }
        const int nig = WGM * nN, gid = wgid / nig, fm = gid * WGM, gsz = (nM - fm) < WGM ? (nM - fm) : WGM;
        u.pm = fm + ((wgid % nig) % gsz); u.pn = (wgid % nig) / gsz; return true;
    }
    __device__ __forceinline__ void a_ready(const Unit&) const {}
    __device__ __forceinline__ void done(const Unit&) const {}
};


__device__ __forceinline__ unsigned cvt_pk_bf16(float lo, float hi) { unsigned r; asm volatile("v_cvt_pk_bf16_f32 %0, %1, %2" : "=v"(r) : "v"(lo), "v"(hi)); return r; }
struct EpiF32 {
    static constexpr bool PERM = false, AFTER_DRAIN = false;
    float* C; int ldc;
    __device__ __forceinline__ void operator()(const f32x4 (&acc)[2][2][4][2], const Unit& u, int wr, int wc, int fr, int fq, PG8_LAS unsigned char*) const {
        const int row0 = u.pm * BM + wr * 64 + fr, col0 = u.pn * BM + wc * 32 + 4 * fq;
#pragma unroll
        for (int ai = 0; ai < 2; ++ai)
#pragma unroll
            for (int m = 0; m < 4; ++m) { float* rowp = C + (size_t)(row0 + ai * HALF + m * 16) * ldc + col0;
#pragma unroll
                for (int bj = 0; bj < 2; ++bj)
#pragma unroll
                    for (int n = 0; n < 2; ++n) *(f32x4*)(rowp + bj * HALF + n * 16) = acc[ai][bj][m][n]; }
    }
};
template <int ACT> struct EpiBf16 {
    static constexpr bool PERM = true, AFTER_DRAIN = false;
    bf16_t* O0; int ld0; bf16_t* O1; int ld1; int split_col;
    __device__ __forceinline__ void operator()(const f32x4 (&acc)[2][2][4][2], const Unit& u, int wr, int wc, int fr, int fq, PG8_LAS unsigned char* lds) const {
        int colt = u.pn * BM; bf16_t* base = O0; int ldc = ld0;
        if (colt >= split_col) { base = O1; ldc = ld1; colt -= split_col; }
        PG8_LAS unsigned char* scr = lds + STAGE_BYTES + (wr * 4 + wc) * 2048;
        const int lane = fq * 16 + fr, rrow = lane >> 2, rch = lane & 3;
        PG8_LAS unsigned char* wp = scr + fr * 64 + 16 * (fq ^ ((fr >> 2) & 3));
        const PG8_LAS unsigned char* rp = scr + rrow * 64 + 16 * (rch ^ fq);
        bf16_t* gp = base + (size_t)(u.pm * BM + wr * 64 + rrow) * ldc + colt + wc * 32 + 8 * rch;
#pragma unroll
        for (int ai = 0; ai < 2; ++ai)
#pragma unroll
            for (int mp = 0; mp < 2; ++mp)
#pragma unroll
                for (int bj = 0; bj < 2; ++bj) {
#pragma unroll
                    for (int mm = 0; mm < 2; ++mm) { f32x4 v0 = acc[ai][bj][2 * mp + mm][0], v1 = acc[ai][bj][2 * mp + mm][1];
                        if (ACT == 1) {
#pragma unroll
                            for (int j = 0; j < 4; ++j) { const float a = fmaxf(v0[j], 0.f), b = fmaxf(v1[j], 0.f); v0[j] = a * a; v1[j] = b * b; } }
                        u32x4 w; w.x = cvt_pk_bf16(v0[0], v0[1]); w.y = cvt_pk_bf16(v0[2], v0[3]); w.z = cvt_pk_bf16(v1[0], v1[1]); w.w = cvt_pk_bf16(v1[2], v1[3]);
                        *(PG8_LAS u32x4*)(wp + mm * 1024) = w; }
#pragma unroll
                    for (int s = 0; s < 2; ++s) { const u32x4 w = *(const PG8_LAS u32x4*)(rp + s * 1024);
                        *(u32x4*)(gp + (size_t)(ai * HALF + mp * 32 + s * 16) * ldc + bj * HALF) = w; } }
    }
};

template <class Epi, class Sched, bool ALIGN_EPI = false, bool SP2 = false>
__device__ __forceinline__ void gemm_phase(PG8_LAS unsigned char* lds, const Gemm g, const Sched& S, const Epi& E, int tid_in) {
    int tid_l = tid_in; asm volatile("" : "+v"(tid_l));
    const int tid = tid_l, wid = __builtin_amdgcn_readfirstlane(tid >> 6), lane = tid & 63, wr = wid >> 2, wc = wid & 3, fr = lane & 15, fq = lane >> 4;
    const int K = g.K, nt = K / BK;
    unsigned voffA[2], voffB[2];
#pragma unroll
    for (int i = 0; i < 2; ++i) { int R, C; stage_rc(tid * 16 + i * 8192, R, C); const int Rb = Epi::PERM ? ((R & ~31) + perm32(R & 31)) : R;
        voffA[i] = (unsigned)(R * g.lda + C) * 2u; voffB[i] = (unsigned)(Rb * g.ldb + C) * 2u; }
    const size_t kstep = (size_t)(BK * 2);
    const size_t hstepA = (size_t)HALF * g.lda * 2, hstepB = (size_t)HALF * g.ldb * 2;
    const size_t tstepA = 2 * hstepA, tstepB = 2 * hstepB, cstepA = (size_t)g.acs * 2;
    const unsigned ldsw = (unsigned)wid * 1024u;
    const int aoff = lds_byte(wr * 64 + fr, fq * 8), boff = lds_byte(wc * 32 + fr, fq * 8);
#define PG8_SA(b, h) (((b) * 2 + (h)) * HTB)
#define PG8_SB(b, h) ((4 + (b) * 2 + (h)) * HTB)
#define PG8_STAGE(bufoff, gbase, voff) do { _Pragma("unroll") for (int _i = 0; _i < 2; ++_i) \
        __builtin_amdgcn_global_load_lds((const unsigned*)((const char*)(gbase) + (voff)[_i]), (PG8_LAS unsigned*)(lds + (bufoff) + ldsw + _i * 8192), 16, 0, 0); } while (0)
#define PG8_LDA(dst, b, h) do { _Pragma("unroll") for (int m = 0; m < 4; ++m) _Pragma("unroll") for (int k = 0; k < 2; ++k) dst[m][k] = *(const PG8_LAS bf16x8*)(lds + PG8_SA(b, h) + aoff + m * 2048 + k * 1024); } while (0)
#define PG8_LDB(dst, b, h) do { _Pragma("unroll") for (int n = 0; n < 2; ++n) _Pragma("unroll") for (int k = 0; k < 2; ++k) dst[n][k] = *(const PG8_LAS bf16x8*)(lds + PG8_SB(b, h) + boff + n * 2048 + k * 1024); } while (0)
#define PG8_MMA(ai, bj, At, Bt) do { __builtin_amdgcn_s_setprio(1); _Pragma("unroll") for (int m = 0; m < 4; ++m) _Pragma("unroll") for (int n = 0; n < 2; ++n) _Pragma("unroll") for (int k = 0; k < 2; ++k) \
        acc[ai][bj][m][n] = __builtin_amdgcn_mfma_f32_16x16x32_bf16(Bt[n][k], At[m][k], acc[ai][bj][m][n], 0, 0, 0); __builtin_amdgcn_s_setprio(0); } while (0)
#define PG8_WAIT_V(n) asm volatile("s_waitcnt vmcnt(" #n ")" ::: "memory")
#define PG8_WAIT_L(n) asm volatile("s_waitcnt lgkmcnt(" #n ")" ::: "memory")
#define PG8_BAR __builtin_amdgcn_s_barrier()
#define PG8_SCHED __builtin_amdgcn_sched_barrier(0)
    Unit cur, nxt; int ui = 0;
    if (!S.next(0, cur)) return;
    f32x4 acc[2][2][4][2];
#pragma unroll
    for (int a = 0; a < 2; ++a)
#pragma unroll
        for (int b = 0; b < 2; ++b)
#pragma unroll
            for (int m = 0; m < 4; ++m)
#pragma unroll
                for (int n = 0; n < 2; ++n) acc[a][b][m][n] = (f32x4){0.f, 0.f, 0.f, 0.f};
    bf16x8 At[4][2], B0[2][2], B1[2][2];
    const char* cA = (const char*)g.A + (size_t)cur.pm * tstepA + (size_t)cur.pn * cstepA; const char* cB = (const char*)g.Bt + (size_t)cur.pn * tstepB;
    S.a_ready(cur);
    if constexpr (SP2) {
        PG8_STAGE(PG8_SB(0, 0), cB, voffB); PG8_STAGE(PG8_SB(0, 1), cB + hstepB, voffB); PG8_STAGE(PG8_SA(0, 0), cA, voffA); PG8_STAGE(PG8_SA(0, 1), cA + hstepA, voffA);
        if (wr == 1) PG8_BAR;
        PG8_WAIT_V(2); PG8_BAR;
        PG8_STAGE(PG8_SB(1, 0), cB + kstep, voffB); PG8_STAGE(PG8_SA(1, 0), cA + kstep, voffA); PG8_STAGE(PG8_SB(1, 1), cB + hstepB + kstep, voffB);
        PG8_WAIT_V(6); PG8_BAR;
    } else {
        PG8_STAGE(PG8_SB(0, 0), cB, voffB); PG8_STAGE(PG8_SA(0, 0), cA, voffA); PG8_STAGE(PG8_SB(0, 1), cB + hstepB, voffB); PG8_STAGE(PG8_SA(0, 1), cA + hstepA, voffA);
        if (wr == 1) PG8_BAR;
        PG8_WAIT_V(4); PG8_BAR;
        PG8_STAGE(PG8_SB(1, 0), cB + kstep, voffB); PG8_STAGE(PG8_SA(1, 0), cA + kstep, voffA); PG8_STAGE(PG8_SB(1, 1), cB + hstepB + kstep, voffB);
        PG8_WAIT_V(6); PG8_BAR;
    }
    for (;;) {
        const bool has_next = S.next(ui + 1, nxt);
        const char* nA = has_next ? (const char*)g.A + (size_t)nxt.pm * tstepA + (size_t)nxt.pn * cstepA : cA; const char* nB = has_next ? (const char*)g.Bt + (size_t)nxt.pn * tstepB : cB;
        for (int t = 0; t < nt; t += 2) {
            const bool last = (t == nt - 2);
            const char* a1 = cA + (size_t)(t + 1) * kstep;
            const char* a2 = last ? nA : cA + (size_t)(t + 2) * kstep; const char* b2 = last ? nB : cB + (size_t)(t + 2) * kstep;
            const char* a3 = a2 + kstep; const char* b3 = b2 + kstep;
            if (last && has_next) S.a_ready(nxt);
            if constexpr (SP2) {
            PG8_LDB(B0, 0, 0); PG8_LDB(B1, 0, 1); PG8_SCHED; PG8_LDA(At, 0, 0); PG8_STAGE(PG8_SA(1, 1), a1 + hstepA, voffA);
            PG8_WAIT_V(8); PG8_WAIT_L(0); PG8_BAR; PG8_MMA(0, 0, At, B0); PG8_MMA(0, 1, At, B1); PG8_BAR; PG8_SCHED;
            PG8_LDA(At, 0, 1); PG8_STAGE(PG8_SB(0, 0), b2, voffB); PG8_STAGE(PG8_SB(0, 1), b2 + hstepB, voffB); PG8_STAGE(PG8_SA(0, 0), a2, voffA);
            PG8_WAIT_V(8); PG8_WAIT_L(0); PG8_BAR; PG8_MMA(1, 0, At, B0); PG8_MMA(1, 1, At, B1); PG8_BAR; PG8_SCHED;
            PG8_LDB(B0, 1, 0); PG8_LDB(B1, 1, 1); PG8_SCHED; PG8_LDA(At, 1, 0); PG8_STAGE(PG8_SA(0, 1), a2 + hstepA, voffA);
            PG8_WAIT_V(8); PG8_WAIT_L(0); PG8_BAR; PG8_MMA(0, 0, At, B0); PG8_MMA(0, 1, At, B1); PG8_BAR; PG8_SCHED;
            PG8_LDA(At, 1, 1); PG8_STAGE(PG8_SB(1, 0), b3, voffB); PG8_STAGE(PG8_SB(1, 1), b3 + hstepB, voffB); PG8_STAGE(PG8_SA(1, 0), a3, voffA);
            PG8_WAIT_V(8); PG8_WAIT_L(0); PG8_BAR; PG8_MMA(1, 0, At, B0); PG8_MMA(1, 1, At, B1); PG8_BAR; PG8_SCHED;
            } else {
            PG8_LDB(B0, 0, 0); PG8_SCHED; PG8_LDA(At, 0, 0); PG8_STAGE(PG8_SA(1, 1), a1 + hstepA, voffA);
            PG8_WAIT_L(8); PG8_BAR; PG8_WAIT_L(0); PG8_MMA(0, 0, At, B0); PG8_BAR; PG8_SCHED;
            PG8_LDB(B1, 0, 1); PG8_STAGE(PG8_SB(0, 0), b2, voffB);
            PG8_BAR; PG8_WAIT_L(0); PG8_MMA(0, 1, At, B1); PG8_BAR;
            PG8_LDA(At, 0, 1); PG8_STAGE(PG8_SA(0, 0), a2, voffA);
            PG8_BAR; PG8_WAIT_L(0); PG8_MMA(1, 0, At, B0); PG8_BAR; PG8_SCHED;
            PG8_STAGE(PG8_SB(0, 1), b2 + hstepB, voffB);
            PG8_WAIT_V(6); PG8_BAR; PG8_MMA(1, 1, At, B1); PG8_BAR;
            PG8_LDB(B0, 1, 0); PG8_SCHED; PG8_LDA(At, 1, 0); PG8_STAGE(PG8_SA(0, 1), a2 + hstepA, voffA);
            PG8_WAIT_L(8); PG8_BAR; PG8_WAIT_L(0); PG8_MMA(0, 0, At, B0); PG8_BAR; PG8_SCHED;
            PG8_LDB(B1, 1, 1); PG8_STAGE(PG8_SB(1, 0), b3, voffB);
            PG8_BAR; PG8_WAIT_L(0); PG8_MMA(0, 1, At, B1); PG8_BAR;
            PG8_LDA(At, 1, 1); PG8_STAGE(PG8_SA(1, 0), a3, voffA);
            PG8_BAR; PG8_WAIT_L(0); PG8_MMA(1, 0, At, B0); PG8_BAR; PG8_SCHED;
            PG8_STAGE(PG8_SB(1, 1), b3 + hstepB, voffB);
            PG8_WAIT_V(6); PG8_BAR; PG8_MMA(1, 1, At, B1); PG8_BAR;
            }
        }
        if constexpr (ALIGN_EPI) { if (wr == 0) PG8_BAR; }
        if constexpr (!Epi::AFTER_DRAIN) { E(acc, cur, wr, wc, fr, fq, lds); S.done(cur); }
        if (!has_next) break;
#pragma unroll
        for (int a = 0; a < 2; ++a)
#pragma unroll
            for (int b = 0; b < 2; ++b)
#pragma unroll
                for (int m = 0; m < 4; ++m)
#pragma unroll
                    for (int n = 0; n < 2; ++n) acc[a][b][m][n] = (f32x4){0.f, 0.f, 0.f, 0.f};
        cur = nxt; cA = nA; cB = nB; ++ui;
        if constexpr (ALIGN_EPI) { if (wr == 1) PG8_BAR; }
    }
    PG8_WAIT_V(0);
    if constexpr (!ALIGN_EPI) { if (wr == 0) PG8_BAR; }
    PG8_BAR;
    if constexpr (Epi::AFTER_DRAIN) { E.fused(acc, cur, wr, wc, fr, fq, lds, wid, lane); S.done(cur); }
#undef PG8_SA
#undef PG8_SB
#undef PG8_STAGE
#undef PG8_LDA
#undef PG8_LDB
#undef PG8_MMA
#undef PG8_WAIT_V
#undef PG8_WAIT_L
#undef PG8_BAR
#undef PG8_SCHED
}
}

constexpr int NWAVES = 8;
constexpr int BATCH = 8, SEQ = 4096, DM = 2048, DEPTH = 4, DFF = 8192, T = BATCH * SEQ;
constexpr int A_HEADS = 32, A_QR = 512, A_KVR = 256, IDX_H = 16, IDX_D = 128, TOPK = 256, A_IN = 912, A_INP = 1024;
constexpr int B_HEADS = 16, B_HD = 128, B_INC = 3 * DM;
constexpr int MODW = 6 * DM;
constexpr float RMS_EPS = 1e-6f;
enum { IN_X = 0, IN_C, IN_RELB, IN_ADAW, IN_ADAB, IN_NORMG, IN_AWIN, IN_AQN, IN_AKVN, IN_AIKN, IN_AWQB, IN_AWIQB, IN_AWUK, IN_AWUV, IN_AWOUT, IN_BWIN, IN_BWOUT, IN_W1, IN_W2, N_IN };

constexpr size_t MiB = 1u << 20;
constexpr size_t WS_CTL = 0, CTL_ZERO_BYTES = 1 * MiB;
constexpr size_t WS_MOD = 1 * MiB;
constexpr size_t WS_MODP = 3 * MiB;
constexpr size_t WS_WAIN = 16 * MiB;
constexpr size_t WS_WQC = 24 * MiB;
constexpr size_t WS_WUV = 44 * MiB;
constexpr size_t WS_WAOUT = 52 * MiB;
constexpr size_t WS_WBIN = 84 * MiB;
constexpr size_t WS_WBOUT = 132 * MiB;
constexpr size_t WS_WM1 = 148 * MiB;
constexpr size_t WS_WM2 = 276 * MiB;
constexpr size_t WS_H = 404 * MiB;
constexpr size_t WS_P = 532 * MiB;
constexpr size_t WS_BIG = 788 * MiB;
constexpr size_t WS_QLAT = 1300 * MiB;
constexpr size_t WS_CKV = 1332 * MiB;
constexpr size_t WS_KIDX = 1348 * MiB;
constexpr size_t WS_WIDX = 1356 * MiB;
constexpr size_t WS_IDX = 1358 * MiB;
constexpr size_t WS_END = 1390 * MiB;
constexpr int CW_BAR = 4096;
constexpr int CW_SBQ = 8192;

constexpr int LDS_BYTES = 163840;
constexpr int MISC_OFF = LDS_BYTES - 256;

#define GAS __attribute__((address_space(1)))
#define LAS __attribute__((address_space(3)))
typedef unsigned short bf16;
typedef unsigned v4u __attribute__((ext_vector_type(4)));
typedef unsigned v2u __attribute__((ext_vector_type(2)));
typedef float f32x4 __attribute__((ext_vector_type(4)));
typedef float f32x2 __attribute__((ext_vector_type(2)));
typedef __bf16 bf16x2_t __attribute__((ext_vector_type(2)));
#define LDS_WAIT() asm volatile("s_waitcnt lgkmcnt(0)" ::: "memory")
#define VM_WAIT() asm volatile("s_waitcnt vmcnt(0)" ::: "memory")
__device__ __forceinline__ unsigned f2bf(float f) { unsigned u = __builtin_bit_cast(unsigned, f); return (u + 0x7fffu + ((u >> 16) & 1u)) >> 16; }
__device__ __forceinline__ unsigned pk2(float lo, float hi) { return f2bf(lo) | (f2bf(hi) << 16); }
__device__ __forceinline__ float bflo(unsigned u) { return __builtin_bit_cast(float, u << 16); }
__device__ __forceinline__ float bfhi(unsigned u) { return __builtin_bit_cast(float, u & 0xffff0000u); }
__device__ __forceinline__ float dot2bf(unsigned a, unsigned b, float c) { return __builtin_amdgcn_fdot2_f32_bf16(__builtin_bit_cast(bf16x2_t, a), __builtin_bit_cast(bf16x2_t, b), c, false); }
#define DPP_F(v, ctrl) __builtin_bit_cast(float, __builtin_amdgcn_update_dpp(0, __builtin_bit_cast(int, (v)), (ctrl), 0xf, 0xf, true))
#define RDL_F(v, l) __builtin_bit_cast(float, __builtin_amdgcn_readlane(__builtin_bit_cast(int, (v)), (l)))
__device__ __forceinline__ float wave_sum(float v, int) {
    v += DPP_F(v, 0xB1); v += DPP_F(v, 0x4E); v += DPP_F(v, 0x124); v += DPP_F(v, 0x128);
    return (RDL_F(v, 0) + RDL_F(v, 16)) + (RDL_F(v, 32) + RDL_F(v, 48));
}
__device__ __forceinline__ float wave_max(float v, int) {
    v = fmaxf(v, DPP_F(v, 0xB1)); v = fmaxf(v, DPP_F(v, 0x4E)); v = fmaxf(v, DPP_F(v, 0x124)); v = fmaxf(v, DPP_F(v, 0x128));
    return fmaxf(fmaxf(RDL_F(v, 0), RDL_F(v, 16)), fmaxf(RDL_F(v, 32), RDL_F(v, 48)));
}
__device__ __forceinline__ float shx(float v, int, int lane) {
    const unsigned u = __builtin_bit_cast(unsigned, v);
    auto r = __builtin_amdgcn_permlane32_swap(u, u, false, false);
    return __builtin_bit_cast(float, (lane & 32) ? r[0] : r[1]);
}

#define XB_TMO      128
#define XB_XCNT(j)  (256  + 64 * (j))
#define XB_XSUB(j)  (1280 + 64 * (j))
#define XB_XGEN(j)  (2304 + 64 * (j))
#define XB_TOP      3328
#define XB_TOPGEN   3392
#define XCD_BAR_WORDS 3456
#define XB_SPIN_CAP (1u << 22)

__device__ __forceinline__ unsigned xb_ld(unsigned* p)              { return __hip_atomic_load(p, __ATOMIC_RELAXED, __HIP_MEMORY_SCOPE_AGENT); }
__device__ __forceinline__ unsigned xb_add(unsigned* p, unsigned v) { return __hip_atomic_fetch_add(p, v, __ATOMIC_RELAXED, __HIP_MEMORY_SCOPE_AGENT); }
__device__ __forceinline__ unsigned xb_xcc_id() { return (unsigned)__builtin_amdgcn_s_getreg((3 << 11) | 20) & 0xFu; }
#define XB_SPIN(cond, bar) do { unsigned _sp = 0; while (cond) { __builtin_amdgcn_s_sleep(1); \
    if ((++_sp & 255u) == 0u) { if (xb_ld(&(bar)[XB_TMO])) break; if (_sp > XB_SPIN_CAP) { atomicAdd(&(bar)[XB_TMO], 1u); break; } } } } while (0)

struct XcdBarrier {
    unsigned* bar; unsigned x;
    volatile LAS unsigned* st;
};

__device__ __forceinline__ XcdBarrier xcd_barrier_post(unsigned* bar, volatile LAS unsigned* st) {
    XcdBarrier b; b.bar = bar; b.x = xb_xcc_id(); b.st = st;
    if (threadIdx.x == 0) (void)xb_add(&bar[XB_XCNT(b.x)], 1u);
    return b;
}
__device__ __forceinline__ void xcd_barrier_complete(unsigned* bar, unsigned x, unsigned& nloc, unsigned& nx) {
    const unsigned G = gridDim.x * gridDim.y * gridDim.z;
    unsigned sum, cnt, mine, sp = 0u;
    for (;;) {
        sum = 0u; cnt = 0u; mine = 0u;
#pragma unroll
        for (unsigned j = 0; j < 16; ++j) { const unsigned c = xb_ld(&bar[XB_XCNT(j)]); sum += c; cnt += (c > 0u) ? 1u : 0u; mine = (j == x) ? c : mine; }
        if (sum == G) break;
        __builtin_amdgcn_s_sleep(1);
        if ((++sp & 255u) == 0u) { if (xb_ld(&bar[XB_TMO])) break; if (sp > XB_SPIN_CAP) { atomicAdd(&bar[XB_TMO], 1u); break; } }
    }
    nloc = mine > 0u ? mine : 1u; nx = cnt > 0u ? cnt : 1u;
}

template <bool CENSUS> __device__ __forceinline__ void xcd_barrier(const XcdBarrier& b) {
    asm volatile("s_waitcnt vmcnt(0)" ::: "memory");
    __syncthreads();
    if (threadIdx.x == 0) {
        unsigned* bar = b.bar;
        __builtin_amdgcn_s_waitcnt(0);
        unsigned nloc = b.st[0], nx = b.st[1];
        if (CENSUS) { if (nloc == 0u) { xcd_barrier_complete(bar, b.x, nloc, nx); b.st[0] = nloc; b.st[1] = nx; } }
        const unsigned old = xb_add(&bar[XB_XSUB(b.x)], 1u);
        const unsigned gen = old / nloc;
        if (old + 1u == (gen + 1u) * nloc) {
            __builtin_amdgcn_fence(__ATOMIC_RELEASE, "agent");
            asm volatile("s_waitcnt vmcnt(0)" ::: "memory");
            const unsigned og = xb_add(&bar[XB_TOP], 1u);
            const unsigned tg = og / nx;
            if (og + 1u == (tg + 1u) * nx) xb_add(&bar[XB_TOPGEN], 1u);
            else XB_SPIN(xb_ld(&bar[XB_TOPGEN]) == tg, bar);
            __builtin_amdgcn_fence(__ATOMIC_ACQUIRE, "agent");
            xb_add(&bar[XB_XGEN(b.x)], 1u);
            asm volatile("s_waitcnt vmcnt(0)" ::: "memory");
        } else {
            XB_SPIN(xb_ld(&bar[XB_XGEN(b.x)]) == gen, bar);
            __builtin_amdgcn_fence(__ATOMIC_ACQUIRE, "agent");
            asm volatile("s_waitcnt vmcnt(0)" ::: "memory");
        }
    }
    __syncthreads();
}

struct Args { const float* in[N_IN]; float* out; unsigned char* ws; int ph_lo, ph_hi; };
#define CAS __attribute__((address_space(4)))
struct Frame {
    LAS unsigned char* lds;
    int tid, lane, wave, G;
    const CAS Args* ap;
    float* out; unsigned char* ws;
    __device__ __forceinline__ const float* inp(int i) const { return ap->in[i]; }
};
#define WSP(type, off) ((type*)(F.ws + (off)))

__device__ __forceinline__ void p0_transpose_item(const float* W, int Nsrc, bf16* dst, int ldo, LAS float* scr, int kb, int nb, int lane) {
    const int k0 = 64 * kb, n0 = 32 * nb, rsub = lane >> 3, c4 = lane & 7, nn = n0 + 4 * c4;
    f32x4 v[8];
#pragma unroll
    for (int i = 0; i < 8; ++i) v[i] = (nn < Nsrc) ? *(const f32x4*)(W + (size_t)(k0 + 8 * i + rsub) * Nsrc + nn) : (f32x4){0.f, 0.f, 0.f, 0.f};
#pragma unroll
    for (int i = 0; i < 8; ++i) { LAS float* d = scr + (8 * i + rsub) * 33 + 4 * c4; d[0] = v[i].x; d[1] = v[i].y; d[2] = v[i].z; d[3] = v[i].w; }
    LDS_WAIT(); asm volatile("" ::: "memory");
    const int c = lane & 7;
#pragma unroll
    for (int j = 0; j < 4; ++j) { const int n = (lane >> 3) + 8 * j; const LAS float* s = scr + (8 * c) * 33 + n;
        v4u o; o.x = pk2(s[0 * 33], s[1 * 33]); o.y = pk2(s[2 * 33], s[3 * 33]); o.z = pk2(s[4 * 33], s[5 * 33]); o.w = pk2(s[6 * 33], s[7 * 33]);
        *(v4u*)(dst + (size_t)(n0 + n) * ldo + k0 + 8 * c) = o; }
    LDS_WAIT(); asm volatile("" ::: "memory");
}
__device__ __forceinline__ void p0_tr_load(f32x4 (&v)[8], const float* W, int Nsrc, int kb, int nb, int lane) {
    const int k0 = 64 * kb, rsub = lane >> 3, nn = 32 * nb + 4 * (lane & 7);
#pragma unroll
    for (int i = 0; i < 8; ++i) v[i] = (nn < Nsrc) ? *(const f32x4*)(W + (size_t)(k0 + 8 * i + rsub) * Nsrc + nn) : (f32x4){0.f, 0.f, 0.f, 0.f};
}
__device__ __forceinline__ void p0_tr_store(const f32x4 (&v)[8], bf16* dst, int ldo, LAS float* scr, int kb, int nb, int lane) {
    const int k0 = 64 * kb, n0 = 32 * nb, rsub = lane >> 3, c4 = lane & 7;
#pragma unroll
    for (int i = 0; i < 8; ++i) { LAS float* d = scr + (8 * i + rsub) * 33 + 4 * c4; d[0] = v[i].x; d[1] = v[i].y; d[2] = v[i].z; d[3] = v[i].w; }
    LDS_WAIT(); asm volatile("" ::: "memory");
    const int c = lane & 7;
#pragma unroll
    for (int j = 0; j < 4; ++j) { const int n = (lane >> 3) + 8 * j; const LAS float* s = scr + (8 * c) * 33 + n;
        v4u o; o.x = pk2(s[0 * 33], s[1 * 33]); o.y = pk2(s[2 * 33], s[3 * 33]); o.z = pk2(s[4 * 33], s[5 * 33]); o.w = pk2(s[6 * 33], s[7 * 33]);
        *(v4u*)(dst + (size_t)(n0 + n) * ldo + k0 + 8 * c) = o; }
    LDS_WAIT(); asm volatile("" ::: "memory");
}
__device__ __forceinline__ void p0_transpose_job(Frame& F, const float* src, size_t sstride, int nmat, int K, int Nsrc, int Npad, bf16* dst, size_t dstride, int ldo) {
    LAS float* scr = (LAS float*)(F.lds + F.wave * 16384);
    const int gw = blockIdx.x * NWAVES + F.wave, NGW = F.G * NWAVES;
    const int nkb = K / 64, nnb = Npad / 32, per = nkb * nnb, tot = nmat * per;
    int it = gw;
    f32x4 v[8], vn[8];
    if (it < tot) { const int m = it / per, r = it % per; p0_tr_load(v, src + (size_t)m * sstride, Nsrc, r / nnb, r % nnb, F.lane); }
    while (it < tot) {
        const int nx = it + NGW;
        if (nx < tot) { const int m = nx / per, r = nx % per; p0_tr_load(vn, src + (size_t)m * sstride, Nsrc, r / nnb, r % nnb, F.lane); }
        { const int m = it / per, r = it % per; p0_tr_store(v, dst + (size_t)m * dstride, ldo, scr, r / nnb, r % nnb, F.lane); }
#pragma unroll
        for (int i = 0; i < 8; ++i) v[i] = vn[i];
        it = nx;
    }
}
__device__ __forceinline__ void ph_prologue(Frame& F) {
    {
        LAS float* sl = (LAS float*)(F.lds);
        LAS float* red = (LAS float*)(F.lds + 8192);
        const float* cin = F.inp(IN_C); const float* ada_w = F.inp(IN_ADAW); float* modp = WSP(float, WS_MODP);
        for (int u = blockIdx.x; u < 768; u += F.G) {
            const int l = u / 192, r = u % 192, ec = r >> 3, dc = r & 7;
            __syncthreads();
            for (int i = F.tid; i < 2048; i += 512) { const int rr = i >> 3, b = i & 7; const float v = cin[b * DM + dc * 256 + rr]; sl[rr * 8 + b] = v / (1.f + __expf(-v)); }
            __syncthreads();
            const int cq = F.tid & 127, dq = F.tid >> 7;
            f32x4 acc[8];
#pragma unroll
            for (int b = 0; b < 8; ++b) acc[b] = (f32x4){0.f, 0.f, 0.f, 0.f};
            const float* wp = ada_w + ((size_t)l * DM + dc * 256 + dq * 64) * MODW + ec * 512 + cq * 4;
#pragma unroll 8
            for (int i = 0; i < 64; ++i) {
                const f32x4 w = *(const f32x4*)(wp + (size_t)i * MODW);
                const f32x4 s0 = *(const LAS f32x4*)(sl + (dq * 64 + i) * 8), s1 = *(const LAS f32x4*)(sl + (dq * 64 + i) * 8 + 4);
                acc[0] += w * s0.x; acc[1] += w * s0.y; acc[2] += w * s0.z; acc[3] += w * s0.w;
                acc[4] += w * s1.x; acc[5] += w * s1.y; acc[6] += w * s1.z; acc[7] += w * s1.w;
            }
#pragma unroll
            for (int b = 0; b < 8; ++b) *(LAS f32x4*)(red + (dq * 8 + b) * 512 + cq * 4) = acc[b];
            __syncthreads();
            { const int b = F.tid >> 6, c0 = (F.tid & 63) * 8;
#pragma unroll
              for (int k = 0; k < 2; ++k) {
                  const f32x4 s = (*(const LAS f32x4*)(red + (0 * 8 + b) * 512 + c0 + 4 * k) + *(const LAS f32x4*)(red + (1 * 8 + b) * 512 + c0 + 4 * k))
                                + (*(const LAS f32x4*)(red + (2 * 8 + b) * 512 + c0 + 4 * k) + *(const LAS f32x4*)(red + (3 * 8 + b) * 512 + c0 + 4 * k));
                  *(f32x4*)(modp + (((size_t)dc * 4 + l) * 8 + b) * MODW + ec * 512 + c0 + 4 * k) = s; } }
        }
        __syncthreads();
    }
    {
        LAS float* Bs = (LAS float*)(F.lds);
        LAS float* As = (LAS float*)(F.lds + 256 * 132 * 4);
        const float* wqb = F.inp(IN_AWQB); const float* wuk = F.inp(IN_AWUK); bf16* wqc = WSP(bf16, WS_WQC);
        for (int u = blockIdx.x; u < 1024; u += F.G) {
            const int j = u >> 9, h = (u & 511) >> 4, rb = u & 15, r0 = rb * 32;
            __syncthreads();
            const float* bsrc = wuk + ((size_t)j * A_HEADS + h) * 256 * 128;
            for (int i = F.tid; i < 256 * 32; i += 512) { const int row = i >> 5, c4 = i & 31; *(LAS f32x4*)(Bs + row * 132 + c4 * 4) = *(const f32x4*)(bsrc + row * 128 + c4 * 4); }
            for (int i = F.tid; i < 32 * 32; i += 512) { const int row = i >> 5, c4 = i & 31; *(LAS f32x4*)(As + row * 128 + c4 * 4) = *(const f32x4*)(wqb + ((size_t)j * A_QR + r0 + row) * 4096 + h * 128 + c4 * 4); }
            __syncthreads();
            const int c = F.tid & 255, rh = F.tid >> 8;
            float acc[16];
#pragma unroll
            for (int q = 0; q < 16; ++q) acc[q] = 0.f;
            for (int d4 = 0; d4 < 32; ++d4) {
                const f32x4 bv = *(const LAS f32x4*)(Bs + c * 132 + d4 * 4);
#pragma unroll
                for (int q = 0; q < 16; ++q) { const f32x4 av = *(const LAS f32x4*)(As + (rh * 16 + q) * 128 + d4 * 4); acc[q] += (av.x * bv.x + av.y * bv.y) + (av.z * bv.z + av.w * bv.w); }
            }
            bf16* orow = wqc + ((size_t)j * 10240 + h * 256 + c) * 512 + r0 + rh * 16;
            v4u o0, o1;
            o0.x = pk2(acc[0], acc[1]); o0.y = pk2(acc[2], acc[3]); o0.z = pk2(acc[4], acc[5]); o0.w = pk2(acc[6], acc[7]);
            o1.x = pk2(acc[8], acc[9]); o1.y = pk2(acc[10], acc[11]); o1.z = pk2(acc[12], acc[13]); o1.w = pk2(acc[14], acc[15]);
            *(v4u*)(orow) = o0; *(v4u*)(orow + 8) = o1;
        }
        __syncthreads();
    }
    p0_transpose_job(F, F.inp(IN_AWIN), (size_t)DM * A_IN, 2, DM, A_IN, A_INP, WSP(bf16, WS_WAIN), (size_t)A_INP * DM, DM);
    p0_transpose_job(F, F.inp(IN_AWIQB), (size_t)A_QR * 2048, 2, A_QR, 2048, 2048, WSP(bf16, WS_WQC) + (size_t)8192 * 512, (size_t)10240 * 512, 512);
    p0_transpose_job(F, F.inp(IN_AWOUT), (size_t)4096 * DM, 2, 4096, DM, DM, WSP(bf16, WS_WAOUT), (size_t)DM * 4096, 4096);
    p0_transpose_job(F, F.inp(IN_BWIN), (size_t)DM * B_INC, 2, DM, B_INC, B_INC, WSP(bf16, WS_WBIN), (size_t)B_INC * DM, DM);
    p0_transpose_job(F, F.inp(IN_BWOUT), (size_t)DM * DM, 2, DM, DM, DM, WSP(bf16, WS_WBOUT), (size_t)DM * DM, DM);
    p0_transpose_job(F, F.inp(IN_W1), (size_t)DM * DFF, 4, DM, DFF, DFF, WSP(bf16, WS_WM1), (size_t)DFF * DM, DM);
    p0_transpose_job(F, F.inp(IN_W2), (size_t)DFF * DM, 4, DFF, DM, DM, WSP(bf16, WS_WM2), (size_t)DM * DFF, DFF);
    {
        LAS float* scr = (LAS float*)(F.lds + F.wave * 16384);
        const int gw = blockIdx.x * NWAVES + F.wave, NGW = F.G * NWAVES;
        const float* wuv = F.inp(IN_AWUV); bf16* d0 = WSP(bf16, WS_WUV);
        for (int it = gw; it < 64 * 16; it += NGW) {
            const int m = it >> 4, r = it & 15, j = m >> 5, h = m & 31;
            bf16* dst = d0 + (size_t)j * 4096 * 512 + (size_t)((h >> 1) * 256 + (h & 1) * 128) * 512 + (h & 1) * 256;
            p0_transpose_item(wuv + (size_t)m * 256 * 128, 128, dst, 512, scr, r >> 2, r & 3, F.lane);
        }
        const int gt = blockIdx.x * 512 + F.tid, NT = F.G * 512;
        for (int i = gt; i < 2 * 4096 * 32; i += NT) {
            const int row = i >> 5, ch = i & 31, hh = (row >> 7) & 1;
            *(v4u*)(d0 + (size_t)row * 512 + (1 - hh) * 256 + ch * 8) = (v4u){0u, 0u, 0u, 0u};
        }
    }
}
__device__ __forceinline__ void ph_modreduce(Frame& F) {
    const float* modp = WSP(float, WS_MODP); float* mod = WSP(float, WS_MOD); const float* ada_b = F.inp(IN_ADAB);
    const int gt = blockIdx.x * 512 + F.tid, NT = F.G * 512;
    for (int i = gt; i < DEPTH * BATCH * MODW / 4; i += NT) {
        const int e4 = i % (MODW / 4), lb = i / (MODW / 4), l = lb >> 3;
        f32x4 s = *(const f32x4*)(ada_b + (size_t)l * MODW + e4 * 4);
#pragma unroll
        for (int dc = 0; dc < 8; ++dc) s += *(const f32x4*)(modp + ((size_t)dc * 32 + lb) * MODW + e4 * 4);
        *(f32x4*)(mod + (size_t)lb * MODW + e4 * 4) = s;
    }
}

__device__ __forceinline__ void ph_post(Frame& F, const bf16* y, const void* xin_, bool xin_f32, void* xout_, bool xout_f32, const float* gate, const float* gy, bf16* hout, const float* gh, const float* shift, const float* scale) {
    LAS float* vec = (LAS float*)F.lds;
    const int rlo = (int)(((long long)blockIdx.x * T) / F.G), rhi = (int)(((long long)(blockIdx.x + 1) * T) / F.G);
    for (int seg = rlo; seg < rhi; ) {
        const int b = seg / SEQ; const int send = ((b + 1) * SEQ < rhi) ? (b + 1) * SEQ : rhi;
        __syncthreads();
        for (int i = F.tid; i < 5 * (DM / 4); i += NWAVES * 64) { const int v = i / (DM / 4), c4 = i % (DM / 4);
            const float* src = (v == 0) ? (y ? gate + (size_t)b * MODW : nullptr) : (v == 1) ? (y ? gy : nullptr) : (v == 2) ? (hout ? gh : nullptr) : (v == 3) ? (hout ? shift + (size_t)b * MODW : nullptr) : (hout ? scale + (size_t)b * MODW : nullptr);
            *(LAS f32x4*)(vec + v * DM + 4 * c4) = src ? *(const f32x4*)(src + 4 * c4) : (f32x4){0.f, 0.f, 0.f, 0.f}; }
        __syncthreads();
        constexpr int NR = 2;
        for (int r0 = seg + 2 * F.wave; r0 < send; r0 += NR * NWAVES) {
            const int r1 = (r0 + 1 < send) ? r0 + 1 : r0;
            int e0 = 4 * F.lane; asm volatile("" : "+v"(e0));
            f32x4 x[NR][8]; v2u yp[NR][8];
            if (xin_f32) { const float* xin = (const float*)xin_;
#pragma unroll
                for (int q = 0; q < NR; ++q) { const int row = q ? r1 : r0;
#pragma unroll
                    for (int j = 0; j < 8; ++j) x[q][j] = *(const f32x4*)(xin + (size_t)row * DM + e0 + 256 * j); }
                if (y) {
#pragma unroll
                    for (int q = 0; q < NR; ++q) { const int row = q ? r1 : r0;
#pragma unroll
                        for (int j = 0; j < 8; ++j) yp[q][j] = *(const v2u*)(y + (size_t)row * DM + e0 + 256 * j); } }
            } else { const bf16* xin = (const bf16*)xin_; v2u xp[NR][8];
#pragma unroll
                for (int q = 0; q < NR; ++q) { const int row = q ? r1 : r0;
#pragma unroll
                    for (int j = 0; j < 8; ++j) xp[q][j] = *(const v2u*)(xin + (size_t)row * DM + e0 + 256 * j); }
                if (y) {
#pragma unroll
                    for (int q = 0; q < NR; ++q) { const int row = q ? r1 : r0;
#pragma unroll
                        for (int j = 0; j < 8; ++j) yp[q][j] = *(const v2u*)(y + (size_t)row * DM + e0 + 256 * j); } }
#pragma unroll
                for (int q = 0; q < NR; ++q) {
#pragma unroll
                    for (int j = 0; j < 8; ++j) { const v2u p = xp[q][j]; x[q][j] = (f32x4){bflo(p.x), bfhi(p.x), bflo(p.y), bfhi(p.y)}; } }
            }
#pragma unroll
            for (int q = 0; q < NR; ++q) { const int row = q ? r1 : r0;
                if (y) {
                    f32x4 yv[8]; float ss = 0.f;
#pragma unroll
                    for (int j = 0; j < 8; ++j) { const v2u p = yp[q][j]; yv[j] = (f32x4){bflo(p.x), bfhi(p.x), bflo(p.y), bfhi(p.y)};
                        ss += (yv[j].x * yv[j].x + yv[j].y * yv[j].y) + (yv[j].z * yv[j].z + yv[j].w * yv[j].w); }
                    const float ry = 1.0f / sqrtf(wave_sum(ss, F.lane) * (1.f / DM) + RMS_EPS);
#pragma unroll
                    for (int j = 0; j < 8; ++j) { const f32x4 g = *(const LAS f32x4*)(vec + 1 * DM + e0 + 256 * j), gt = *(const LAS f32x4*)(vec + 0 * DM + e0 + 256 * j);
                        x[q][j] += gt * (yv[j] * ry * g); }
                    if (xout_f32) { float* xout = (float*)xout_;
#pragma unroll
                        for (int j = 0; j < 8; ++j) *(f32x4*)(xout + (size_t)row * DM + e0 + 256 * j) = x[q][j];
                    } else { bf16* xout = (bf16*)xout_;
#pragma unroll
                        for (int j = 0; j < 8; ++j) { v2u o; o.x = pk2(x[q][j].x, x[q][j].y); o.y = pk2(x[q][j].z, x[q][j].w); *(v2u*)(xout + (size_t)row * DM + e0 + 256 * j) = o; } }
                }
                if (hout) {
                    float ss = 0.f;
#pragma unroll
                    for (int j = 0; j < 8; ++j) ss += (x[q][j].x * x[q][j].x + x[q][j].y * x[q][j].y) + (x[q][j].z * x[q][j].z + x[q][j].w * x[q][j].w);
                    const float rx = 1.0f / sqrtf(wave_sum(ss, F.lane) * (1.f / DM) + RMS_EPS);
#pragma unroll
                    for (int j = 0; j < 8; ++j) { const f32x4 g = *(const LAS f32x4*)(vec + 2 * DM + e0 + 256 * j), sh = *(const LAS f32x4*)(vec + 3 * DM + e0 + 256 * j), sc = *(const LAS f32x4*)(vec + 4 * DM + e0 + 256 * j);
                        const f32x4 hv = (x[q][j] * rx * g) * (sc + 1.0f) + sh;
                        v2u o; o.x = pk2(hv.x, hv.y); o.y = pk2(hv.z, hv.w);
                        *(v2u*)(hout + (size_t)row * DM + e0 + 256 * j) = o; }
                }
            }
        }
        seg = send;
    }
}
__device__ __forceinline__ void ph_dsa_norm(Frame& F, const float* proj, const float* qn, const float* kvn, const float* ikn, bf16* qlat, bf16* ckv, bf16* kidx, float* widx) {
    const int gw = blockIdx.x * NWAVES + F.wave, NGW = F.G * NWAVES; const int e0 = 4 * F.lane;
    for (int row = gw; row < T; row += NGW) {
        f32x4 v[4];
#pragma unroll
        for (int j = 0; j < 4; ++j) v[j] = *(const f32x4*)(proj + (size_t)row * A_INP + e0 + 256 * j);
        float sq = 0.f;
#pragma unroll
        for (int j = 0; j < 2; ++j) sq += (v[j].x * v[j].x + v[j].y * v[j].y) + (v[j].z * v[j].z + v[j].w * v[j].w);
        const float rq = 1.0f / sqrtf(wave_sum(sq, F.lane) * (1.f / A_QR) + RMS_EPS);
#pragma unroll
        for (int j = 0; j < 2; ++j) { const f32x4 g = *(const f32x4*)(qn + e0 + 256 * j); const f32x4 o = v[j] * rq * g; v2u w; w.x = pk2(o.x, o.y); w.y = pk2(o.z, o.w);
            *(v2u*)(qlat + (size_t)row * A_QR + e0 + 256 * j) = w; }
        const float skv = (v[2].x * v[2].x + v[2].y * v[2].y) + (v[2].z * v[2].z + v[2].w * v[2].w);
        const float rkv = 1.0f / sqrtf(wave_sum(skv, F.lane) * (1.f / A_KVR) + RMS_EPS);
        { const f32x4 g = *(const f32x4*)(kvn + e0); const f32x4 o = v[2] * rkv * g; v2u w; w.x = pk2(o.x, o.y); w.y = pk2(o.z, o.w); *(v2u*)(ckv + (size_t)row * A_KVR + e0) = w; }
        const bool isk = F.lane < 32;
        const float s1 = isk ? (v[3].x + v[3].y) + (v[3].z + v[3].w) : 0.f;
        const float mean = wave_sum(s1, F.lane) * (1.f / IDX_D);
        const f32x4 dv = v[3] - mean;
        const float s2 = isk ? (dv.x * dv.x + dv.y * dv.y) + (dv.z * dv.z + dv.w * dv.w) : 0.f;
        const float rk = 1.0f / sqrtf(wave_sum(s2, F.lane) * (1.f / IDX_D) + RMS_EPS);
        if (isk) { const f32x4 g = *(const f32x4*)(ikn + e0); const f32x4 o = dv * rk * g; v2u w; w.x = pk2(o.x, o.y); w.y = pk2(o.z, o.w); *(v2u*)(kidx + (size_t)row * IDX_D + e0) = w; }
        else if (F.lane < 36) { *(f32x4*)(widx + (size_t)row * IDX_H + (e0 - 128)) = v[3] * 0.02209708691207961f; }
    }
}

__device__ __forceinline__ int wave_scan_incl(int v, int lane, int& total) {
    v += __builtin_amdgcn_update_dpp(0, v, 0x111, 0xf, 0xf, true); v += __builtin_amdgcn_update_dpp(0, v, 0x112, 0xf, 0xf, true);
    v += __builtin_amdgcn_update_dpp(0, v, 0x114, 0xf, 0xf, true); v += __builtin_amdgcn_update_dpp(0, v, 0x118, 0xf, 0xf, true);
    const int t0 = __builtin_amdgcn_readlane(v, 15), t1 = __builtin_amdgcn_readlane(v, 31), t2 = __builtin_amdgcn_readlane(v, 47), t3 = __builtin_amdgcn_readlane(v, 63);
    v += (lane >= 16 ? t0 : 0) + (lane >= 32 ? t1 : 0) + (lane >= 48 ? t2 : 0);
    total = (t0 + t1) + (t2 + t3);
    return v;
}
template <bool G, class SP> __device__ __forceinline__ void topk_select_row(SP sc, int t, int* out, int lane, LAS int* lst) {
    const int n = t + 1;
    if (n <= TOPK) { for (int i = lane; i < TOPK; i += 64) out[i] = (i < n) ? i : 0; return; }
    const int ni = G ? 2 * ((n + 127) >> 7) : (n + 63) >> 6;
#define TOPK_KEYIDX(i) (G ? 128 * ((i) >> 1) + 2 * lane + ((i) & 1) : 64 * (i) + lane)
    unsigned key[64];
#pragma unroll
    for (int g = 0; g < 8; ++g) {
        if (8 * g < ni) {
            if constexpr (G) {
#pragma unroll
                for (int j = 4 * g; j < 4 * g + 4; ++j) { const unsigned d = __hip_atomic_load((const unsigned*)sc + 64 * j + lane, __ATOMIC_RELAXED, __HIP_MEMORY_SCOPE_AGENT);
#pragma unroll
                    for (int e = 0; e < 2; ++e) { const int s = 128 * j + 2 * lane + e; const unsigned h = e ? (d >> 16) : (d & 0xffffu); const unsigned k = (h & 0x8000u) ? (~h & 0xffffu) : (h | 0x8000u); key[2 * j + e] = (s < n) ? k : 0u; } }
            } else {
#pragma unroll
                for (int i = 8 * g; i < 8 * g + 8; ++i) { const int s = 64 * i + lane; const unsigned h = sc[s < n ? s : n - 1]; const unsigned k = (h & 0x8000u) ? (~h & 0xffffu) : (h | 0x8000u); key[i] = (s < n) ? k : 0u; }
            }
        } else {
#pragma unroll
            for (int i = 8 * g; i < 8 * g + 8; ++i) key[i] = 0u;
        }
    }
    unsigned prefix = 0u;
    for (int bit = 15; bit >= 0; --bit) {
        const unsigned cand = prefix | (1u << bit); int cl = 0;
#pragma unroll
        for (int g = 0; g < 8; ++g) if (8 * g < ni) {
#pragma unroll
            for (int i = 8 * g; i < 8 * g + 8; ++i) cl += (key[i] >= cand) ? 1 : 0; }
        cl += __builtin_amdgcn_update_dpp(0, cl, 0xB1, 0xf, 0xf, true); cl += __builtin_amdgcn_update_dpp(0, cl, 0x4E, 0xf, 0xf, true);
        cl += __builtin_amdgcn_update_dpp(0, cl, 0x124, 0xf, 0xf, true); cl += __builtin_amdgcn_update_dpp(0, cl, 0x128, 0xf, 0xf, true);
        const int cnt = (__builtin_amdgcn_readlane(cl, 0) + __builtin_amdgcn_readlane(cl, 16)) + (__builtin_amdgcn_readlane(cl, 32) + __builtin_amdgcn_readlane(cl, 48));
        if (cnt >= TOPK) prefix = cand;
    }
    int cg = 0, ce = 0;
#pragma unroll
    for (int g = 0; g < 8; ++g) if (8 * g < ni) {
#pragma unroll
        for (int i = 8 * g; i < 8 * g + 8; ++i) { cg += (key[i] > prefix) ? 1 : 0; ce += (key[i] == prefix) ? 1 : 0; } }
    int tg, te;
    const int bg = wave_scan_incl(cg, lane, tg) - cg, be = wave_scan_incl(ce, lane, te) - ce;
    int quota = (TOPK - tg) - be; quota = quota < 0 ? 0 : (quota > ce ? ce : quota);
    int pg = bg, pe = tg + (be < TOPK - tg ? be : TOPK - tg);
    const int dummy = TOPK + lane;
#pragma unroll
    for (int g = 0; g < 8; ++g) if (8 * g < ni) {
#pragma unroll
        for (int i = 8 * g; i < 8 * g + 8; ++i) {
            const bool gt = key[i] > prefix, eq = (key[i] == prefix) && (quota > 0);
            const int pos = gt ? pg : (eq ? pe : dummy);
            lst[pos] = TOPK_KEYIDX(i);
            pg += gt ? 1 : 0; pe += eq ? 1 : 0; quota -= eq ? 1 : 0;
        } }
    asm volatile("s_waitcnt lgkmcnt(0)" ::: "memory");
    *(v4u*)(out + 4 * lane) = *(const LAS v4u*)(lst + 4 * lane);
#undef TOPK_KEYIDX
}
__device__ __forceinline__ int t5_bucket(int d) {
    if (d < 16) return d;
    int bkt = 16;
    bkt += (d >= 19) + (d >= 21) + (d >= 24) + (d >= 27) + (d >= 31) + (d >= 35) + (d >= 40) + (d >= 46) + (d >= 52) + (d >= 59) + (d >= 67) + (d >= 77) + (d >= 87) + (d >= 99) + (d >= 113);
    return bkt;
}

typedef short bf16x8 __attribute__((ext_vector_type(8)));
typedef short s16x4 __attribute__((ext_vector_type(4)));
typedef float f32x16 __attribute__((ext_vector_type(16)));
__device__ __forceinline__ unsigned offb(unsigned row, unsigned ch) { return 256u * row + 16u * (ch ^ (((row & 3u) << 2) | ((row >> 2) & 3u))); }
__device__ __forceinline__ unsigned tr_base_perm(unsigned lane, unsigned c, unsigned t) {
    const unsigned h = lane >> 5, blk = (lane >> 4) & 1u, q = (lane & 15u) >> 2, p = lane & 3u;
    return offb(8u * t + 4u * h + q, 4u * c + 2u * blk + (p >> 1)) + 8u * (p & 1u);
}
__device__ __forceinline__ bf16x8 tr_frag_at(LAS unsigned char* img, unsigned b0, unsigned b1, unsigned ks) {
    const s16x4 lo = __builtin_amdgcn_ds_read_tr16_b64_v4i16((LAS s16x4*)(img + b0 + 4096u * ks));
    const s16x4 hi = __builtin_amdgcn_ds_read_tr16_b64_v4i16((LAS s16x4*)(img + b1 + 4096u * ks));
    return __builtin_shufflevector(lo, hi, 0, 1, 2, 3, 4, 5, 6, 7);
}

__device__ __forceinline__ void ph_indexer(Frame& F, const bf16* qidx, const bf16* kidx, const float* widx, int* idxo) {
    constexpr int NQ = 8;
    LAS unsigned short* sc = (LAS unsigned short*)(F.lds);
    LAS float* wsh = (LAS float*)(F.lds + 65536);
    LAS unsigned char* ring = F.lds + 66560;
    const int r = F.lane & 31, hf = F.lane >> 5, rp = F.wave & 1, kq = F.wave >> 1;
    const int drow = 4 * F.wave + (F.lane >> 4), dch = (F.lane & 15) ^ (((F.lane >> 4) << 2) | (F.wave & 3));
    for (int u = blockIdx.x; u < BATCH * (SEQ / NQ); u += F.G) {
        const int b = u & 7, t0 = (u >> 3) * NQ;
        const int nt = (t0 + NQ + 31) >> 5, ns = (nt + 3) >> 2;
        const bf16* kbase = kidx + (size_t)(b * SEQ + drow) * IDX_D + dch * 8;
        __syncthreads();
#pragma unroll
        for (int j = 0; j < 4; ++j) __builtin_amdgcn_global_load_lds((const unsigned*)(kbase + (size_t)(j * 32) * IDX_D), (LAS unsigned*)(ring + j * 8192 + F.wave * 1024), 16, 0, 0);
        if (F.tid < NQ * 16) wsh[F.tid] = widx[(size_t)(b * SEQ + t0 + (F.tid >> 4)) * IDX_H + (F.tid & 15)];
        bf16x8 Af[2][8];
#pragma unroll
        for (int rt = 0; rt < 2; ++rt) { const int query = t0 + 4 * rp + 2 * rt + ((r >> 2) & 1), head = 4 * (r >> 3) + (r & 3);
            const bf16* ap = qidx + (size_t)(b * SEQ + query) * 2048 + head * 128 + 8 * hf;
#pragma unroll
            for (int ks = 0; ks < 8; ++ks) Af[rt][ks] = *(const bf16x8*)(ap + 16 * ks); }
        for (int s = 0; s < ns; ++s) {
            asm volatile("s_waitcnt vmcnt(0) lgkmcnt(0)" ::: "memory"); __builtin_amdgcn_s_barrier(); asm volatile("" ::: "memory");
            if (s + 1 < ns) {
#pragma unroll
                for (int j = 0; j < 4; ++j) __builtin_amdgcn_global_load_lds((const unsigned*)(kbase + (size_t)((4 * (s + 1) + j) * 32) * IDX_D), (LAS unsigned*)(ring + ((s + 1) & 1) * 32768 + j * 8192 + F.wave * 1024), 16, 0, 0);
            }
            const int kt = 4 * s + kq;
            if (kt < nt) {
                LAS unsigned char* tile = ring + (s & 1) * 32768 + kq * 8192;
                bf16x8 Bf[8];
#pragma unroll
                for (int ks = 0; ks < 8; ++ks) Bf[ks] = *(const LAS bf16x8*)(tile + offb((unsigned)r, (unsigned)(2 * ks + hf)));
#pragma unroll
                for (int rt = 0; rt < 2; ++rt) {
                    f32x16 acc;
#pragma unroll
                    for (int i = 0; i < 16; ++i) acc[i] = 0.f;
#pragma unroll
                    for (int ks = 0; ks < 8; ++ks) acc = __builtin_amdgcn_mfma_f32_32x32x16_bf16(Af[rt][ks], Bf[ks], acc, 0, 0, 0);
                    float s0 = 0.f, s1 = 0.f;
#pragma unroll
                    for (int i4 = 0; i4 < 4; ++i4) { const f32x4 w4 = *(const LAS f32x4*)(wsh + (4 * rp + 2 * rt + hf) * 16 + 4 * i4);
                        s0 += w4.x * fmaxf(acc[4 * i4], 0.f) + w4.z * fmaxf(acc[4 * i4 + 2], 0.f); s1 += w4.y * fmaxf(acc[4 * i4 + 1], 0.f) + w4.w * fmaxf(acc[4 * i4 + 3], 0.f); }
                    sc[(4 * rp + 2 * rt + hf) * 4096 + kt * 32 + r] = __builtin_bit_cast(unsigned short, (_Float16)(s0 + s1));
                }
            }
        }
        __syncthreads();
        for (int q = F.wave; q < NQ; q += NWAVES) topk_select_row<false>(sc + q * 4096, t0 + q, idxo + (size_t)(b * SEQ + t0 + q) * TOPK, F.lane, (LAS int*)(F.lds + 132096) + F.wave * 320);
    }
}

#define LDS_BARRIER() do { asm volatile("s_waitcnt lgkmcnt(0)" ::: "memory"); __builtin_amdgcn_s_barrier(); asm volatile("" ::: "memory"); } while (0)
__device__ __forceinline__ int relane(int lane) { asm volatile("" : "+v"(lane)); return lane; }
__device__ __forceinline__ void ph_sparse_attn(Frame& F, bf16* qa_olat, const bf16* ckv, const int* idxi, const float* relb) {
    LAS unsigned char* KV = F.lds;
    LAS unsigned char* PF = F.lds + 131072;
    LAS float* wmax = (LAS float*)(F.lds + 147456);
    LAS float* wsum = wmax + 256;
    LAS unsigned char* bks = F.lds + 147456 + 2048;
    LAS float* relbs = (LAS float*)(F.lds + 147456 + 2048 + 512);
    LAS float* invw = (LAS float*)(F.lds + 147456 + 2048 + 512 + 4224);
    LAS unsigned char* blut = F.lds + 147456 + 2048 + 512 + 4224 + 1024;
    const float scale = 0.08838834764831845f;
    const int w = F.wave;
    __syncthreads();
    for (int i = F.tid; i < 1024; i += 512) relbs[i] = relb[i];
    if (F.tid < 32) relbs[1024 + F.tid] = -INFINITY;
    if (F.tid < 128) blut[F.tid] = (unsigned char)t5_bucket(F.tid);
    int u = blockIdx.x;
    if (u >= T) return;
    int idc[16]; int bid; v4u R[16]; v4u Qr[2];
    {
        const int cc = F.lane & 31, r = F.lane & 31, hf = F.lane >> 5;
        const int t = u % SEQ, b = u / SEQ;
        const int* ip = idxi + (size_t)u * TOPK + 32 * w + hf;
#pragma unroll
        for (int k = 0; k < 16; ++k) idc[k] = ip[2 * k];
        const bf16* kb = ckv + (size_t)b * SEQ * A_KVR + cc * 8;
#pragma unroll
        for (int k = 0; k < 16; ++k) R[k] = *(const v4u*)(kb + (size_t)idc[k] * A_KVR);
        if (F.tid < 256) { const int id = idxi[(size_t)u * TOPK + F.tid]; const int d = t - id; bks[F.tid] = (F.tid <= t) ? (unsigned char)t5_bucket(d > 0 ? d : 0) : (unsigned char)32; }
        const int u2 = (u + F.G < T) ? u + F.G : u;
        const int* ip2 = idxi + (size_t)u2 * TOPK + 32 * w + hf;
#pragma unroll
        for (int k = 0; k < 16; ++k) idc[k] = ip2[2 * k];
        bid = (F.tid < 256) ? idxi[(size_t)u2 * TOPK + F.tid] : -1;
        { const v4u* qp = (const v4u*)(qa_olat + (size_t)u * A_HEADS * A_KVR);
#pragma unroll
          for (int j = 0; j < 2; ++j) { const int id = 2 * w + j, head = 8 * (id & 3) + (F.lane & 7), pos = 8 * (id >> 2) + (F.lane >> 3); Qr[j] = qp[head * 32 + pos]; } }
    }
    unsigned wro[16], qwo[2], trb[2];
    { const unsigned r0 = F.lane & 31, hf0 = F.lane >> 5; const unsigned c0 = (r0 & 15u) ^ (4u * hf0);
#pragma unroll
      for (int k = 0; k < 16; ++k) wro[k] = (r0 >> 4) * 65536u + 256u * (32u * w + hf0) + 512u * k + 16u * (c0 ^ (unsigned)(8 * (k & 1) + ((k >> 1) & 3)));
#pragma unroll
      for (int j = 0; j < 2; ++j) { const int id = 2 * w + j, head = 8 * (id & 3) + (F.lane & 7), pos = 8 * (id >> 2) + (F.lane >> 3); qwo[j] = (pos >> 1) * 1024 + ((pos & 1) * 32 + head) * 16; }
      trb[0] = tr_base_perm((unsigned)F.lane, (unsigned)(w & 3), 0u); trb[1] = tr_base_perm((unsigned)F.lane, (unsigned)(w & 3), 1u); }
    unsigned rdo[16];
    { const unsigned r0 = F.lane & 31, hf0 = F.lane >> 5, row = 32u * w + r0, xr = ((row & 3u) << 2) | ((row >> 2) & 3u);
#pragma unroll
      for (int ks = 0; ks < 16; ++ks) rdo[ks] = 256u * row + (ks >> 3) * 65536u + 16u * ((unsigned)(2 * (ks & 7) + hf0) ^ xr); }
    for (int it = 0; u < T; u += F.G, ++it) {
        const int un = u + F.G, unn = u + 2 * F.G, par = it & 1;
        LDS_BARRIER();
        const int l2 = relane(F.lane), r = l2 & 31, hf = l2 >> 5;
        {
#pragma unroll
          for (int k = 0; k < 16; ++k) *(LAS v4u*)(KV + wro[k]) = R[k]; }
        *(LAS v4u*)(PF + qwo[0]) = Qr[0]; *(LAS v4u*)(PF + qwo[1]) = Qr[1];
        LDS_BARRIER();
        const int tid1 = w * 64 + l2;
        const int unb = (un < T) ? un : u; const int bn = unb / SEQ, tn = unb % SEQ;
        const bf16* kbn = ckv + (size_t)bn * SEQ * A_KVR + r * 8;
        f32x16 acc;
#pragma unroll
        for (int i = 0; i < 16; ++i) acc[i] = 0.f;
        {
#pragma unroll
          for (int ks = 0; ks < 16; ++ks) { const bf16x8 a = *(const LAS bf16x8*)(KV + rdo[ks]);
              acc = __builtin_amdgcn_mfma_f32_32x32x16_bf16(a, *(const LAS bf16x8*)(PF + ks * 1024 + l2 * 16), acc, 0, 0, 0);
              R[ks] = *(const v4u*)(kbn + (size_t)idc[ks] * A_KVR); } }
        if (tid1 < 256) { int d = tn - bid; d = d < 0 ? 0 : (d > 127 ? 127 : d); bks[(par ^ 1) * 256 + tid1] = (tid1 <= tn) ? blut[d] : (unsigned char)32; }
        { const v4u* qp = (const v4u*)(qa_olat + (size_t)unb * A_HEADS * A_KVR);
#pragma unroll
          for (int j = 0; j < 2; ++j) { const int id = 2 * w + j, head = 8 * (id & 3) + (l2 & 7), pos = 8 * (id >> 2) + (l2 >> 3); Qr[j] = qp[head * 32 + pos]; } }
        float lg[16]; float m = -INFINITY;
#pragma unroll
        for (int g = 0; g < 4; ++g) { const unsigned b4 = *(const LAS unsigned*)(bks + par * 256 + 32 * w + 8 * g + 4 * hf);
#pragma unroll
            for (int j = 0; j < 4; ++j) { const unsigned bk = (b4 >> (8 * j)) & 255u; const int i = 4 * g + j;
                lg[i] = acc[i] * scale + relbs[bk * 32 + r]; m = fmaxf(m, lg[i]); } }
        m = fmaxf(m, shx(m, 32, l2));
        if (hf == 0) wmax[r * 8 + w] = m;
        LDS_BARRIER();
        { const f32x4 m0 = *(const LAS f32x4*)(wmax + r * 8), m1 = *(const LAS f32x4*)(wmax + r * 8 + 4);
          m = fmaxf(fmaxf(fmaxf(m0.x, m0.y), fmaxf(m0.z, m0.w)), fmaxf(fmaxf(m1.x, m1.y), fmaxf(m1.z, m1.w))); }
        float s = 0.f;
#pragma unroll
        for (int i = 0; i < 16; ++i) { lg[i] = __expf(lg[i] - m); s += lg[i]; }
        s += shx(s, 32, l2);
        if (hf == 0) wsum[r * 8 + w] = s;
#pragma unroll
        for (int s2 = 0; s2 < 2; ++s2) { v4u pk; pk.x = pk2(lg[8 * s2 + 0], lg[8 * s2 + 1]); pk.y = pk2(lg[8 * s2 + 2], lg[8 * s2 + 3]); pk.z = pk2(lg[8 * s2 + 4], lg[8 * s2 + 5]); pk.w = pk2(lg[8 * s2 + 6], lg[8 * s2 + 7]);
            *(LAS v4u*)(PF + (2 * w + s2) * 1024 + l2 * 16) = pk; }
        LDS_BARRIER();
        const int l3 = relane(F.lane), r3 = l3 & 31, hf3 = l3 >> 5;
        if (hf3 == 0) { const f32x4 s0 = *(const LAS f32x4*)(wsum + r3 * 8), s1 = *(const LAS f32x4*)(wsum + r3 * 8 + 4);
            invw[w * 32 + r3] = 1.0f / (((s0.x + s0.y) + (s0.z + s0.w)) + ((s1.x + s1.y) + (s1.z + s1.w))); }
        f32x16 o;
#pragma unroll
        for (int i = 0; i < 16; ++i) o[i] = 0.f;
        LAS unsigned char* img = KV + (w >> 2) * 65536;
        const int unc = (unn < T) ? unn : u;
        const int* ip2 = idxi + (size_t)unc * TOPK + 32 * w + hf3;
        const unsigned tb0 = trb[0], tb1 = trb[1];
#pragma unroll
        for (int ks = 0; ks < 16; ++ks) { const bf16x8 a = *(const LAS bf16x8*)(PF + ks * 1024 + l3 * 16);
            const bf16x8 bb = tr_frag_at(img, tb0, tb1, (unsigned)ks);
            o = __builtin_amdgcn_mfma_f32_32x32x16_bf16(a, bb, o, 0, 0, 0);
            idc[ks] = ip2[2 * ks]; }
        if (w * 64 + l3 < 256) bid = idxi[(size_t)unc * TOPK + w * 64 + l3];
        bf16* op = qa_olat + ((size_t)u * A_HEADS + 4 * hf3) * A_KVR + 32 * w + r3;
#pragma unroll
        for (int g = 0; g < 4; ++g) { const f32x4 iv = *(const LAS f32x4*)(invw + w * 32 + 8 * g + 4 * hf3);
            op[(8 * g + 0) * A_KVR] = (bf16)f2bf(o[4 * g + 0] * iv.x); op[(8 * g + 1) * A_KVR] = (bf16)f2bf(o[4 * g + 1] * iv.y);
            op[(8 * g + 2) * A_KVR] = (bf16)f2bf(o[4 * g + 2] * iv.z); op[(8 * g + 3) * A_KVR] = (bf16)f2bf(o[4 * g + 3] * iv.w); }
    }
}

__device__ __forceinline__ void ph_sb_attn(Frame& F, const bf16* qkv, bf16* o_out, unsigned* qctr) {
    LAS unsigned char* img = F.lds + F.wave * 8192;
    LAS unsigned char* qimg = F.lds + 65536 + F.wave * 8192;
    const int r = F.lane & 31, hf = F.lane >> 5;
    const float scale = 0.08838834764831845f;
    constexpr int NTASK8 = BATCH * B_HEADS * (SEQ / 32) / 8;
    const int myx = (int)(xb_xcc_id() & 7u);
    for (int qi = 0; qi < 8; ++qi) { const int qsel = (myx + qi) & 7;
    for (;;) {
        int task = 0;
        if (F.lane == 0) task = (int)__hip_atomic_fetch_add(qctr + 64 * qsel, 1u, __ATOMIC_RELAXED, __HIP_MEMORY_SCOPE_AGENT);
        task = __builtin_amdgcn_readfirstlane(task);
        if (task >= NTASK8) break;
        task += qsel * NTASK8;
        const int qt = task & 127, bh = task >> 7, h = bh & 15, b = bh >> 4, t0 = qt * 32;
        v4u Kr[8], Vr[8];
#pragma unroll
        for (int k = 0; k < 8; ++k) { const int n = F.lane + 64 * k; *(LAS v4u*)(qimg + offb(n >> 4, n & 15)) = *(const v4u*)(qkv + (size_t)(b * SEQ + t0 + (n >> 4)) * B_INC + h * B_HD + (n & 15) * 8); }
        {
#pragma unroll
          for (int k = 0; k < 8; ++k) { const int n = F.lane + 64 * k; const bf16* rp = qkv + (size_t)(b * SEQ + qt * 32 + (n >> 4)) * B_INC + h * B_HD + (n & 15) * 8; Kr[k] = *(const v4u*)(rp + DM); Vr[k] = *(const v4u*)(rp + 2 * DM); } }
        f32x16 o[4];
#pragma unroll
        for (int dt = 0; dt < 4; ++dt)
#pragma unroll
            for (int i = 0; i < 16; ++i) o[dt][i] = 0.f;
        float Rc = 1.f;
        for (int kt = qt; kt >= 0; --kt) {
            const int ll = relane(F.lane), r = ll & 31, hf = ll >> 5;
#pragma unroll
            for (int k = 0; k < 8; ++k) { const int n = ll + 64 * k; *(LAS v4u*)(img + offb(n >> 4, n & 15)) = Kr[k]; }
            f32x16 acc;
#pragma unroll
            for (int i = 0; i < 16; ++i) acc[i] = 0.f;
#pragma unroll
            for (int ks = 0; ks < 8; ++ks) acc = __builtin_amdgcn_mfma_f32_32x32x16_bf16(*(const LAS bf16x8*)(img + offb(r, 2 * ks + hf)), *(const LAS bf16x8*)(qimg + offb(r, 2 * ks + hf)), acc, 0, 0, 0);
            asm volatile("s_waitcnt lgkmcnt(0)" ::: "memory");
#pragma unroll
            for (int k = 0; k < 8; ++k) { const int n = ll + 64 * k; *(LAS v4u*)(img + offb(n >> 4, n & 15)) = Vr[k]; }
            float be[16], om[16];
            const bool diag = (kt == qt);
#pragma unroll
            for (int i = 0; i < 16; ++i) { const float z = fminf(acc[i] * scale, 80.f);
                const float e = __expf(z), rr = __builtin_amdgcn_rcpf(1.0f + e);
                be[i] = e * rr; om[i] = rr; }
            if (diag) {
#pragma unroll
                for (int i = 0; i < 16; ++i) { const int kap = 8 * (i >> 2) + 4 * hf + (i & 3); if (kap >= r) { be[i] = 0.f; om[i] = 1.f; } } }
            float sfx[16], Gt[4], Go[4];
#pragma unroll
            for (int g = 0; g < 4; ++g) { sfx[4 * g + 3] = 1.f; sfx[4 * g + 2] = om[4 * g + 3]; sfx[4 * g + 1] = sfx[4 * g + 2] * om[4 * g + 2]; sfx[4 * g + 0] = sfx[4 * g + 1] * om[4 * g + 1]; Gt[g] = sfx[4 * g + 0] * om[4 * g + 0]; }
#pragma unroll
            for (int g = 0; g < 4; ++g) Go[g] = shx(Gt[g], 32, ll);
            float SP[4]; SP[3] = 1.f; SP[2] = Gt[3] * Go[3]; SP[1] = SP[2] * (Gt[2] * Go[2]); SP[0] = SP[1] * (Gt[1] * Go[1]);
            float wgt[16];
#pragma unroll
            for (int g = 0; g < 4; ++g) { const float Rg = Rc * SP[g] * (hf == 0 ? Go[g] : 1.f);
#pragma unroll
                for (int j = 0; j < 4; ++j) wgt[4 * g + j] = be[4 * g + j] * (Rg * sfx[4 * g + j]); }
            Rc = Rc * (SP[0] * (Gt[0] * Go[0]));
            if (kt > 0) {
#pragma unroll
                for (int k = 0; k < 8; ++k) { const int n = F.lane + 64 * k; const bf16* rp = qkv + (size_t)(b * SEQ + (kt - 1) * 32 + (n >> 4)) * B_INC + h * B_HD + (n & 15) * 8; Kr[k] = *(const v4u*)(rp + DM); Vr[k] = *(const v4u*)(rp + 2 * DM); }
            }
            asm volatile("s_waitcnt lgkmcnt(0)" ::: "memory");
#pragma unroll
            for (int s2 = 0; s2 < 2; ++s2) {
                v4u pk; pk.x = pk2(wgt[8 * s2 + 0], wgt[8 * s2 + 1]); pk.y = pk2(wgt[8 * s2 + 2], wgt[8 * s2 + 3]); pk.z = pk2(wgt[8 * s2 + 4], wgt[8 * s2 + 5]); pk.w = pk2(wgt[8 * s2 + 6], wgt[8 * s2 + 7]);
                const bf16x8 pa = __builtin_bit_cast(bf16x8, pk);
#pragma unroll
                for (int dt = 0; dt < 4; ++dt) { const bf16x8 vb = tr_frag_at(img, tr_base_perm((unsigned)ll, (unsigned)dt, 0u), tr_base_perm((unsigned)ll, (unsigned)dt, 1u), (unsigned)s2);
                    o[dt] = __builtin_amdgcn_mfma_f32_32x32x16_bf16(pa, vb, o[dt], 0, 0, 0); }
            }
            if (__ballot(Rc >= 0x1p-40f) == 0ull) break;
        }
#pragma unroll
        for (int dt = 0; dt < 4; ++dt)
#pragma unroll
            for (int i = 0; i < 16; ++i) { const int qrow = 8 * (i >> 2) + 4 * hf + (i & 3);
                o_out[(size_t)(b * SEQ + t0 + qrow) * DM + h * B_HD + 32 * dt + r] = (bf16)f2bf(o[dt][i]); }
    }
    }
}

constexpr int PH_LAYER0 = 3, PH_PER_LAYER = 16, PH_END = PH_LAYER0 + DEPTH * PH_PER_LAYER;
typedef pg8::bf16_t gb16;
__device__ __forceinline__ bool relaunder(Frame& F) { int l_; asm volatile("v_mbcnt_lo_u32_b32 %0, -1, 0\n\tv_mbcnt_hi_u32_b32 %0, -1, %0" : "=v"(l_)); F.lane = l_; F.tid = F.wave * 64 + l_; return true; }
template <class Epi> __device__ __forceinline__ void run_gemm(Frame& F, const bf16* A, const bf16* Bt, int N, int K, int lda, int ldb, int acs, const Epi& E) {
    pg8::Gemm g{(const gb16*)A, (const gb16*)Bt, T, N, K, lda, ldb, acs}; pg8::StaticOrder S; S.init(T, N, F.G, (F.G == 256) ? (int)((blockIdx.x & 31) * 8 + (blockIdx.x >> 5)) : (int)blockIdx.x);
    pg8::gemm_phase<Epi, pg8::StaticOrder, true, true>(F.lds, g, S, E, F.tid);
}
__global__ void __launch_bounds__(NWAVES * 64, 2) fwd_kernel(Args args) {
    extern __shared__ __attribute__((aligned(16))) unsigned char lds_raw[];
    Frame F;
    F.lds = (LAS unsigned char*)lds_raw;
    F.tid = threadIdx.x; F.lane = F.tid & 63; F.wave = __builtin_amdgcn_readfirstlane(F.tid >> 6); F.G = gridDim.x;
    F.ap = (const CAS Args*)__builtin_amdgcn_kernarg_segment_ptr();
    F.out = args.out; F.ws = args.ws;
    volatile LAS unsigned* MISC = (volatile LAS unsigned*)(F.lds + MISC_OFF);
    if (F.tid < 64) MISC[F.tid] = 0u;
    __syncthreads();
    const int lo = args.ph_lo, hi = args.ph_hi;
    XcdBarrier bar; bar.bar = (unsigned*)(F.ws + WS_CTL) + CW_BAR; bar.x = 0; bar.st = nullptr;
    if (hi - lo > 1) { bar = xcd_barrier_post((unsigned*)(F.ws + WS_CTL) + CW_BAR, MISC + 8); xcd_barrier<true>(bar); }
#define IN(k) (lo <= (k) && (k) < hi && relaunder(F))
#define INR(k) (lo <= (k) && (k) < hi)
#define GRID_BAR() do { XcdBarrier b2_ = bar; b2_.x = (unsigned)__builtin_amdgcn_readfirstlane((int)bar.x); asm volatile("" : "+s"(b2_.bar), "+s"(b2_.x)); xcd_barrier<false>(b2_); } while (0)
#define SEAM(k) do { if (INR((k) + 1)) GRID_BAR(); } while (0)

    float* mod = WSP(float, WS_MOD);
    const float* normg = F.inp(IN_NORMG);
    bf16* Hb = WSP(bf16, WS_H);
    if (IN(0)) { ph_prologue(F); SEAM(0); }
    if (IN(1)) { ph_modreduce(F); SEAM(1); }
    if (IN(2)) { ph_post(F, nullptr, F.inp(IN_X), true, nullptr, false, nullptr, nullptr, Hb, normg + 0 * DM, mod + 0 * DM, mod + 1 * DM); SEAM(2); }

    for (int L = 0; L < DEPTH; ++L) {
        const int pb = PH_LAYER0 + PH_PER_LAYER * L, j = L >> 1;
        const float* modL = mod + (size_t)L * BATCH * MODW;
        const float* ng = normg + (size_t)L * 4 * DM;
        const bool lastL = (L == DEPTH - 1);
        bf16* XB = (bf16*)((unsigned char*)F.out + 128 * MiB); bf16* XL = WSP(bf16, WS_P + 128 * MiB);
        if ((L & 1) == 0) {
            float* proj = WSP(float, WS_P); bf16* qidx = WSP(bf16, WS_P + 128 * MiB); bf16* ob = WSP(bf16, WS_P);
            bf16* big = WSP(bf16, WS_BIG);
            bf16* qlat = WSP(bf16, WS_QLAT); bf16* ckv = WSP(bf16, WS_CKV); bf16* kidx = WSP(bf16, WS_KIDX); float* widx = WSP(float, WS_WIDX); int* idxb = WSP(int, WS_IDX);
            if (IN(pb + 0)) { pg8::EpiF32 E{proj, A_INP}; run_gemm(F, Hb, WSP(bf16, WS_WAIN) + (size_t)j * A_INP * DM, A_INP, DM, DM, DM, 0, E); SEAM(pb + 0); }
            if (IN(pb + 1)) { ph_dsa_norm(F, proj, F.inp(IN_AQN) + j * A_QR, F.inp(IN_AKVN) + j * A_KVR, F.inp(IN_AIKN) + j * IDX_D, qlat, ckv, kidx, widx); SEAM(pb + 1); }
            if (IN(pb + 2)) { pg8::EpiBf16<0> E{(gb16*)big, 8192, (gb16*)qidx, 2048, 8192}; run_gemm(F, qlat, WSP(bf16, WS_WQC) + (size_t)j * 10240 * 512, 10240, A_QR, A_QR, A_QR, 0, E); SEAM(pb + 2); }
            if (IN(pb + 3)) { ph_indexer(F, qidx, kidx, widx, idxb); SEAM(pb + 3); }
            if (IN(pb + 4)) { ph_sparse_attn(F, big, ckv, idxb, F.inp(IN_RELB)); SEAM(pb + 4); }
            if (IN(pb + 5)) { pg8::EpiBf16<0> E{(gb16*)ob, 4096, (gb16*)ob, 4096, 1 << 30}; run_gemm(F, big, WSP(bf16, WS_WUV) + (size_t)j * 4096 * 512, 4096, 512, 8192, 512, 512, E); SEAM(pb + 5); }
            if (IN(pb + 6)) { pg8::EpiBf16<0> E{(gb16*)big, DM, (gb16*)big, DM, 1 << 30}; run_gemm(F, ob, WSP(bf16, WS_WAOUT) + (size_t)j * DM * 4096, DM, 4096, 4096, 4096, 0, E); SEAM(pb + 6); }
        } else {
            bf16* qkv = WSP(bf16, WS_BIG); bf16* ob = WSP(bf16, WS_P); bf16* big = WSP(bf16, WS_BIG);
            if (IN(pb + 0)) { pg8::EpiBf16<0> E{(gb16*)qkv, B_INC, (gb16*)qkv, B_INC, 1 << 30}; run_gemm(F, Hb, WSP(bf16, WS_WBIN) + (size_t)j * B_INC * DM, B_INC, DM, DM, DM, 0, E); SEAM(pb + 0); }
            if (IN(pb + 1)) { ph_sb_attn(F, qkv, ob, (unsigned*)(F.ws + WS_CTL) + CW_SBQ + 512 * j); SEAM(pb + 1); }
            if (IN(pb + 2)) { pg8::EpiBf16<0> E{(gb16*)big, DM, (gb16*)big, DM, 1 << 30}; run_gemm(F, ob, WSP(bf16, WS_WBOUT) + (size_t)j * DM * DM, DM, DM, DM, DM, 0, E); if (INR(pb + 7)) GRID_BAR(); }
        }
        if (IN(pb + 7)) { ph_post(F, WSP(bf16, WS_BIG), (L == 0) ? (const void*)F.inp(IN_X) : (const void*)XB, L == 0, lastL ? (void*)XL : (void*)XB, false, modL + 2 * DM, ng + 1 * DM, Hb, ng + 2 * DM, modL + 3 * DM, modL + 4 * DM); SEAM(pb + 7); }
        if (IN(pb + 8)) { pg8::EpiBf16<1> E{(gb16*)WSP(bf16, WS_BIG), DFF, (gb16*)WSP(bf16, WS_BIG), DFF, 1 << 30}; run_gemm(F, Hb, WSP(bf16, WS_WM1) + (size_t)L * DFF * DM, DFF, DM, DM, DM, 0, E); SEAM(pb + 8); }
        if (IN(pb + 9)) { pg8::EpiBf16<0> E{(gb16*)WSP(bf16, WS_P), DM, (gb16*)WSP(bf16, WS_P), DM, 1 << 30}; run_gemm(F, WSP(bf16, WS_BIG), WSP(bf16, WS_WM2) + (size_t)L * DM * DFF, DM, DFF, DFF, DFF, 0, E); SEAM(pb + 9); }
        if (IN(pb + 10)) {
            const float* modN = mod + (size_t)(L + 1) * BATCH * MODW; const float* ngN = normg + (size_t)(L + 1) * 4 * DM;
            ph_post(F, WSP(bf16, WS_P), lastL ? (const void*)XL : (const void*)XB, false, lastL ? (void*)F.out : (void*)XB, lastL, modL + 5 * DM, ng + 3 * DM, lastL ? nullptr : Hb, ngN, modN + 0 * DM, modN + 1 * DM);
            if (!lastL && INR(pb + PH_PER_LAYER)) GRID_BAR();
        }
    }
#undef IN
#undef INR
#undef GRID_BAR
#undef SEAM
}

extern "C" void kernel_launch(void* const* d_in, const int* in_sizes, int n_in, void* d_out, int out_size, void* d_ws, size_t ws_size, hipStream_t stream) {
    static int grid = 0;
    if (grid == 0) {
        if (n_in != N_IN || out_size != T * DM || ws_size < WS_END) { fprintf(stderr, "kernel_launch: unexpected problem: n_in %d out %d ws %zu (need %zu); nothing launched\n", n_in, out_size, ws_size, (size_t)WS_END); grid = -1; return; }
        int dev = 0, cus = 0, per_cu = 0;
        if (hipGetDevice(&dev) != hipSuccess || hipDeviceGetAttribute(&cus, hipDeviceAttributeMultiprocessorCount, dev) != hipSuccess) { grid = -1; return; }
        if (hipFuncSetAttribute((const void*)fwd_kernel, hipFuncAttributeMaxDynamicSharedMemorySize, LDS_BYTES) != hipSuccess) { fprintf(stderr, "kernel_launch: hipFuncSetAttribute(%d B LDS) failed\n", LDS_BYTES); grid = -1; return; }
        if (hipOccupancyMaxActiveBlocksPerMultiprocessor(&per_cu, (const void*)fwd_kernel, NWAVES * 64, LDS_BYTES) != hipSuccess || per_cu < 1) { fprintf(stderr, "kernel_launch: occupancy query says %d workgroups per CU; nothing launched\n", per_cu); (void)hipGetLastError(); grid = -1; return; }
        grid = cus * (per_cu < 1 ? per_cu : 1);
    }
    if (grid < 0) return;
    (void)hipMemsetAsync((char*)d_ws + WS_CTL, 0, CTL_ZERO_BYTES, stream);
    Args a{};
    for (int i = 0; i < N_IN; ++i) a.in[i] = (const float*)d_in[i];
    a.out = (float*)d_out; a.ws = (unsigned char*)d_ws;
#if ONE_LAUNCH
    a.ph_lo = 0; a.ph_hi = PH_END;
    hipLaunchKernelGGL(fwd_kernel, dim3(grid), dim3(NWAVES * 64), LDS_BYTES, stream, a);
#else
    for (int p = 0; p < PH_END; ++p) {
        if (p >= PH_LAYER0) { const int L = (p - PH_LAYER0) / PH_PER_LAYER, r = (p - PH_LAYER0) % PH_PER_LAYER;
            if (r > 10) continue; if ((L & 1) && r >= 3 && r <= 6) continue; }
        a.ph_lo = p; a.ph_hi = p + 1;
        hipLaunchKernelGGL(fwd_kernel, dim3(grid), dim3(NWAVES * 64), LDS_BYTES, stream, a);
    }
#endif
}
```

```cpp
#include <hip/hip_runtime.h>
#include <cstdio>
#include <cstdint>
#ifndef ONE_LAUNCH
#define ONE_LAUNCH 1
#endif
namespace pg8 {
#define PG8_LAS __attribute__((address_space(3)))
typedef unsigned short bf16_t;
typedef short bf16x8 __attribute__((ext_vector_type(8)));
typedef float f32x4 __attribute__((ext_vector_type(4)));
typedef unsigned u32x4 __attribute__((ext_vector_type(4)));
constexpr int BM = 256, BK = 64, HALF = 128, HTB = HALF * BK * 2  , STAGE_BYTES = 8 * HTB, NXCD = 8, WGM = 4;

__host__ __device__ __forceinline__ int lds_byte(int r, int c) { const int st = (r >> 4) * 2 + (c >> 5), rr = r & 15, cc = c & 31, ob = rr * 64 + cc * 2; return st * 1024 + (ob ^ (((ob >> 9) & 1) << 5)); }
__host__ __device__ __forceinline__ void stage_rc(int b, int& R, int& C) { const int st = b / 1024, sb = b % 1024, swz = sb ^ (((sb >> 9) & 1) << 5); R = (st >> 1) * 16 + swz / 64; C = (st & 1) * 32 + (swz % 64) / 2; }
__host__ __device__ __forceinline__ int perm32(int rho) { const int n = rho >> 4, i = rho & 15; return 8 * (i >> 2) + 4 * n + (i & 3); }

struct Unit { int pm, pn; };
struct Gemm { const bf16_t* A; const bf16_t* Bt; int M, N, K, lda, ldb, acs; };

struct StaticOrder {
    int nM, nN, nwg, G, c;
    __host__ __device__ void init(int M, int N, int G_, int c_) { nM = M / BM; nN = N / BM; nwg = nM * nN; G = G_; c = c_; }
    __host__ __device__ bool next(int i, Unit& u) const {
        const long L = (long)i * G + c; if (L >= nwg) return false;
        int wgid = (int)L; { const int q = nwg / NXCD, r = nwg % NXCD, xcd = wgid % NXCD, off = wgid / NXCD; wgid = (xcd < r ? xcd * (q + 1) : r * (q + 1) + (xcd - r) * q) + off; }
        const int nig = WGM * nN, gid = wgid / nig, fm = gid * WGM, gsz = (nM - fm) < WGM ? (nM - fm) : WGM;
        u.pm = fm + ((wgid % nig) % gsz); u.pn = (wgid % nig) / gsz; return true;
    }
    __device__ __forceinline__ void a_ready(const Unit&) const {}
    __device__ __forceinline__ void done(const Unit&) const {}
};


__device__ __forceinline__ unsigned cvt_pk_bf16(float lo, float hi) { unsigned r; asm volatile("v_cvt_pk_bf16_f32 %0, %1, %2" : "=v"(r) : "v"(lo), "v"(hi)); return r; }
struct EpiF32 {
    static constexpr bool PERM = false, AFTER_DRAIN = false;
    float* C; int ldc;
    __device__ __forceinline__ void operator()(const f32x4 (&acc)[2][2][4][2], const Unit& u, int wr, int wc, int fr, int fq, PG8_LAS unsigned char*) const {
        const int row0 = u.pm * BM + wr * 64 + fr, col0 = u.pn * BM + wc * 32 + 4 * fq;
#pragma unroll
        for (int ai = 0; ai < 2; ++ai)
#pragma unroll
            for (int m = 0; m < 4; ++m) { float* rowp = C + (size_t)(row0 + ai * HALF + m * 16) * ldc + col0;
#pragma unroll
                for (int bj = 0; bj < 2; ++bj)
#pragma unroll
                    for (int n = 0; n < 2; ++n) *(f32x4*)(rowp + bj * HALF + n * 16) = acc[ai][bj][m][n]; }
    }
};
template <int ACT> struct EpiBf16 {
    static constexpr bool PERM = true, AFTER_DRAIN = false;
    bf16_t* O0; int ld0; bf16_t* O1; int ld1; int split_col;
    __device__ __forceinline__ void operator()(const f32x4 (&acc)[2][2][4][2], const Unit& u, int wr, int wc, int fr, int fq, PG8_LAS unsigned char* lds) const {
        int colt = u.pn * BM; bf16_t* base = O0; int ldc = ld0;
        if (colt >= split_col) { base = O1; ldc = ld1; colt -= split_col; }
        PG8_LAS unsigned char* scr = lds + STAGE_BYTES + (wr * 4 + wc) * 2048;
        const int lane = fq * 16 + fr, rrow = lane >> 3, rch = lane & 7;
        PG8_LAS unsigned char* wp = scr + fr * 128 + 16 * (fq ^ (fr >> 1));
        const int wsw = ((fr >> 1) & 4) ? -64 : 64;
        const PG8_LAS unsigned char* rp = scr + rrow * 128 + 16 * (rch ^ ((rrow >> 1) & 7));
        const int rsw = (rch & 4) ? -64 : 64;
        bf16_t* gp = base + (size_t)(u.pm * BM + wr * 64 + rrow) * ldc + colt + wc * 64 + 8 * rch;
#pragma unroll
        for (int ai = 0; ai < 2; ++ai)
#pragma unroll
            for (int m = 0; m < 4; ++m) {
#pragma unroll
                for (int bj = 0; bj < 2; ++bj) { f32x4 v0 = acc[ai][bj][m][0], v1 = acc[ai][bj][m][1];
                    if (ACT == 1) {
#pragma unroll
                        for (int j = 0; j < 4; ++j) { const float a = fmaxf(v0[j], 0.f), b = fmaxf(v1[j], 0.f); v0[j] = a * a; v1[j] = b * b; } }
                    u32x4 w; w.x = cvt_pk_bf16(v0[0], v0[1]); w.y = cvt_pk_bf16(v0[2], v0[3]); w.z = cvt_pk_bf16(v1[0], v1[1]); w.w = cvt_pk_bf16(v1[2], v1[3]);
                    *(PG8_LAS u32x4*)(wp + (bj ? wsw : 0)) = w; }
#pragma unroll
                for (int s = 0; s < 2; ++s) { const u32x4 w = *(const PG8_LAS u32x4*)(rp + s * 1024 + (s ? rsw : 0));
                    *(u32x4*)(gp + (size_t)(ai * HALF + m * 16 + s * 8) * ldc) = w; } }
    }
};

template <class Epi, class Sched, bool ALIGN_EPI = false, bool SP2 = false>
__device__ __forceinline__ void gemm_phase(PG8_LAS unsigned char* lds, const Gemm g, const Sched& S, const Epi& E, int tid_in) {
    int tid_l = tid_in; asm volatile("" : "+v"(tid_l));
    const int tid = tid_l, wid = __builtin_amdgcn_readfirstlane(tid >> 6), lane = tid & 63, wr = wid >> 2, wc = wid & 3, fr = lane & 15, fq = lane >> 4;
    const int K = g.K, nt = K / BK;
    unsigned voffA[2], voffB[2];
#pragma unroll
    for (int i = 0; i < 2; ++i) { int R, C; stage_rc(tid * 16 + i * 8192, R, C); const int Rb = Epi::PERM ? ((R >> 5) * 64 + perm32(R & 31)) : R;
        voffA[i] = (unsigned)(R * g.lda + C) * 2u; voffB[i] = (unsigned)(Rb * g.ldb + C) * 2u; }
    const size_t kstep = (size_t)(BK * 2);
    const size_t hstepA = (size_t)HALF * g.lda * 2, hstepB = (size_t)(Epi::PERM ? 32 : HALF) * g.ldb * 2;
    const size_t tstepA = 2 * hstepA, tstepB = (size_t)BM * g.ldb * 2, cstepA = (size_t)g.acs * 2;
    const unsigned ldsw = (unsigned)wid * 1024u;
    const int aoff = lds_byte(wr * 64 + fr, fq * 8), boff = lds_byte(wc * 32 + fr, fq * 8);
#define PG8_SA(b, h) (((b) * 2 + (h)) * HTB)
#define PG8_SB(b, h) ((4 + (b) * 2 + (h)) * HTB)
#define PG8_STAGE(bufoff, gbase, voff) do { _Pragma("unroll") for (int _i = 0; _i < 2; ++_i) \
        __builtin_amdgcn_global_load_lds((const unsigned*)((const char*)(gbase) + (voff)[_i]), (PG8_LAS unsigned*)(lds + (bufoff) + ldsw + _i * 8192), 16, 0, 0); } while (0)
#define PG8_LDA(dst, b, h) do { _Pragma("unroll") for (int m = 0; m < 4; ++m) _Pragma("unroll") for (int k = 0; k < 2; ++k) dst[m][k] = *(const PG8_LAS bf16x8*)(lds + PG8_SA(b, h) + aoff + m * 2048 + k * 1024); } while (0)
#define PG8_LDB(dst, b, h) do { _Pragma("unroll") for (int n = 0; n < 2; ++n) _Pragma("unroll") for (int k = 0; k < 2; ++k) dst[n][k] = *(const PG8_LAS bf16x8*)(lds + PG8_SB(b, h) + boff + n * 2048 + k * 1024); } while (0)
#define PG8_MMA(ai, bj, At, Bt) do { __builtin_amdgcn_s_setprio(1); _Pragma("unroll") for (int m = 0; m < 4; ++m) _Pragma("unroll") for (int n = 0; n < 2; ++n) _Pragma("unroll") for (int k = 0; k < 2; ++k) \
        acc[ai][bj][m][n] = __builtin_amdgcn_mfma_f32_16x16x32_bf16(Bt[n][k], At[m][k], acc[ai][bj][m][n], 0, 0, 0); __builtin_amdgcn_s_setprio(0); } while (0)
#define PG8_WAIT_V(n) asm volatile("s_waitcnt vmcnt(" #n ")" ::: "memory")
#define PG8_WAIT_L(n) asm volatile("s_waitcnt lgkmcnt(" #n ")" ::: "memory")
#define PG8_BAR __builtin_amdgcn_s_barrier()
#define PG8_SCHED __builtin_amdgcn_sched_barrier(0)
    Unit cur, nxt; int ui = 0;
    if (!S.next(0, cur)) return;
    f32x4 acc[2][2][4][2];
#pragma unroll
    for (int a = 0; a < 2; ++a)
#pragma unroll
        for (int b = 0; b < 2; ++b)
#pragma unroll
            for (int m = 0; m < 4; ++m)
#pragma unroll
                for (int n = 0; n < 2; ++n) acc[a][b][m][n] = (f32x4){0.f, 0.f, 0.f, 0.f};
    bf16x8 At[4][2], B0[2][2], B1[2][2];
    const char* cA = (const char*)g.A + (size_t)cur.pm * tstepA + (size_t)cur.pn * cstepA; const char* cB = (const char*)g.Bt + (size_t)cur.pn * tstepB;
    S.a_ready(cur);
    if constexpr (SP2) {
        PG8_STAGE(PG8_SB(0, 0), cB, voffB); PG8_STAGE(PG8_SB(0, 1), cB + hstepB, voffB); PG8_STAGE(PG8_SA(0, 0), cA, voffA); PG8_STAGE(PG8_SA(0, 1), cA + hstepA, voffA);
        if (wr == 1) PG8_BAR;
        PG8_WAIT_V(2); PG8_BAR;
        PG8_STAGE(PG8_SB(1, 0), cB + kstep, voffB); PG8_STAGE(PG8_SA(1, 0), cA + kstep, voffA); PG8_STAGE(PG8_SB(1, 1), cB + hstepB + kstep, voffB);
        PG8_WAIT_V(6); PG8_BAR;
    } else {
        PG8_STAGE(PG8_SB(0, 0), cB, voffB); PG8_STAGE(PG8_SA(0, 0), cA, voffA); PG8_STAGE(PG8_SB(0, 1), cB + hstepB, voffB); PG8_STAGE(PG8_SA(0, 1), cA + hstepA, voffA);
        if (wr == 1) PG8_BAR;
        PG8_WAIT_V(4); PG8_BAR;
        PG8_STAGE(PG8_SB(1, 0), cB + kstep, voffB); PG8_STAGE(PG8_SA(1, 0), cA + kstep, voffA); PG8_STAGE(PG8_SB(1, 1), cB + hstepB + kstep, voffB);
        PG8_WAIT_V(6); PG8_BAR;
    }
    for (;;) {
        const bool has_next = S.next(ui + 1, nxt);
        const char* nA = has_next ? (const char*)g.A + (size_t)nxt.pm * tstepA + (size_t)nxt.pn * cstepA : cA; const char* nB = has_next ? (const char*)g.Bt + (size_t)nxt.pn * tstepB : cB;
        for (int t = 0; t < nt; t += 2) {
            const bool last = (t == nt - 2);
            const char* a1 = cA + (size_t)(t + 1) * kstep;
            const char* a2 = last ? nA : cA + (size_t)(t + 2) * kstep; const char* b2 = last ? nB : cB + (size_t)(t + 2) * kstep;
            const char* a3 = a2 + kstep; const char* b3 = b2 + kstep;
            if (last && has_next) S.a_ready(nxt);
            if constexpr (SP2) {
            PG8_LDB(B0, 0, 0); PG8_LDB(B1, 0, 1); PG8_SCHED; PG8_LDA(At, 0, 0); PG8_STAGE(PG8_SA(1, 1), a1 + hstepA, voffA);
            PG8_WAIT_V(8); PG8_WAIT_L(0); PG8_BAR; PG8_MMA(0, 0, At, B0); PG8_MMA(0, 1, At, B1); PG8_BAR; PG8_SCHED;
            PG8_LDA(At, 0, 1); PG8_STAGE(PG8_SB(0, 0), b2, voffB); PG8_STAGE(PG8_SB(0, 1), b2 + hstepB, voffB); PG8_STAGE(PG8_SA(0, 0), a2, voffA);
            PG8_WAIT_V(8); PG8_WAIT_L(0); PG8_BAR; PG8_MMA(1, 0, At, B0); PG8_MMA(1, 1, At, B1); PG8_BAR; PG8_SCHED;
            PG8_LDB(B0, 1, 0); PG8_LDB(B1, 1, 1); PG8_SCHED; PG8_LDA(At, 1, 0); PG8_STAGE(PG8_SA(0, 1), a2 + hstepA, voffA);
            PG8_WAIT_V(8); PG8_WAIT_L(0); PG8_BAR; PG8_MMA(0, 0, At, B0); PG8_MMA(0, 1, At, B1); PG8_BAR; PG8_SCHED;
            PG8_LDA(At, 1, 1); PG8_STAGE(PG8_SB(1, 0), b3, voffB); PG8_STAGE(PG8_SB(1, 1), b3 + hstepB, voffB); PG8_STAGE(PG8_SA(1, 0), a3, voffA);
            PG8_WAIT_V(8); PG8_WAIT_L(0); PG8_BAR; PG8_MMA(1, 0, At, B0); PG8_MMA(1, 1, At, B1); PG8_BAR; PG8_SCHED;
            } else {
            PG8_LDB(B0, 0, 0); PG8_SCHED; PG8_LDA(At, 0, 0); PG8_STAGE(PG8_SA(1, 1), a1 + hstepA, voffA);
            PG8_WAIT_L(8); PG8_BAR; PG8_WAIT_L(0); PG8_MMA(0, 0, At, B0); PG8_BAR; PG8_SCHED;
            PG8_LDB(B1, 0, 1); PG8_STAGE(PG8_SB(0, 0), b2, voffB);
            PG8_BAR; PG8_WAIT_L(0); PG8_MMA(0, 1, At, B1); PG8_BAR;
            PG8_LDA(At, 0, 1); PG8_STAGE(PG8_SA(0, 0), a2, voffA);
            PG8_BAR; PG8_WAIT_L(0); PG8_MMA(1, 0, At, B0); PG8_BAR; PG8_SCHED;
            PG8_STAGE(PG8_SB(0, 1), b2 + hstepB, voffB);
            PG8_WAIT_V(6); PG8_BAR; PG8_MMA(1, 1, At, B1); PG8_BAR;
            PG8_LDB(B0, 1, 0); PG8_SCHED; PG8_LDA(At, 1, 0); PG8_STAGE(PG8_SA(0, 1), a2 + hstepA, voffA);
            PG8_WAIT_L(8); PG8_BAR; PG8_WAIT_L(0); PG8_MMA(0, 0, At, B0); PG8_BAR; PG8_SCHED;
            PG8_LDB(B1, 1, 1); PG8_STAGE(PG8_SB(1, 0), b3, voffB);
            PG8_BAR; PG8_WAIT_L(0); PG8_MMA(0, 1, At, B1); PG8_BAR;
            PG8_LDA(At, 1, 1); PG8_STAGE(PG8_SA(1, 0), a3, voffA);
            PG8_BAR; PG8_WAIT_L(0); PG8_MMA(1, 0, At, B0); PG8_BAR; PG8_SCHED;
            PG8_STAGE(PG8_SB(1, 1), b3 + hstepB, voffB);
            PG8_WAIT_V(6); PG8_BAR; PG8_MMA(1, 1, At, B1); PG8_BAR;
            }
        }
        if constexpr (ALIGN_EPI) { if (wr == 0) PG8_BAR; }
        if constexpr (!Epi::AFTER_DRAIN) { E(acc, cur, wr, wc, fr, fq, lds); S.done(cur); }
        if (!has_next) break;
#pragma unroll
        for (int a = 0; a < 2; ++a)
#pragma unroll
            for (int b = 0; b < 2; ++b)
#pragma unroll
                for (int m = 0; m < 4; ++m)
#pragma unroll
                    for (int n = 0; n < 2; ++n) acc[a][b][m][n] = (f32x4){0.f, 0.f, 0.f, 0.f};
        cur = nxt; cA = nA; cB = nB; ++ui;
        if constexpr (ALIGN_EPI) { if (wr == 1) PG8_BAR; }
    }
    PG8_WAIT_V(0);
    if constexpr (!ALIGN_EPI) { if (wr == 0) PG8_BAR; }
    PG8_BAR;
    if constexpr (Epi::AFTER_DRAIN) { E.fused(acc, cur, wr, wc, fr, fq, lds, wid, lane); S.done(cur); }
#undef PG8_SA
#undef PG8_SB
#undef PG8_STAGE
#undef PG8_LDA
#undef PG8_LDB
#undef PG8_MMA
#undef PG8_WAIT_V
#undef PG8_WAIT_L
#undef PG8_BAR
#undef PG8_SCHED
}
}

constexpr int NWAVES = 8;
constexpr int BATCH = 8, SEQ = 4096, DM = 2048, DEPTH = 4, DFF = 8192, T = BATCH * SEQ;
constexpr int A_HEADS = 32, A_QR = 512, A_KVR = 256, IDX_H = 16, IDX_D = 128, TOPK = 256, A_IN = 912, A_INP = 1024;
constexpr int B_HEADS = 16, B_HD = 128, B_INC = 3 * DM;
constexpr int MODW = 6 * DM;
constexpr float RMS_EPS = 1e-6f;
enum { IN_X = 0, IN_C, IN_RELB, IN_ADAW, IN_ADAB, IN_NORMG, IN_AWIN, IN_AQN, IN_AKVN, IN_AIKN, IN_AWQB, IN_AWIQB, IN_AWUK, IN_AWUV, IN_AWOUT, IN_BWIN, IN_BWOUT, IN_W1, IN_W2, N_IN };

constexpr size_t MiB = 1u << 20;
constexpr size_t WS_CTL = 0, CTL_ZERO_BYTES = 1 * MiB;
constexpr size_t WS_MOD = 1 * MiB;
constexpr size_t WS_MODP = 3 * MiB;
constexpr size_t WS_WAIN = 16 * MiB;
constexpr size_t WS_WQC = 24 * MiB;
constexpr size_t WS_WUV = 44 * MiB;
constexpr size_t WS_WAOUT = 52 * MiB;
constexpr size_t WS_WBIN = 84 * MiB;
constexpr size_t WS_WBOUT = 132 * MiB;
constexpr size_t WS_WM1 = 148 * MiB;
constexpr size_t WS_WM2 = 276 * MiB;
constexpr size_t WS_H = 404 * MiB;
constexpr size_t WS_P = 532 * MiB;
constexpr size_t WS_BIG = 788 * MiB;
constexpr size_t WS_QLAT = 1300 * MiB;
constexpr size_t WS_CKV = 1332 * MiB;
constexpr size_t WS_KIDX = 1348 * MiB;
constexpr size_t WS_WIDX = 1356 * MiB;
constexpr size_t WS_IDX = 1358 * MiB;
constexpr size_t WS_END = 1390 * MiB;
constexpr int CW_BAR = 4096;
constexpr int CW_SBQ = 8192;

constexpr int LDS_BYTES = 163840;
constexpr int MISC_OFF = LDS_BYTES - 256;

#define GAS __attribute__((address_space(1)))
#define LAS __attribute__((address_space(3)))
typedef unsigned short bf16;
typedef unsigned v4u __attribute__((ext_vector_type(4)));
typedef unsigned v2u __attribute__((ext_vector_type(2)));
typedef float f32x4 __attribute__((ext_vector_type(4)));
typedef float f32x2 __attribute__((ext_vector_type(2)));
typedef __bf16 bf16x2_t __attribute__((ext_vector_type(2)));
#define LDS_WAIT() asm volatile("s_waitcnt lgkmcnt(0)" ::: "memory")
#define VM_WAIT() asm volatile("s_waitcnt vmcnt(0)" ::: "memory")
__device__ __forceinline__ unsigned f2bf(float f) { unsigned u = __builtin_bit_cast(unsigned, f); return (u + 0x7fffu + ((u >> 16) & 1u)) >> 16; }
__device__ __forceinline__ unsigned pk2(float lo, float hi) { return f2bf(lo) | (f2bf(hi) << 16); }
__device__ __forceinline__ float bflo(unsigned u) { return __builtin_bit_cast(float, u << 16); }
__device__ __forceinline__ float bfhi(unsigned u) { return __builtin_bit_cast(float, u & 0xffff0000u); }
__device__ __forceinline__ float dot2bf(unsigned a, unsigned b, float c) { return __builtin_amdgcn_fdot2_f32_bf16(__builtin_bit_cast(bf16x2_t, a), __builtin_bit_cast(bf16x2_t, b), c, false); }
#define DPP_F(v, ctrl) __builtin_bit_cast(float, __builtin_amdgcn_update_dpp(0, __builtin_bit_cast(int, (v)), (ctrl), 0xf, 0xf, true))
#define RDL_F(v, l) __builtin_bit_cast(float, __builtin_amdgcn_readlane(__builtin_bit_cast(int, (v)), (l)))
__device__ __forceinline__ float wave_sum(float v, int) {
    v += DPP_F(v, 0xB1); v += DPP_F(v, 0x4E); v += DPP_F(v, 0x124); v += DPP_F(v, 0x128);
    return (RDL_F(v, 0) + RDL_F(v, 16)) + (RDL_F(v, 32) + RDL_F(v, 48));
}
__device__ __forceinline__ float wave_max(float v, int) {
    v = fmaxf(v, DPP_F(v, 0xB1)); v = fmaxf(v, DPP_F(v, 0x4E)); v = fmaxf(v, DPP_F(v, 0x124)); v = fmaxf(v, DPP_F(v, 0x128));
    return fmaxf(fmaxf(RDL_F(v, 0), RDL_F(v, 16)), fmaxf(RDL_F(v, 32), RDL_F(v, 48)));
}
__device__ __forceinline__ float shx(float v, int, int lane) {
    const unsigned u = __builtin_bit_cast(unsigned, v);
    auto r = __builtin_amdgcn_permlane32_swap(u, u, false, false);
    return __builtin_bit_cast(float, (lane & 32) ? r[0] : r[1]);
}

#define XB_TMO      128
#define XB_XCNT(j)  (256  + 64 * (j))
#define XB_XSUB(j)  (1280 + 64 * (j))
#define XB_XGEN(j)  (2304 + 64 * (j))
#define XB_TOP      3328
#define XB_TOPGEN   3392
#define XCD_BAR_WORDS 3456
#define XB_SPIN_CAP (1u << 22)

__device__ __forceinline__ unsigned xb_ld(unsigned* p)              { return __hip_atomic_load(p, __ATOMIC_RELAXED, __HIP_MEMORY_SCOPE_AGENT); }
__device__ __forceinline__ unsigned xb_add(unsigned* p, unsigned v) { return __hip_atomic_fetch_add(p, v, __ATOMIC_RELAXED, __HIP_MEMORY_SCOPE_AGENT); }
__device__ __forceinline__ unsigned xb_xcc_id() { return (unsigned)__builtin_amdgcn_s_getreg((3 << 11) | 20) & 0xFu; }
#define XB_SPIN(cond, bar) do { unsigned _sp = 0; while (cond) { __builtin_amdgcn_s_sleep(1); \
    if ((++_sp & 255u) == 0u) { if (xb_ld(&(bar)[XB_TMO])) break; if (_sp > XB_SPIN_CAP) { atomicAdd(&(bar)[XB_TMO], 1u); break; } } } } while (0)

struct XcdBarrier {
    unsigned* bar; unsigned x;
    volatile LAS unsigned* st;
};

__device__ __forceinline__ XcdBarrier xcd_barrier_post(unsigned* bar, volatile LAS unsigned* st) {
    XcdBarrier b; b.bar = bar; b.x = xb_xcc_id(); b.st = st;
    if (threadIdx.x == 0) (void)xb_add(&bar[XB_XCNT(b.x)], 1u);
    return b;
}
__device__ __forceinline__ void xcd_barrier_complete(unsigned* bar, unsigned x, unsigned& nloc, unsigned& nx) {
    const unsigned G = gridDim.x * gridDim.y * gridDim.z;
    unsigned sum, cnt, mine, sp = 0u;
    for (;;) {
        sum = 0u; cnt = 0u; mine = 0u;
#pragma unroll
        for (unsigned j = 0; j < 16; ++j) { const unsigned c = xb_ld(&bar[XB_XCNT(j)]); sum += c; cnt += (c > 0u) ? 1u : 0u; mine = (j == x) ? c : mine; }
        if (sum == G) break;
        __builtin_amdgcn_s_sleep(1);
        if ((++sp & 255u) == 0u) { if (xb_ld(&bar[XB_TMO])) break; if (sp > XB_SPIN_CAP) { atomicAdd(&bar[XB_TMO], 1u); break; } }
    }
    nloc = mine > 0u ? mine : 1u; nx = cnt > 0u ? cnt : 1u;
}

template <bool CENSUS> __device__ __forceinline__ void xcd_barrier(const XcdBarrier& b) {
    asm volatile("s_waitcnt vmcnt(0)" ::: "memory");
    __syncthreads();
    if (threadIdx.x == 0) {
        unsigned* bar = b.bar;
        __builtin_amdgcn_s_waitcnt(0);
        unsigned nloc = b.st[0], nx = b.st[1];
        if (CENSUS) { if (nloc == 0u) { xcd_barrier_complete(bar, b.x, nloc, nx); b.st[0] = nloc; b.st[1] = nx; } }
        const unsigned old = xb_add(&bar[XB_XSUB(b.x)], 1u);
        const unsigned gen = old / nloc;
        if (old + 1u == (gen + 1u) * nloc) {
            __builtin_amdgcn_fence(__ATOMIC_RELEASE, "agent");
            asm volatile("s_waitcnt vmcnt(0)" ::: "memory");
            const unsigned og = xb_add(&bar[XB_TOP], 1u);
            const unsigned tg = og / nx;
            if (og + 1u == (tg + 1u) * nx) xb_add(&bar[XB_TOPGEN], 1u);
            else XB_SPIN(xb_ld(&bar[XB_TOPGEN]) == tg, bar);
            __builtin_amdgcn_fence(__ATOMIC_ACQUIRE, "agent");
            xb_add(&bar[XB_XGEN(b.x)], 1u);
            asm volatile("s_waitcnt vmcnt(0)" ::: "memory");
        } else {
            XB_SPIN(xb_ld(&bar[XB_XGEN(b.x)]) == gen, bar);
            __builtin_amdgcn_fence(__ATOMIC_ACQUIRE, "agent");
            asm volatile("s_waitcnt vmcnt(0)" ::: "memory");
        }
    }
    __syncthreads();
}

struct Args { const float* in[N_IN]; float* out; unsigned char* ws; int ph_lo, ph_hi; };
#define CAS __attribute__((address_space(4)))
struct Frame {
    LAS unsigned char* lds;
    int tid, lane, wave, G;
    const CAS Args* ap;
    float* out; unsigned char* ws;
    __device__ __forceinline__ const float* inp(int i) const { return ap->in[i]; }
};
#define WSP(type, off) ((type*)(F.ws + (off)))

__device__ __forceinline__ void p0_transpose_item(const float* W, int Nsrc, bf16* dst, int ldo, LAS float* scr, int kb, int nb, int lane) {
    const int k0 = 64 * kb, n0 = 32 * nb, rsub = lane >> 3, c4 = lane & 7, nn = n0 + 4 * c4;
    f32x4 v[8];
#pragma unroll
    for (int i = 0; i < 8; ++i) v[i] = (nn < Nsrc) ? *(const f32x4*)(W + (size_t)(k0 + 8 * i + rsub) * Nsrc + nn) : (f32x4){0.f, 0.f, 0.f, 0.f};
#pragma unroll
    for (int i = 0; i < 8; ++i) { LAS float* d = scr + (8 * i + rsub) * 33 + 4 * c4; d[0] = v[i].x; d[1] = v[i].y; d[2] = v[i].z; d[3] = v[i].w; }
    LDS_WAIT(); asm volatile("" ::: "memory");
    const int c = lane & 7;
#pragma unroll
    for (int j = 0; j < 4; ++j) { const int n = (lane >> 3) + 8 * j; const LAS float* s = scr + (8 * c) * 33 + n;
        v4u o; o.x = pk2(s[0 * 33], s[1 * 33]); o.y = pk2(s[2 * 33], s[3 * 33]); o.z = pk2(s[4 * 33], s[5 * 33]); o.w = pk2(s[6 * 33], s[7 * 33]);
        *(v4u*)(dst + (size_t)(n0 + n) * ldo + k0 + 8 * c) = o; }
    LDS_WAIT(); asm volatile("" ::: "memory");
}
__device__ __forceinline__ void p0_tr_load(f32x4 (&v)[8], const float* W, int Nsrc, int kb, int nb, int lane) {
    const int k0 = 64 * kb, rsub = lane >> 3, nn = 32 * nb + 4 * (lane & 7);
#pragma unroll
    for (int i = 0; i < 8; ++i) v[i] = (nn < Nsrc) ? *(const f32x4*)(W + (size_t)(k0 + 8 * i + rsub) * Nsrc + nn) : (f32x4){0.f, 0.f, 0.f, 0.f};
}
__device__ __forceinline__ void p0_tr_store(const f32x4 (&v)[8], bf16* dst, int ldo, LAS float* scr, int kb, int nb, int lane) {
    const int k0 = 64 * kb, n0 = 32 * nb, rsub = lane >> 3, c4 = lane & 7;
#pragma unroll
    for (int i = 0; i < 8; ++i) { LAS float* d = scr + (8 * i + rsub) * 33 + 4 * c4; d[0] = v[i].x; d[1] = v[i].y; d[2] = v[i].z; d[3] = v[i].w; }
    LDS_WAIT(); asm volatile("" ::: "memory");
    const int c = lane & 7;
#pragma unroll
    for (int j = 0; j < 4; ++j) { const int n = (lane >> 3) + 8 * j; const LAS float* s = scr + (8 * c) * 33 + n;
        v4u o; o.x = pk2(s[0 * 33], s[1 * 33]); o.y = pk2(s[2 * 33], s[3 * 33]); o.z = pk2(s[4 * 33], s[5 * 33]); o.w = pk2(s[6 * 33], s[7 * 33]);
        *(v4u*)(dst + (size_t)(n0 + n) * ldo + k0 + 8 * c) = o; }
    LDS_WAIT(); asm volatile("" ::: "memory");
}
__device__ __forceinline__ void p0_transpose_job(Frame& F, const float* src, size_t sstride, int nmat, int K, int Nsrc, int Npad, bf16* dst, size_t dstride, int ldo) {
    LAS float* scr = (LAS float*)(F.lds + F.wave * 16384);
    const int gw = blockIdx.x * NWAVES + F.wave, NGW = F.G * NWAVES;
    const int nkb = K / 64, nnb = Npad / 32, per = nkb * nnb, tot = nmat * per;
    int it = gw;
    f32x4 v[8], vn[8];
    if (it < tot) { const int m = it / per, r = it % per; p0_tr_load(v, src + (size_t)m * sstride, Nsrc, r / nnb, r % nnb, F.lane); }
    while (it < tot) {
        const int nx = it + NGW;
        if (nx < tot) { const int m = nx / per, r = nx % per; p0_tr_load(vn, src + (size_t)m * sstride, Nsrc, r / nnb, r % nnb, F.lane); }
        { const int m = it / per, r = it % per; p0_tr_store(v, dst + (size_t)m * dstride, ldo, scr, r / nnb, r % nnb, F.lane); }
#pragma unroll
        for (int i = 0; i < 8; ++i) v[i] = vn[i];
        it = nx;
    }
}
__device__ __forceinline__ void ph_prologue(Frame& F) {
    {
        LAS float* sl = (LAS float*)(F.lds);
        LAS float* red = (LAS float*)(F.lds + 8192);
        const float* cin = F.inp(IN_C); const float* ada_w = F.inp(IN_ADAW); float* modp = WSP(float, WS_MODP);
        for (int u = blockIdx.x; u < 768; u += F.G) {
            const int l = u / 192, r = u % 192, ec = r >> 3, dc = r & 7;
            __syncthreads();
            for (int i = F.tid; i < 2048; i += 512) { const int rr = i >> 3, b = i & 7; const float v = cin[b * DM + dc * 256 + rr]; sl[rr * 8 + b] = v / (1.f + __expf(-v)); }
            __syncthreads();
            const int cq = F.tid & 127, dq = F.tid >> 7;
            f32x4 acc[8];
#pragma unroll
            for (int b = 0; b < 8; ++b) acc[b] = (f32x4){0.f, 0.f, 0.f, 0.f};
            const float* wp = ada_w + ((size_t)l * DM + dc * 256 + dq * 64) * MODW + ec * 512 + cq * 4;
#pragma unroll 8
            for (int i = 0; i < 64; ++i) {
                const f32x4 w = *(const f32x4*)(wp + (size_t)i * MODW);
                const f32x4 s0 = *(const LAS f32x4*)(sl + (dq * 64 + i) * 8), s1 = *(const LAS f32x4*)(sl + (dq * 64 + i) * 8 + 4);
                acc[0] += w * s0.x; acc[1] += w * s0.y; acc[2] += w * s0.z; acc[3] += w * s0.w;
                acc[4] += w * s1.x; acc[5] += w * s1.y; acc[6] += w * s1.z; acc[7] += w * s1.w;
            }
#pragma unroll
            for (int b = 0; b < 8; ++b) *(LAS f32x4*)(red + (dq * 8 + b) * 512 + cq * 4) = acc[b];
            __syncthreads();
            { const int b = F.tid >> 6, c0 = (F.tid & 63) * 8;
#pragma unroll
              for (int k = 0; k < 2; ++k) {
                  const f32x4 s = (*(const LAS f32x4*)(red + (0 * 8 + b) * 512 + c0 + 4 * k) + *(const LAS f32x4*)(red + (1 * 8 + b) * 512 + c0 + 4 * k))
                                + (*(const LAS f32x4*)(red + (2 * 8 + b) * 512 + c0 + 4 * k) + *(const LAS f32x4*)(red + (3 * 8 + b) * 512 + c0 + 4 * k));
                  *(f32x4*)(modp + (((size_t)dc * 4 + l) * 8 + b) * MODW + ec * 512 + c0 + 4 * k) = s; } }
        }
        __syncthreads();
    }
    {
        LAS float* Bs = (LAS float*)(F.lds);
        LAS float* As = (LAS float*)(F.lds + 256 * 132 * 4);
        const float* wqb = F.inp(IN_AWQB); const float* wuk = F.inp(IN_AWUK); bf16* wqc = WSP(bf16, WS_WQC);
        for (int u = blockIdx.x; u < 1024; u += F.G) {
            const int j = u >> 9, h = (u & 511) >> 4, rb = u & 15, r0 = rb * 32;
            __syncthreads();
            const float* bsrc = wuk + ((size_t)j * A_HEADS + h) * 256 * 128;
            for (int i = F.tid; i < 256 * 32; i += 512) { const int row = i >> 5, c4 = i & 31; *(LAS f32x4*)(Bs + row * 132 + c4 * 4) = *(const f32x4*)(bsrc + row * 128 + c4 * 4); }
            for (int i = F.tid; i < 32 * 32; i += 512) { const int row = i >> 5, c4 = i & 31; *(LAS f32x4*)(As + row * 128 + c4 * 4) = *(const f32x4*)(wqb + ((size_t)j * A_QR + r0 + row) * 4096 + h * 128 + c4 * 4); }
            __syncthreads();
            const int c = F.tid & 255, rh = F.tid >> 8;
            float acc[16];
#pragma unroll
            for (int q = 0; q < 16; ++q) acc[q] = 0.f;
            for (int d4 = 0; d4 < 32; ++d4) {
                const f32x4 bv = *(const LAS f32x4*)(Bs + c * 132 + d4 * 4);
#pragma unroll
                for (int q = 0; q < 16; ++q) { const f32x4 av = *(const LAS f32x4*)(As + (rh * 16 + q) * 128 + d4 * 4); acc[q] += (av.x * bv.x + av.y * bv.y) + (av.z * bv.z + av.w * bv.w); }
            }
            bf16* orow = wqc + ((size_t)j * 10240 + h * 256 + c) * 512 + r0 + rh * 16;
            v4u o0, o1;
            o0.x = pk2(acc[0], acc[1]); o0.y = pk2(acc[2], acc[3]); o0.z = pk2(acc[4], acc[5]); o0.w = pk2(acc[6], acc[7]);
            o1.x = pk2(acc[8], acc[9]); o1.y = pk2(acc[10], acc[11]); o1.z = pk2(acc[12], acc[13]); o1.w = pk2(acc[14], acc[15]);
            *(v4u*)(orow) = o0; *(v4u*)(orow + 8) = o1;
        }
        __syncthreads();
    }
    p0_transpose_job(F, F.inp(IN_AWIN), (size_t)DM * A_IN, 2, DM, A_IN, A_INP, WSP(bf16, WS_WAIN), (size_t)A_INP * DM, DM);
    p0_transpose_job(F, F.inp(IN_AWIQB), (size_t)A_QR * 2048, 2, A_QR, 2048, 2048, WSP(bf16, WS_WQC) + (size_t)8192 * 512, (size_t)10240 * 512, 512);
    p0_transpose_job(F, F.inp(IN_AWOUT), (size_t)4096 * DM, 2, 4096, DM, DM, WSP(bf16, WS_WAOUT), (size_t)DM * 4096, 4096);
    p0_transpose_job(F, F.inp(IN_BWIN), (size_t)DM * B_INC, 2, DM, B_INC, B_INC, WSP(bf16, WS_WBIN), (size_t)B_INC * DM, DM);
    p0_transpose_job(F, F.inp(IN_BWOUT), (size_t)DM * DM, 2, DM, DM, DM, WSP(bf16, WS_WBOUT), (size_t)DM * DM, DM);
    p0_transpose_job(F, F.inp(IN_W1), (size_t)DM * DFF, 4, DM, DFF, DFF, WSP(bf16, WS_WM1), (size_t)DFF * DM, DM);
    p0_transpose_job(F, F.inp(IN_W2), (size_t)DFF * DM, 4, DFF, DM, DM, WSP(bf16, WS_WM2), (size_t)DM * DFF, DFF);
    {
        LAS float* scr = (LAS float*)(F.lds + F.wave * 16384);
        const int gw = blockIdx.x * NWAVES + F.wave, NGW = F.G * NWAVES;
        const float* wuv = F.inp(IN_AWUV); bf16* d0 = WSP(bf16, WS_WUV);
        for (int it = gw; it < 64 * 16; it += NGW) {
            const int m = it >> 4, r = it & 15, j = m >> 5, h = m & 31;
            bf16* dst = d0 + (size_t)j * 4096 * 512 + (size_t)((h >> 1) * 256 + (h & 1) * 128) * 512 + (h & 1) * 256;
            p0_transpose_item(wuv + (size_t)m * 256 * 128, 128, dst, 512, scr, r >> 2, r & 3, F.lane);
        }
        const int gt = blockIdx.x * 512 + F.tid, NT = F.G * 512;
        for (int i = gt; i < 2 * 4096 * 32; i += NT) {
            const int row = i >> 5, ch = i & 31, hh = (row >> 7) & 1;
            *(v4u*)(d0 + (size_t)row * 512 + (1 - hh) * 256 + ch * 8) = (v4u){0u, 0u, 0u, 0u};
        }
    }
}
__device__ __forceinline__ void ph_modreduce(Frame& F) {
    const float* modp = WSP(float, WS_MODP); float* mod = WSP(float, WS_MOD); const float* ada_b = F.inp(IN_ADAB);
    const int gt = blockIdx.x * 512 + F.tid, NT = F.G * 512;
    for (int i = gt; i < DEPTH * BATCH * MODW / 4; i += NT) {
        const int e4 = i % (MODW / 4), lb = i / (MODW / 4), l = lb >> 3;
        f32x4 s = *(const f32x4*)(ada_b + (size_t)l * MODW + e4 * 4);
#pragma unroll
        for (int dc = 0; dc < 8; ++dc) s += *(const f32x4*)(modp + ((size_t)dc * 32 + lb) * MODW + e4 * 4);
        *(f32x4*)(mod + (size_t)lb * MODW + e4 * 4) = s;
    }
}

__device__ __forceinline__ void ph_post(Frame& F, const bf16* y, const void* xin_, bool xin_f32, void* xout_, bool xout_f32, const float* gate, const float* gy, bf16* hout, const float* gh, const float* shift, const float* scale) {
    LAS float* vec = (LAS float*)F.lds;
    const int rlo = (int)(((long long)blockIdx.x * T) / F.G), rhi = (int)(((long long)(blockIdx.x + 1) * T) / F.G);
    for (int seg = rlo; seg < rhi; ) {
        const int b = seg / SEQ; const int send = ((b + 1) * SEQ < rhi) ? (b + 1) * SEQ : rhi;
        __syncthreads();
        for (int i = F.tid; i < 5 * (DM / 4); i += NWAVES * 64) { const int v = i / (DM / 4), c4 = i % (DM / 4);
            const float* src = (v == 0) ? (y ? gate + (size_t)b * MODW : nullptr) : (v == 1) ? (y ? gy : nullptr) : (v == 2) ? (hout ? gh : nullptr) : (v == 3) ? (hout ? shift + (size_t)b * MODW : nullptr) : (hout ? scale + (size_t)b * MODW : nullptr);
            *(LAS f32x4*)(vec + v * DM + 4 * c4) = src ? *(const f32x4*)(src + 4 * c4) : (f32x4){0.f, 0.f, 0.f, 0.f}; }
        __syncthreads();
        constexpr int NR = 2;
        for (int r0 = seg + 2 * F.wave; r0 < send; r0 += NR * NWAVES) {
            const int r1 = (r0 + 1 < send) ? r0 + 1 : r0;
            int e0 = 4 * F.lane; asm volatile("" : "+v"(e0));
            f32x4 x[NR][8]; v2u yp[NR][8];
            if (xin_f32) { const float* xin = (const float*)xin_;
#pragma unroll
                for (int q = 0; q < NR; ++q) { const int row = q ? r1 : r0;
#pragma unroll
                    for (int j = 0; j < 8; ++j) x[q][j] = *(const f32x4*)(xin + (size_t)row * DM + e0 + 256 * j); }
                if (y) {
#pragma unroll
                    for (int q = 0; q < NR; ++q) { const int row = q ? r1 : r0;
#pragma unroll
                        for (int j = 0; j < 8; ++j) yp[q][j] = *(const v2u*)(y + (size_t)row * DM + e0 + 256 * j); } }
            } else { const bf16* xin = (const bf16*)xin_; v2u xp[NR][8];
#pragma unroll
                for (int q = 0; q < NR; ++q) { const int row = q ? r1 : r0;
#pragma unroll
                    for (int j = 0; j < 8; ++j) xp[q][j] = *(const v2u*)(xin + (size_t)row * DM + e0 + 256 * j); }
                if (y) {
#pragma unroll
                    for (int q = 0; q < NR; ++q) { const int row = q ? r1 : r0;
#pragma unroll
                        for (int j = 0; j < 8; ++j) yp[q][j] = *(const v2u*)(y + (size_t)row * DM + e0 + 256 * j); } }
#pragma unroll
                for (int q = 0; q < NR; ++q) {
#pragma unroll
                    for (int j = 0; j < 8; ++j) { const v2u p = xp[q][j]; x[q][j] = (f32x4){bflo(p.x), bfhi(p.x), bflo(p.y), bfhi(p.y)}; } }
            }
#pragma unroll
            for (int q = 0; q < NR; ++q) { const int row = q ? r1 : r0;
                if (y) {
                    f32x4 yv[8]; float ss = 0.f;
#pragma unroll
                    for (int j = 0; j < 8; ++j) { const v2u p = yp[q][j]; yv[j] = (f32x4){bflo(p.x), bfhi(p.x), bflo(p.y), bfhi(p.y)};
                        ss += (yv[j].x * yv[j].x + yv[j].y * yv[j].y) + (yv[j].z * yv[j].z + yv[j].w * yv[j].w); }
                    const float ry = 1.0f / sqrtf(wave_sum(ss, F.lane) * (1.f / DM) + RMS_EPS);
#pragma unroll
                    for (int j = 0; j < 8; ++j) { const f32x4 g = *(const LAS f32x4*)(vec + 1 * DM + e0 + 256 * j), gt = *(const LAS f32x4*)(vec + 0 * DM + e0 + 256 * j);
                        x[q][j] += gt * (yv[j] * ry * g); }
                    if (xout_f32) { float* xout = (float*)xout_;
#pragma unroll
                        for (int j = 0; j < 8; ++j) *(f32x4*)(xout + (size_t)row * DM + e0 + 256 * j) = x[q][j];
                    } else { bf16* xout = (bf16*)xout_;
#pragma unroll
                        for (int j = 0; j < 8; ++j) { v2u o; o.x = pk2(x[q][j].x, x[q][j].y); o.y = pk2(x[q][j].z, x[q][j].w); *(v2u*)(xout + (size_t)row * DM + e0 + 256 * j) = o; } }
                }
                if (hout) {
                    float ss = 0.f;
#pragma unroll
                    for (int j = 0; j < 8; ++j) ss += (x[q][j].x * x[q][j].x + x[q][j].y * x[q][j].y) + (x[q][j].z * x[q][j].z + x[q][j].w * x[q][j].w);
                    const float rx = 1.0f / sqrtf(wave_sum(ss, F.lane) * (1.f / DM) + RMS_EPS);
#pragma unroll
                    for (int j = 0; j < 8; ++j) { const f32x4 g = *(const LAS f32x4*)(vec + 2 * DM + e0 + 256 * j), sh = *(const LAS f32x4*)(vec + 3 * DM + e0 + 256 * j), sc = *(const LAS f32x4*)(vec + 4 * DM + e0 + 256 * j);
                        const f32x4 hv = (x[q][j] * rx * g) * (sc + 1.0f) + sh;
                        v2u o; o.x = pk2(hv.x, hv.y); o.y = pk2(hv.z, hv.w);
                        *(v2u*)(hout + (size_t)row * DM + e0 + 256 * j) = o; }
                }
            }
        }
        seg = send;
    }
}
__device__ __forceinline__ void ph_dsa_norm(Frame& F, const float* proj, const float* qn, const float* kvn, const float* ikn, bf16* qlat, bf16* ckv, bf16* kidx, float* widx) {
    const int gw = blockIdx.x * NWAVES + F.wave, NGW = F.G * NWAVES; const int e0 = 4 * F.lane;
    for (int row = gw; row < T; row += NGW) {
        f32x4 v[4];
#pragma unroll
        for (int j = 0; j < 4; ++j) v[j] = *(const f32x4*)(proj + (size_t)row * A_INP + e0 + 256 * j);
        float sq = 0.f;
#pragma unroll
        for (int j = 0; j < 2; ++j) sq += (v[j].x * v[j].x + v[j].y * v[j].y) + (v[j].z * v[j].z + v[j].w * v[j].w);
        const float rq = 1.0f / sqrtf(wave_sum(sq, F.lane) * (1.f / A_QR) + RMS_EPS);
#pragma unroll
        for (int j = 0; j < 2; ++j) { const f32x4 g = *(const f32x4*)(qn + e0 + 256 * j); const f32x4 o = v[j] * rq * g; v2u w; w.x = pk2(o.x, o.y); w.y = pk2(o.z, o.w);
            *(v2u*)(qlat + (size_t)row * A_QR + e0 + 256 * j) = w; }
        const float skv = (v[2].x * v[2].x + v[2].y * v[2].y) + (v[2].z * v[2].z + v[2].w * v[2].w);
        const float rkv = 1.0f / sqrtf(wave_sum(skv, F.lane) * (1.f / A_KVR) + RMS_EPS);
        { const f32x4 g = *(const f32x4*)(kvn + e0); const f32x4 o = v[2] * rkv * g; v2u w; w.x = pk2(o.x, o.y); w.y = pk2(o.z, o.w); *(v2u*)(ckv + (size_t)row * A_KVR + e0) = w; }
        const bool isk = F.lane < 32;
        const float s1 = isk ? (v[3].x + v[3].y) + (v[3].z + v[3].w) : 0.f;
        const float mean = wave_sum(s1, F.lane) * (1.f / IDX_D);
        const f32x4 dv = v[3] - mean;
        const float s2 = isk ? (dv.x * dv.x + dv.y * dv.y) + (dv.z * dv.z + dv.w * dv.w) : 0.f;
        const float rk = 1.0f / sqrtf(wave_sum(s2, F.lane) * (1.f / IDX_D) + RMS_EPS);
        if (isk) { const f32x4 g = *(const f32x4*)(ikn + e0); const f32x4 o = dv * rk * g; v2u w; w.x = pk2(o.x, o.y); w.y = pk2(o.z, o.w); *(v2u*)(kidx + (size_t)row * IDX_D + e0) = w; }
        else if (F.lane < 36) { *(f32x4*)(widx + (size_t)row * IDX_H + (e0 - 128)) = v[3] * 0.02209708691207961f; }
    }
}

__device__ __forceinline__ int wave_scan_incl(int v, int lane, int& total) {
    v += __builtin_amdgcn_update_dpp(0, v, 0x111, 0xf, 0xf, true); v += __builtin_amdgcn_update_dpp(0, v, 0x112, 0xf, 0xf, true);
    v += __builtin_amdgcn_update_dpp(0, v, 0x114, 0xf, 0xf, true); v += __builtin_amdgcn_update_dpp(0, v, 0x118, 0xf, 0xf, true);
    const int t0 = __builtin_amdgcn_readlane(v, 15), t1 = __builtin_amdgcn_readlane(v, 31), t2 = __builtin_amdgcn_readlane(v, 47), t3 = __builtin_amdgcn_readlane(v, 63);
    v += (lane >= 16 ? t0 : 0) + (lane >= 32 ? t1 : 0) + (lane >= 48 ? t2 : 0);
    total = (t0 + t1) + (t2 + t3);
    return v;
}
template <bool G, class SP> __device__ __forceinline__ void topk_select_row(SP sc, int t, int* out, int lane, LAS int* lst) {
    const int n = t + 1;
    if (n <= TOPK) { for (int i = lane; i < TOPK; i += 64) out[i] = (i < n) ? i : 0; return; }
    const int ni = G ? 2 * ((n + 127) >> 7) : (n + 63) >> 6;
#define TOPK_KEYIDX(i) (G ? 128 * ((i) >> 1) + 2 * lane + ((i) & 1) : 64 * (i) + lane)
    unsigned key[64];
#pragma unroll
    for (int g = 0; g < 8; ++g) {
        if (8 * g < ni) {
            if constexpr (G) {
#pragma unroll
                for (int j = 4 * g; j < 4 * g + 4; ++j) { const unsigned d = __hip_atomic_load((const unsigned*)sc + 64 * j + lane, __ATOMIC_RELAXED, __HIP_MEMORY_SCOPE_AGENT);
#pragma unroll
                    for (int e = 0; e < 2; ++e) { const int s = 128 * j + 2 * lane + e; const unsigned h = e ? (d >> 16) : (d & 0xffffu); const unsigned k = (h & 0x8000u) ? (~h & 0xffffu) : (h | 0x8000u); key[2 * j + e] = (s < n) ? k : 0u; } }
            } else {
#pragma unroll
                for (int i = 8 * g; i < 8 * g + 8; ++i) { const int s = 64 * i + lane; const unsigned h = sc[s < n ? s : n - 1]; const unsigned k = (h & 0x8000u) ? (~h & 0xffffu) : (h | 0x8000u); key[i] = (s < n) ? k : 0u; }
            }
        } else {
#pragma unroll
            for (int i = 8 * g; i < 8 * g + 8; ++i) key[i] = 0u;
        }
    }
    unsigned prefix = 0u;
    for (int bit = 15; bit >= 0; --bit) {
        const unsigned cand = prefix | (1u << bit); int cl = 0;
#pragma unroll
        for (int g = 0; g < 8; ++g) if (8 * g < ni) {
#pragma unroll
            for (int i = 8 * g; i < 8 * g + 8; ++i) cl += (key[i] >= cand) ? 1 : 0; }
        cl += __builtin_amdgcn_update_dpp(0, cl, 0xB1, 0xf, 0xf, true); cl += __builtin_amdgcn_update_dpp(0, cl, 0x4E, 0xf, 0xf, true);
        cl += __builtin_amdgcn_update_dpp(0, cl, 0x124, 0xf, 0xf, true); cl += __builtin_amdgcn_update_dpp(0, cl, 0x128, 0xf, 0xf, true);
        const int cnt = (__builtin_amdgcn_readlane(cl, 0) + __builtin_amdgcn_readlane(cl, 16)) + (__builtin_amdgcn_readlane(cl, 32) + __builtin_amdgcn_readlane(cl, 48));
        if (cnt >= TOPK) prefix = cand;
    }
    int cg = 0, ce = 0;
#pragma unroll
    for (int g = 0; g < 8; ++g) if (8 * g < ni) {
#pragma unroll
        for (int i = 8 * g; i < 8 * g + 8; ++i) { cg += (key[i] > prefix) ? 1 : 0; ce += (key[i] == prefix) ? 1 : 0; } }
    int tg, te;
    const int bg = wave_scan_incl(cg, lane, tg) - cg, be = wave_scan_incl(ce, lane, te) - ce;
    int quota = (TOPK - tg) - be; quota = quota < 0 ? 0 : (quota > ce ? ce : quota);
    int pg = bg, pe = tg + (be < TOPK - tg ? be : TOPK - tg);
    const int dummy = TOPK + lane;
#pragma unroll
    for (int g = 0; g < 8; ++g) if (8 * g < ni) {
#pragma unroll
        for (int i = 8 * g; i < 8 * g + 8; ++i) {
            const bool gt = key[i] > prefix, eq = (key[i] == prefix) && (quota > 0);
            const int pos = gt ? pg : (eq ? pe : dummy);
            lst[pos] = TOPK_KEYIDX(i);
            pg += gt ? 1 : 0; pe += eq ? 1 : 0; quota -= eq ? 1 : 0;
        } }
    asm volatile("s_waitcnt lgkmcnt(0)" ::: "memory");
    *(v4u*)(out + 4 * lane) = *(const LAS v4u*)(lst + 4 * lane);
#undef TOPK_KEYIDX
}
__device__ __forceinline__ int t5_bucket(int d) {
    if (d < 16) return d;
    int bkt = 16;
    bkt += (d >= 19) + (d >= 21) + (d >= 24) + (d >= 27) + (d >= 31) + (d >= 35) + (d >= 40) + (d >= 46) + (d >= 52) + (d >= 59) + (d >= 67) + (d >= 77) + (d >= 87) + (d >= 99) + (d >= 113);
    return bkt;
}

typedef short bf16x8 __attribute__((ext_vector_type(8)));
typedef short s16x4 __attribute__((ext_vector_type(4)));
typedef float f32x16 __attribute__((ext_vector_type(16)));
__device__ __forceinline__ unsigned offb(unsigned row, unsigned ch) { return 256u * row + 16u * (ch ^ (((row & 3u) << 2) | ((row >> 2) & 3u))); }
__device__ __forceinline__ unsigned tr_base_perm(unsigned lane, unsigned c, unsigned t) {
    const unsigned h = lane >> 5, blk = (lane >> 4) & 1u, q = (lane & 15u) >> 2, p = lane & 3u;
    return offb(8u * t + 4u * h + q, 4u * c + 2u * blk + (p >> 1)) + 8u * (p & 1u);
}
__device__ __forceinline__ bf16x8 tr_frag_at(LAS unsigned char* img, unsigned b0, unsigned b1, unsigned ks) {
    const s16x4 lo = __builtin_amdgcn_ds_read_tr16_b64_v4i16((LAS s16x4*)(img + b0 + 4096u * ks));
    const s16x4 hi = __builtin_amdgcn_ds_read_tr16_b64_v4i16((LAS s16x4*)(img + b1 + 4096u * ks));
    return __builtin_shufflevector(lo, hi, 0, 1, 2, 3, 4, 5, 6, 7);
}

__device__ __forceinline__ void ph_indexer(Frame& F, const bf16* qidx, const bf16* kidx, const float* widx, int* idxo) {
    constexpr int NQ = 8;
    LAS unsigned short* sc = (LAS unsigned short*)(F.lds);
    LAS float* wsh = (LAS float*)(F.lds + 65536);
    LAS unsigned char* ring = F.lds + 66560;
    const int r = F.lane & 31, hf = F.lane >> 5, rp = F.wave & 1, kq = F.wave >> 1;
    const int drow = 4 * F.wave + (F.lane >> 4), dch = (F.lane & 15) ^ (((F.lane >> 4) << 2) | (F.wave & 3));
    for (int u = blockIdx.x; u < BATCH * (SEQ / NQ); u += F.G) {
        const int b = u & 7, t0 = (u >> 3) * NQ;
        const int nt = (t0 + NQ + 31) >> 5, ns = (nt + 3) >> 2;
        const bf16* kbase = kidx + (size_t)(b * SEQ + drow) * IDX_D + dch * 8;
        __syncthreads();
#pragma unroll
        for (int j = 0; j < 4; ++j) __builtin_amdgcn_global_load_lds((const unsigned*)(kbase + (size_t)(j * 32) * IDX_D), (LAS unsigned*)(ring + j * 8192 + F.wave * 1024), 16, 0, 0);
        if (F.tid < NQ * 16) wsh[F.tid] = widx[(size_t)(b * SEQ + t0 + (F.tid >> 4)) * IDX_H + (F.tid & 15)];
        bf16x8 Af[2][8];
#pragma unroll
        for (int rt = 0; rt < 2; ++rt) { const int query = t0 + 4 * rp + 2 * rt + ((r >> 2) & 1), head = 4 * (r >> 3) + (r & 3);
            const bf16* ap = qidx + (size_t)(b * SEQ + query) * 2048 + head * 128 + 8 * hf;
#pragma unroll
            for (int ks = 0; ks < 8; ++ks) Af[rt][ks] = *(const bf16x8*)(ap + 16 * ks); }
        for (int s = 0; s < ns; ++s) {
            asm volatile("s_waitcnt vmcnt(0) lgkmcnt(0)" ::: "memory"); __builtin_amdgcn_s_barrier(); asm volatile("" ::: "memory");
            if (s + 1 < ns) {
#pragma unroll
                for (int j = 0; j < 4; ++j) __builtin_amdgcn_global_load_lds((const unsigned*)(kbase + (size_t)((4 * (s + 1) + j) * 32) * IDX_D), (LAS unsigned*)(ring + ((s + 1) & 1) * 32768 + j * 8192 + F.wave * 1024), 16, 0, 0);
            }
            const int kt = 4 * s + kq;
            if (kt < nt) {
                LAS unsigned char* tile = ring + (s & 1) * 32768 + kq * 8192;
                bf16x8 Bf[8];
#pragma unroll
                for (int ks = 0; ks < 8; ++ks) Bf[ks] = *(const LAS bf16x8*)(tile + offb((unsigned)r, (unsigned)(2 * ks + hf)));
#pragma unroll
                for (int rt = 0; rt < 2; ++rt) {
                    f32x16 acc;
#pragma unroll
                    for (int i = 0; i < 16; ++i) acc[i] = 0.f;
#pragma unroll
                    for (int ks = 0; ks < 8; ++ks) acc = __builtin_amdgcn_mfma_f32_32x32x16_bf16(Af[rt][ks], Bf[ks], acc, 0, 0, 0);
                    float s0 = 0.f, s1 = 0.f;
#pragma unroll
                    for (int i4 = 0; i4 < 4; ++i4) { const f32x4 w4 = *(const LAS f32x4*)(wsh + (4 * rp + 2 * rt + hf) * 16 + 4 * i4);
                        s0 += w4.x * fmaxf(acc[4 * i4], 0.f) + w4.z * fmaxf(acc[4 * i4 + 2], 0.f); s1 += w4.y * fmaxf(acc[4 * i4 + 1], 0.f) + w4.w * fmaxf(acc[4 * i4 + 3], 0.f); }
                    sc[(4 * rp + 2 * rt + hf) * 4096 + kt * 32 + r] = __builtin_bit_cast(unsigned short, (_Float16)(s0 + s1));
                }
            }
        }
        __syncthreads();
        for (int q = F.wave; q < NQ; q += NWAVES) topk_select_row<false>(sc + q * 4096, t0 + q, idxo + (size_t)(b * SEQ + t0 + q) * TOPK, F.lane, (LAS int*)(F.lds + 132096) + F.wave * 320);
    }
}

#define LDS_BARRIER() do { asm volatile("s_waitcnt lgkmcnt(0)" ::: "memory"); __builtin_amdgcn_s_barrier(); asm volatile("" ::: "memory"); } while (0)
__device__ __forceinline__ int relane(int lane) { asm volatile("" : "+v"(lane)); return lane; }
__device__ __forceinline__ void ph_sparse_attn(Frame& F, bf16* qa_olat, const bf16* ckv, const int* idxi, const float* relb) {
    LAS unsigned char* KV = F.lds;
    LAS unsigned char* PF = F.lds + 131072;
    LAS float* wmax = (LAS float*)(F.lds + 147456);
    LAS float* wsum = wmax + 256;
    LAS unsigned char* bks = F.lds + 147456 + 2048;
    LAS float* relbs = (LAS float*)(F.lds + 147456 + 2048 + 512);
    LAS float* invw = (LAS float*)(F.lds + 147456 + 2048 + 512 + 4224);
    LAS unsigned char* blut = F.lds + 147456 + 2048 + 512 + 4224 + 1024;
    const float scale = 0.08838834764831845f;
    const int w = F.wave;
    __syncthreads();
    for (int i = F.tid; i < 1024; i += 512) relbs[i] = relb[i];
    if (F.tid < 32) relbs[1024 + F.tid] = -INFINITY;
    if (F.tid < 128) blut[F.tid] = (unsigned char)t5_bucket(F.tid);
    int u = blockIdx.x;
    if (u >= T) return;
    int idc[16]; int bid; v4u R[16]; v4u Qr[2];
    {
        const int cc = F.lane & 31, r = F.lane & 31, hf = F.lane >> 5;
        const int t = u % SEQ, b = u / SEQ;
        const int* ip = idxi + (size_t)u * TOPK + 32 * w + hf;
#pragma unroll
        for (int k = 0; k < 16; ++k) idc[k] = ip[2 * k];
        const bf16* kb = ckv + (size_t)b * SEQ * A_KVR + cc * 8;
#pragma unroll
        for (int k = 0; k < 16; ++k) R[k] = *(const v4u*)(kb + (size_t)idc[k] * A_KVR);
        if (F.tid < 256) { const int id = idxi[(size_t)u * TOPK + F.tid]; const int d = t - id; bks[F.tid] = (F.tid <= t) ? (unsigned char)t5_bucket(d > 0 ? d : 0) : (unsigned char)32; }
        const int u2 = (u + F.G < T) ? u + F.G : u;
        const int* ip2 = idxi + (size_t)u2 * TOPK + 32 * w + hf;
#pragma unroll
        for (int k = 0; k < 16; ++k) idc[k] = ip2[2 * k];
        bid = (F.tid < 256) ? idxi[(size_t)u2 * TOPK + F.tid] : -1;
        { const v4u* qp = (const v4u*)(qa_olat + (size_t)u * A_HEADS * A_KVR);
#pragma unroll
          for (int j = 0; j < 2; ++j) { const int id = 2 * w + j, head = 8 * (id & 3) + (F.lane & 7), pos = 8 * (id >> 2) + (F.lane >> 3); Qr[j] = qp[head * 32 + pos]; } }
    }
    unsigned wro[16], qwo[2], trb[2];
    { const unsigned r0 = F.lane & 31, hf0 = F.lane >> 5; const unsigned c0 = (r0 & 15u) ^ (4u * hf0);
#pragma unroll
      for (int k = 0; k < 16; ++k) wro[k] = (r0 >> 4) * 65536u + 256u * (32u * w + hf0) + 512u * k + 16u * (c0 ^ (unsigned)(8 * (k & 1) + ((k >> 1) & 3)));
#pragma unroll
      for (int j = 0; j < 2; ++j) { const int id = 2 * w + j, head = 8 * (id & 3) + (F.lane & 7), pos = 8 * (id >> 2) + (F.lane >> 3); qwo[j] = (pos >> 1) * 1024 + ((pos & 1) * 32 + head) * 16; }
      trb[0] = tr_base_perm((unsigned)F.lane, (unsigned)(w & 3), 0u); trb[1] = tr_base_perm((unsigned)F.lane, (unsigned)(w & 3), 1u); }
    unsigned rdo[16];
    { const unsigned r0 = F.lane & 31, hf0 = F.lane >> 5, row = 32u * w + r0, xr = ((row & 3u) << 2) | ((row >> 2) & 3u);
#pragma unroll
      for (int ks = 0; ks < 16; ++ks) rdo[ks] = 256u * row + (ks >> 3) * 65536u + 16u * ((unsigned)(2 * (ks & 7) + hf0) ^ xr); }
    for (int it = 0; u < T; u += F.G, ++it) {
        const int un = u + F.G, unn = u + 2 * F.G, par = it & 1;
        LDS_BARRIER();
        const int l2 = relane(F.lane), r = l2 & 31, hf = l2 >> 5;
        {
#pragma unroll
          for (int k = 0; k < 16; ++k) *(LAS v4u*)(KV + wro[k]) = R[k]; }
        *(LAS v4u*)(PF + qwo[0]) = Qr[0]; *(LAS v4u*)(PF + qwo[1]) = Qr[1];
        LDS_BARRIER();
        const int tid1 = w * 64 + l2;
        const int unb = (un < T) ? un : u; const int bn = unb / SEQ, tn = unb % SEQ;
        const bf16* kbn = ckv + (size_t)bn * SEQ * A_KVR + r * 8;
        f32x16 acc;
#pragma unroll
        for (int i = 0; i < 16; ++i) acc[i] = 0.f;
        {
#pragma unroll
          for (int ks = 0; ks < 16; ++ks) { const bf16x8 a = *(const LAS bf16x8*)(KV + rdo[ks]);
              acc = __builtin_amdgcn_mfma_f32_32x32x16_bf16(a, *(const LAS bf16x8*)(PF + ks * 1024 + l2 * 16), acc, 0, 0, 0);
              R[ks] = *(const v4u*)(kbn + (size_t)idc[ks] * A_KVR); } }
        if (tid1 < 256) { int d = tn - bid; d = d < 0 ? 0 : (d > 127 ? 127 : d); bks[(par ^ 1) * 256 + tid1] = (tid1 <= tn) ? blut[d] : (unsigned char)32; }
        { const v4u* qp = (const v4u*)(qa_olat + (size_t)unb * A_HEADS * A_KVR);
#pragma unroll
          for (int j = 0; j < 2; ++j) { const int id = 2 * w + j, head = 8 * (id & 3) + (l2 & 7), pos = 8 * (id >> 2) + (l2 >> 3); Qr[j] = qp[head * 32 + pos]; } }
        float lg[16]; float m = -INFINITY;
#pragma unroll
        for (int g = 0; g < 4; ++g) { const unsigned b4 = *(const LAS unsigned*)(bks + par * 256 + 32 * w + 8 * g + 4 * hf);
#pragma unroll
            for (int j = 0; j < 4; ++j) { const unsigned bk = (b4 >> (8 * j)) & 255u; const int i = 4 * g + j;
                lg[i] = acc[i] * scale + relbs[bk * 32 + r]; m = fmaxf(m, lg[i]); } }
        m = fmaxf(m, shx(m, 32, l2));
        if (hf == 0) wmax[r * 8 + w] = m;
        LDS_BARRIER();
        { const f32x4 m0 = *(const LAS f32x4*)(wmax + r * 8), m1 = *(const LAS f32x4*)(wmax + r * 8 + 4);
          m = fmaxf(fmaxf(fmaxf(m0.x, m0.y), fmaxf(m0.z, m0.w)), fmaxf(fmaxf(m1.x, m1.y), fmaxf(m1.z, m1.w))); }
        float s = 0.f;
#pragma unroll
        for (int i = 0; i < 16; ++i) { lg[i] = __expf(lg[i] - m); s += lg[i]; }
        s += shx(s, 32, l2);
        if (hf == 0) wsum[r * 8 + w] = s;
#pragma unroll
        for (int s2 = 0; s2 < 2; ++s2) { v4u pk; pk.x = pk2(lg[8 * s2 + 0], lg[8 * s2 + 1]); pk.y = pk2(lg[8 * s2 + 2], lg[8 * s2 + 3]); pk.z = pk2(lg[8 * s2 + 4], lg[8 * s2 + 5]); pk.w = pk2(lg[8 * s2 + 6], lg[8 * s2 + 7]);
            *(LAS v4u*)(PF + (2 * w + s2) * 1024 + l2 * 16) = pk; }
        LDS_BARRIER();
        const int l3 = relane(F.lane), r3 = l3 & 31, hf3 = l3 >> 5;
        if (hf3 == 0) { const f32x4 s0 = *(const LAS f32x4*)(wsum + r3 * 8), s1 = *(const LAS f32x4*)(wsum + r3 * 8 + 4);
            invw[w * 32 + r3] = 1.0f / (((s0.x + s0.y) + (s0.z + s0.w)) + ((s1.x + s1.y) + (s1.z + s1.w))); }
        f32x16 o;
#pragma unroll
        for (int i = 0; i < 16; ++i) o[i] = 0.f;
        LAS unsigned char* img = KV + (w >> 2) * 65536;
        const int unc = (unn < T) ? unn : u;
        const int* ip2 = idxi + (size_t)unc * TOPK + 32 * w + hf3;
        const unsigned tb0 = trb[0], tb1 = trb[1];
#pragma unroll
        for (int ks = 0; ks < 16; ++ks) { const bf16x8 a = *(const LAS bf16x8*)(PF + ks * 1024 + l3 * 16);
            const bf16x8 bb = tr_frag_at(img, tb0, tb1, (unsigned)ks);
            o = __builtin_amdgcn_mfma_f32_32x32x16_bf16(a, bb, o, 0, 0, 0);
            idc[ks] = ip2[2 * ks]; }
        if (w * 64 + l3 < 256) bid = idxi[(size_t)unc * TOPK + w * 64 + l3];
        bf16* op = qa_olat + ((size_t)u * A_HEADS + 4 * hf3) * A_KVR + 32 * w + r3;
#pragma unroll
        for (int g = 0; g < 4; ++g) { const f32x4 iv = *(const LAS f32x4*)(invw + w * 32 + 8 * g + 4 * hf3);
            op[(8 * g + 0) * A_KVR] = (bf16)f2bf(o[4 * g + 0] * iv.x); op[(8 * g + 1) * A_KVR] = (bf16)f2bf(o[4 * g + 1] * iv.y);
            op[(8 * g + 2) * A_KVR] = (bf16)f2bf(o[4 * g + 2] * iv.z); op[(8 * g + 3) * A_KVR] = (bf16)f2bf(o[4 * g + 3] * iv.w); }
    }
}

__device__ __forceinline__ void ph_sb_attn(Frame& F, const bf16* qkv, bf16* o_out, unsigned* qctr) {
    LAS unsigned char* img = F.lds + F.wave * 8192;
    LAS unsigned char* qimg = F.lds + 65536 + F.wave * 8192;
    const int r = F.lane & 31, hf = F.lane >> 5;
    const float scale = 0.08838834764831845f;
    constexpr int NTASK8 = BATCH * B_HEADS * (SEQ / 32) / 8;
    const int myx = (int)(xb_xcc_id() & 7u);
    for (int qi = 0; qi < 8; ++qi) { const int qsel = (myx + qi) & 7;
    for (;;) {
        int task = 0;
        if (F.lane == 0) task = (int)__hip_atomic_fetch_add(qctr + 64 * qsel, 1u, __ATOMIC_RELAXED, __HIP_MEMORY_SCOPE_AGENT);
        task = __builtin_amdgcn_readfirstlane(task);
        if (task >= NTASK8) break;
        task += qsel * NTASK8;
        const int qt = task & 127, bh = task >> 7, h = bh & 15, b = bh >> 4, t0 = qt * 32;
        v4u Kr[8], Vr[8];
#pragma unroll
        for (int k = 0; k < 8; ++k) { const int n = F.lane + 64 * k; *(LAS v4u*)(qimg + offb(n >> 4, n & 15)) = *(const v4u*)(qkv + (size_t)(b * SEQ + t0 + (n >> 4)) * B_INC + h * B_HD + (n & 15) * 8); }
        {
#pragma unroll
          for (int k = 0; k < 8; ++k) { const int n = F.lane + 64 * k; const bf16* rp = qkv + (size_t)(b * SEQ + qt * 32 + (n >> 4)) * B_INC + h * B_HD + (n & 15) * 8; Kr[k] = *(const v4u*)(rp + DM); Vr[k] = *(const v4u*)(rp + 2 * DM); } }
        f32x16 o[4];
#pragma unroll
        for (int dt = 0; dt < 4; ++dt)
#pragma unroll
            for (int i = 0; i < 16; ++i) o[dt][i] = 0.f;
        float Rc = 1.f;
        for (int kt = qt; kt >= 0; --kt) {
            const int ll = relane(F.lane), r = ll & 31, hf = ll >> 5;
#pragma unroll
            for (int k = 0; k < 8; ++k) { const int n = ll + 64 * k; *(LAS v4u*)(img + offb(n >> 4, n & 15)) = Kr[k]; }
            f32x16 acc;
#pragma unroll
            for (int i = 0; i < 16; ++i) acc[i] = 0.f;
#pragma unroll
            for (int ks = 0; ks < 8; ++ks) acc = __builtin_amdgcn_mfma_f32_32x32x16_bf16(*(const LAS bf16x8*)(img + offb(r, 2 * ks + hf)), *(const LAS bf16x8*)(qimg + offb(r, 2 * ks + hf)), acc, 0, 0, 0);
            asm volatile("s_waitcnt lgkmcnt(0)" ::: "memory");
#pragma unroll
            for (int k = 0; k < 8; ++k) { const int n = ll + 64 * k; *(LAS v4u*)(img + offb(n >> 4, n & 15)) = Vr[k]; }
            float be[16], om[16];
            const bool diag = (kt == qt);
#pragma unroll
            for (int i = 0; i < 16; ++i) { const float z = fminf(acc[i] * scale, 80.f);
                const float e = __expf(z), rr = __builtin_amdgcn_rcpf(1.0f + e);
                be[i] = e * rr; om[i] = rr; }
            if (diag) {
#pragma unroll
                for (int i = 0; i < 16; ++i) { const int kap = 8 * (i >> 2) + 4 * hf + (i & 3); if (kap >= r) { be[i] = 0.f; om[i] = 1.f; } } }
            float sfx[16], Gt[4], Go[4];
#pragma unroll
            for (int g = 0; g < 4; ++g) { sfx[4 * g + 3] = 1.f; sfx[4 * g + 2] = om[4 * g + 3]; sfx[4 * g + 1] = sfx[4 * g + 2] * om[4 * g + 2]; sfx[4 * g + 0] = sfx[4 * g + 1] * om[4 * g + 1]; Gt[g] = sfx[4 * g + 0] * om[4 * g + 0]; }
#pragma unroll
            for (int g = 0; g < 4; ++g) Go[g] = shx(Gt[g], 32, ll);
            float SP[4]; SP[3] = 1.f; SP[2] = Gt[3] * Go[3]; SP[1] = SP[2] * (Gt[2] * Go[2]); SP[0] = SP[1] * (Gt[1] * Go[1]);
            float wgt[16];
#pragma unroll
            for (int g = 0; g < 4; ++g) { const float Rg = Rc * SP[g] * (hf == 0 ? Go[g] : 1.f);
#pragma unroll
                for (int j = 0; j < 4; ++j) wgt[4 * g + j] = be[4 * g + j] * (Rg * sfx[4 * g + j]); }
            Rc = Rc * (SP[0] * (Gt[0] * Go[0]));
            if (kt > 0) {
#pragma unroll
                for (int k = 0; k < 8; ++k) { const int n = F.lane + 64 * k; const bf16* rp = qkv + (size_t)(b * SEQ + (kt - 1) * 32 + (n >> 4)) * B_INC + h * B_HD + (n & 15) * 8; Kr[k] = *(const v4u*)(rp + DM); Vr[k] = *(const v4u*)(rp + 2 * DM); }
            }
            asm volatile("s_waitcnt lgkmcnt(0)" ::: "memory");
#pragma unroll
            for (int s2 = 0; s2 < 2; ++s2) {
                v4u pk; pk.x = pk2(wgt[8 * s2 + 0], wgt[8 * s2 + 1]); pk.y = pk2(wgt[8 * s2 + 2], wgt[8 * s2 + 3]); pk.z = pk2(wgt[8 * s2 + 4], wgt[8 * s2 + 5]); pk.w = pk2(wgt[8 * s2 + 6], wgt[8 * s2 + 7]);
                const bf16x8 pa = __builtin_bit_cast(bf16x8, pk);
#pragma unroll
                for (int dt = 0; dt < 4; ++dt) { const bf16x8 vb = tr_frag_at(img, tr_base_perm((unsigned)ll, (unsigned)dt, 0u), tr_base_perm((unsigned)ll, (unsigned)dt, 1u), (unsigned)s2);
                    o[dt] = __builtin_amdgcn_mfma_f32_32x32x16_bf16(pa, vb, o[dt], 0, 0, 0); }
            }
            if (__ballot(Rc >= 0x1p-40f) == 0ull) break;
        }
#pragma unroll
        for (int dt = 0; dt < 4; ++dt)
#pragma unroll
            for (int i = 0; i < 16; ++i) { const int qrow = 8 * (i >> 2) + 4 * hf + (i & 3);
                o_out[(size_t)(b * SEQ + t0 + qrow) * DM + h * B_HD + 32 * dt + r] = (bf16)f2bf(o[dt][i]); }
    }
    }
}

constexpr int PH_LAYER0 = 3, PH_PER_LAYER = 16, PH_END = PH_LAYER0 + DEPTH * PH_PER_LAYER;
typedef pg8::bf16_t gb16;
__device__ __forceinline__ bool relaunder(Frame& F) { int l_; asm volatile("v_mbcnt_lo_u32_b32 %0, -1, 0\n\tv_mbcnt_hi_u32_b32 %0, -1, %0" : "=v"(l_)); F.lane = l_; F.tid = F.wave * 64 + l_; return true; }
template <class Epi> __device__ __forceinline__ void run_gemm(Frame& F, const bf16* A, const bf16* Bt, int N, int K, int lda, int ldb, int acs, const Epi& E) {
    pg8::Gemm g{(const gb16*)A, (const gb16*)Bt, T, N, K, lda, ldb, acs}; pg8::StaticOrder S; S.init(T, N, F.G, (F.G == 256) ? (int)((blockIdx.x & 31) * 8 + (blockIdx.x >> 5)) : (int)blockIdx.x);
    pg8::gemm_phase<Epi, pg8::StaticOrder, true, true>(F.lds, g, S, E, F.tid);
}
__global__ void __launch_bounds__(NWAVES * 64, 2) fwd_kernel(Args args) {
    extern __shared__ __attribute__((aligned(16))) unsigned char lds_raw[];
    Frame F;
    F.lds = (LAS unsigned char*)lds_raw;
    F.tid = threadIdx.x; F.lane = F.tid & 63; F.wave = __builtin_amdgcn_readfirstlane(F.tid >> 6); F.G = gridDim.x;
    F.ap = (const CAS Args*)__builtin_amdgcn_kernarg_segment_ptr();
    F.out = args.out; F.ws = args.ws;
    volatile LAS unsigned* MISC = (volatile LAS unsigned*)(F.lds + MISC_OFF);
    if (F.tid < 64) MISC[F.tid] = 0u;
    __syncthreads();
    const int lo = args.ph_lo, hi = args.ph_hi;
    XcdBarrier bar; bar.bar = (unsigned*)(F.ws + WS_CTL) + CW_BAR; bar.x = 0; bar.st = nullptr;
    if (hi - lo > 1) { bar = xcd_barrier_post((unsigned*)(F.ws + WS_CTL) + CW_BAR, MISC + 8); xcd_barrier<true>(bar); }
#define IN(k) (lo <= (k) && (k) < hi && relaunder(F))
#define INR(k) (lo <= (k) && (k) < hi)
#define GRID_BAR() do { XcdBarrier b2_ = bar; b2_.x = (unsigned)__builtin_amdgcn_readfirstlane((int)bar.x); asm volatile("" : "+s"(b2_.bar), "+s"(b2_.x)); xcd_barrier<false>(b2_); } while (0)
#define SEAM(k) do { if (INR((k) + 1)) GRID_BAR(); } while (0)

    float* mod = WSP(float, WS_MOD);
    const float* normg = F.inp(IN_NORMG);
    bf16* Hb = WSP(bf16, WS_H);
    if (IN(0)) { ph_prologue(F); SEAM(0); }
    if (IN(1)) { ph_modreduce(F); SEAM(1); }
    if (IN(2)) { ph_post(F, nullptr, F.inp(IN_X), true, nullptr, false, nullptr, nullptr, Hb, normg + 0 * DM, mod + 0 * DM, mod + 1 * DM); SEAM(2); }

    for (int L = 0; L < DEPTH; ++L) {
        const int pb = PH_LAYER0 + PH_PER_LAYER * L, j = L >> 1;
        const float* modL = mod + (size_t)L * BATCH * MODW;
        const float* ng = normg + (size_t)L * 4 * DM;
        const bool lastL = (L == DEPTH - 1);
        bf16* XB = (bf16*)((unsigned char*)F.out + 128 * MiB); bf16* XL = WSP(bf16, WS_P + 128 * MiB);
        if ((L & 1) == 0) {
            float* proj = WSP(float, WS_P); bf16* qidx = WSP(bf16, WS_P + 128 * MiB); bf16* ob = WSP(bf16, WS_P);
            bf16* big = WSP(bf16, WS_BIG);
            bf16* qlat = WSP(bf16, WS_QLAT); bf16* ckv = WSP(bf16, WS_CKV); bf16* kidx = WSP(bf16, WS_KIDX); float* widx = WSP(float, WS_WIDX); int* idxb = WSP(int, WS_IDX);
            if (IN(pb + 0)) { pg8::EpiF32 E{proj, A_INP}; run_gemm(F, Hb, WSP(bf16, WS_WAIN) + (size_t)j * A_INP * DM, A_INP, DM, DM, DM, 0, E); SEAM(pb + 0); }
            if (IN(pb + 1)) { ph_dsa_norm(F, proj, F.inp(IN_AQN) + j * A_QR, F.inp(IN_AKVN) + j * A_KVR, F.inp(IN_AIKN) + j * IDX_D, qlat, ckv, kidx, widx); SEAM(pb + 1); }
            if (IN(pb + 2)) { pg8::EpiBf16<0> E{(gb16*)big, 8192, (gb16*)qidx, 2048, 8192}; run_gemm(F, qlat, WSP(bf16, WS_WQC) + (size_t)j * 10240 * 512, 10240, A_QR, A_QR, A_QR, 0, E); SEAM(pb + 2); }
            if (IN(pb + 3)) { ph_indexer(F, qidx, kidx, widx, idxb); SEAM(pb + 3); }
            if (IN(pb + 4)) { ph_sparse_attn(F, big, ckv, idxb, F.inp(IN_RELB)); SEAM(pb + 4); }
            if (IN(pb + 5)) { pg8::EpiBf16<0> E{(gb16*)ob, 4096, (gb16*)ob, 4096, 1 << 30}; run_gemm(F, big, WSP(bf16, WS_WUV) + (size_t)j * 4096 * 512, 4096, 512, 8192, 512, 512, E); SEAM(pb + 5); }
            if (IN(pb + 6)) { pg8::EpiBf16<0> E{(gb16*)big, DM, (gb16*)big, DM, 1 << 30}; run_gemm(F, ob, WSP(bf16, WS_WAOUT) + (size_t)j * DM * 4096, DM, 4096, 4096, 4096, 0, E); SEAM(pb + 6); }
        } else {
            bf16* qkv = WSP(bf16, WS_BIG); bf16* ob = WSP(bf16, WS_P); bf16* big = WSP(bf16, WS_BIG);
            if (IN(pb + 0)) { pg8::EpiBf16<0> E{(gb16*)qkv, B_INC, (gb16*)qkv, B_INC, 1 << 30}; run_gemm(F, Hb, WSP(bf16, WS_WBIN) + (size_t)j * B_INC * DM, B_INC, DM, DM, DM, 0, E); SEAM(pb + 0); }
            if (IN(pb + 1)) { ph_sb_attn(F, qkv, ob, (unsigned*)(F.ws + WS_CTL) + CW_SBQ + 512 * j); SEAM(pb + 1); }
            if (IN(pb + 2)) { pg8::EpiBf16<0> E{(gb16*)big, DM, (gb16*)big, DM, 1 << 30}; run_gemm(F, ob, WSP(bf16, WS_WBOUT) + (size_t)j * DM * DM, DM, DM, DM, DM, 0, E); if (INR(pb + 7)) GRID_BAR(); }
        }
        if (IN(pb + 7)) { ph_post(F, WSP(bf16, WS_BIG), (L == 0) ? (const void*)F.inp(IN_X) : (const void*)XB, L == 0, lastL ? (void*)XL : (void*)XB, false, modL + 2 * DM, ng + 1 * DM, Hb, ng + 2 * DM, modL + 3 * DM, modL + 4 * DM); SEAM(pb + 7); }
        if (IN(pb + 8)) { pg8::EpiBf16<1> E{(gb16*)WSP(bf16, WS_BIG), DFF, (gb16*)WSP(bf16, WS_BIG), DFF, 1 << 30}; run_gemm(F, Hb, WSP(bf16, WS_WM1) + (size_t)L * DFF * DM, DFF, DM, DM, DM, 0, E); SEAM(pb + 8); }
        if (IN(pb + 9)) { pg8::EpiBf16<0> E{(gb16*)WSP(bf16, WS_P), DM, (gb16*)WSP(bf16, WS_P), DM, 1 << 30}; run_gemm(F, WSP(bf16, WS_BIG), WSP(bf16, WS_WM2) + (size_t)L * DM * DFF, DM, DFF, DFF, DFF, 0, E); SEAM(pb + 9); }
        if (IN(pb + 10)) {
            const float* modN = mod + (size_t)(L + 1) * BATCH * MODW; const float* ngN = normg + (size_t)(L + 1) * 4 * DM;
            ph_post(F, WSP(bf16, WS_P), lastL ? (const void*)XL : (const void*)XB, false, lastL ? (void*)F.out : (void*)XB, lastL, modL + 5 * DM, ng + 3 * DM, lastL ? nullptr : Hb, ngN, modN + 0 * DM, modN + 1 * DM);
            if (!lastL && INR(pb + PH_PER_LAYER)) GRID_BAR();
        }
    }
#undef IN
#undef INR
#undef GRID_BAR
#undef SEAM
}

extern "C" void kernel_launch(void* const* d_in, const int* in_sizes, int n_in, void* d_out, int out_size, void* d_ws, size_t ws_size, hipStream_t stream) {
    static int grid = 0;
    if (grid == 0) {
        if (n_in != N_IN || out_size != T * DM || ws_size < WS_END) { fprintf(stderr, "kernel_launch: unexpected problem: n_in %d out %d ws %zu (need %zu); nothing launched\n", n_in, out_size, ws_size, (size_t)WS_END); grid = -1; return; }
        int dev = 0, cus = 0, per_cu = 0;
        if (hipGetDevice(&dev) != hipSuccess || hipDeviceGetAttribute(&cus, hipDeviceAttributeMultiprocessorCount, dev) != hipSuccess) { grid = -1; return; }
        if (hipFuncSetAttribute((const void*)fwd_kernel, hipFuncAttributeMaxDynamicSharedMemorySize, LDS_BYTES) != hipSuccess) { fprintf(stderr, "kernel_launch: hipFuncSetAttribute(%d B LDS) failed\n", LDS_BYTES); grid = -1; return; }
        if (hipOccupancyMaxActiveBlocksPerMultiprocessor(&per_cu, (const void*)fwd_kernel, NWAVES * 64, LDS_BYTES) != hipSuccess || per_cu < 1) { fprintf(stderr, "kernel_launch: occupancy query says %d workgroups per CU; nothing launched\n", per_cu); (void)hipGetLastError(); grid = -1; return; }
        grid = cus * (per_cu < 1 ? per_cu : 1);
    }
    if (grid < 0) return;
    (void)hipMemsetAsync((char*)d_ws + WS_CTL, 0, CTL_ZERO_BYTES, stream);
    Args a{};
    for (int i = 0; i < N_IN; ++i) a.in[i] = (const float*)d_in[i];
    a.out = (float*)d_out; a.ws = (unsigned char*)d_ws;
#if ONE_LAUNCH
    a.ph_lo = 0; a.ph_hi = PH_END;
    hipLaunchKernelGGL(fwd_kernel, dim3(grid), dim3(NWAVES * 64), LDS_BYTES, stream, a);
#else
    for (int p = 0; p < PH_END; ++p) {
        if (p >= PH_LAYER0) { const int L = (p - PH_LAYER0) / PH_PER_LAYER, r = (p - PH_LAYER0) % PH_PER_LAYER;
            if (r > 10) continue; if ((L & 1) && r >= 3 && r <= 6) continue; }
        a.ph_lo = p; a.ph_hi = p + 1;
        hipLaunchKernelGGL(fwd_kernel, dim3(grid), dim3(NWAVES * 64), LDS_BYTES, stream, a);
    }
#endif
}
```

```cpp
#include <hip/hip_runtime.h>
#include <cstdio>
#include <cstdint>
#ifndef ONE_LAUNCH
#define ONE_LAUNCH 1
#endif
namespace pg8 {
#define PG8_LAS __attribute__((address_space(3)))
typedef unsigned short bf16_t;
typedef short bf16x8 __attribute__((ext_vector_type(8)));
typedef float f32x4 __attribute__((ext_vector_type(4)));
typedef unsigned u32x4 __attribute__((ext_vector_type(4)));
constexpr int BM = 256, BK = 64, HALF = 128, HTB = HALF * BK * 2  , STAGE_BYTES = 8 * HTB, NXCD = 8, WGM = 4;

__host__ __device__ __forceinline__ int lds_byte(int r, int c) { const int st = (r >> 4) * 2 + (c >> 5), rr = r & 15, cc = c & 31, ob = rr * 64 + cc * 2; return st * 1024 + (ob ^ (((ob >> 9) & 1) << 5)); }
__host__ __device__ __forceinline__ void stage_rc(int b, int& R, int& C) { const int st = b / 1024, sb = b % 1024, swz = sb ^ (((sb >> 9) & 1) << 5); R = (st >> 1) * 16 + swz / 64; C = (st & 1) * 32 + (swz % 64) / 2; }
__host__ __device__ __forceinline__ int perm32(int rho) { const int n = rho >> 4, i = rho & 15; return 8 * (i >> 2) + 4 * n + (i & 3); }

struct Unit { int pm, pn; };
struct Gemm { const bf16_t* A; const bf16_t* Bt; int M, N, K, lda, ldb, acs; };

struct StaticOrder {
    int nM, nN, nwg, G, c;
    __host__ __device__ void init(int M, int N, int G_, int c_) { nM = M / BM; nN = N / BM; nwg = nM * nN; G = G_; c = c_; }
    __host__ __device__ bool next(int i, Unit& u) const {
        const long L = (long)i * G + c; if (L >= nwg) return false;
        int wgid = (int)L; { const int q = nwg / NXCD, r = nwg % NXCD, xcd = wgid % NXCD, off = wgid / NXCD; wgid = (xcd < r ? xcd * (q + 1) : r * (q + 1) + (xcd - r) * q) + off; }
        const int nig = WGM * nN, gid = wgid / nig, fm = gid * WGM, gsz = (nM - fm) < WGM ? (nM - fm) : WGM;
        u.pm = fm + ((wgid % nig) % gsz); u.pn = (wgid % nig) / gsz; return true;
    }
    __device__ __forceinline__ void a_ready(const Unit&) const {}
    __device__ __forceinline__ void done(const Unit&) const {}
};


__device__ __forceinline__ float relu_f(float x) { float r; asm("v_max_f32 %0, 0, %1" : "=v"(r) : "v"(x)); return r; }
__device__ __forceinline__ unsigned cvt_pk_bf16(float lo, float hi) { unsigned r; asm("v_cvt_pk_bf16_f32 %0, %1, %2" : "=v"(r) : "v"(lo), "v"(hi)); return r; }
struct EpiF32 {
    static constexpr bool PERM = false, AFTER_DRAIN = false;
    float* C; int ldc;
    __device__ __forceinline__ void operator()(const f32x4 (&acc)[2][2][4][2], const Unit& u, int wr, int wc, int fr, int fq, PG8_LAS unsigned char* lds) const {
        PG8_LAS unsigned char* scr = lds + STAGE_BYTES + (wr * 4 + wc) * 2048;
        const int lane = fq * 16 + fr, rrow = lane >> 3, rch = lane & 7;
        PG8_LAS unsigned char* wp = scr + fr * 128 + 16 * (fq ^ (fr >> 1));
        const int wsw = ((fr >> 1) & 4) ? -64 : 64;
        const PG8_LAS unsigned char* rp = scr + rrow * 128 + 16 * (rch ^ ((rrow >> 1) & 7));
        const int rsw = (rch & 4) ? -64 : 64;
        float* gp = C + (size_t)(u.pm * BM + wr * 64 + rrow) * ldc + u.pn * BM + wc * 32 + 4 * rch;
#pragma unroll
        for (int ai = 0; ai < 2; ++ai)
#pragma unroll
            for (int m = 0; m < 4; ++m)
#pragma unroll
                for (int bj = 0; bj < 2; ++bj) {
#pragma unroll
                    for (int n = 0; n < 2; ++n) *(PG8_LAS f32x4*)(wp + (n ? wsw : 0)) = acc[ai][bj][m][n];
#pragma unroll
                    for (int s = 0; s < 2; ++s) { const f32x4 w = *(const PG8_LAS f32x4*)(rp + s * 1024 + (s ? rsw : 0));
                        *(f32x4*)(gp + (size_t)(ai * HALF + m * 16 + s * 8) * ldc + bj * HALF) = w; } }
    }
};
template <int ACT> struct EpiBf16 {
    static constexpr bool PERM = true, AFTER_DRAIN = false;
    bf16_t* O0; int ld0; bf16_t* O1; int ld1; int split_col;
    __device__ __forceinline__ void operator()(const f32x4 (&acc)[2][2][4][2], const Unit& u, int wr, int wc, int fr, int fq, PG8_LAS unsigned char* lds) const {
        int colt = u.pn * BM; bf16_t* base = O0; int ldc = ld0;
        if (colt >= split_col) { base = O1; ldc = ld1; colt -= split_col; }
        PG8_LAS unsigned char* scr = lds + STAGE_BYTES + (wr * 4 + wc) * 2048;
        const int lane = fq * 16 + fr, rrow = lane >> 3, rch = lane & 7;
        PG8_LAS unsigned char* wp = scr + fr * 128 + 16 * (fq ^ (fr >> 1));
        const int wsw = ((fr >> 1) & 4) ? -64 : 64;
        const PG8_LAS unsigned char* rp = scr + rrow * 128 + 16 * (rch ^ ((rrow >> 1) & 7));
        const int rsw = (rch & 4) ? -64 : 64;
        bf16_t* gp = base + (size_t)(u.pm * BM + wr * 64 + rrow) * ldc + colt + wc * 64 + 8 * rch;
        u32x4 rd[2];
#pragma unroll
        for (int it = 0; it < 8; ++it) { const int ai = it >> 2, m = it & 3;
#pragma unroll
            for (int bj = 0; bj < 2; ++bj) { f32x4 v0 = acc[ai][bj][m][0], v1 = acc[ai][bj][m][1];
                if (ACT == 1) {
#pragma unroll
                    for (int j = 0; j < 4; ++j) { const float a = relu_f(v0[j]), b = relu_f(v1[j]); v0[j] = a * a; v1[j] = b * b; } }
                u32x4 w; w.x = cvt_pk_bf16(v0[0], v0[1]); w.y = cvt_pk_bf16(v0[2], v0[3]); w.z = cvt_pk_bf16(v1[0], v1[1]); w.w = cvt_pk_bf16(v1[2], v1[3]);
                *(PG8_LAS u32x4*)(wp + (bj ? wsw : 0)) = w; }
            if (it > 0) { const int pa = (it - 1) >> 2, pm_ = (it - 1) & 3;
#pragma unroll
                for (int s = 0; s < 2; ++s) *(u32x4*)(gp + (size_t)(pa * HALF + pm_ * 16 + s * 8) * ldc) = rd[s]; }
#pragma unroll
            for (int s = 0; s < 2; ++s) rd[s] = *(const PG8_LAS u32x4*)(rp + s * 1024 + (s ? rsw : 0)); }
#pragma unroll
        for (int s = 0; s < 2; ++s) *(u32x4*)(gp + (size_t)(HALF + 3 * 16 + s * 8) * ldc) = rd[s];
    }
};

template <class Epi, class Sched, bool ALIGN_EPI = false, bool SP2 = false>
__device__ __forceinline__ void gemm_phase(PG8_LAS unsigned char* lds, const Gemm g, const Sched& S, const Epi& E, int tid_in) {
    int tid_l = tid_in; asm volatile("" : "+v"(tid_l));
    const int tid = tid_l, wid = __builtin_amdgcn_readfirstlane(tid >> 6), lane = tid & 63, wr = wid >> 2, wc = wid & 3, fr = lane & 15, fq = lane >> 4;
    const int K = g.K, nt = K / BK;
    unsigned voffA[2], voffB[2];
#pragma unroll
    for (int i = 0; i < 2; ++i) { int R, C; stage_rc(tid * 16 + i * 8192, R, C); const int Rb = Epi::PERM ? ((R >> 5) * 64 + perm32(R & 31)) : R;
        voffA[i] = (unsigned)(R * g.lda + C) * 2u; voffB[i] = (unsigned)(Rb * g.ldb + C) * 2u; }
    const size_t kstep = (size_t)(BK * 2);
    const size_t hstepA = (size_t)HALF * g.lda * 2, hstepB = (size_t)(Epi::PERM ? 32 : HALF) * g.ldb * 2;
    const size_t tstepA = 2 * hstepA, tstepB = (size_t)BM * g.ldb * 2, cstepA = (size_t)g.acs * 2;
    const unsigned ldsw = (unsigned)wid * 1024u;
    const int aoff = lds_byte(wr * 64 + fr, fq * 8), boff = lds_byte(wc * 32 + fr, fq * 8);
#define PG8_SA(b, h) (((b) * 2 + (h)) * HTB)
#define PG8_SB(b, h) ((4 + (b) * 2 + (h)) * HTB)
#define PG8_STAGE(bufoff, gbase, voff) do { _Pragma("unroll") for (int _i = 0; _i < 2; ++_i) \
        __builtin_amdgcn_global_load_lds((const unsigned*)((const char*)(gbase) + (voff)[_i]), (PG8_LAS unsigned*)(lds + (bufoff) + ldsw + _i * 8192), 16, 0, 0); } while (0)
#define PG8_LDA(dst, b, h) do { _Pragma("unroll") for (int m = 0; m < 4; ++m) _Pragma("unroll") for (int k = 0; k < 2; ++k) dst[m][k] = *(const PG8_LAS bf16x8*)(lds + PG8_SA(b, h) + aoff + m * 2048 + k * 1024); } while (0)
#define PG8_LDB(dst, b, h) do { _Pragma("unroll") for (int n = 0; n < 2; ++n) _Pragma("unroll") for (int k = 0; k < 2; ++k) dst[n][k] = *(const PG8_LAS bf16x8*)(lds + PG8_SB(b, h) + boff + n * 2048 + k * 1024); } while (0)
#define PG8_MMA(ai, bj, At, Bt) do { __builtin_amdgcn_s_setprio(1); _Pragma("unroll") for (int m = 0; m < 4; ++m) _Pragma("unroll") for (int n = 0; n < 2; ++n) _Pragma("unroll") for (int k = 0; k < 2; ++k) \
        acc[ai][bj][m][n] = __builtin_amdgcn_mfma_f32_16x16x32_bf16(Bt[n][k], At[m][k], acc[ai][bj][m][n], 0, 0, 0); __builtin_amdgcn_s_setprio(0); } while (0)
#define PG8_WAIT_V(n) asm volatile("s_waitcnt vmcnt(" #n ")" ::: "memory")
#define PG8_WAIT_L(n) asm volatile("s_waitcnt lgkmcnt(" #n ")" ::: "memory")
#define PG8_BAR __builtin_amdgcn_s_barrier()
#define PG8_SCHED __builtin_amdgcn_sched_barrier(0)
    Unit cur, nxt; int ui = 0;
    if (!S.next(0, cur)) return;
    f32x4 acc[2][2][4][2];
#pragma unroll
    for (int a = 0; a < 2; ++a)
#pragma unroll
        for (int b = 0; b < 2; ++b)
#pragma unroll
            for (int m = 0; m < 4; ++m)
#pragma unroll
                for (int n = 0; n < 2; ++n) acc[a][b][m][n] = (f32x4){0.f, 0.f, 0.f, 0.f};
    bf16x8 At[4][2], B0[2][2], B1[2][2];
    const char* cA = (const char*)g.A + (size_t)cur.pm * tstepA + (size_t)cur.pn * cstepA; const char* cB = (const char*)g.Bt + (size_t)cur.pn * tstepB;
    S.a_ready(cur);
    if constexpr (SP2) {
        PG8_STAGE(PG8_SB(0, 0), cB, voffB); PG8_STAGE(PG8_SB(0, 1), cB + hstepB, voffB); PG8_STAGE(PG8_SA(0, 0), cA, voffA); PG8_STAGE(PG8_SA(0, 1), cA + hstepA, voffA);
        if (wr == 1) PG8_BAR;
        PG8_WAIT_V(2); PG8_BAR;
        PG8_STAGE(PG8_SB(1, 0), cB + kstep, voffB); PG8_STAGE(PG8_SA(1, 0), cA + kstep, voffA); PG8_STAGE(PG8_SB(1, 1), cB + hstepB + kstep, voffB);
        PG8_WAIT_V(6); PG8_BAR;
    } else {
        PG8_STAGE(PG8_SB(0, 0), cB, voffB); PG8_STAGE(PG8_SA(0, 0), cA, voffA); PG8_STAGE(PG8_SB(0, 1), cB + hstepB, voffB); PG8_STAGE(PG8_SA(0, 1), cA + hstepA, voffA);
        if (wr == 1) PG8_BAR;
        PG8_WAIT_V(4); PG8_BAR;
        PG8_STAGE(PG8_SB(1, 0), cB + kstep, voffB); PG8_STAGE(PG8_SA(1, 0), cA + kstep, voffA); PG8_STAGE(PG8_SB(1, 1), cB + hstepB + kstep, voffB);
        PG8_WAIT_V(6); PG8_BAR;
    }
    for (;;) {
        const bool has_next = S.next(ui + 1, nxt);
        const char* nA = has_next ? (const char*)g.A + (size_t)nxt.pm * tstepA + (size_t)nxt.pn * cstepA : cA; const char* nB = has_next ? (const char*)g.Bt + (size_t)nxt.pn * tstepB : cB;
        for (int t = 0; t < nt; t += 2) {
            const bool last = (t == nt - 2);
            const char* a1 = cA + (size_t)(t + 1) * kstep;
            const char* a2 = last ? nA : cA + (size_t)(t + 2) * kstep; const char* b2 = last ? nB : cB + (size_t)(t + 2) * kstep;
            const char* a3 = a2 + kstep; const char* b3 = b2 + kstep;
            if (last && has_next) S.a_ready(nxt);
            if constexpr (SP2) {
            PG8_LDB(B0, 0, 0); PG8_LDB(B1, 0, 1); PG8_SCHED; PG8_LDA(At, 0, 0); PG8_STAGE(PG8_SA(1, 1), a1 + hstepA, voffA);
            PG8_WAIT_V(8); PG8_WAIT_L(0); PG8_BAR; PG8_MMA(0, 0, At, B0); PG8_MMA(0, 1, At, B1); PG8_BAR; PG8_SCHED;
            PG8_LDA(At, 0, 1); PG8_STAGE(PG8_SB(0, 0), b2, voffB); PG8_STAGE(PG8_SB(0, 1), b2 + hstepB, voffB); PG8_STAGE(PG8_SA(0, 0), a2, voffA);
            PG8_WAIT_V(8); PG8_WAIT_L(0); PG8_BAR; PG8_MMA(1, 0, At, B0); PG8_MMA(1, 1, At, B1); PG8_BAR; PG8_SCHED;
            PG8_LDB(B0, 1, 0); PG8_LDB(B1, 1, 1); PG8_SCHED; PG8_LDA(At, 1, 0); PG8_STAGE(PG8_SA(0, 1), a2 + hstepA, voffA);
            PG8_WAIT_V(8); PG8_WAIT_L(0); PG8_BAR; PG8_MMA(0, 0, At, B0); PG8_MMA(0, 1, At, B1); PG8_BAR; PG8_SCHED;
            PG8_LDA(At, 1, 1); PG8_STAGE(PG8_SB(1, 0), b3, voffB); PG8_STAGE(PG8_SB(1, 1), b3 + hstepB, voffB); PG8_STAGE(PG8_SA(1, 0), a3, voffA);
            PG8_WAIT_V(8); PG8_WAIT_L(0); PG8_BAR; PG8_MMA(1, 0, At, B0); PG8_MMA(1, 1, At, B1); PG8_BAR; PG8_SCHED;
            } else {
            PG8_LDB(B0, 0, 0); PG8_SCHED; PG8_LDA(At, 0, 0); PG8_STAGE(PG8_SA(1, 1), a1 + hstepA, voffA);
            PG8_WAIT_L(8); PG8_BAR; PG8_WAIT_L(0); PG8_MMA(0, 0, At, B0); PG8_BAR; PG8_SCHED;
            PG8_LDB(B1, 0, 1); PG8_STAGE(PG8_SB(0, 0), b2, voffB);
            PG8_BAR; PG8_WAIT_L(0); PG8_MMA(0, 1, At, B1); PG8_BAR;
            PG8_LDA(At, 0, 1); PG8_STAGE(PG8_SA(0, 0), a2, voffA);
            PG8_BAR; PG8_WAIT_L(0); PG8_MMA(1, 0, At, B0); PG8_BAR; PG8_SCHED;
            PG8_STAGE(PG8_SB(0, 1), b2 + hstepB, voffB);
            PG8_WAIT_V(6); PG8_BAR; PG8_MMA(1, 1, At, B1); PG8_BAR;
            PG8_LDB(B0, 1, 0); PG8_SCHED; PG8_LDA(At, 1, 0); PG8_STAGE(PG8_SA(0, 1), a2 + hstepA, voffA);
            PG8_WAIT_L(8); PG8_BAR; PG8_WAIT_L(0); PG8_MMA(0, 0, At, B0); PG8_BAR; PG8_SCHED;
            PG8_LDB(B1, 1, 1); PG8_STAGE(PG8_SB(1, 0), b3, voffB);
            PG8_BAR; PG8_WAIT_L(0); PG8_MMA(0, 1, At, B1); PG8_BAR;
            PG8_LDA(At, 1, 1); PG8_STAGE(PG8_SA(1, 0), a3, voffA);
            PG8_BAR; PG8_WAIT_L(0); PG8_MMA(1, 0, At, B0); PG8_BAR; PG8_SCHED;
            PG8_STAGE(PG8_SB(1, 1), b3 + hstepB, voffB);
            PG8_WAIT_V(6); PG8_BAR; PG8_MMA(1, 1, At, B1); PG8_BAR;
            }
        }
        if constexpr (ALIGN_EPI) { if (wr == 0) PG8_BAR; }
        if constexpr (!Epi::AFTER_DRAIN) { E(acc, cur, wr, wc, fr, fq, lds); S.done(cur); }
        if (!has_next) break;
#pragma unroll
        for (int a = 0; a < 2; ++a)
#pragma unroll
            for (int b = 0; b < 2; ++b)
#pragma unroll
                for (int m = 0; m < 4; ++m)
#pragma unroll
                    for (int n = 0; n < 2; ++n) acc[a][b][m][n] = (f32x4){0.f, 0.f, 0.f, 0.f};
        cur = nxt; cA = nA; cB = nB; ++ui;
        if constexpr (ALIGN_EPI) { if (wr == 1) PG8_BAR; }
    }
    PG8_WAIT_V(0);
    if constexpr (!ALIGN_EPI) { if (wr == 0) PG8_BAR; }
    PG8_BAR;
    if constexpr (Epi::AFTER_DRAIN) { E.fused(acc, cur, wr, wc, fr, fq, lds, wid, lane); S.done(cur); }
#undef PG8_SA
#undef PG8_SB
#undef PG8_STAGE
#undef PG8_LDA
#undef PG8_LDB
#undef PG8_MMA
#undef PG8_WAIT_V
#undef PG8_WAIT_L
#undef PG8_BAR
#undef PG8_SCHED
}
}

constexpr int NWAVES = 8;
constexpr int BATCH = 8, SEQ = 4096, DM = 2048, DEPTH = 4, DFF = 8192, T = BATCH * SEQ;
constexpr int A_HEADS = 32, A_QR = 512, A_KVR = 256, IDX_H = 16, IDX_D = 128, TOPK = 256, A_IN = 912, A_INP = 1024;
constexpr int B_HEADS = 16, B_HD = 128, B_INC = 3 * DM;
constexpr int MODW = 6 * DM;
constexpr float RMS_EPS = 1e-6f;
enum { IN_X = 0, IN_C, IN_RELB, IN_ADAW, IN_ADAB, IN_NORMG, IN_AWIN, IN_AQN, IN_AKVN, IN_AIKN, IN_AWQB, IN_AWIQB, IN_AWUK, IN_AWUV, IN_AWOUT, IN_BWIN, IN_BWOUT, IN_W1, IN_W2, N_IN };

constexpr size_t MiB = 1u << 20;
constexpr size_t WS_CTL = 0, CTL_ZERO_BYTES = 1 * MiB;
constexpr size_t WS_MOD = 1 * MiB;
constexpr size_t WS_MODP = 3 * MiB;
constexpr size_t WS_WAIN = 16 * MiB;
constexpr size_t WS_WQC = 24 * MiB;
constexpr size_t WS_WUV = 44 * MiB;
constexpr size_t WS_WAOUT = 52 * MiB;
constexpr size_t WS_WBIN = 84 * MiB;
constexpr size_t WS_WBOUT = 132 * MiB;
constexpr size_t WS_WM1 = 148 * MiB;
constexpr size_t WS_WM2 = 276 * MiB;
constexpr size_t WS_H = 404 * MiB;
constexpr size_t WS_P = 532 * MiB;
constexpr size_t WS_BIG = 788 * MiB;
constexpr size_t WS_QLAT = 1300 * MiB;
constexpr size_t WS_CKV = 1332 * MiB;
constexpr size_t WS_KIDX = 1348 * MiB;
constexpr size_t WS_WIDX = 1356 * MiB;
constexpr size_t WS_IDX = 1358 * MiB;
constexpr size_t WS_END = 1390 * MiB;
constexpr int CW_BAR = 4096;
constexpr int CW_SBQ = 8192;

constexpr int LDS_BYTES = 163840;
constexpr int MISC_OFF = LDS_BYTES - 256;

#define GAS __attribute__((address_space(1)))
#define LAS __attribute__((address_space(3)))
typedef unsigned short bf16;
typedef unsigned v4u __attribute__((ext_vector_type(4)));
typedef unsigned v2u __attribute__((ext_vector_type(2)));
typedef float f32x4 __attribute__((ext_vector_type(4)));
typedef float f32x2 __attribute__((ext_vector_type(2)));
typedef __bf16 bf16x2_t __attribute__((ext_vector_type(2)));
#define LDS_WAIT() asm volatile("s_waitcnt lgkmcnt(0)" ::: "memory")
#define VM_WAIT() asm volatile("s_waitcnt vmcnt(0)" ::: "memory")
__device__ __forceinline__ unsigned f2bf(float f) { unsigned u = __builtin_bit_cast(unsigned, f); return (u + 0x7fffu + ((u >> 16) & 1u)) >> 16; }
__device__ __forceinline__ unsigned pk2(float lo, float hi) { return f2bf(lo) | (f2bf(hi) << 16); }
__device__ __forceinline__ float bflo(unsigned u) { return __builtin_bit_cast(float, u << 16); }
__device__ __forceinline__ float bfhi(unsigned u) { return __builtin_bit_cast(float, u & 0xffff0000u); }
__device__ __forceinline__ float dot2bf(unsigned a, unsigned b, float c) { return __builtin_amdgcn_fdot2_f32_bf16(__builtin_bit_cast(bf16x2_t, a), __builtin_bit_cast(bf16x2_t, b), c, false); }
#define DPP_F(v, ctrl) __builtin_bit_cast(float, __builtin_amdgcn_update_dpp(0, __builtin_bit_cast(int, (v)), (ctrl), 0xf, 0xf, true))
#define RDL_F(v, l) __builtin_bit_cast(float, __builtin_amdgcn_readlane(__builtin_bit_cast(int, (v)), (l)))
__device__ __forceinline__ float wave_sum(float v, int) {
    v += DPP_F(v, 0xB1); v += DPP_F(v, 0x4E); v += DPP_F(v, 0x124); v += DPP_F(v, 0x128);
    return (RDL_F(v, 0) + RDL_F(v, 16)) + (RDL_F(v, 32) + RDL_F(v, 48));
}
__device__ __forceinline__ float wave_max(float v, int) {
    v = fmaxf(v, DPP_F(v, 0xB1)); v = fmaxf(v, DPP_F(v, 0x4E)); v = fmaxf(v, DPP_F(v, 0x124)); v = fmaxf(v, DPP_F(v, 0x128));
    return fmaxf(fmaxf(RDL_F(v, 0), RDL_F(v, 16)), fmaxf(RDL_F(v, 32), RDL_F(v, 48)));
}
__device__ __forceinline__ float shx(float v, int, int lane) {
    const unsigned u = __builtin_bit_cast(unsigned, v);
    auto r = __builtin_amdgcn_permlane32_swap(u, u, false, false);
    return __builtin_bit_cast(float, (lane & 32) ? r[0] : r[1]);
}

#define XB_TMO      128
#define XB_XCNT(j)  (256  + 64 * (j))
#define XB_XSUB(j)  (1280 + 64 * (j))
#define XB_XGEN(j)  (2304 + 64 * (j))
#define XB_TOP      3328
#define XB_TOPGEN   3392
#define XCD_BAR_WORDS 3456
#define XB_SPIN_CAP (1u << 22)

__device__ __forceinline__ unsigned xb_ld(unsigned* p)              { return __hip_atomic_load(p, __ATOMIC_RELAXED, __HIP_MEMORY_SCOPE_AGENT); }
__device__ __forceinline__ unsigned xb_add(unsigned* p, unsigned v) { return __hip_atomic_fetch_add(p, v, __ATOMIC_RELAXED, __HIP_MEMORY_SCOPE_AGENT); }
__device__ __forceinline__ unsigned xb_xcc_id() { return (unsigned)__builtin_amdgcn_s_getreg((3 << 11) | 20) & 0xFu; }
#define XB_SPIN(cond, bar) do { unsigned _sp = 0; while (cond) { __builtin_amdgcn_s_sleep(1); \
    if ((++_sp & 255u) == 0u) { if (xb_ld(&(bar)[XB_TMO])) break; if (_sp > XB_SPIN_CAP) { atomicAdd(&(bar)[XB_TMO], 1u); break; } } } } while (0)

struct XcdBarrier {
    unsigned* bar; unsigned x;
    volatile LAS unsigned* st;
};

__device__ __forceinline__ XcdBarrier xcd_barrier_post(unsigned* bar, volatile LAS unsigned* st) {
    XcdBarrier b; b.bar = bar; b.x = xb_xcc_id(); b.st = st;
    if (threadIdx.x == 0) (void)xb_add(&bar[XB_XCNT(b.x)], 1u);
    return b;
}
__device__ __forceinline__ void xcd_barrier_complete(unsigned* bar, unsigned x, unsigned& nloc, unsigned& nx) {
    const unsigned G = gridDim.x * gridDim.y * gridDim.z;
    unsigned sum, cnt, mine, sp = 0u;
    for (;;) {
        sum = 0u; cnt = 0u; mine = 0u;
#pragma unroll
        for (unsigned j = 0; j < 16; ++j) { const unsigned c = xb_ld(&bar[XB_XCNT(j)]); sum += c; cnt += (c > 0u) ? 1u : 0u; mine = (j == x) ? c : mine; }
        if (sum == G) break;
        __builtin_amdgcn_s_sleep(1);
        if ((++sp & 255u) == 0u) { if (xb_ld(&bar[XB_TMO])) break; if (sp > XB_SPIN_CAP) { atomicAdd(&bar[XB_TMO], 1u); break; } }
    }
    nloc = mine > 0u ? mine : 1u; nx = cnt > 0u ? cnt : 1u;
}

template <bool CENSUS> __device__ __forceinline__ void xcd_barrier(const XcdBarrier& b) {
    asm volatile("s_waitcnt vmcnt(0)" ::: "memory");
    __syncthreads();
    if (threadIdx.x == 0) {
        unsigned* bar = b.bar;
        __builtin_amdgcn_s_waitcnt(0);
        unsigned nloc = b.st[0], nx = b.st[1];
        if (CENSUS) { if (nloc == 0u) { xcd_barrier_complete(bar, b.x, nloc, nx); b.st[0] = nloc; b.st[1] = nx; } }
        const unsigned old = xb_add(&bar[XB_XSUB(b.x)], 1u);
        const unsigned gen = old / nloc;
        if (old + 1u == (gen + 1u) * nloc) {
            __builtin_amdgcn_fence(__ATOMIC_RELEASE, "agent");
            asm volatile("s_waitcnt vmcnt(0)" ::: "memory");
            const unsigned og = xb_add(&bar[XB_TOP], 1u);
            const unsigned tg = og / nx;
            if (og + 1u == (tg + 1u) * nx) xb_add(&bar[XB_TOPGEN], 1u);
            else XB_SPIN(xb_ld(&bar[XB_TOPGEN]) == tg, bar);
            __builtin_amdgcn_fence(__ATOMIC_ACQUIRE, "agent");
            xb_add(&bar[XB_XGEN(b.x)], 1u);
            asm volatile("s_waitcnt vmcnt(0)" ::: "memory");
        } else {
            XB_SPIN(xb_ld(&bar[XB_XGEN(b.x)]) == gen, bar);
            __builtin_amdgcn_fence(__ATOMIC_ACQUIRE, "agent");
            asm volatile("s_waitcnt vmcnt(0)" ::: "memory");
        }
    }
    __syncthreads();
}

struct Args { const float* in[N_IN]; float* out; unsigned char* ws; int ph_lo, ph_hi; };
#define CAS __attribute__((address_space(4)))
struct Frame {
    LAS unsigned char* lds;
    int tid, lane, wave, G;
    const CAS Args* ap;
    float* out; unsigned char* ws;
    __device__ __forceinline__ const float* inp(int i) const { return ap->in[i]; }
};
#define WSP(type, off) ((type*)(F.ws + (off)))

__device__ __forceinline__ void p0_transpose_item(const float* W, int Nsrc, bf16* dst, int ldo, LAS float* scr, int kb, int nb, int lane) {
    const int k0 = 64 * kb, n0 = 32 * nb, rsub = lane >> 3, c4 = lane & 7, nn = n0 + 4 * c4;
    f32x4 v[8];
#pragma unroll
    for (int i = 0; i < 8; ++i) v[i] = (nn < Nsrc) ? *(const f32x4*)(W + (size_t)(k0 + 8 * i + rsub) * Nsrc + nn) : (f32x4){0.f, 0.f, 0.f, 0.f};
#pragma unroll
    for (int i = 0; i < 8; ++i) { LAS float* d = scr + (8 * i + rsub) * 33 + 4 * c4; d[0] = v[i].x; d[1] = v[i].y; d[2] = v[i].z; d[3] = v[i].w; }
    LDS_WAIT(); asm volatile("" ::: "memory");
    const int c = lane & 7;
#pragma unroll
    for (int j = 0; j < 4; ++j) { const int n = (lane >> 3) + 8 * j; const LAS float* s = scr + (8 * c) * 33 + n;
        v4u o; o.x = pk2(s[0 * 33], s[1 * 33]); o.y = pk2(s[2 * 33], s[3 * 33]); o.z = pk2(s[4 * 33], s[5 * 33]); o.w = pk2(s[6 * 33], s[7 * 33]);
        *(v4u*)(dst + (size_t)(n0 + n) * ldo + k0 + 8 * c) = o; }
    LDS_WAIT(); asm volatile("" ::: "memory");
}
__device__ __forceinline__ void p0_tr_load(f32x4 (&v)[8], const float* W, int Nsrc, int kb, int nb, int lane) {
    const int k0 = 64 * kb, rsub = lane >> 3, nn = 32 * nb + 4 * (lane & 7);
#pragma unroll
    for (int i = 0; i < 8; ++i) v[i] = (nn < Nsrc) ? *(const f32x4*)(W + (size_t)(k0 + 8 * i + rsub) * Nsrc + nn) : (f32x4){0.f, 0.f, 0.f, 0.f};
}
__device__ __forceinline__ void p0_tr_store(const f32x4 (&v)[8], bf16* dst, int ldo, LAS float* scr, int kb, int nb, int lane) {
    const int k0 = 64 * kb, n0 = 32 * nb, rsub = lane >> 3, c4 = lane & 7;
#pragma unroll
    for (int i = 0; i < 8; ++i) { LAS float* d = scr + (8 * i + rsub) * 33 + 4 * c4; d[0] = v[i].x; d[1] = v[i].y; d[2] = v[i].z; d[3] = v[i].w; }
    LDS_WAIT(); asm volatile("" ::: "memory");
    const int c = lane & 7;
#pragma unroll
    for (int j = 0; j < 4; ++j) { const int n = (lane >> 3) + 8 * j; const LAS float* s = scr + (8 * c) * 33 + n;
        v4u o; o.x = pk2(s[0 * 33], s[1 * 33]); o.y = pk2(s[2 * 33], s[3 * 33]); o.z = pk2(s[4 * 33], s[5 * 33]); o.w = pk2(s[6 * 33], s[7 * 33]);
        *(v4u*)(dst + (size_t)(n0 + n) * ldo + k0 + 8 * c) = o; }
    LDS_WAIT(); asm volatile("" ::: "memory");
}
__device__ __forceinline__ void p0_transpose_job(Frame& F, const float* src, size_t sstride, int nmat, int K, int Nsrc, int Npad, bf16* dst, size_t dstride, int ldo) {
    LAS float* scr = (LAS float*)(F.lds + F.wave * 16384);
    const int gw = blockIdx.x * NWAVES + F.wave, NGW = F.G * NWAVES;
    const int nkb = K / 64, nnb = Npad / 32, per = nkb * nnb, tot = nmat * per;
    int it = gw;
    f32x4 v[8], vn[8];
    if (it < tot) { const int m = it / per, r = it % per; p0_tr_load(v, src + (size_t)m * sstride, Nsrc, r / nnb, r % nnb, F.lane); }
    while (it < tot) {
        const int nx = it + NGW;
        if (nx < tot) { const int m = nx / per, r = nx % per; p0_tr_load(vn, src + (size_t)m * sstride, Nsrc, r / nnb, r % nnb, F.lane); }
        { const int m = it / per, r = it % per; p0_tr_store(v, dst + (size_t)m * dstride, ldo, scr, r / nnb, r % nnb, F.lane); }
#pragma unroll
        for (int i = 0; i < 8; ++i) v[i] = vn[i];
        it = nx;
    }
}
__device__ __forceinline__ void ph_prologue(Frame& F) {
    {
        LAS float* sl = (LAS float*)(F.lds);
        LAS float* red = (LAS float*)(F.lds + 8192);
        const float* cin = F.inp(IN_C); const float* ada_w = F.inp(IN_ADAW); float* modp = WSP(float, WS_MODP);
        for (int u = blockIdx.x; u < 768; u += F.G) {
            const int l = u / 192, r = u % 192, ec = r >> 3, dc = r & 7;
            __syncthreads();
            for (int i = F.tid; i < 2048; i += 512) { const int rr = i >> 3, b = i & 7; const float v = cin[b * DM + dc * 256 + rr]; sl[rr * 8 + b] = v / (1.f + __expf(-v)); }
            __syncthreads();
            const int cq = F.tid & 127, dq = F.tid >> 7;
            f32x4 acc[8];
#pragma unroll
            for (int b = 0; b < 8; ++b) acc[b] = (f32x4){0.f, 0.f, 0.f, 0.f};
            const float* wp = ada_w + ((size_t)l * DM + dc * 256 + dq * 64) * MODW + ec * 512 + cq * 4;
#pragma unroll 8
            for (int i = 0; i < 64; ++i) {
                const f32x4 w = *(const f32x4*)(wp + (size_t)i * MODW);
                const f32x4 s0 = *(const LAS f32x4*)(sl + (dq * 64 + i) * 8), s1 = *(const LAS f32x4*)(sl + (dq * 64 + i) * 8 + 4);
                acc[0] += w * s0.x; acc[1] += w * s0.y; acc[2] += w * s0.z; acc[3] += w * s0.w;
                acc[4] += w * s1.x; acc[5] += w * s1.y; acc[6] += w * s1.z; acc[7] += w * s1.w;
            }
#pragma unroll
            for (int b = 0; b < 8; ++b) *(LAS f32x4*)(red + (dq * 8 + b) * 512 + cq * 4) = acc[b];
            __syncthreads();
            { const int b = F.tid >> 6, c0 = (F.tid & 63) * 8;
#pragma unroll
              for (int k = 0; k < 2; ++k) {
                  const f32x4 s = (*(const LAS f32x4*)(red + (0 * 8 + b) * 512 + c0 + 4 * k) + *(const LAS f32x4*)(red + (1 * 8 + b) * 512 + c0 + 4 * k))
                                + (*(const LAS f32x4*)(red + (2 * 8 + b) * 512 + c0 + 4 * k) + *(const LAS f32x4*)(red + (3 * 8 + b) * 512 + c0 + 4 * k));
                  *(f32x4*)(modp + (((size_t)dc * 4 + l) * 8 + b) * MODW + ec * 512 + c0 + 4 * k) = s; } }
        }
        __syncthreads();
    }
    {
        LAS float* Bs = (LAS float*)(F.lds);
        LAS float* As = (LAS float*)(F.lds + 256 * 132 * 4);
        const float* wqb = F.inp(IN_AWQB); const float* wuk = F.inp(IN_AWUK); bf16* wqc = WSP(bf16, WS_WQC);
        for (int u = blockIdx.x; u < 1024; u += F.G) {
            const int j = u >> 9, h = (u & 511) >> 4, rb = u & 15, r0 = rb * 32;
            __syncthreads();
            const float* bsrc = wuk + ((size_t)j * A_HEADS + h) * 256 * 128;
            for (int i = F.tid; i < 256 * 32; i += 512) { const int row = i >> 5, c4 = i & 31; *(LAS f32x4*)(Bs + row * 132 + c4 * 4) = *(const f32x4*)(bsrc + row * 128 + c4 * 4); }
            for (int i = F.tid; i < 32 * 32; i += 512) { const int row = i >> 5, c4 = i & 31; *(LAS f32x4*)(As + row * 128 + c4 * 4) = *(const f32x4*)(wqb + ((size_t)j * A_QR + r0 + row) * 4096 + h * 128 + c4 * 4); }
            __syncthreads();
            const int c = F.tid & 255, rh = F.tid >> 8;
            float acc[16];
#pragma unroll
            for (int q = 0; q < 16; ++q) acc[q] = 0.f;
            for (int d4 = 0; d4 < 32; ++d4) {
                const f32x4 bv = *(const LAS f32x4*)(Bs + c * 132 + d4 * 4);
#pragma unroll
                for (int q = 0; q < 16; ++q) { const f32x4 av = *(const LAS f32x4*)(As + (rh * 16 + q) * 128 + d4 * 4); acc[q] += (av.x * bv.x + av.y * bv.y) + (av.z * bv.z + av.w * bv.w); }
            }
            bf16* orow = wqc + ((size_t)j * 10240 + h * 256 + c) * 512 + r0 + rh * 16;
            v4u o0, o1;
            o0.x = pk2(acc[0], acc[1]); o0.y = pk2(acc[2], acc[3]); o0.z = pk2(acc[4], acc[5]); o0.w = pk2(acc[6], acc[7]);
            o1.x = pk2(acc[8], acc[9]); o1.y = pk2(acc[10], acc[11]); o1.z = pk2(acc[12], acc[13]); o1.w = pk2(acc[14], acc[15]);
            *(v4u*)(orow) = o0; *(v4u*)(orow + 8) = o1;
        }
        __syncthreads();
    }
    p0_transpose_job(F, F.inp(IN_AWIN), (size_t)DM * A_IN, 2, DM, A_IN, A_INP, WSP(bf16, WS_WAIN), (size_t)A_INP * DM, DM);
    p0_transpose_job(F, F.inp(IN_AWIQB), (size_t)A_QR * 2048, 2, A_QR, 2048, 2048, WSP(bf16, WS_WQC) + (size_t)8192 * 512, (size_t)10240 * 512, 512);
    p0_transpose_job(F, F.inp(IN_AWOUT), (size_t)4096 * DM, 2, 4096, DM, DM, WSP(bf16, WS_WAOUT), (size_t)DM * 4096, 4096);
    p0_transpose_job(F, F.inp(IN_BWIN), (size_t)DM * B_INC, 2, DM, B_INC, B_INC, WSP(bf16, WS_WBIN), (size_t)B_INC * DM, DM);
    p0_transpose_job(F, F.inp(IN_BWOUT), (size_t)DM * DM, 2, DM, DM, DM, WSP(bf16, WS_WBOUT), (size_t)DM * DM, DM);
    p0_transpose_job(F, F.inp(IN_W1), (size_t)DM * DFF, 4, DM, DFF, DFF, WSP(bf16, WS_WM1), (size_t)DFF * DM, DM);
    p0_transpose_job(F, F.inp(IN_W2), (size_t)DFF * DM, 4, DFF, DM, DM, WSP(bf16, WS_WM2), (size_t)DM * DFF, DFF);
    {
        LAS float* scr = (LAS float*)(F.lds + F.wave * 16384);
        const int gw = blockIdx.x * NWAVES + F.wave, NGW = F.G * NWAVES;
        const float* wuv = F.inp(IN_AWUV); bf16* d0 = WSP(bf16, WS_WUV);
        for (int it = gw; it < 64 * 16; it += NGW) {
            const int m = it >> 4, r = it & 15, j = m >> 5, h = m & 31;
            bf16* dst = d0 + (size_t)j * 4096 * 512 + (size_t)((h >> 1) * 256 + (h & 1) * 128) * 512 + (h & 1) * 256;
            p0_transpose_item(wuv + (size_t)m * 256 * 128, 128, dst, 512, scr, r >> 2, r & 3, F.lane);
        }
        const int gt = blockIdx.x * 512 + F.tid, NT = F.G * 512;
        for (int i = gt; i < 2 * 4096 * 32; i += NT) {
            const int row = i >> 5, ch = i & 31, hh = (row >> 7) & 1;
            *(v4u*)(d0 + (size_t)row * 512 + (1 - hh) * 256 + ch * 8) = (v4u){0u, 0u, 0u, 0u};
        }
    }
}
__device__ __forceinline__ void ph_modreduce(Frame& F) {
    const float* modp = WSP(float, WS_MODP); float* mod = WSP(float, WS_MOD); const float* ada_b = F.inp(IN_ADAB);
    const int gt = blockIdx.x * 512 + F.tid, NT = F.G * 512;
    for (int i = gt; i < DEPTH * BATCH * MODW / 4; i += NT) {
        const int e4 = i % (MODW / 4), lb = i / (MODW / 4), l = lb >> 3;
        f32x4 s = *(const f32x4*)(ada_b + (size_t)l * MODW + e4 * 4);
#pragma unroll
        for (int dc = 0; dc < 8; ++dc) s += *(const f32x4*)(modp + ((size_t)dc * 32 + lb) * MODW + e4 * 4);
        *(f32x4*)(mod + (size_t)lb * MODW + e4 * 4) = s;
    }
}

__device__ __forceinline__ void ph_post(Frame& F, const bf16* y, const void* xin_, bool xin_f32, void* xout_, bool xout_f32, const float* gate, const float* gy, bf16* hout, const float* gh, const float* shift, const float* scale) {
    LAS float* vec = (LAS float*)F.lds;
    const int rlo = (int)(((long long)blockIdx.x * T) / F.G), rhi = (int)(((long long)(blockIdx.x + 1) * T) / F.G);
    for (int seg = rlo; seg < rhi; ) {
        const int b = seg / SEQ; const int send = ((b + 1) * SEQ < rhi) ? (b + 1) * SEQ : rhi;
        __syncthreads();
        for (int i = F.tid; i < 5 * (DM / 4); i += NWAVES * 64) { const int v = i / (DM / 4), c4 = i % (DM / 4);
            const float* src = (v == 0) ? (y ? gate + (size_t)b * MODW : nullptr) : (v == 1) ? (y ? gy : nullptr) : (v == 2) ? (hout ? gh : nullptr) : (v == 3) ? (hout ? shift + (size_t)b * MODW : nullptr) : (hout ? scale + (size_t)b * MODW : nullptr);
            *(LAS f32x4*)(vec + v * DM + 4 * c4) = src ? *(const f32x4*)(src + 4 * c4) : (f32x4){0.f, 0.f, 0.f, 0.f}; }
        __syncthreads();
        constexpr int NR = 2;
        for (int r0 = seg + 2 * F.wave; r0 < send; r0 += NR * NWAVES) {
            const int r1 = (r0 + 1 < send) ? r0 + 1 : r0;
            int e0 = 4 * F.lane; asm volatile("" : "+v"(e0));
            f32x4 x[NR][8]; v2u yp[NR][8];
            if (xin_f32) { const float* xin = (const float*)xin_;
#pragma unroll
                for (int q = 0; q < NR; ++q) { const int row = q ? r1 : r0;
#pragma unroll
                    for (int j = 0; j < 8; ++j) x[q][j] = *(const f32x4*)(xin + (size_t)row * DM + e0 + 256 * j); }
                if (y) {
#pragma unroll
                    for (int q = 0; q < NR; ++q) { const int row = q ? r1 : r0;
#pragma unroll
                        for (int j = 0; j < 8; ++j) yp[q][j] = *(const v2u*)(y + (size_t)row * DM + e0 + 256 * j); } }
            } else { const bf16* xin = (const bf16*)xin_; v2u xp[NR][8];
#pragma unroll
                for (int q = 0; q < NR; ++q) { const int row = q ? r1 : r0;
#pragma unroll
                    for (int j = 0; j < 8; ++j) xp[q][j] = *(const v2u*)(xin + (size_t)row * DM + e0 + 256 * j); }
                if (y) {
#pragma unroll
                    for (int q = 0; q < NR; ++q) { const int row = q ? r1 : r0;
#pragma unroll
                        for (int j = 0; j < 8; ++j) yp[q][j] = *(const v2u*)(y + (size_t)row * DM + e0 + 256 * j); } }
#pragma unroll
                for (int q = 0; q < NR; ++q) {
#pragma unroll
                    for (int j = 0; j < 8; ++j) { const v2u p = xp[q][j]; x[q][j] = (f32x4){bflo(p.x), bfhi(p.x), bflo(p.y), bfhi(p.y)}; } }
            }
#pragma unroll
            for (int q = 0; q < NR; ++q) { const int row = q ? r1 : r0;
                if (y) {
                    f32x4 yv[8]; float ss = 0.f;
#pragma unroll
                    for (int j = 0; j < 8; ++j) { const v2u p = yp[q][j]; yv[j] = (f32x4){bflo(p.x), bfhi(p.x), bflo(p.y), bfhi(p.y)};
                        ss += (yv[j].x * yv[j].x + yv[j].y * yv[j].y) + (yv[j].z * yv[j].z + yv[j].w * yv[j].w); }
                    const float ry = 1.0f / sqrtf(wave_sum(ss, F.lane) * (1.f / DM) + RMS_EPS);
#pragma unroll
                    for (int j = 0; j < 8; ++j) { const f32x4 g = *(const LAS f32x4*)(vec + 1 * DM + e0 + 256 * j), gt = *(const LAS f32x4*)(vec + 0 * DM + e0 + 256 * j);
                        x[q][j] += gt * (yv[j] * ry * g); }
                    if (xout_f32) { float* xout = (float*)xout_;
#pragma unroll
                        for (int j = 0; j < 8; ++j) *(f32x4*)(xout + (size_t)row * DM + e0 + 256 * j) = x[q][j];
                    } else { bf16* xout = (bf16*)xout_;
#pragma unroll
                        for (int j = 0; j < 8; ++j) { v2u o; o.x = pk2(x[q][j].x, x[q][j].y); o.y = pk2(x[q][j].z, x[q][j].w); *(v2u*)(xout + (size_t)row * DM + e0 + 256 * j) = o; } }
                }
                if (hout) {
                    float ss = 0.f;
#pragma unroll
                    for (int j = 0; j < 8; ++j) ss += (x[q][j].x * x[q][j].x + x[q][j].y * x[q][j].y) + (x[q][j].z * x[q][j].z + x[q][j].w * x[q][j].w);
                    const float rx = 1.0f / sqrtf(wave_sum(ss, F.lane) * (1.f / DM) + RMS_EPS);
#pragma unroll
                    for (int j = 0; j < 8; ++j) { const f32x4 g = *(const LAS f32x4*)(vec + 2 * DM + e0 + 256 * j), sh = *(const LAS f32x4*)(vec + 3 * DM + e0 + 256 * j), sc = *(const LAS f32x4*)(vec + 4 * DM + e0 + 256 * j);
                        const f32x4 hv = (x[q][j] * rx * g) * (sc + 1.0f) + sh;
                        v2u o; o.x = pk2(hv.x, hv.y); o.y = pk2(hv.z, hv.w);
                        *(v2u*)(hout + (size_t)row * DM + e0 + 256 * j) = o; }
                }
            }
        }
        seg = send;
    }
}
__device__ __forceinline__ void ph_dsa_norm(Frame& F, const float* proj, const float* qn, const float* kvn, const float* ikn, bf16* qlat, bf16* ckv, bf16* kidx, float* widx) {
    const int gw = blockIdx.x * NWAVES + F.wave, NGW = F.G * NWAVES; const int e0 = 4 * F.lane;
    for (int row = gw; row < T; row += NGW) {
        f32x4 v[4];
#pragma unroll
        for (int j = 0; j < 4; ++j) v[j] = *(const f32x4*)(proj + (size_t)row * A_INP + e0 + 256 * j);
        float sq = 0.f;
#pragma unroll
        for (int j = 0; j < 2; ++j) sq += (v[j].x * v[j].x + v[j].y * v[j].y) + (v[j].z * v[j].z + v[j].w * v[j].w);
        const float rq = 1.0f / sqrtf(wave_sum(sq, F.lane) * (1.f / A_QR) + RMS_EPS);
#pragma unroll
        for (int j = 0; j < 2; ++j) { const f32x4 g = *(const f32x4*)(qn + e0 + 256 * j); const f32x4 o = v[j] * rq * g; v2u w; w.x = pk2(o.x, o.y); w.y = pk2(o.z, o.w);
            *(v2u*)(qlat + (size_t)row * A_QR + e0 + 256 * j) = w; }
        const float skv = (v[2].x * v[2].x + v[2].y * v[2].y) + (v[2].z * v[2].z + v[2].w * v[2].w);
        const float rkv = 1.0f / sqrtf(wave_sum(skv, F.lane) * (1.f / A_KVR) + RMS_EPS);
        { const f32x4 g = *(const f32x4*)(kvn + e0); const f32x4 o = v[2] * rkv * g; v2u w; w.x = pk2(o.x, o.y); w.y = pk2(o.z, o.w); *(v2u*)(ckv + (size_t)row * A_KVR + e0) = w; }
        const bool isk = F.lane < 32;
        const float s1 = isk ? (v[3].x + v[3].y) + (v[3].z + v[3].w) : 0.f;
        const float mean = wave_sum(s1, F.lane) * (1.f / IDX_D);
        const f32x4 dv = v[3] - mean;
        const float s2 = isk ? (dv.x * dv.x + dv.y * dv.y) + (dv.z * dv.z + dv.w * dv.w) : 0.f;
        const float rk = 1.0f / sqrtf(wave_sum(s2, F.lane) * (1.f / IDX_D) + RMS_EPS);
        if (isk) { const f32x4 g = *(const f32x4*)(ikn + e0); const f32x4 o = dv * rk * g; v2u w; w.x = pk2(o.x, o.y); w.y = pk2(o.z, o.w); *(v2u*)(kidx + (size_t)row * IDX_D + e0) = w; }
        else if (F.lane < 36) { *(f32x4*)(widx + (size_t)row * IDX_H + (e0 - 128)) = v[3] * 0.02209708691207961f; }
    }
}

__device__ __forceinline__ int wave_scan_incl(int v, int lane, int& total) {
    v += __builtin_amdgcn_update_dpp(0, v, 0x111, 0xf, 0xf, true); v += __builtin_amdgcn_update_dpp(0, v, 0x112, 0xf, 0xf, true);
    v += __builtin_amdgcn_update_dpp(0, v, 0x114, 0xf, 0xf, true); v += __builtin_amdgcn_update_dpp(0, v, 0x118, 0xf, 0xf, true);
    const int t0 = __builtin_amdgcn_readlane(v, 15), t1 = __builtin_amdgcn_readlane(v, 31), t2 = __builtin_amdgcn_readlane(v, 47), t3 = __builtin_amdgcn_readlane(v, 63);
    v += (lane >= 16 ? t0 : 0) + (lane >= 32 ? t1 : 0) + (lane >= 48 ? t2 : 0);
    total = (t0 + t1) + (t2 + t3);
    return v;
}
template <bool G, class SP> __device__ __forceinline__ void topk_select_row(SP sc, int t, int* out, int lane, LAS int* lst) {
    const int n = t + 1;
    if (n <= TOPK) { for (int i = lane; i < TOPK; i += 64) out[i] = (i < n) ? i : 0; return; }
    const int ni = G ? 2 * ((n + 127) >> 7) : (n + 63) >> 6;
#define TOPK_KEYIDX(i) (G ? 128 * ((i) >> 1) + 2 * lane + ((i) & 1) : 64 * (i) + lane)
    unsigned key[64];
#pragma unroll
    for (int g = 0; g < 8; ++g) {
        if (8 * g < ni) {
            if constexpr (G) {
#pragma unroll
                for (int j = 4 * g; j < 4 * g + 4; ++j) { const unsigned d = __hip_atomic_load((const unsigned*)sc + 64 * j + lane, __ATOMIC_RELAXED, __HIP_MEMORY_SCOPE_AGENT);
#pragma unroll
                    for (int e = 0; e < 2; ++e) { const int s = 128 * j + 2 * lane + e; const unsigned h = e ? (d >> 16) : (d & 0xffffu); const unsigned k = (h & 0x8000u) ? (~h & 0xffffu) : (h | 0x8000u); key[2 * j + e] = (s < n) ? k : 0u; } }
            } else {
#pragma unroll
                for (int i = 8 * g; i < 8 * g + 8; ++i) { const int s = 64 * i + lane; const unsigned h = sc[s < n ? s : n - 1]; const unsigned k = (h & 0x8000u) ? (~h & 0xffffu) : (h | 0x8000u); key[i] = (s < n) ? k : 0u; }
            }
        } else {
#pragma unroll
            for (int i = 8 * g; i < 8 * g + 8; ++i) key[i] = 0u;
        }
    }
    unsigned prefix = 0u;
    for (int bit = 15; bit >= 0; --bit) {
        const unsigned cand = prefix | (1u << bit); int cl = 0;
#pragma unroll
        for (int g = 0; g < 8; ++g) if (8 * g < ni) {
#pragma unroll
            for (int i = 8 * g; i < 8 * g + 8; ++i) cl += (key[i] >= cand) ? 1 : 0; }
        cl += __builtin_amdgcn_update_dpp(0, cl, 0xB1, 0xf, 0xf, true); cl += __builtin_amdgcn_update_dpp(0, cl, 0x4E, 0xf, 0xf, true);
        cl += __builtin_amdgcn_update_dpp(0, cl, 0x124, 0xf, 0xf, true); cl += __builtin_amdgcn_update_dpp(0, cl, 0x128, 0xf, 0xf, true);
        const int cnt = (__builtin_amdgcn_readlane(cl, 0) + __builtin_amdgcn_readlane(cl, 16)) + (__builtin_amdgcn_readlane(cl, 32) + __builtin_amdgcn_readlane(cl, 48));
        if (cnt >= TOPK) prefix = cand;
    }
    int cg = 0, ce = 0;
#pragma unroll
    for (int g = 0; g < 8; ++g) if (8 * g < ni) {
#pragma unroll
        for (int i = 8 * g; i < 8 * g + 8; ++i) { cg += (key[i] > prefix) ? 1 : 0; ce += (key[i] == prefix) ? 1 : 0; } }
    int tg, te;
    const int bg = wave_scan_incl(cg, lane, tg) - cg, be = wave_scan_incl(ce, lane, te) - ce;
    int quota = (TOPK - tg) - be; quota = quota < 0 ? 0 : (quota > ce ? ce : quota);
    int pg = bg, pe = tg + (be < TOPK - tg ? be : TOPK - tg);
    const int dummy = TOPK + lane;
#pragma unroll
    for (int g = 0; g < 8; ++g) if (8 * g < ni) {
#pragma unroll
        for (int i = 8 * g; i < 8 * g + 8; ++i) {
            const bool gt = key[i] > prefix, eq = (key[i] == prefix) && (quota > 0);
            const int pos = gt ? pg : (eq ? pe : dummy);
            lst[pos] = TOPK_KEYIDX(i);
            pg += gt ? 1 : 0; pe += eq ? 1 : 0; quota -= eq ? 1 : 0;
        } }
    asm volatile("s_waitcnt lgkmcnt(0)" ::: "memory");
    *(v4u*)(out + 4 * lane) = *(const LAS v4u*)(lst + 4 * lane);
#undef TOPK_KEYIDX
}
__device__ __forceinline__ int t5_bucket(int d) {
    if (d < 16) return d;
    int bkt = 16;
    bkt += (d >= 19) + (d >= 21) + (d >= 24) + (d >= 27) + (d >= 31) + (d >= 35) + (d >= 40) + (d >= 46) + (d >= 52) + (d >= 59) + (d >= 67) + (d >= 77) + (d >= 87) + (d >= 99) + (d >= 113);
    return bkt;
}

typedef short bf16x8 __attribute__((ext_vector_type(8)));
typedef short s16x4 __attribute__((ext_vector_type(4)));
typedef float f32x16 __attribute__((ext_vector_type(16)));
__device__ __forceinline__ unsigned offb(unsigned row, unsigned ch) { return 256u * row + 16u * (ch ^ (((row & 3u) << 2) | ((row >> 2) & 3u))); }
__device__ __forceinline__ unsigned tr_base_perm(unsigned lane, unsigned c, unsigned t) {
    const unsigned h = lane >> 5, blk = (lane >> 4) & 1u, q = (lane & 15u) >> 2, p = lane & 3u;
    return offb(8u * t + 4u * h + q, 4u * c + 2u * blk + (p >> 1)) + 8u * (p & 1u);
}
__device__ __forceinline__ bf16x8 tr_frag_at(LAS unsigned char* img, unsigned b0, unsigned b1, unsigned ks) {
    const s16x4 lo = __builtin_amdgcn_ds_read_tr16_b64_v4i16((LAS s16x4*)(img + b0 + 4096u * ks));
    const s16x4 hi = __builtin_amdgcn_ds_read_tr16_b64_v4i16((LAS s16x4*)(img + b1 + 4096u * ks));
    return __builtin_shufflevector(lo, hi, 0, 1, 2, 3, 4, 5, 6, 7);
}

__device__ __forceinline__ void ph_indexer(Frame& F, const bf16* qidx, const bf16* kidx, const float* widx, int* idxo) {
    constexpr int NQ = 8;
    LAS unsigned short* sc = (LAS unsigned short*)(F.lds);
    LAS float* wsh = (LAS float*)(F.lds + 65536);
    LAS unsigned char* ring = F.lds + 66560;
    const int r = F.lane & 31, hf = F.lane >> 5, rp = F.wave & 1, kq = F.wave >> 1;
    const int drow = 4 * F.wave + (F.lane >> 4), dch = (F.lane & 15) ^ (((F.lane >> 4) << 2) | (F.wave & 3));
    for (int u = blockIdx.x; u < BATCH * (SEQ / NQ); u += F.G) {
        const int b = u & 7, t0 = (u >> 3) * NQ;
        const int nt = (t0 + NQ + 31) >> 5, ns = (nt + 3) >> 2;
        const bf16* kbase = kidx + (size_t)(b * SEQ + drow) * IDX_D + dch * 8;
        __syncthreads();
#pragma unroll
        for (int j = 0; j < 4; ++j) __builtin_amdgcn_global_load_lds((const unsigned*)(kbase + (size_t)(j * 32) * IDX_D), (LAS unsigned*)(ring + j * 8192 + F.wave * 1024), 16, 0, 0);
        if (F.tid < NQ * 16) wsh[F.tid] = widx[(size_t)(b * SEQ + t0 + (F.tid >> 4)) * IDX_H + (F.tid & 15)];
        bf16x8 Af[2][8];
#pragma unroll
        for (int rt = 0; rt < 2; ++rt) { const int query = t0 + 4 * rp + 2 * rt + ((r >> 2) & 1), head = 4 * (r >> 3) + (r & 3);
            const bf16* ap = qidx + (size_t)(b * SEQ + query) * 2048 + head * 128 + 8 * hf;
#pragma unroll
            for (int ks = 0; ks < 8; ++ks) Af[rt][ks] = *(const bf16x8*)(ap + 16 * ks); }
        for (int s = 0; s < ns; ++s) {
            asm volatile("s_waitcnt vmcnt(0) lgkmcnt(0)" ::: "memory"); __builtin_amdgcn_s_barrier(); asm volatile("" ::: "memory");
            if (s + 1 < ns) {
#pragma unroll
                for (int j = 0; j < 4; ++j) __builtin_amdgcn_global_load_lds((const unsigned*)(kbase + (size_t)((4 * (s + 1) + j) * 32) * IDX_D), (LAS unsigned*)(ring + ((s + 1) & 1) * 32768 + j * 8192 + F.wave * 1024), 16, 0, 0);
            }
            const int kt = 4 * s + kq;
            if (kt < nt) {
                LAS unsigned char* tile = ring + (s & 1) * 32768 + kq * 8192;
                bf16x8 Bf[8];
#pragma unroll
                for (int ks = 0; ks < 8; ++ks) Bf[ks] = *(const LAS bf16x8*)(tile + offb((unsigned)r, (unsigned)(2 * ks + hf)));
#pragma unroll
                for (int rt = 0; rt < 2; ++rt) {
                    f32x16 acc;
#pragma unroll
                    for (int i = 0; i < 16; ++i) acc[i] = 0.f;
#pragma unroll
                    for (int ks = 0; ks < 8; ++ks) acc = __builtin_amdgcn_mfma_f32_32x32x16_bf16(Af[rt][ks], Bf[ks], acc, 0, 0, 0);
                    float s0 = 0.f, s1 = 0.f;
#pragma unroll
                    for (int i4 = 0; i4 < 4; ++i4) { const f32x4 w4 = *(const LAS f32x4*)(wsh + (4 * rp + 2 * rt + hf) * 16 + 4 * i4);
                        s0 += w4.x * fmaxf(acc[4 * i4], 0.f) + w4.z * fmaxf(acc[4 * i4 + 2], 0.f); s1 += w4.y * fmaxf(acc[4 * i4 + 1], 0.f) + w4.w * fmaxf(acc[4 * i4 + 3], 0.f); }
                    sc[(4 * rp + 2 * rt + hf) * 4096 + kt * 32 + r] = __builtin_bit_cast(unsigned short, (_Float16)(s0 + s1));
                }
            }
        }
        __syncthreads();
        for (int q = F.wave; q < NQ; q += NWAVES) topk_select_row<false>(sc + q * 4096, t0 + q, idxo + (size_t)(b * SEQ + t0 + q) * TOPK, F.lane, (LAS int*)(F.lds + 132096) + F.wave * 320);
    }
}

#define LDS_BARRIER() do { asm volatile("s_waitcnt lgkmcnt(0)" ::: "memory"); __builtin_amdgcn_s_barrier(); asm volatile("" ::: "memory"); } while (0)
__device__ __forceinline__ int relane(int lane) { asm volatile("" : "+v"(lane)); return lane; }
__device__ __forceinline__ void ph_sparse_attn(Frame& F, bf16* qa_olat, const bf16* ckv, const int* idxi, const float* relb) {
    LAS unsigned char* KV = F.lds;
    LAS unsigned char* PF = F.lds + 131072;
    LAS float* wmax = (LAS float*)(F.lds + 147456);
    LAS float* wsum = wmax + 256;
    LAS unsigned char* bks = F.lds + 147456 + 2048;
    LAS float* relbs = (LAS float*)(F.lds + 147456 + 2048 + 512);
    LAS float* invw = (LAS float*)(F.lds + 147456 + 2048 + 512 + 4224);
    LAS unsigned char* blut = F.lds + 147456 + 2048 + 512 + 4224 + 1024;
    const float scale = 0.08838834764831845f;
    const int w = F.wave;
    __syncthreads();
    for (int i = F.tid; i < 1024; i += 512) relbs[i] = relb[i];
    if (F.tid < 32) relbs[1024 + F.tid] = -INFINITY;
    if (F.tid < 128) blut[F.tid] = (unsigned char)t5_bucket(F.tid);
    int u = blockIdx.x;
    if (u >= T) return;
    int idc[16]; int bid; v4u R[16]; v4u Qr[2];
    {
        const int cc = F.lane & 31, r = F.lane & 31, hf = F.lane >> 5;
        const int t = u % SEQ, b = u / SEQ;
        const int* ip = idxi + (size_t)u * TOPK + 32 * w + hf;
#pragma unroll
        for (int k = 0; k < 16; ++k) idc[k] = ip[2 * k];
        const bf16* kb = ckv + (size_t)b * SEQ * A_KVR + cc * 8;
#pragma unroll
        for (int k = 0; k < 16; ++k) R[k] = *(const v4u*)(kb + (size_t)idc[k] * A_KVR);
        if (F.tid < 256) { const int id = idxi[(size_t)u * TOPK + F.tid]; const int d = t - id; bks[F.tid] = (F.tid <= t) ? (unsigned char)t5_bucket(d > 0 ? d : 0) : (unsigned char)32; }
        const int u2 = (u + F.G < T) ? u + F.G : u;
        const int* ip2 = idxi + (size_t)u2 * TOPK + 32 * w + hf;
#pragma unroll
        for (int k = 0; k < 16; ++k) idc[k] = ip2[2 * k];
        bid = (F.tid < 256) ? idxi[(size_t)u2 * TOPK + F.tid] : -1;
        { const v4u* qp = (const v4u*)(qa_olat + (size_t)u * A_HEADS * A_KVR);
#pragma unroll
          for (int j = 0; j < 2; ++j) { const int id = 2 * w + j, head = 8 * (id & 3) + (F.lane & 7), pos = 8 * (id >> 2) + (F.lane >> 3); Qr[j] = qp[head * 32 + pos]; } }
    }
    unsigned wro[16], qwo[2], trb[2];
    { const unsigned r0 = F.lane & 31, hf0 = F.lane >> 5; const unsigned c0 = (r0 & 15u) ^ (4u * hf0);
#pragma unroll
      for (int k = 0; k < 16; ++k) wro[k] = (r0 >> 4) * 65536u + 256u * (32u * w + hf0) + 512u * k + 16u * (c0 ^ (unsigned)(8 * (k & 1) + ((k >> 1) & 3)));
#pragma unroll
      for (int j = 0; j < 2; ++j) { const int id = 2 * w + j, head = 8 * (id & 3) + (F.lane & 7), pos = 8 * (id >> 2) + (F.lane >> 3); qwo[j] = (pos >> 1) * 1024 + ((pos & 1) * 32 + head) * 16; }
      trb[0] = tr_base_perm((unsigned)F.lane, (unsigned)(w & 3), 0u); trb[1] = tr_base_perm((unsigned)F.lane, (unsigned)(w & 3), 1u); }
    unsigned rdo[16];
    { const unsigned r0 = F.lane & 31, hf0 = F.lane >> 5, row = 32u * w + r0, xr = ((row & 3u) << 2) | ((row >> 2) & 3u);
#pragma unroll
      for (int ks = 0; ks < 16; ++ks) rdo[ks] = 256u * row + (ks >> 3) * 65536u + 16u * ((unsigned)(2 * (ks & 7) + hf0) ^ xr); }
    for (int it = 0; u < T; u += F.G, ++it) {
        const int un = u + F.G, unn = u + 2 * F.G, par = it & 1;
        LDS_BARRIER();
        const int l2 = relane(F.lane), r = l2 & 31, hf = l2 >> 5;
        {
#pragma unroll
          for (int k = 0; k < 16; ++k) *(LAS v4u*)(KV + wro[k]) = R[k]; }
        *(LAS v4u*)(PF + qwo[0]) = Qr[0]; *(LAS v4u*)(PF + qwo[1]) = Qr[1];
        LDS_BARRIER();
        const int tid1 = w * 64 + l2;
        const int unb = (un < T) ? un : u; const int bn = unb / SEQ, tn = unb % SEQ;
        const bf16* kbn = ckv + (size_t)bn * SEQ * A_KVR + r * 8;
        f32x16 acc;
#pragma unroll
        for (int i = 0; i < 16; ++i) acc[i] = 0.f;
        {
#pragma unroll
          for (int ks = 0; ks < 16; ++ks) { const bf16x8 a = *(const LAS bf16x8*)(KV + rdo[ks]);
              acc = __builtin_amdgcn_mfma_f32_32x32x16_bf16(a, *(const LAS bf16x8*)(PF + ks * 1024 + l2 * 16), acc, 0, 0, 0);
              R[ks] = *(const v4u*)(kbn + (size_t)idc[ks] * A_KVR); } }
        if (tid1 < 256) { int d = tn - bid; d = d < 0 ? 0 : (d > 127 ? 127 : d); bks[(par ^ 1) * 256 + tid1] = (tid1 <= tn) ? blut[d] : (unsigned char)32; }
        { const v4u* qp = (const v4u*)(qa_olat + (size_t)unb * A_HEADS * A_KVR);
#pragma unroll
          for (int j = 0; j < 2; ++j) { const int id = 2 * w + j, head = 8 * (id & 3) + (l2 & 7), pos = 8 * (id >> 2) + (l2 >> 3); Qr[j] = qp[head * 32 + pos]; } }
        float lg[16]; float m = -INFINITY;
#pragma unroll
        for (int g = 0; g < 4; ++g) { const unsigned b4 = *(const LAS unsigned*)(bks + par * 256 + 32 * w + 8 * g + 4 * hf);
#pragma unroll
            for (int j = 0; j < 4; ++j) { const unsigned bk = (b4 >> (8 * j)) & 255u; const int i = 4 * g + j;
                lg[i] = acc[i] * scale + relbs[bk * 32 + r]; m = fmaxf(m, lg[i]); } }
        m = fmaxf(m, shx(m, 32, l2));
        if (hf == 0) wmax[r * 8 + w] = m;
        LDS_BARRIER();
        { const f32x4 m0 = *(const LAS f32x4*)(wmax + r * 8), m1 = *(const LAS f32x4*)(wmax + r * 8 + 4);
          m = fmaxf(fmaxf(fmaxf(m0.x, m0.y), fmaxf(m0.z, m0.w)), fmaxf(fmaxf(m1.x, m1.y), fmaxf(m1.z, m1.w))); }
        float s = 0.f;
#pragma unroll
        for (int i = 0; i < 16; ++i) { lg[i] = __expf(lg[i] - m); s += lg[i]; }
        s += shx(s, 32, l2);
        if (hf == 0) wsum[r * 8 + w] = s;
#pragma unroll
        for (int s2 = 0; s2 < 2; ++s2) { v4u pk; pk.x = pk2(lg[8 * s2 + 0], lg[8 * s2 + 1]); pk.y = pk2(lg[8 * s2 + 2], lg[8 * s2 + 3]); pk.z = pk2(lg[8 * s2 + 4], lg[8 * s2 + 5]); pk.w = pk2(lg[8 * s2 + 6], lg[8 * s2 + 7]);
            *(LAS v4u*)(PF + (2 * w + s2) * 1024 + l2 * 16) = pk; }
        LDS_BARRIER();
        const int l3 = relane(F.lane), r3 = l3 & 31, hf3 = l3 >> 5;
        if (hf3 == 0) { const f32x4 s0 = *(const LAS f32x4*)(wsum + r3 * 8), s1 = *(const LAS f32x4*)(wsum + r3 * 8 + 4);
            invw[w * 32 + r3] = 1.0f / (((s0.x + s0.y) + (s0.z + s0.w)) + ((s1.x + s1.y) + (s1.z + s1.w))); }
        f32x16 o;
#pragma unroll
        for (int i = 0; i < 16; ++i) o[i] = 0.f;
        LAS unsigned char* img = KV + (w >> 2) * 65536;
        const int unc = (unn < T) ? unn : u;
        const int* ip2 = idxi + (size_t)unc * TOPK + 32 * w + hf3;
        const unsigned tb0 = trb[0], tb1 = trb[1];
#pragma unroll
        for (int ks = 0; ks < 16; ++ks) { const bf16x8 a = *(const LAS bf16x8*)(PF + ks * 1024 + l3 * 16);
            const bf16x8 bb = tr_frag_at(img, tb0, tb1, (unsigned)ks);
            o = __builtin_amdgcn_mfma_f32_32x32x16_bf16(a, bb, o, 0, 0, 0);
            idc[ks] = ip2[2 * ks]; }
        if (w * 64 + l3 < 256) bid = idxi[(size_t)unc * TOPK + w * 64 + l3];
        bf16* op = qa_olat + ((size_t)u * A_HEADS + 4 * hf3) * A_KVR + 32 * w + r3;
#pragma unroll
        for (int g = 0; g < 4; ++g) { const f32x4 iv = *(const LAS f32x4*)(invw + w * 32 + 8 * g + 4 * hf3);
            op[(8 * g + 0) * A_KVR] = (bf16)f2bf(o[4 * g + 0] * iv.x); op[(8 * g + 1) * A_KVR] = (bf16)f2bf(o[4 * g + 1] * iv.y);
            op[(8 * g + 2) * A_KVR] = (bf16)f2bf(o[4 * g + 2] * iv.z); op[(8 * g + 3) * A_KVR] = (bf16)f2bf(o[4 * g + 3] * iv.w); }
    }
}

__device__ __forceinline__ void ph_sb_attn(Frame& F, const bf16* qkv, bf16* o_out, unsigned* qctr) {
    LAS unsigned char* img = F.lds + F.wave * 8192;
    LAS unsigned char* qimg = F.lds + 65536 + F.wave * 8192;
    const int r = F.lane & 31, hf = F.lane >> 5;
    const float scale = 0.08838834764831845f;
    constexpr int NTASK8 = BATCH * B_HEADS * (SEQ / 32) / 8;
    const int myx = (int)(xb_xcc_id() & 7u);
    for (int qi = 0; qi < 8; ++qi) { const int qsel = (myx + qi) & 7;
    for (;;) {
        int task = 0;
        if (F.lane == 0) task = (int)__hip_atomic_fetch_add(qctr + 64 * qsel, 1u, __ATOMIC_RELAXED, __HIP_MEMORY_SCOPE_AGENT);
        task = __builtin_amdgcn_readfirstlane(task);
        if (task >= NTASK8) break;
        task += qsel * NTASK8;
        const int qt = task & 127, bh = task >> 7, h = bh & 15, b = bh >> 4, t0 = qt * 32;
        v4u Kr[8], Vr[8];
#pragma unroll
        for (int k = 0; k < 8; ++k) { const int n = F.lane + 64 * k; *(LAS v4u*)(qimg + offb(n >> 4, n & 15)) = *(const v4u*)(qkv + (size_t)(b * SEQ + t0 + (n >> 4)) * B_INC + h * B_HD + (n & 15) * 8); }
        {
#pragma unroll
          for (int k = 0; k < 8; ++k) { const int n = F.lane + 64 * k; const bf16* rp = qkv + (size_t)(b * SEQ + qt * 32 + (n >> 4)) * B_INC + h * B_HD + (n & 15) * 8; Kr[k] = *(const v4u*)(rp + DM); Vr[k] = *(const v4u*)(rp + 2 * DM); } }
        f32x16 o[4];
#pragma unroll
        for (int dt = 0; dt < 4; ++dt)
#pragma unroll
            for (int i = 0; i < 16; ++i) o[dt][i] = 0.f;
        float Rc = 1.f;
        for (int kt = qt; kt >= 0; --kt) {
            const int ll = relane(F.lane), r = ll & 31, hf = ll >> 5;
#pragma unroll
            for (int k = 0; k < 8; ++k) { const int n = ll + 64 * k; *(LAS v4u*)(img + offb(n >> 4, n & 15)) = Kr[k]; }
            f32x16 acc;
#pragma unroll
            for (int i = 0; i < 16; ++i) acc[i] = 0.f;
#pragma unroll
            for (int ks = 0; ks < 8; ++ks) acc = __builtin_amdgcn_mfma_f32_32x32x16_bf16(*(const LAS bf16x8*)(img + offb(r, 2 * ks + hf)), *(const LAS bf16x8*)(qimg + offb(r, 2 * ks + hf)), acc, 0, 0, 0);
            asm volatile("s_waitcnt lgkmcnt(0)" ::: "memory");
#pragma unroll
            for (int k = 0; k < 8; ++k) { const int n = ll + 64 * k; *(LAS v4u*)(img + offb(n >> 4, n & 15)) = Vr[k]; }
            float be[16], om[16];
            const bool diag = (kt == qt);
#pragma unroll
            for (int i = 0; i < 16; ++i) { const float z = fminf(acc[i] * scale, 80.f);
                const float e = __expf(z), rr = __builtin_amdgcn_rcpf(1.0f + e);
                be[i] = e * rr; om[i] = rr; }
            if (diag) {
#pragma unroll
                for (int i = 0; i < 16; ++i) { const int kap = 8 * (i >> 2) + 4 * hf + (i & 3); if (kap >= r) { be[i] = 0.f; om[i] = 1.f; } } }
            float sfx[16], Gt[4], Go[4];
#pragma unroll
            for (int g = 0; g < 4; ++g) { sfx[4 * g + 3] = 1.f; sfx[4 * g + 2] = om[4 * g + 3]; sfx[4 * g + 1] = sfx[4 * g + 2] * om[4 * g + 2]; sfx[4 * g + 0] = sfx[4 * g + 1] * om[4 * g + 1]; Gt[g] = sfx[4 * g + 0] * om[4 * g + 0]; }
#pragma unroll
            for (int g = 0; g < 4; ++g) Go[g] = shx(Gt[g], 32, ll);
            float SP[4]; SP[3] = 1.f; SP[2] = Gt[3] * Go[3]; SP[1] = SP[2] * (Gt[2] * Go[2]); SP[0] = SP[1] * (Gt[1] * Go[1]);
            float wgt[16];
#pragma unroll
            for (int g = 0; g < 4; ++g) { const float Rg = Rc * SP[g] * (hf == 0 ? Go[g] : 1.f);
#pragma unroll
                for (int j = 0; j < 4; ++j) wgt[4 * g + j] = be[4 * g + j] * (Rg * sfx[4 * g + j]); }
            Rc = Rc * (SP[0] * (Gt[0] * Go[0]));
            if (kt > 0) {
#pragma unroll
                for (int k = 0; k < 8; ++k) { const int n = F.lane + 64 * k; const bf16* rp = qkv + (size_t)(b * SEQ + (kt - 1) * 32 + (n >> 4)) * B_INC + h * B_HD + (n & 15) * 8; Kr[k] = *(const v4u*)(rp + DM); Vr[k] = *(const v4u*)(rp + 2 * DM); }
            }
            asm volatile("s_waitcnt lgkmcnt(0)" ::: "memory");
#pragma unroll
            for (int s2 = 0; s2 < 2; ++s2) {
                v4u pk; pk.x = pk2(wgt[8 * s2 + 0], wgt[8 * s2 + 1]); pk.y = pk2(wgt[8 * s2 + 2], wgt[8 * s2 + 3]); pk.z = pk2(wgt[8 * s2 + 4], wgt[8 * s2 + 5]); pk.w = pk2(wgt[8 * s2 + 6], wgt[8 * s2 + 7]);
                const bf16x8 pa = __builtin_bit_cast(bf16x8, pk);
#pragma unroll
                for (int dt = 0; dt < 4; ++dt) { const bf16x8 vb = tr_frag_at(img, tr_base_perm((unsigned)ll, (unsigned)dt, 0u), tr_base_perm((unsigned)ll, (unsigned)dt, 1u), (unsigned)s2);
                    o[dt] = __builtin_amdgcn_mfma_f32_32x32x16_bf16(pa, vb, o[dt], 0, 0, 0); }
            }
            if (__ballot(Rc >= 0x1p-40f) == 0ull) break;
        }
#pragma unroll
        for (int dt = 0; dt < 4; ++dt)
#pragma unroll
            for (int i = 0; i < 16; ++i) { const int qrow = 8 * (i >> 2) + 4 * hf + (i & 3);
                o_out[(size_t)(b * SEQ + t0 + qrow) * DM + h * B_HD + 32 * dt + r] = (bf16)f2bf(o[dt][i]); }
    }
    }
}

constexpr int PH_LAYER0 = 3, PH_PER_LAYER = 16, PH_END = PH_LAYER0 + DEPTH * PH_PER_LAYER;
typedef pg8::bf16_t gb16;
__device__ __forceinline__ bool relaunder(Frame& F) { int l_; asm volatile("v_mbcnt_lo_u32_b32 %0, -1, 0\n\tv_mbcnt_hi_u32_b32 %0, -1, %0" : "=v"(l_)); F.lane = l_; F.tid = F.wave * 64 + l_; return true; }
template <class Epi> __device__ __forceinline__ void run_gemm(Frame& F, const bf16* A, const bf16* Bt, int N, int K, int lda, int ldb, int acs, const Epi& E) {
    pg8::Gemm g{(const gb16*)A, (const gb16*)Bt, T, N, K, lda, ldb, acs}; pg8::StaticOrder S; S.init(T, N, F.G, (F.G == 256) ? (int)((blockIdx.x & 31) * 8 + (blockIdx.x >> 5)) : (int)blockIdx.x);
    pg8::gemm_phase<Epi, pg8::StaticOrder, true, true>(F.lds, g, S, E, F.tid);
}
__global__ void __launch_bounds__(NWAVES * 64, 2) fwd_kernel(Args args) {
    extern __shared__ __attribute__((aligned(16))) unsigned char lds_raw[];
    Frame F;
    F.lds = (LAS unsigned char*)lds_raw;
    F.tid = threadIdx.x; F.lane = F.tid & 63; F.wave = __builtin_amdgcn_readfirstlane(F.tid >> 6); F.G = gridDim.x;
    F.ap = (const CAS Args*)__builtin_amdgcn_kernarg_segment_ptr();
    F.out = args.out; F.ws = args.ws;
    volatile LAS unsigned* MISC = (volatile LAS unsigned*)(F.lds + MISC_OFF);
    if (F.tid < 64) MISC[F.tid] = 0u;
    __syncthreads();
    const int lo = args.ph_lo, hi = args.ph_hi;
    XcdBarrier bar; bar.bar = (unsigned*)(F.ws + WS_CTL) + CW_BAR; bar.x = 0; bar.st = nullptr;
    if (hi - lo > 1) { bar = xcd_barrier_post((unsigned*)(F.ws + WS_CTL) + CW_BAR, MISC + 8); xcd_barrier<true>(bar); }
#define IN(k) (lo <= (k) && (k) < hi && relaunder(F))
#define INR(k) (lo <= (k) && (k) < hi)
#define GRID_BAR() do { XcdBarrier b2_ = bar; b2_.x = (unsigned)__builtin_amdgcn_readfirstlane((int)bar.x); asm volatile("" : "+s"(b2_.bar), "+s"(b2_.x)); xcd_barrier<false>(b2_); } while (0)
#define SEAM(k) do { if (INR((k) + 1)) GRID_BAR(); } while (0)

    float* mod = WSP(float, WS_MOD);
    const float* normg = F.inp(IN_NORMG);
    bf16* Hb = WSP(bf16, WS_H);
    if (IN(0)) { ph_prologue(F); SEAM(0); }
    if (IN(1)) { ph_modreduce(F); SEAM(1); }
    if (IN(2)) { ph_post(F, nullptr, F.inp(IN_X), true, nullptr, false, nullptr, nullptr, Hb, normg + 0 * DM, mod + 0 * DM, mod + 1 * DM); SEAM(2); }

    for (int L = 0; L < DEPTH; ++L) {
        const int pb = PH_LAYER0 + PH_PER_LAYER * L, j = L >> 1;
        const float* modL = mod + (size_t)L * BATCH * MODW;
        const float* ng = normg + (size_t)L * 4 * DM;
        const bool lastL = (L == DEPTH - 1);
        bf16* XB = (bf16*)((unsigned char*)F.out + 128 * MiB); bf16* XL = WSP(bf16, WS_P + 128 * MiB);
        if ((L & 1) == 0) {
            float* proj = WSP(float, WS_P); bf16* qidx = WSP(bf16, WS_P + 128 * MiB); bf16* ob = WSP(bf16, WS_P);
            bf16* big = WSP(bf16, WS_BIG);
            bf16* qlat = WSP(bf16, WS_QLAT); bf16* ckv = WSP(bf16, WS_CKV); bf16* kidx = WSP(bf16, WS_KIDX); float* widx = WSP(float, WS_WIDX); int* idxb = WSP(int, WS_IDX);
            if (IN(pb + 0)) { pg8::EpiF32 E{proj, A_INP}; run_gemm(F, Hb, WSP(bf16, WS_WAIN) + (size_t)j * A_INP * DM, A_INP, DM, DM, DM, 0, E); SEAM(pb + 0); }
            if (IN(pb + 1)) { ph_dsa_norm(F, proj, F.inp(IN_AQN) + j * A_QR, F.inp(IN_AKVN) + j * A_KVR, F.inp(IN_AIKN) + j * IDX_D, qlat, ckv, kidx, widx); SEAM(pb + 1); }
            if (IN(pb + 2)) { pg8::EpiBf16<0> E{(gb16*)big, 8192, (gb16*)qidx, 2048, 8192}; run_gemm(F, qlat, WSP(bf16, WS_WQC) + (size_t)j * 10240 * 512, 10240, A_QR, A_QR, A_QR, 0, E); SEAM(pb + 2); }
            if (IN(pb + 3)) { ph_indexer(F, qidx, kidx, widx, idxb); SEAM(pb + 3); }
            if (IN(pb + 4)) { ph_sparse_attn(F, big, ckv, idxb, F.inp(IN_RELB)); SEAM(pb + 4); }
            if (IN(pb + 5)) { pg8::EpiBf16<0> E{(gb16*)ob, 4096, (gb16*)ob, 4096, 1 << 30}; run_gemm(F, big, WSP(bf16, WS_WUV) + (size_t)j * 4096 * 512, 4096, 512, 8192, 512, 512, E); SEAM(pb + 5); }
            if (IN(pb + 6)) { pg8::EpiBf16<0> E{(gb16*)big, DM, (gb16*)big, DM, 1 << 30}; run_gemm(F, ob, WSP(bf16, WS_WAOUT) + (size_t)j * DM * 4096, DM, 4096, 4096, 4096, 0, E); SEAM(pb + 6); }
        } else {
            bf16* qkv = WSP(bf16, WS_BIG); bf16* ob = WSP(bf16, WS_P); bf16* big = WSP(bf16, WS_BIG);
            if (IN(pb + 0)) { pg8::EpiBf16<0> E{(gb16*)qkv, B_INC, (gb16*)qkv, B_INC, 1 << 30}; run_gemm(F, Hb, WSP(bf16, WS_WBIN) + (size_t)j * B_INC * DM, B_INC, DM, DM, DM, 0, E); SEAM(pb + 0); }
            if (IN(pb + 1)) { ph_sb_attn(F, qkv, ob, (unsigned*)(F.ws + WS_CTL) + CW_SBQ + 512 * j); SEAM(pb + 1); }
            if (IN(pb + 2)) { pg8::EpiBf16<0> E{(gb16*)big, DM, (gb16*)big, DM, 1 << 30}; run_gemm(F, ob, WSP(bf16, WS_WBOUT) + (size_t)j * DM * DM, DM, DM, DM, DM, 0, E); if (INR(pb + 7)) GRID_BAR(); }
        }
        if (IN(pb + 7)) { ph_post(F, WSP(bf16, WS_BIG), (L == 0) ? (const void*)F.inp(IN_X) : (const void*)XB, L == 0, lastL ? (void*)XL : (void*)XB, false, modL + 2 * DM, ng + 1 * DM, Hb, ng + 2 * DM, modL + 3 * DM, modL + 4 * DM); SEAM(pb + 7); }
        if (IN(pb + 8)) { pg8::EpiBf16<1> E{(gb16*)WSP(bf16, WS_BIG), DFF, (gb16*)WSP(bf16, WS_BIG), DFF, 1 << 30}; run_gemm(F, Hb, WSP(bf16, WS_WM1) + (size_t)L * DFF * DM, DFF, DM, DM, DM, 0, E); SEAM(pb + 8); }
        if (IN(pb + 9)) { pg8::EpiBf16<0> E{(gb16*)WSP(bf16, WS_P), DM, (gb16*)WSP(bf16, WS_P), DM, 1 << 30}; run_gemm(F, WSP(bf16, WS_BIG), WSP(bf16, WS_WM2) + (size_t)L * DM * DFF, DM, DFF, DFF, DFF, 0, E); SEAM(pb + 9); }
        if (IN(pb + 10)) {
            const float* modN = mod + (size_t)(L + 1) * BATCH * MODW; const float* ngN = normg + (size_t)(L + 1) * 4 * DM;
            ph_post(F, WSP(bf16, WS_P), lastL ? (const void*)XL : (const void*)XB, false, lastL ? (void*)F.out : (void*)XB, lastL, modL + 5 * DM, ng + 3 * DM, lastL ? nullptr : Hb, ngN, modN + 0 * DM, modN + 1 * DM);
            if (!lastL && INR(pb + PH_PER_LAYER)) GRID_BAR();
        }
    }
#undef IN
#undef INR
#undef GRID_BAR
#undef SEAM
}

extern "C" void kernel_launch(void* const* d_in, const int* in_sizes, int n_in, void* d_out, int out_size, void* d_ws, size_t ws_size, hipStream_t stream) {
    static int grid = 0;
    if (grid == 0) {
        if (n_in != N_IN || out_size != T * DM || ws_size < WS_END) { fprintf(stderr, "kernel_launch: unexpected problem: n_in %d out %d ws %zu (need %zu); nothing launched\n", n_in, out_size, ws_size, (size_t)WS_END); grid = -1; return; }
        int dev = 0, cus = 0, per_cu = 0;
        if (hipGetDevice(&dev) != hipSuccess || hipDeviceGetAttribute(&cus, hipDeviceAttributeMultiprocessorCount, dev) != hipSuccess) { grid = -1; return; }
        if (hipFuncSetAttribute((const void*)fwd_kernel, hipFuncAttributeMaxDynamicSharedMemorySize, LDS_BYTES) != hipSuccess) { fprintf(stderr, "kernel_launch: hipFuncSetAttribute(%d B LDS) failed\n", LDS_BYTES); grid = -1; return; }
        if (hipOccupancyMaxActiveBlocksPerMultiprocessor(&per_cu, (const void*)fwd_kernel, NWAVES * 64, LDS_BYTES) != hipSuccess || per_cu < 1) { fprintf(stderr, "kernel_launch: occupancy query says %d workgroups per CU; nothing launched\n", per_cu); (void)hipGetLastError(); grid = -1; return; }
        grid = cus * (per_cu < 1 ? per_cu : 1);
    }
    if (grid < 0) return;
    (void)hipMemsetAsync((char*)d_ws + WS_CTL, 0, CTL_ZERO_BYTES, stream);
    Args a{};
    for (int i = 0; i < N_IN; ++i) a.in[i] = (const float*)d_in[i];
    a.out = (float*)d_out; a.ws = (unsigned char*)d_ws;
#if ONE_LAUNCH
    a.ph_lo = 0; a.ph_hi = PH_END;
    hipLaunchKernelGGL(fwd_kernel, dim3(grid), dim3(NWAVES * 64), LDS_BYTES, stream, a);
#else
    for (int p = 0; p < PH_END; ++p) {
        if (p >= PH_LAYER0) { const int L = (p - PH_LAYER0) / PH_PER_LAYER, r = (p - PH_LAYER0) % PH_PER_LAYER;
            if (r > 10) continue; if ((L & 1) && r >= 3 && r <= 6) continue; }
        a.ph_lo = p; a.ph_hi = p + 1;
        hipLaunchKernelGGL(fwd_kernel, dim3(grid), dim3(NWAVES * 64), LDS_BYTES, stream, a);
    }
#endif
}
```

```cpp
#include <hip/hip_runtime.h>
#include <cstdio>
#include <cstdint>
#ifndef ONE_LAUNCH
#define ONE_LAUNCH 1
#endif
namespace pg8 {
#define PG8_LAS __attribute__((address_space(3)))
typedef unsigned short bf16_t;
typedef short bf16x8 __attribute__((ext_vector_type(8)));
typedef float f32x4 __attribute__((ext_vector_type(4)));
typedef unsigned u32x4 __attribute__((ext_vector_type(4)));
constexpr int BM = 256, BK = 64, HALF = 128, HTB = HALF * BK * 2  , STAGE_BYTES = 8 * HTB, NXCD = 8, WGM = 4;

__host__ __device__ __forceinline__ int lds_byte(int r, int c) { const int st = (r >> 4) * 2 + (c >> 5), rr = r & 15, cc = c & 31, ob = rr * 64 + cc * 2; return st * 1024 + (ob ^ (((ob >> 9) & 1) << 5)); }
__host__ __device__ __forceinline__ void stage_rc(int b, int& R, int& C) { const int st = b / 1024, sb = b % 1024, swz = sb ^ (((sb >> 9) & 1) << 5); R = (st >> 1) * 16 + swz / 64; C = (st & 1) * 32 + (swz % 64) / 2; }
__host__ __device__ __forceinline__ int perm32(int rho) { const int n = rho >> 4, i = rho & 15; return 8 * (i >> 2) + 4 * n + (i & 3); }

struct Unit { int pm, pn; };
struct Gemm { const bf16_t* A; const bf16_t* Bt; int M, N, K, lda, ldb, acs; };

struct StaticOrder {
    int nM, nN, nwg, G, c;
    __host__ __device__ void init(int M, int N, int G_, int c_) { nM = M / BM; nN = N / BM; nwg = nM * nN; G = G_; c = c_; }
    __host__ __device__ bool next(int i, Unit& u) const {
        const long L = (long)i * G + c; if (L >= nwg) return false;
        int wgid = (int)L; { const int q = nwg / NXCD, r = nwg % NXCD, xcd = wgid % NXCD, off = wgid / NXCD; wgid = (xcd < r ? xcd * (q + 1) : r * (q + 1) + (xcd - r) * q) + off; }
        const int nig = WGM * nN, gid = wgid / nig, fm = gid * WGM, gsz = (nM - fm) < WGM ? (nM - fm) : WGM;
        u.pm = fm + ((wgid % nig) % gsz); u.pn = (wgid % nig) / gsz; return true;
    }
    __device__ __forceinline__ void a_ready(const Unit&) const {}
    __device__ __forceinline__ void done(const Unit&) const {}
};


__device__ __forceinline__ float relu_f(float x) { float r; asm("v_max_f32 %0, 0, %1" : "=v"(r) : "v"(x)); return r; }
__device__ __forceinline__ unsigned cvt_pk_bf16(float lo, float hi) { unsigned r; asm("v_cvt_pk_bf16_f32 %0, %1, %2" : "=v"(r) : "v"(lo), "v"(hi)); return r; }
struct EpiF32 {
    static constexpr bool PERM = false, AFTER_DRAIN = false;
    float* C; int ldc;
    __device__ __forceinline__ void operator()(const f32x4 (&acc)[2][2][4][2], const Unit& u, int wr, int wc, int fr, int fq, PG8_LAS unsigned char* lds) const {
        PG8_LAS unsigned char* scr = lds + STAGE_BYTES + (wr * 4 + wc) * 2048;
        const int lane = fq * 16 + fr, rrow = lane >> 3, rch = lane & 7;
        PG8_LAS unsigned char* wp = scr + fr * 128 + 16 * (fq ^ (fr >> 1));
        const int wsw = ((fr >> 1) & 4) ? -64 : 64;
        const PG8_LAS unsigned char* rp = scr + rrow * 128 + 16 * (rch ^ ((rrow >> 1) & 7));
        const int rsw = (rch & 4) ? -64 : 64;
        float* gp = C + (size_t)(u.pm * BM + wr * 64 + rrow) * ldc + u.pn * BM + wc * 32 + 4 * rch;
#pragma unroll
        for (int ai = 0; ai < 2; ++ai)
#pragma unroll
            for (int m = 0; m < 4; ++m)
#pragma unroll
                for (int bj = 0; bj < 2; ++bj) {
#pragma unroll
                    for (int n = 0; n < 2; ++n) *(PG8_LAS f32x4*)(wp + (n ? wsw : 0)) = acc[ai][bj][m][n];
#pragma unroll
                    for (int s = 0; s < 2; ++s) { const f32x4 w = *(const PG8_LAS f32x4*)(rp + s * 1024 + (s ? rsw : 0));
                        *(f32x4*)(gp + (size_t)(ai * HALF + m * 16 + s * 8) * ldc + bj * HALF) = w; } }
    }
};
template <int ACT> struct EpiBf16 {
    static constexpr bool PERM = true, AFTER_DRAIN = false;
    bf16_t* O0; int ld0; bf16_t* O1; int ld1; int split_col;
    __device__ __forceinline__ void operator()(const f32x4 (&acc)[2][2][4][2], const Unit& u, int wr, int wc, int fr, int fq, PG8_LAS unsigned char* lds) const {
        int colt = u.pn * BM; bf16_t* base = O0; int ldc = ld0;
        if (colt >= split_col) { base = O1; ldc = ld1; colt -= split_col; }
        PG8_LAS unsigned char* scr = lds + STAGE_BYTES + (wr * 4 + wc) * 2048;
        const int lane = fq * 16 + fr, rrow = lane >> 3, rch = lane & 7;
        PG8_LAS unsigned char* wp = scr + fr * 128 + 16 * (fq ^ (fr >> 1));
        const int wsw = ((fr >> 1) & 4) ? -64 : 64;
        const PG8_LAS unsigned char* rp = scr + rrow * 128 + 16 * (rch ^ ((rrow >> 1) & 7));
        const int rsw = (rch & 4) ? -64 : 64;
        bf16_t* gp = base + (size_t)(u.pm * BM + wr * 64 + rrow) * ldc + colt + wc * 64 + 8 * rch;
        u32x4 rd[2];
#pragma unroll
        for (int it = 0; it < 8; ++it) { const int ai = it >> 2, m = it & 3;
#pragma unroll
            for (int bj = 0; bj < 2; ++bj) { f32x4 v0 = acc[ai][bj][m][0], v1 = acc[ai][bj][m][1];
                if (ACT == 1) {
#pragma unroll
                    for (int j = 0; j < 4; ++j) { const float a = relu_f(v0[j]), b = relu_f(v1[j]); v0[j] = a * a; v1[j] = b * b; } }
                u32x4 w; w.x = cvt_pk_bf16(v0[0], v0[1]); w.y = cvt_pk_bf16(v0[2], v0[3]); w.z = cvt_pk_bf16(v1[0], v1[1]); w.w = cvt_pk_bf16(v1[2], v1[3]);
                *(PG8_LAS u32x4*)(wp + (bj ? wsw : 0)) = w; }
            if (it > 0) { const int pa = (it - 1) >> 2, pm_ = (it - 1) & 3;
#pragma unroll
                for (int s = 0; s < 2; ++s) *(u32x4*)(gp + (size_t)(pa * HALF + pm_ * 16 + s * 8) * ldc) = rd[s]; }
#pragma unroll
            for (int s = 0; s < 2; ++s) rd[s] = *(const PG8_LAS u32x4*)(rp + s * 1024 + (s ? rsw : 0)); }
#pragma unroll
        for (int s = 0; s < 2; ++s) *(u32x4*)(gp + (size_t)(HALF + 3 * 16 + s * 8) * ldc) = rd[s];
    }
};

template <class Epi, class Sched, bool ALIGN_EPI = false, bool SP2 = false>
__device__ __forceinline__ void gemm_phase(PG8_LAS unsigned char* lds, const Gemm g, const Sched& S, const Epi& E, int tid_in) {
    int tid_l = tid_in; asm volatile("" : "+v"(tid_l));
    const int tid = tid_l, wid = __builtin_amdgcn_readfirstlane(tid >> 6), lane = tid & 63, wr = wid >> 2, wc = wid & 3, fr = lane & 15, fq = lane >> 4;
    const int K = g.K, nt = K / BK;
    unsigned voffA[2], voffB[2];
#pragma unroll
    for (int i = 0; i < 2; ++i) { int R, C; stage_rc(tid * 16 + i * 8192, R, C); const int Rb = Epi::PERM ? ((R >> 5) * 64 + perm32(R & 31)) : R;
        voffA[i] = (unsigned)(R * g.lda + C) * 2u; voffB[i] = (unsigned)(Rb * g.ldb + C) * 2u; }
    const size_t kstep = (size_t)(BK * 2);
    const size_t hstepA = (size_t)HALF * g.lda * 2, hstepB = (size_t)(Epi::PERM ? 32 : HALF) * g.ldb * 2;
    const size_t tstepA = 2 * hstepA, tstepB = (size_t)BM * g.ldb * 2, cstepA = (size_t)g.acs * 2;
    const unsigned ldsw = (unsigned)wid * 1024u;
    const int aoff = lds_byte(wr * 64 + fr, fq * 8), boff = lds_byte(wc * 32 + fr, fq * 8);
#define PG8_SA(b, h) (((b) * 2 + (h)) * HTB)
#define PG8_SB(b, h) ((4 + (b) * 2 + (h)) * HTB)
#define PG8_STAGE(bufoff, gbase, voff) do { _Pragma("unroll") for (int _i = 0; _i < 2; ++_i) \
        __builtin_amdgcn_global_load_lds((const unsigned*)((const char*)(gbase) + (voff)[_i]), (PG8_LAS unsigned*)(lds + (bufoff) + ldsw + _i * 8192), 16, 0, 0); } while (0)
#define PG8_LDA(dst, b, h) do { _Pragma("unroll") for (int m = 0; m < 4; ++m) _Pragma("unroll") for (int k = 0; k < 2; ++k) dst[m][k] = *(const PG8_LAS bf16x8*)(lds + PG8_SA(b, h) + aoff + m * 2048 + k * 1024); } while (0)
#define PG8_LDB(dst, b, h) do { _Pragma("unroll") for (int n = 0; n < 2; ++n) _Pragma("unroll") for (int k = 0; k < 2; ++k) dst[n][k] = *(const PG8_LAS bf16x8*)(lds + PG8_SB(b, h) + boff + n * 2048 + k * 1024); } while (0)
#define PG8_MMA(ai, bj, At, Bt) do { __builtin_amdgcn_s_setprio(1); _Pragma("unroll") for (int m = 0; m < 4; ++m) _Pragma("unroll") for (int n = 0; n < 2; ++n) _Pragma("unroll") for (int k = 0; k < 2; ++k) \
        acc[ai][bj][m][n] = __builtin_amdgcn_mfma_f32_16x16x32_bf16(Bt[n][k], At[m][k], acc[ai][bj][m][n], 0, 0, 0); __builtin_amdgcn_s_setprio(0); } while (0)
#define PG8_WAIT_V(n) asm volatile("s_waitcnt vmcnt(" #n ")" ::: "memory")
#define PG8_WAIT_L(n) asm volatile("s_waitcnt lgkmcnt(" #n ")" ::: "memory")
#define PG8_BAR __builtin_amdgcn_s_barrier()
#define PG8_SCHED __builtin_amdgcn_sched_barrier(0)
    Unit cur, nxt; int ui = 0;
    if (!S.next(0, cur)) return;
    f32x4 acc[2][2][4][2];
#pragma unroll
    for (int a = 0; a < 2; ++a)
#pragma unroll
        for (int b = 0; b < 2; ++b)
#pragma unroll
            for (int m = 0; m < 4; ++m)
#pragma unroll
                for (int n = 0; n < 2; ++n) acc[a][b][m][n] = (f32x4){0.f, 0.f, 0.f, 0.f};
    bf16x8 At[4][2], B0[2][2], B1[2][2];
    const char* cA = (const char*)g.A + (size_t)cur.pm * tstepA + (size_t)cur.pn * cstepA; const char* cB = (const char*)g.Bt + (size_t)cur.pn * tstepB;
    S.a_ready(cur);
    if constexpr (SP2) {
        PG8_STAGE(PG8_SB(0, 0), cB, voffB); PG8_STAGE(PG8_SB(0, 1), cB + hstepB, voffB); PG8_STAGE(PG8_SA(0, 0), cA, voffA); PG8_STAGE(PG8_SA(0, 1), cA + hstepA, voffA);
        if (wr == 1) PG8_BAR;
        PG8_WAIT_V(2); PG8_BAR;
        PG8_STAGE(PG8_SB(1, 0), cB + kstep, voffB); PG8_STAGE(PG8_SA(1, 0), cA + kstep, voffA); PG8_STAGE(PG8_SB(1, 1), cB + hstepB + kstep, voffB);
        PG8_WAIT_V(6); PG8_BAR;
    } else {
        PG8_STAGE(PG8_SB(0, 0), cB, voffB); PG8_STAGE(PG8_SA(0, 0), cA, voffA); PG8_STAGE(PG8_SB(0, 1), cB + hstepB, voffB); PG8_STAGE(PG8_SA(0, 1), cA + hstepA, voffA);
        if (wr == 1) PG8_BAR;
        PG8_WAIT_V(4); PG8_BAR;
        PG8_STAGE(PG8_SB(1, 0), cB + kstep, voffB); PG8_STAGE(PG8_SA(1, 0), cA + kstep, voffA); PG8_STAGE(PG8_SB(1, 1), cB + hstepB + kstep, voffB);
        PG8_WAIT_V(6); PG8_BAR;
    }
    for (;;) {
        const bool has_next = S.next(ui + 1, nxt);
        const char* nA = has_next ? (const char*)g.A + (size_t)nxt.pm * tstepA + (size_t)nxt.pn * cstepA : cA; const char* nB = has_next ? (const char*)g.Bt + (size_t)nxt.pn * tstepB : cB;
        for (int t = 0; t < nt; t += 2) {
            const bool last = (t == nt - 2);
            const char* a1 = cA + (size_t)(t + 1) * kstep;
            const char* a2 = last ? nA : cA + (size_t)(t + 2) * kstep; const char* b2 = last ? nB : cB + (size_t)(t + 2) * kstep;
            const char* a3 = a2 + kstep; const char* b3 = b2 + kstep;
            if (last && has_next) S.a_ready(nxt);
            if constexpr (SP2) {
            PG8_LDB(B0, 0, 0); PG8_LDB(B1, 0, 1); PG8_SCHED; PG8_LDA(At, 0, 0); PG8_STAGE(PG8_SA(1, 1), a1 + hstepA, voffA);
            PG8_WAIT_V(8); PG8_WAIT_L(0); PG8_BAR; PG8_MMA(0, 0, At, B0); PG8_MMA(0, 1, At, B1); PG8_BAR; PG8_SCHED;
            PG8_LDA(At, 0, 1); PG8_STAGE(PG8_SB(0, 0), b2, voffB); PG8_STAGE(PG8_SB(0, 1), b2 + hstepB, voffB); PG8_STAGE(PG8_SA(0, 0), a2, voffA);
            PG8_WAIT_V(8); PG8_WAIT_L(0); PG8_BAR; PG8_MMA(1, 0, At, B0); PG8_MMA(1, 1, At, B1); PG8_BAR; PG8_SCHED;
            PG8_LDB(B0, 1, 0); PG8_LDB(B1, 1, 1); PG8_SCHED; PG8_LDA(At, 1, 0); PG8_STAGE(PG8_SA(0, 1), a2 + hstepA, voffA);
            PG8_WAIT_V(8); PG8_WAIT_L(0); PG8_BAR; PG8_MMA(0, 0, At, B0); PG8_MMA(0, 1, At, B1); PG8_BAR; PG8_SCHED;
            PG8_LDA(At, 1, 1); PG8_STAGE(PG8_SB(1, 0), b3, voffB); PG8_STAGE(PG8_SB(1, 1), b3 + hstepB, voffB); PG8_STAGE(PG8_SA(1, 0), a3, voffA);
            PG8_WAIT_V(8); PG8_WAIT_L(0); PG8_BAR; PG8_MMA(1, 0, At, B0); PG8_MMA(1, 1, At, B1); PG8_BAR; PG8_SCHED;
            } else {
            PG8_LDB(B0, 0, 0); PG8_SCHED; PG8_LDA(At, 0, 0); PG8_STAGE(PG8_SA(1, 1), a1 + hstepA, voffA);
            PG8_WAIT_L(8); PG8_BAR; PG8_WAIT_L(0); PG8_MMA(0, 0, At, B0); PG8_BAR; PG8_SCHED;
            PG8_LDB(B1, 0, 1); PG8_STAGE(PG8_SB(0, 0), b2, voffB);
            PG8_BAR; PG8_WAIT_L(0); PG8_MMA(0, 1, At, B1); PG8_BAR;
            PG8_LDA(At, 0, 1); PG8_STAGE(PG8_SA(0, 0), a2, voffA);
            PG8_BAR; PG8_WAIT_L(0); PG8_MMA(1, 0, At, B0); PG8_BAR; PG8_SCHED;
            PG8_STAGE(PG8_SB(0, 1), b2 + hstepB, voffB);
            PG8_WAIT_V(6); PG8_BAR; PG8_MMA(1, 1, At, B1); PG8_BAR;
            PG8_LDB(B0, 1, 0); PG8_SCHED; PG8_LDA(At, 1, 0); PG8_STAGE(PG8_SA(0, 1), a2 + hstepA, voffA);
            PG8_WAIT_L(8); PG8_BAR; PG8_WAIT_L(0); PG8_MMA(0, 0, At, B0); PG8_BAR; PG8_SCHED;
            PG8_LDB(B1, 1, 1); PG8_STAGE(PG8_SB(1, 0), b3, voffB);
            PG8_BAR; PG8_WAIT_L(0); PG8_MMA(0, 1, At, B1); PG8_BAR;
            PG8_LDA(At, 1, 1); PG8_STAGE(PG8_SA(1, 0), a3, voffA);
            PG8_BAR; PG8_WAIT_L(0); PG8_MMA(1, 0, At, B0); PG8_BAR; PG8_SCHED;
            PG8_STAGE(PG8_SB(1, 1), b3 + hstepB, voffB);
            PG8_WAIT_V(6); PG8_BAR; PG8_MMA(1, 1, At, B1); PG8_BAR;
            }
        }
        if constexpr (ALIGN_EPI) { if (wr == 0) PG8_BAR; }
        if constexpr (!Epi::AFTER_DRAIN) { E(acc, cur, wr, wc, fr, fq, lds); S.done(cur); }
        if (!has_next) break;
#pragma unroll
        for (int a = 0; a < 2; ++a)
#pragma unroll
            for (int b = 0; b < 2; ++b)
#pragma unroll
                for (int m = 0; m < 4; ++m)
#pragma unroll
                    for (int n = 0; n < 2; ++n) acc[a][b][m][n] = (f32x4){0.f, 0.f, 0.f, 0.f};
        cur = nxt; cA = nA; cB = nB; ++ui;
        if constexpr (ALIGN_EPI) { if (wr == 1) PG8_BAR; }
    }
    PG8_WAIT_V(0);
    if constexpr (!ALIGN_EPI) { if (wr == 0) PG8_BAR; }
    PG8_BAR;
    if constexpr (Epi::AFTER_DRAIN) { E.fused(acc, cur, wr, wc, fr, fq, lds, wid, lane); S.done(cur); }
#undef PG8_SA
#undef PG8_SB
#undef PG8_STAGE
#undef PG8_LDA
#undef PG8_LDB
#undef PG8_MMA
#undef PG8_WAIT_V
#undef PG8_WAIT_L
#undef PG8_BAR
#undef PG8_SCHED
}
}

constexpr int NWAVES = 8;
constexpr int BATCH = 8, SEQ = 4096, DM = 2048, DEPTH = 4, DFF = 8192, T = BATCH * SEQ;
constexpr int A_HEADS = 32, A_QR = 512, A_KVR = 256, IDX_H = 16, IDX_D = 128, TOPK = 256, A_IN = 912, A_INP = 1024;
constexpr int B_HEADS = 16, B_HD = 128, B_INC = 3 * DM;
constexpr int MODW = 6 * DM;
constexpr float RMS_EPS = 1e-6f;
enum { IN_X = 0, IN_C, IN_RELB, IN_ADAW, IN_ADAB, IN_NORMG, IN_AWIN, IN_AQN, IN_AKVN, IN_AIKN, IN_AWQB, IN_AWIQB, IN_AWUK, IN_AWUV, IN_AWOUT, IN_BWIN, IN_BWOUT, IN_W1, IN_W2, N_IN };

constexpr size_t MiB = 1u << 20;
constexpr size_t WS_CTL = 0, CTL_ZERO_BYTES = 1 * MiB;
constexpr size_t WS_MOD = 1 * MiB;
constexpr size_t WS_MODP = 3 * MiB;
constexpr size_t WS_WAIN = 16 * MiB;
constexpr size_t WS_WQC = 24 * MiB;
constexpr size_t WS_WUV = 44 * MiB;
constexpr size_t WS_WAOUT = 52 * MiB;
constexpr size_t WS_WBIN = 84 * MiB;
constexpr size_t WS_WBOUT = 132 * MiB;
constexpr size_t WS_WM1 = 148 * MiB;
constexpr size_t WS_WM2 = 276 * MiB;
constexpr size_t WS_H = 404 * MiB;
constexpr size_t WS_P = 532 * MiB;
constexpr size_t WS_BIG = 788 * MiB;
constexpr size_t WS_QLAT = 1300 * MiB;
constexpr size_t WS_CKV = 1332 * MiB;
constexpr size_t WS_KIDX = 1348 * MiB;
constexpr size_t WS_WIDX = 1356 * MiB;
constexpr size_t WS_IDX = 1358 * MiB;
constexpr size_t WS_END = 1390 * MiB;
constexpr int CW_BAR = 4096;
constexpr int CW_SBQ = 8192;

constexpr int LDS_BYTES = 163840;
constexpr int MISC_OFF = LDS_BYTES - 256;

#define GAS __attribute__((address_space(1)))
#define LAS __attribute__((address_space(3)))
typedef unsigned short bf16;
typedef unsigned v4u __attribute__((ext_vector_type(4)));
typedef unsigned v2u __attribute__((ext_vector_type(2)));
typedef float f32x4 __attribute__((ext_vector_type(4)));
typedef float f32x2 __attribute__((ext_vector_type(2)));
typedef __bf16 bf16x2_t __attribute__((ext_vector_type(2)));
#define LDS_WAIT() asm volatile("s_waitcnt lgkmcnt(0)" ::: "memory")
#define VM_WAIT() asm volatile("s_waitcnt vmcnt(0)" ::: "memory")
__device__ __forceinline__ unsigned f2bf(float f) { unsigned u = __builtin_bit_cast(unsigned, f); return (u + 0x7fffu + ((u >> 16) & 1u)) >> 16; }
__device__ __forceinline__ unsigned pk2(float lo, float hi) { return f2bf(lo) | (f2bf(hi) << 16); }
__device__ __forceinline__ float bflo(unsigned u) { return __builtin_bit_cast(float, u << 16); }
__device__ __forceinline__ float bfhi(unsigned u) { return __builtin_bit_cast(float, u & 0xffff0000u); }
__device__ __forceinline__ float dot2bf(unsigned a, unsigned b, float c) { return __builtin_amdgcn_fdot2_f32_bf16(__builtin_bit_cast(bf16x2_t, a), __builtin_bit_cast(bf16x2_t, b), c, false); }
#define DPP_F(v, ctrl) __builtin_bit_cast(float, __builtin_amdgcn_update_dpp(0, __builtin_bit_cast(int, (v)), (ctrl), 0xf, 0xf, true))
#define RDL_F(v, l) __builtin_bit_cast(float, __builtin_amdgcn_readlane(__builtin_bit_cast(int, (v)), (l)))
__device__ __forceinline__ float wave_sum(float v, int) {
    v += DPP_F(v, 0xB1); v += DPP_F(v, 0x4E); v += DPP_F(v, 0x124); v += DPP_F(v, 0x128);
    return (RDL_F(v, 0) + RDL_F(v, 16)) + (RDL_F(v, 32) + RDL_F(v, 48));
}
__device__ __forceinline__ float wave_max(float v, int) {
    v = fmaxf(v, DPP_F(v, 0xB1)); v = fmaxf(v, DPP_F(v, 0x4E)); v = fmaxf(v, DPP_F(v, 0x124)); v = fmaxf(v, DPP_F(v, 0x128));
    return fmaxf(fmaxf(RDL_F(v, 0), RDL_F(v, 16)), fmaxf(RDL_F(v, 32), RDL_F(v, 48)));
}
__device__ __forceinline__ float shx(float v, int, int lane) {
    const unsigned u = __builtin_bit_cast(unsigned, v);
    auto r = __builtin_amdgcn_permlane32_swap(u, u, false, false);
    return __builtin_bit_cast(float, (lane & 32) ? r[0] : r[1]);
}

#define XB_TMO      128
#define XB_XCNT(j)  (256  + 64 * (j))
#define XB_XSUB(j)  (1280 + 64 * (j))
#define XB_XGEN(j)  (2304 + 64 * (j))
#define XB_TOP      3328
#define XB_TOPGEN   3392
#define XCD_BAR_WORDS 3456
#define XB_SPIN_CAP (1u << 22)

__device__ __forceinline__ unsigned xb_ld(unsigned* p)              { return __hip_atomic_load(p, __ATOMIC_RELAXED, __HIP_MEMORY_SCOPE_AGENT); }
__device__ __forceinline__ unsigned xb_add(unsigned* p, unsigned v) { return __hip_atomic_fetch_add(p, v, __ATOMIC_RELAXED, __HIP_MEMORY_SCOPE_AGENT); }
__device__ __forceinline__ unsigned xb_xcc_id() { return (unsigned)__builtin_amdgcn_s_getreg((3 << 11) | 20) & 0xFu; }
#define XB_SPIN(cond, bar) do { unsigned _sp = 0; while (cond) { __builtin_amdgcn_s_sleep(1); \
    if ((++_sp & 255u) == 0u) { if (xb_ld(&(bar)[XB_TMO])) break; if (_sp > XB_SPIN_CAP) { atomicAdd(&(bar)[XB_TMO], 1u); break; } } } } while (0)

struct XcdBarrier {
    unsigned* bar; unsigned x;
    volatile LAS unsigned* st;
};

__device__ __forceinline__ XcdBarrier xcd_barrier_post(unsigned* bar, volatile LAS unsigned* st) {
    XcdBarrier b; b.bar = bar; b.x = xb_xcc_id(); b.st = st;
    if (threadIdx.x == 0) (void)xb_add(&bar[XB_XCNT(b.x)], 1u);
    return b;
}
__device__ __forceinline__ void xcd_barrier_complete(unsigned* bar, unsigned x, unsigned& nloc, unsigned& nx) {
    const unsigned G = gridDim.x * gridDim.y * gridDim.z;
    unsigned sum, cnt, mine, sp = 0u;
    for (;;) {
        sum = 0u; cnt = 0u; mine = 0u;
#pragma unroll
        for (unsigned j = 0; j < 16; ++j) { const unsigned c = xb_ld(&bar[XB_XCNT(j)]); sum += c; cnt += (c > 0u) ? 1u : 0u; mine = (j == x) ? c : mine; }
        if (sum == G) break;
        __builtin_amdgcn_s_sleep(1);
        if ((++sp & 255u) == 0u) { if (xb_ld(&bar[XB_TMO])) break; if (sp > XB_SPIN_CAP) { atomicAdd(&bar[XB_TMO], 1u); break; } }
    }
    nloc = mine > 0u ? mine : 1u; nx = cnt > 0u ? cnt : 1u;
}

template <bool CENSUS> __device__ __forceinline__ void xcd_barrier(const XcdBarrier& b) {
    asm volatile("s_waitcnt vmcnt(0)" ::: "memory");
    __syncthreads();
    if (threadIdx.x == 0) {
        unsigned* bar = b.bar;
        __builtin_amdgcn_s_waitcnt(0);
        unsigned nloc = b.st[0], nx = b.st[1];
        if (CENSUS) { if (nloc == 0u) { xcd_barrier_complete(bar, b.x, nloc, nx); b.st[0] = nloc; b.st[1] = nx; } }
        const unsigned old = xb_add(&bar[XB_XSUB(b.x)], 1u);
        const unsigned gen = old / nloc;
        if (old + 1u == (gen + 1u) * nloc) {
            __builtin_amdgcn_fence(__ATOMIC_RELEASE, "agent");
            asm volatile("s_waitcnt vmcnt(0)" ::: "memory");
            const unsigned og = xb_add(&bar[XB_TOP], 1u);
            const unsigned tg = og / nx;
            if (og + 1u == (tg + 1u) * nx) xb_add(&bar[XB_TOPGEN], 1u);
            else XB_SPIN(xb_ld(&bar[XB_TOPGEN]) == tg, bar);
            __builtin_amdgcn_fence(__ATOMIC_ACQUIRE, "agent");
            xb_add(&bar[XB_XGEN(b.x)], 1u);
            asm volatile("s_waitcnt vmcnt(0)" ::: "memory");
        } else {
            XB_SPIN(xb_ld(&bar[XB_XGEN(b.x)]) == gen, bar);
            __builtin_amdgcn_fence(__ATOMIC_ACQUIRE, "agent");
            asm volatile("s_waitcnt vmcnt(0)" ::: "memory");
        }
    }
    __syncthreads();
}

struct Args { const float* in[N_IN]; float* out; unsigned char* ws; int ph_lo, ph_hi; };
#define CAS __attribute__((address_space(4)))
struct Frame {
    LAS unsigned char* lds;
    int tid, lane, wave, G;
    const CAS Args* ap;
    float* out; unsigned char* ws;
    __device__ __forceinline__ const float* inp(int i) const { return ap->in[i]; }
};
#define WSP(type, off) ((type*)(F.ws + (off)))

__device__ __forceinline__ void p0_transpose_item(const float* W, int Nsrc, bf16* dst, int ldo, LAS float* scr, int kb, int nb, int lane) {
    const int k0 = 64 * kb, n0 = 32 * nb, rsub = lane >> 3, c4 = lane & 7, nn = n0 + 4 * c4;
    f32x4 v[8];
#pragma unroll
    for (int i = 0; i < 8; ++i) v[i] = (nn < Nsrc) ? *(const f32x4*)(W + (size_t)(k0 + 8 * i + rsub) * Nsrc + nn) : (f32x4){0.f, 0.f, 0.f, 0.f};
#pragma unroll
    for (int i = 0; i < 8; ++i) { LAS float* d = scr + (8 * i + rsub) * 33 + 4 * c4; d[0] = v[i].x; d[1] = v[i].y; d[2] = v[i].z; d[3] = v[i].w; }
    LDS_WAIT(); asm volatile("" ::: "memory");
    const int c = lane & 7;
#pragma unroll
    for (int j = 0; j < 4; ++j) { const int n = (lane >> 3) + 8 * j; const LAS float* s = scr + (8 * c) * 33 + n;
        v4u o; o.x = pk2(s[0 * 33], s[1 * 33]); o.y = pk2(s[2 * 33], s[3 * 33]); o.z = pk2(s[4 * 33], s[5 * 33]); o.w = pk2(s[6 * 33], s[7 * 33]);
        *(v4u*)(dst + (size_t)(n0 + n) * ldo + k0 + 8 * c) = o; }
    LDS_WAIT(); asm volatile("" ::: "memory");
}
__device__ __forceinline__ void p0_tr_load(f32x4 (&v)[8], const float* W, int Nsrc, int kb, int nb, int lane) {
    const int k0 = 64 * kb, rsub = lane >> 3, nn = 32 * nb + 4 * (lane & 7);
#pragma unroll
    for (int i = 0; i < 8; ++i) v[i] = (nn < Nsrc) ? *(const f32x4*)(W + (size_t)(k0 + 8 * i + rsub) * Nsrc + nn) : (f32x4){0.f, 0.f, 0.f, 0.f};
}
__device__ __forceinline__ void p0_tr_store(const f32x4 (&v)[8], bf16* dst, int ldo, LAS float* scr, int kb, int nb, int lane) {
    const int k0 = 64 * kb, n0 = 32 * nb, rsub = lane >> 3, c4 = lane & 7;
#pragma unroll
    for (int i = 0; i < 8; ++i) { LAS float* d = scr + (8 * i + rsub) * 33 + 4 * c4; d[0] = v[i].x; d[1] = v[i].y; d[2] = v[i].z; d[3] = v[i].w; }
    LDS_WAIT(); asm volatile("" ::: "memory");
    const int c = lane & 7;
#pragma unroll
    for (int j = 0; j < 4; ++j) { const int n = (lane >> 3) + 8 * j; const LAS float* s = scr + (8 * c) * 33 + n;
        v4u o; o.x = pk2(s[0 * 33], s[1 * 33]); o.y = pk2(s[2 * 33], s[3 * 33]); o.z = pk2(s[4 * 33], s[5 * 33]); o.w = pk2(s[6 * 33], s[7 * 33]);
        *(v4u*)(dst + (size_t)(n0 + n) * ldo + k0 + 8 * c) = o; }
    LDS_WAIT(); asm volatile("" ::: "memory");
}
__device__ __forceinline__ void p0_transpose_job(Frame& F, const float* src, size_t sstride, int nmat, int K, int Nsrc, int Npad, bf16* dst, size_t dstride, int ldo) {
    LAS float* scr = (LAS float*)(F.lds + F.wave * 16384);
    const int gw = blockIdx.x * NWAVES + F.wave, NGW = F.G * NWAVES;
    const int nkb = K / 64, nnb = Npad / 32, per = nkb * nnb, tot = nmat * per;
    int it = gw;
    f32x4 v[8], vn[8];
    if (it < tot) { const int m = it / per, r = it % per; p0_tr_load(v, src + (size_t)m * sstride, Nsrc, r / nnb, r % nnb, F.lane); }
    while (it < tot) {
        const int nx = it + NGW;
        if (nx < tot) { const int m = nx / per, r = nx % per; p0_tr_load(vn, src + (size_t)m * sstride, Nsrc, r / nnb, r % nnb, F.lane); }
        { const int m = it / per, r = it % per; p0_tr_store(v, dst + (size_t)m * dstride, ldo, scr, r / nnb, r % nnb, F.lane); }
#pragma unroll
        for (int i = 0; i < 8; ++i) v[i] = vn[i];
        it = nx;
    }
}
__device__ __forceinline__ void ph_prologue(Frame& F) {
    {
        LAS float* sl = (LAS float*)(F.lds);
        LAS float* red = (LAS float*)(F.lds + 8192);
        const float* cin = F.inp(IN_C); const float* ada_w = F.inp(IN_ADAW); float* modp = WSP(float, WS_MODP);
        for (int u = blockIdx.x; u < 768; u += F.G) {
            const int l = u / 192, r = u % 192, ec = r >> 3, dc = r & 7;
            __syncthreads();
            for (int i = F.tid; i < 2048; i += 512) { const int rr = i >> 3, b = i & 7; const float v = cin[b * DM + dc * 256 + rr]; sl[rr * 8 + b] = v / (1.f + __expf(-v)); }
            __syncthreads();
            const int cq = F.tid & 127, dq = F.tid >> 7;
            f32x4 acc[8];
#pragma unroll
            for (int b = 0; b < 8; ++b) acc[b] = (f32x4){0.f, 0.f, 0.f, 0.f};
            const float* wp = ada_w + ((size_t)l * DM + dc * 256 + dq * 64) * MODW + ec * 512 + cq * 4;
#pragma unroll 8
            for (int i = 0; i < 64; ++i) {
                const f32x4 w = *(const f32x4*)(wp + (size_t)i * MODW);
                const f32x4 s0 = *(const LAS f32x4*)(sl + (dq * 64 + i) * 8), s1 = *(const LAS f32x4*)(sl + (dq * 64 + i) * 8 + 4);
                acc[0] += w * s0.x; acc[1] += w * s0.y; acc[2] += w * s0.z; acc[3] += w * s0.w;
                acc[4] += w * s1.x; acc[5] += w * s1.y; acc[6] += w * s1.z; acc[7] += w * s1.w;
            }
#pragma unroll
            for (int b = 0; b < 8; ++b) *(LAS f32x4*)(red + (dq * 8 + b) * 512 + cq * 4) = acc[b];
            __syncthreads();
            { const int b = F.tid >> 6, c0 = (F.tid & 63) * 8;
#pragma unroll
              for (int k = 0; k < 2; ++k) {
                  const f32x4 s = (*(const LAS f32x4*)(red + (0 * 8 + b) * 512 + c0 + 4 * k) + *(const LAS f32x4*)(red + (1 * 8 + b) * 512 + c0 + 4 * k))
                                + (*(const LAS f32x4*)(red + (2 * 8 + b) * 512 + c0 + 4 * k) + *(const LAS f32x4*)(red + (3 * 8 + b) * 512 + c0 + 4 * k));
                  *(f32x4*)(modp + (((size_t)dc * 4 + l) * 8 + b) * MODW + ec * 512 + c0 + 4 * k) = s; } }
        }
        __syncthreads();
    }
    {
        LAS float* Bs = (LAS float*)(F.lds);
        LAS float* As = (LAS float*)(F.lds + 256 * 132 * 4);
        const float* wqb = F.inp(IN_AWQB); const float* wuk = F.inp(IN_AWUK); bf16* wqc = WSP(bf16, WS_WQC);
        for (int u = blockIdx.x; u < 1024; u += F.G) {
            const int j = u >> 9, h = (u & 511) >> 4, rb = u & 15, r0 = rb * 32;
            __syncthreads();
            const float* bsrc = wuk + ((size_t)j * A_HEADS + h) * 256 * 128;
            for (int i = F.tid; i < 256 * 32; i += 512) { const int row = i >> 5, c4 = i & 31; *(LAS f32x4*)(Bs + row * 132 + c4 * 4) = *(const f32x4*)(bsrc + row * 128 + c4 * 4); }
            for (int i = F.tid; i < 32 * 32; i += 512) { const int row = i >> 5, c4 = i & 31; *(LAS f32x4*)(As + row * 128 + c4 * 4) = *(const f32x4*)(wqb + ((size_t)j * A_QR + r0 + row) * 4096 + h * 128 + c4 * 4); }
            __syncthreads();
            const int c = F.tid & 255, rh = F.tid >> 8;
            float acc[16];
#pragma unroll
            for (int q = 0; q < 16; ++q) acc[q] = 0.f;
            for (int d4 = 0; d4 < 32; ++d4) {
                const f32x4 bv = *(const LAS f32x4*)(Bs + c * 132 + d4 * 4);
#pragma unroll
                for (int q = 0; q < 16; ++q) { const f32x4 av = *(const LAS f32x4*)(As + (rh * 16 + q) * 128 + d4 * 4); acc[q] += (av.x * bv.x + av.y * bv.y) + (av.z * bv.z + av.w * bv.w); }
            }
            bf16* orow = wqc + ((size_t)j * 10240 + h * 256 + c) * 512 + r0 + rh * 16;
            v4u o0, o1;
            o0.x = pk2(acc[0], acc[1]); o0.y = pk2(acc[2], acc[3]); o0.z = pk2(acc[4], acc[5]); o0.w = pk2(acc[6], acc[7]);
            o1.x = pk2(acc[8], acc[9]); o1.y = pk2(acc[10], acc[11]); o1.z = pk2(acc[12], acc[13]); o1.w = pk2(acc[14], acc[15]);
            *(v4u*)(orow) = o0; *(v4u*)(orow + 8) = o1;
        }
        __syncthreads();
    }
    p0_transpose_job(F, F.inp(IN_AWIN), (size_t)DM * A_IN, 2, DM, A_IN, A_INP, WSP(bf16, WS_WAIN), (size_t)A_INP * DM, DM);
    p0_transpose_job(F, F.inp(IN_AWIQB), (size_t)A_QR * 2048, 2, A_QR, 2048, 2048, WSP(bf16, WS_WQC) + (size_t)8192 * 512, (size_t)10240 * 512, 512);
    p0_transpose_job(F, F.inp(IN_AWOUT), (size_t)4096 * DM, 2, 4096, DM, DM, WSP(bf16, WS_WAOUT), (size_t)DM * 4096, 4096);
    p0_transpose_job(F, F.inp(IN_BWIN), (size_t)DM * B_INC, 2, DM, B_INC, B_INC, WSP(bf16, WS_WBIN), (size_t)B_INC * DM, DM);
    p0_transpose_job(F, F.inp(IN_BWOUT), (size_t)DM * DM, 2, DM, DM, DM, WSP(bf16, WS_WBOUT), (size_t)DM * DM, DM);
    p0_transpose_job(F, F.inp(IN_W1), (size_t)DM * DFF, 4, DM, DFF, DFF, WSP(bf16, WS_WM1), (size_t)DFF * DM, DM);
    p0_transpose_job(F, F.inp(IN_W2), (size_t)DFF * DM, 4, DFF, DM, DM, WSP(bf16, WS_WM2), (size_t)DM * DFF, DFF);
    {
        LAS float* scr = (LAS float*)(F.lds + F.wave * 16384);
        const int gw = blockIdx.x * NWAVES + F.wave, NGW = F.G * NWAVES;
        const float* wuv = F.inp(IN_AWUV); bf16* d0 = WSP(bf16, WS_WUV);
        for (int it = gw; it < 64 * 16; it += NGW) {
            const int m = it >> 4, r = it & 15, j = m >> 5, h = m & 31;
            bf16* dst = d0 + (size_t)j * 4096 * 512 + (size_t)((h >> 1) * 256 + (h & 1) * 128) * 512 + (h & 1) * 256;
            p0_transpose_item(wuv + (size_t)m * 256 * 128, 128, dst, 512, scr, r >> 2, r & 3, F.lane);
        }
        const int gt = blockIdx.x * 512 + F.tid, NT = F.G * 512;
        for (int i = gt; i < 2 * 4096 * 32; i += NT) {
            const int row = i >> 5, ch = i & 31, hh = (row >> 7) & 1;
            *(v4u*)(d0 + (size_t)row * 512 + (1 - hh) * 256 + ch * 8) = (v4u){0u, 0u, 0u, 0u};
        }
    }
}
__device__ __forceinline__ void ph_modreduce(Frame& F) {
    const float* modp = WSP(float, WS_MODP); float* mod = WSP(float, WS_MOD); const float* ada_b = F.inp(IN_ADAB);
    const int gt = blockIdx.x * 512 + F.tid, NT = F.G * 512;
    for (int i = gt; i < DEPTH * BATCH * MODW / 4; i += NT) {
        const int e4 = i % (MODW / 4), lb = i / (MODW / 4), l = lb >> 3;
        f32x4 s = *(const f32x4*)(ada_b + (size_t)l * MODW + e4 * 4);
#pragma unroll
        for (int dc = 0; dc < 8; ++dc) s += *(const f32x4*)(modp + ((size_t)dc * 32 + lb) * MODW + e4 * 4);
        *(f32x4*)(mod + (size_t)lb * MODW + e4 * 4) = s;
    }
}

__device__ __forceinline__ void ph_post(Frame& F, const bf16* y, const void* xin_, bool xin_f32, void* xout_, bool xout_f32, const float* gate, const float* gy, bf16* hout, const float* gh, const float* shift, const float* scale) {
    LAS float* vec = (LAS float*)F.lds;
    const int rlo = (int)(((long long)blockIdx.x * T) / F.G), rhi = (int)(((long long)(blockIdx.x + 1) * T) / F.G);
    for (int seg = rlo; seg < rhi; ) {
        const int b = seg / SEQ; const int send = ((b + 1) * SEQ < rhi) ? (b + 1) * SEQ : rhi;
        __syncthreads();
        for (int i = F.tid; i < 5 * (DM / 4); i += NWAVES * 64) { const int v = i / (DM / 4), c4 = i % (DM / 4);
            const float* src = (v == 0) ? (y ? gate + (size_t)b * MODW : nullptr) : (v == 1) ? (y ? gy : nullptr) : (v == 2) ? (hout ? gh : nullptr) : (v == 3) ? (hout ? shift + (size_t)b * MODW : nullptr) : (hout ? scale + (size_t)b * MODW : nullptr);
            *(LAS f32x4*)(vec + v * DM + 4 * c4) = src ? *(const f32x4*)(src + 4 * c4) : (f32x4){0.f, 0.f, 0.f, 0.f}; }
        __syncthreads();
        constexpr int NR = 2;
        for (int r0 = seg + 2 * F.wave; r0 < send; r0 += NR * NWAVES) {
            const int r1 = (r0 + 1 < send) ? r0 + 1 : r0;
            int e0 = 4 * F.lane; asm volatile("" : "+v"(e0));
            f32x4 x[NR][8]; v2u yp[NR][8];
            if (xin_f32) { const float* xin = (const float*)xin_;
#pragma unroll
                for (int q = 0; q < NR; ++q) { const int row = q ? r1 : r0;
#pragma unroll
                    for (int j = 0; j < 8; ++j) x[q][j] = *(const f32x4*)(xin + (size_t)row * DM + e0 + 256 * j); }
                if (y) {
#pragma unroll
                    for (int q = 0; q < NR; ++q) { const int row = q ? r1 : r0;
#pragma unroll
                        for (int j = 0; j < 8; ++j) yp[q][j] = *(const v2u*)(y + (size_t)row * DM + e0 + 256 * j); } }
            } else { const bf16* xin = (const bf16*)xin_; v2u xp[NR][8];
#pragma unroll
                for (int q = 0; q < NR; ++q) { const int row = q ? r1 : r0;
#pragma unroll
                    for (int j = 0; j < 8; ++j) xp[q][j] = *(const v2u*)(xin + (size_t)row * DM + e0 + 256 * j); }
                if (y) {
#pragma unroll
                    for (int q = 0; q < NR; ++q) { const int row = q ? r1 : r0;
#pragma unroll
                        for (int j = 0; j < 8; ++j) yp[q][j] = *(const v2u*)(y + (size_t)row * DM + e0 + 256 * j); } }
#pragma unroll
                for (int q = 0; q < NR; ++q) {
#pragma unroll
                    for (int j = 0; j < 8; ++j) { const v2u p = xp[q][j]; x[q][j] = (f32x4){bflo(p.x), bfhi(p.x), bflo(p.y), bfhi(p.y)}; } }
            }
#pragma unroll
            for (int q = 0; q < NR; ++q) { const int row = q ? r1 : r0;
                if (y) {
                    f32x4 yv[8]; float ss = 0.f;
#pragma unroll
                    for (int j = 0; j < 8; ++j) { const v2u p = yp[q][j]; yv[j] = (f32x4){bflo(p.x), bfhi(p.x), bflo(p.y), bfhi(p.y)};
                        ss += (yv[j].x * yv[j].x + yv[j].y * yv[j].y) + (yv[j].z * yv[j].z + yv[j].w * yv[j].w); }
                    const float ry = 1.0f / sqrtf(wave_sum(ss, F.lane) * (1.f / DM) + RMS_EPS);
#pragma unroll
                    for (int j = 0; j < 8; ++j) { const f32x4 g = *(const LAS f32x4*)(vec + 1 * DM + e0 + 256 * j), gt = *(const LAS f32x4*)(vec + 0 * DM + e0 + 256 * j);
                        x[q][j] += gt * (yv[j] * ry * g); }
                    if (xout_f32) { float* xout = (float*)xout_;
#pragma unroll
                        for (int j = 0; j < 8; ++j) *(f32x4*)(xout + (size_t)row * DM + e0 + 256 * j) = x[q][j];
                    } else { bf16* xout = (bf16*)xout_;
#pragma unroll
                        for (int j = 0; j < 8; ++j) { v2u o; o.x = pk2(x[q][j].x, x[q][j].y); o.y = pk2(x[q][j].z, x[q][j].w); *(v2u*)(xout + (size_t)row * DM + e0 + 256 * j) = o; } }
                }
                if (hout) {
                    float ss = 0.f;
#pragma unroll
                    for (int j = 0; j < 8; ++j) ss += (x[q][j].x * x[q][j].x + x[q][j].y * x[q][j].y) + (x[q][j].z * x[q][j].z + x[q][j].w * x[q][j].w);
                    const float rx = 1.0f / sqrtf(wave_sum(ss, F.lane) * (1.f / DM) + RMS_EPS);
#pragma unroll
                    for (int j = 0; j < 8; ++j) { const f32x4 g = *(const LAS f32x4*)(vec + 2 * DM + e0 + 256 * j), sh = *(const LAS f32x4*)(vec + 3 * DM + e0 + 256 * j), sc = *(const LAS f32x4*)(vec + 4 * DM + e0 + 256 * j);
                        const f32x4 hv = (x[q][j] * rx * g) * (sc + 1.0f) + sh;
                        v2u o; o.x = pk2(hv.x, hv.y); o.y = pk2(hv.z, hv.w);
                        *(v2u*)(hout + (size_t)row * DM + e0 + 256 * j) = o; }
                }
            }
        }
        seg = send;
    }
}
__device__ __forceinline__ void ph_dsa_norm(Frame& F, const float* proj, const float* qn, const float* kvn, const float* ikn, bf16* qlat, bf16* ckv, bf16* kidx, float* widx) {
    const int gw = blockIdx.x * NWAVES + F.wave, NGW = F.G * NWAVES; const int e0 = 4 * F.lane;
    for (int row = gw; row < T; row += NGW) {
        f32x4 v[4];
#pragma unroll
        for (int j = 0; j < 4; ++j) v[j] = *(const f32x4*)(proj + (size_t)row * A_INP + e0 + 256 * j);
        float sq = 0.f;
#pragma unroll
        for (int j = 0; j < 2; ++j) sq += (v[j].x * v[j].x + v[j].y * v[j].y) + (v[j].z * v[j].z + v[j].w * v[j].w);
        const float rq = 1.0f / sqrtf(wave_sum(sq, F.lane) * (1.f / A_QR) + RMS_EPS);
#pragma unroll
        for (int j = 0; j < 2; ++j) { const f32x4 g = *(const f32x4*)(qn + e0 + 256 * j); const f32x4 o = v[j] * rq * g; v2u w; w.x = pk2(o.x, o.y); w.y = pk2(o.z, o.w);
            *(v2u*)(qlat + (size_t)row * A_QR + e0 + 256 * j) = w; }
        const float skv = (v[2].x * v[2].x + v[2].y * v[2].y) + (v[2].z * v[2].z + v[2].w * v[2].w);
        const float rkv = 1.0f / sqrtf(wave_sum(skv, F.lane) * (1.f / A_KVR) + RMS_EPS);
        { const f32x4 g = *(const f32x4*)(kvn + e0); const f32x4 o = v[2] * rkv * g; v2u w; w.x = pk2(o.x, o.y); w.y = pk2(o.z, o.w); *(v2u*)(ckv + (size_t)row * A_KVR + e0) = w; }
        const bool isk = F.lane < 32;
        const float s1 = isk ? (v[3].x + v[3].y) + (v[3].z + v[3].w) : 0.f;
        const float mean = wave_sum(s1, F.lane) * (1.f / IDX_D);
        const f32x4 dv = v[3] - mean;
        const float s2 = isk ? (dv.x * dv.x + dv.y * dv.y) + (dv.z * dv.z + dv.w * dv.w) : 0.f;
        const float rk = 1.0f / sqrtf(wave_sum(s2, F.lane) * (1.f / IDX_D) + RMS_EPS);
        if (isk) { const f32x4 g = *(const f32x4*)(ikn + e0); const f32x4 o = dv * rk * g; v2u w; w.x = pk2(o.x, o.y); w.y = pk2(o.z, o.w); *(v2u*)(kidx + (size_t)row * IDX_D + e0) = w; }
        else if (F.lane < 36) { *(f32x4*)(widx + (size_t)row * IDX_H + (e0 - 128)) = v[3] * 0.02209708691207961f; }
    }
}

__device__ __forceinline__ int wave_scan_incl(int v, int lane, int& total) {
    v += __builtin_amdgcn_update_dpp(0, v, 0x111, 0xf, 0xf, true); v += __builtin_amdgcn_update_dpp(0, v, 0x112, 0xf, 0xf, true);
    v += __builtin_amdgcn_update_dpp(0, v, 0x114, 0xf, 0xf, true); v += __builtin_amdgcn_update_dpp(0, v, 0x118, 0xf, 0xf, true);
    const int t0 = __builtin_amdgcn_readlane(v, 15), t1 = __builtin_amdgcn_readlane(v, 31), t2 = __builtin_amdgcn_readlane(v, 47), t3 = __builtin_amdgcn_readlane(v, 63);
    v += (lane >= 16 ? t0 : 0) + (lane >= 32 ? t1 : 0) + (lane >= 48 ? t2 : 0);
    total = (t0 + t1) + (t2 + t3);
    return v;
}
template <bool G, class SP> __device__ __forceinline__ void topk_select_row(SP sc, int t, int* out, int lane, LAS int* lst) {
    const int n = t + 1;
    if (n <= TOPK) { for (int i = lane; i < TOPK; i += 64) out[i] = (i < n) ? i : 0; return; }
    const int ni = G ? 2 * ((n + 127) >> 7) : (n + 63) >> 6;
#define TOPK_KEYIDX(i) (G ? 128 * ((i) >> 1) + 2 * lane + ((i) & 1) : 64 * (i) + lane)
    unsigned key[64];
#pragma unroll
    for (int g = 0; g < 8; ++g) {
        if (8 * g < ni) {
            if constexpr (G) {
#pragma unroll
                for (int j = 4 * g; j < 4 * g + 4; ++j) { const unsigned d = __hip_atomic_load((const unsigned*)sc + 64 * j + lane, __ATOMIC_RELAXED, __HIP_MEMORY_SCOPE_AGENT);
#pragma unroll
                    for (int e = 0; e < 2; ++e) { const int s = 128 * j + 2 * lane + e; const unsigned h = e ? (d >> 16) : (d & 0xffffu); const unsigned k = (h & 0x8000u) ? (~h & 0xffffu) : (h | 0x8000u); key[2 * j + e] = (s < n) ? k : 0u; } }
            } else {
#pragma unroll
                for (int i = 8 * g; i < 8 * g + 8; ++i) { const int s = 64 * i + lane; const unsigned h = sc[s < n ? s : n - 1]; const unsigned k = (h & 0x8000u) ? (~h & 0xffffu) : (h | 0x8000u); key[i] = (s < n) ? k : 0u; }
            }
        } else {
#pragma unroll
            for (int i = 8 * g; i < 8 * g + 8; ++i) key[i] = 0u;
        }
    }
    unsigned prefix = 0u;
    for (int bit = 15; bit >= 0; --bit) {
        const unsigned cand = prefix | (1u << bit); int cl = 0;
#pragma unroll
        for (int g = 0; g < 8; ++g) if (8 * g < ni) {
#pragma unroll
            for (int i = 8 * g; i < 8 * g + 8; ++i) cl += (key[i] >= cand) ? 1 : 0; }
        cl += __builtin_amdgcn_update_dpp(0, cl, 0xB1, 0xf, 0xf, true); cl += __builtin_amdgcn_update_dpp(0, cl, 0x4E, 0xf, 0xf, true);
        cl += __builtin_amdgcn_update_dpp(0, cl, 0x124, 0xf, 0xf, true); cl += __builtin_amdgcn_update_dpp(0, cl, 0x128, 0xf, 0xf, true);
        const int cnt = (__builtin_amdgcn_readlane(cl, 0) + __builtin_amdgcn_readlane(cl, 16)) + (__builtin_amdgcn_readlane(cl, 32) + __builtin_amdgcn_readlane(cl, 48));
        if (cnt >= TOPK) prefix = cand;
    }
    int cg = 0, ce = 0;
#pragma unroll
    for (int g = 0; g < 8; ++g) if (8 * g < ni) {
#pragma unroll
        for (int i = 8 * g; i < 8 * g + 8; ++i) { cg += (key[i] > prefix) ? 1 : 0; ce += (key[i] == prefix) ? 1 : 0; } }
    int tg, te;
    const int bg = wave_scan_incl(cg, lane, tg) - cg, be = wave_scan_incl(ce, lane, te) - ce;
    int quota = (TOPK - tg) - be; quota = quota < 0 ? 0 : (quota > ce ? ce : quota);
    int pg = bg, pe = tg + (be < TOPK - tg ? be : TOPK - tg);
    const int dummy = TOPK + lane;
#pragma unroll
    for (int g = 0; g < 8; ++g) if (8 * g < ni) {
#pragma unroll
        for (int i = 8 * g; i < 8 * g + 8; ++i) {
            const bool gt = key[i] > prefix, eq = (key[i] == prefix) && (quota > 0);
            const int pos = gt ? pg : (eq ? pe : dummy);
            lst[pos] = TOPK_KEYIDX(i);
            pg += gt ? 1 : 0; pe += eq ? 1 : 0; quota -= eq ? 1 : 0;
        } }
    asm volatile("s_waitcnt lgkmcnt(0)" ::: "memory");
    *(v4u*)(out + 4 * lane) = *(const LAS v4u*)(lst + 4 * lane);
#undef TOPK_KEYIDX
}
__device__ __forceinline__ int t5_bucket(int d) {
    if (d < 16) return d;
    int bkt = 16;
    bkt += (d >= 19) + (d >= 21) + (d >= 24) + (d >= 27) + (d >= 31) + (d >= 35) + (d >= 40) + (d >= 46) + (d >= 52) + (d >= 59) + (d >= 67) + (d >= 77) + (d >= 87) + (d >= 99) + (d >= 113);
    return bkt;
}

typedef short bf16x8 __attribute__((ext_vector_type(8)));
typedef short s16x4 __attribute__((ext_vector_type(4)));
typedef float f32x16 __attribute__((ext_vector_type(16)));
__device__ __forceinline__ unsigned offb(unsigned row, unsigned ch) { return 256u * row + 16u * (ch ^ (((row & 3u) << 2) | ((row >> 2) & 3u))); }
__device__ __forceinline__ unsigned tr_base_perm(unsigned lane, unsigned c, unsigned t) {
    const unsigned h = lane >> 5, blk = (lane >> 4) & 1u, q = (lane & 15u) >> 2, p = lane & 3u;
    return offb(8u * t + 4u * h + q, 4u * c + 2u * blk + (p >> 1)) + 8u * (p & 1u);
}
__device__ __forceinline__ bf16x8 tr_frag_at(LAS unsigned char* img, unsigned b0, unsigned b1, unsigned ks) {
    const s16x4 lo = __builtin_amdgcn_ds_read_tr16_b64_v4i16((LAS s16x4*)(img + b0 + 4096u * ks));
    const s16x4 hi = __builtin_amdgcn_ds_read_tr16_b64_v4i16((LAS s16x4*)(img + b1 + 4096u * ks));
    return __builtin_shufflevector(lo, hi, 0, 1, 2, 3, 4, 5, 6, 7);
}

__device__ __forceinline__ void ph_indexer(Frame& F, const bf16* qidx, const bf16* kidx, const float* widx, int* idxo) {
    constexpr int NQ = 8;
    LAS unsigned short* sc = (LAS unsigned short*)(F.lds);
    LAS float* wsh = (LAS float*)(F.lds + 65536);
    LAS unsigned char* ring = F.lds + 66560;
    const int r = F.lane & 31, hf = F.lane >> 5, rp = F.wave & 1, kq = F.wave >> 1;
    const int drow = 4 * F.wave + (F.lane >> 4), dch = (F.lane & 15) ^ (((F.lane >> 4) << 2) | (F.wave & 3));
    for (int u = blockIdx.x; u < BATCH * (SEQ / NQ); u += F.G) {
        const int b = u & 7, t0 = (u >> 3) * NQ;
        const int nt = (t0 + NQ + 31) >> 5, ns = (nt + 3) >> 2;
        const bf16* kbase = kidx + (size_t)(b * SEQ + drow) * IDX_D + dch * 8;
        __syncthreads();
#pragma unroll
        for (int j = 0; j < 4; ++j) __builtin_amdgcn_global_load_lds((const unsigned*)(kbase + (size_t)(j * 32) * IDX_D), (LAS unsigned*)(ring + j * 8192 + F.wave * 1024), 16, 0, 0);
        if (F.tid < NQ * 16) wsh[F.tid] = widx[(size_t)(b * SEQ + t0 + (F.tid >> 4)) * IDX_H + (F.tid & 15)];
        { const bf16* qb = qidx + (size_t)(b * SEQ + t0 + ((drow >> 2) & 1)) * 2048 + (4 * (drow >> 3) + (drow & 3)) * 128 + dch * 8;
#pragma unroll
          for (int j = 0; j < 4; ++j) __builtin_amdgcn_global_load_lds((const unsigned*)(qb + (size_t)(2 * j) * 2048), (LAS unsigned*)(ring + 32768 + j * 8192 + F.wave * 1024), 16, 0, 0); }
        bf16x8 Af[2][8];
        for (int s = 0; s < ns; ++s) {
            asm volatile("s_waitcnt vmcnt(0) lgkmcnt(0)" ::: "memory"); __builtin_amdgcn_s_barrier(); asm volatile("" ::: "memory");
            if (s == 0) {
#pragma unroll
                for (int rt = 0; rt < 2; ++rt)
#pragma unroll
                    for (int ks = 0; ks < 8; ++ks) Af[rt][ks] = *(const LAS bf16x8*)(ring + 32768 + (2 * rp + rt) * 8192 + offb((unsigned)r, (unsigned)(2 * ks + hf)));
                asm volatile("s_waitcnt lgkmcnt(0)" ::: "memory"); __builtin_amdgcn_s_barrier(); asm volatile("" ::: "memory");
            }
            if (s + 1 < ns) {
#pragma unroll
                for (int j = 0; j < 4; ++j) __builtin_amdgcn_global_load_lds((const unsigned*)(kbase + (size_t)((4 * (s + 1) + j) * 32) * IDX_D), (LAS unsigned*)(ring + ((s + 1) & 1) * 32768 + j * 8192 + F.wave * 1024), 16, 0, 0);
            }
            const int kt = 4 * s + kq;
            if (kt < nt) {
                LAS unsigned char* tile = ring + (s & 1) * 32768 + kq * 8192;
                bf16x8 Bf[8];
#pragma unroll
                for (int ks = 0; ks < 8; ++ks) Bf[ks] = *(const LAS bf16x8*)(tile + offb((unsigned)r, (unsigned)(2 * ks + hf)));
#pragma unroll
                for (int rt = 0; rt < 2; ++rt) {
                    f32x16 acc;
#pragma unroll
                    for (int i = 0; i < 16; ++i) acc[i] = 0.f;
#pragma unroll
                    for (int ks = 0; ks < 8; ++ks) acc = __builtin_amdgcn_mfma_f32_32x32x16_bf16(Af[rt][ks], Bf[ks], acc, 0, 0, 0);
                    float s0 = 0.f, s1 = 0.f;
#pragma unroll
                    for (int i4 = 0; i4 < 4; ++i4) { const f32x4 w4 = *(const LAS f32x4*)(wsh + (4 * rp + 2 * rt + hf) * 16 + 4 * i4);
                        s0 += w4.x * fmaxf(acc[4 * i4], 0.f) + w4.z * fmaxf(acc[4 * i4 + 2], 0.f); s1 += w4.y * fmaxf(acc[4 * i4 + 1], 0.f) + w4.w * fmaxf(acc[4 * i4 + 3], 0.f); }
                    sc[(4 * rp + 2 * rt + hf) * 4096 + kt * 32 + r] = __builtin_bit_cast(unsigned short, (_Float16)(s0 + s1));
                }
            }
        }
        __syncthreads();
        for (int q = F.wave; q < NQ; q += NWAVES) topk_select_row<false>(sc + q * 4096, t0 + q, idxo + (size_t)(b * SEQ + t0 + q) * TOPK, F.lane, (LAS int*)(F.lds + 132096) + F.wave * 320);
    }
}

#define LDS_BARRIER() do { asm volatile("s_waitcnt lgkmcnt(0)" ::: "memory"); __builtin_amdgcn_s_barrier(); asm volatile("" ::: "memory"); } while (0)
__device__ __forceinline__ int relane(int lane) { asm volatile("" : "+v"(lane)); return lane; }
__device__ __forceinline__ void ph_sparse_attn(Frame& F, bf16* qa_olat, const bf16* ckv, const int* idxi, const float* relb) {
    LAS unsigned char* KV = F.lds;
    LAS unsigned char* PF = F.lds + 131072;
    LAS float* wmax = (LAS float*)(F.lds + 147456);
    LAS float* wsum = wmax + 256;
    LAS unsigned char* bks = F.lds + 147456 + 2048;
    LAS float* relbs = (LAS float*)(F.lds + 147456 + 2048 + 512);
    LAS float* invw = (LAS float*)(F.lds + 147456 + 2048 + 512 + 4224);
    LAS unsigned char* blut = F.lds + 147456 + 2048 + 512 + 4224 + 1024;
    const float scale = 0.08838834764831845f;
    const int w = F.wave;
    __syncthreads();
    for (int i = F.tid; i < 1024; i += 512) relbs[i] = relb[i];
    if (F.tid < 32) relbs[1024 + F.tid] = -INFINITY;
    if (F.tid < 128) blut[F.tid] = (unsigned char)t5_bucket(F.tid);
    int u = blockIdx.x;
    if (u >= T) return;
    int idc[16]; int bid; v4u R[16]; v4u Qr[2];
    {
        const int cc = F.lane & 31, r = F.lane & 31, hf = F.lane >> 5;
        const int t = u % SEQ, b = u / SEQ;
        const int* ip = idxi + (size_t)u * TOPK + 32 * w + hf;
#pragma unroll
        for (int k = 0; k < 16; ++k) idc[k] = ip[2 * k];
        const bf16* kb = ckv + (size_t)b * SEQ * A_KVR + cc * 8;
#pragma unroll
        for (int k = 0; k < 16; ++k) R[k] = *(const v4u*)(kb + (size_t)idc[k] * A_KVR);
        if (F.tid < 256) { const int id = idxi[(size_t)u * TOPK + F.tid]; const int d = t - id; bks[F.tid] = (F.tid <= t) ? (unsigned char)t5_bucket(d > 0 ? d : 0) : (unsigned char)32; }
        const int u2 = (u + F.G < T) ? u + F.G : u;
        const int* ip2 = idxi + (size_t)u2 * TOPK + 32 * w + hf;
#pragma unroll
        for (int k = 0; k < 16; ++k) idc[k] = ip2[2 * k];
        bid = (F.tid < 256) ? idxi[(size_t)u2 * TOPK + F.tid] : -1;
        { const v4u* qp = (const v4u*)(qa_olat + (size_t)u * A_HEADS * A_KVR);
#pragma unroll
          for (int j = 0; j < 2; ++j) { const int id = 2 * w + j, head = 8 * (id & 3) + (F.lane & 7), pos = 8 * (id >> 2) + (F.lane >> 3); Qr[j] = qp[head * 32 + pos]; } }
    }
    unsigned wro[16], qwo[2], trb[2];
    { const unsigned r0 = F.lane & 31, hf0 = F.lane >> 5; const unsigned c0 = (r0 & 15u) ^ (4u * hf0);
#pragma unroll
      for (int k = 0; k < 16; ++k) wro[k] = (r0 >> 4) * 65536u + 256u * (32u * w + hf0) + 512u * k + 16u * (c0 ^ (unsigned)(8 * (k & 1) + ((k >> 1) & 3)));
#pragma unroll
      for (int j = 0; j < 2; ++j) { const int id = 2 * w + j, head = 8 * (id & 3) + (F.lane & 7), pos = 8 * (id >> 2) + (F.lane >> 3); qwo[j] = (pos >> 1) * 1024 + ((pos & 1) * 32 + head) * 16; }
      trb[0] = tr_base_perm((unsigned)F.lane, (unsigned)(w & 3), 0u); trb[1] = tr_base_perm((unsigned)F.lane, (unsigned)(w & 3), 1u); }
    unsigned rdo[16];
    { const unsigned r0 = F.lane & 31, hf0 = F.lane >> 5, row = 32u * w + r0, xr = ((row & 3u) << 2) | ((row >> 2) & 3u);
#pragma unroll
      for (int ks = 0; ks < 16; ++ks) rdo[ks] = 256u * row + (ks >> 3) * 65536u + 16u * ((unsigned)(2 * (ks & 7) + hf0) ^ xr); }
    for (int it = 0; u < T; u += F.G, ++it) {
        const int un = u + F.G, unn = u + 2 * F.G, par = it & 1;
        LDS_BARRIER();
        const int l2 = relane(F.lane), r = l2 & 31, hf = l2 >> 5;
        {
#pragma unroll
          for (int k = 0; k < 16; ++k) *(LAS v4u*)(KV + wro[k]) = R[k]; }
        *(LAS v4u*)(PF + qwo[0]) = Qr[0]; *(LAS v4u*)(PF + qwo[1]) = Qr[1];
        LDS_BARRIER();
        const int tid1 = w * 64 + l2;
        const int unb = (un < T) ? un : u; const int bn = unb / SEQ, tn = unb % SEQ;
        const bf16* kbn = ckv + (size_t)bn * SEQ * A_KVR + r * 8;
        f32x16 acc;
#pragma unroll
        for (int i = 0; i < 16; ++i) acc[i] = 0.f;
        {
#pragma unroll
          for (int ks = 0; ks < 16; ++ks) { const bf16x8 a = *(const LAS bf16x8*)(KV + rdo[ks]);
              acc = __builtin_amdgcn_mfma_f32_32x32x16_bf16(a, *(const LAS bf16x8*)(PF + ks * 1024 + l2 * 16), acc, 0, 0, 0);
              R[ks] = *(const v4u*)(kbn + (size_t)idc[ks] * A_KVR); } }
        if (tid1 < 256) { int d = tn - bid; d = d < 0 ? 0 : (d > 127 ? 127 : d); bks[(par ^ 1) * 256 + tid1] = (tid1 <= tn) ? blut[d] : (unsigned char)32; }
        { const v4u* qp = (const v4u*)(qa_olat + (size_t)unb * A_HEADS * A_KVR);
#pragma unroll
          for (int j = 0; j < 2; ++j) { const int id = 2 * w + j, head = 8 * (id & 3) + (l2 & 7), pos = 8 * (id >> 2) + (l2 >> 3); Qr[j] = qp[head * 32 + pos]; } }
        float lg[16]; float m = -INFINITY;
#pragma unroll
        for (int g = 0; g < 4; ++g) { const unsigned b4 = *(const LAS unsigned*)(bks + par * 256 + 32 * w + 8 * g + 4 * hf);
#pragma unroll
            for (int j = 0; j < 4; ++j) { const unsigned bk = (b4 >> (8 * j)) & 255u; const int i = 4 * g + j;
                lg[i] = acc[i] * scale + relbs[bk * 32 + r]; m = fmaxf(m, lg[i]); } }
        m = fmaxf(m, shx(m, 32, l2));
        if (hf == 0) wmax[r * 8 + w] = m;
        LDS_BARRIER();
        { const f32x4 m0 = *(const LAS f32x4*)(wmax + r * 8), m1 = *(const LAS f32x4*)(wmax + r * 8 + 4);
          m = fmaxf(fmaxf(fmaxf(m0.x, m0.y), fmaxf(m0.z, m0.w)), fmaxf(fmaxf(m1.x, m1.y), fmaxf(m1.z, m1.w))); }
        float s = 0.f;
#pragma unroll
        for (int i = 0; i < 16; ++i) { lg[i] = __expf(lg[i] - m); s += lg[i]; }
        s += shx(s, 32, l2);
        if (hf == 0) wsum[r * 8 + w] = s;
#pragma unroll
        for (int s2 = 0; s2 < 2; ++s2) { v4u pk; pk.x = pk2(lg[8 * s2 + 0], lg[8 * s2 + 1]); pk.y = pk2(lg[8 * s2 + 2], lg[8 * s2 + 3]); pk.z = pk2(lg[8 * s2 + 4], lg[8 * s2 + 5]); pk.w = pk2(lg[8 * s2 + 6], lg[8 * s2 + 7]);
            *(LAS v4u*)(PF + (2 * w + s2) * 1024 + l2 * 16) = pk; }
        LDS_BARRIER();
        const int l3 = relane(F.lane), r3 = l3 & 31, hf3 = l3 >> 5;
        if (hf3 == 0) { const f32x4 s0 = *(const LAS f32x4*)(wsum + r3 * 8), s1 = *(const LAS f32x4*)(wsum + r3 * 8 + 4);
            invw[w * 32 + r3] = 1.0f / (((s0.x + s0.y) + (s0.z + s0.w)) + ((s1.x + s1.y) + (s1.z + s1.w))); }
        f32x16 o;
#pragma unroll
        for (int i = 0; i < 16; ++i) o[i] = 0.f;
        LAS unsigned char* img = KV + (w >> 2) * 65536;
        const int unc = (unn < T) ? unn : u;
        const int* ip2 = idxi + (size_t)unc * TOPK + 32 * w + hf3;
        const unsigned tb0 = trb[0], tb1 = trb[1];
#pragma unroll
        for (int ks = 0; ks < 16; ++ks) { const bf16x8 a = *(const LAS bf16x8*)(PF + ks * 1024 + l3 * 16);
            const bf16x8 bb = tr_frag_at(img, tb0, tb1, (unsigned)ks);
            o = __builtin_amdgcn_mfma_f32_32x32x16_bf16(a, bb, o, 0, 0, 0);
            idc[ks] = ip2[2 * ks]; }
        if (w * 64 + l3 < 256) bid = idxi[(size_t)unc * TOPK + w * 64 + l3];
        bf16* op = qa_olat + ((size_t)u * A_HEADS + 4 * hf3) * A_KVR + 32 * w + r3;
#pragma unroll
        for (int g = 0; g < 4; ++g) { const f32x4 iv = *(const LAS f32x4*)(invw + w * 32 + 8 * g + 4 * hf3);
            op[(8 * g + 0) * A_KVR] = (bf16)f2bf(o[4 * g + 0] * iv.x); op[(8 * g + 1) * A_KVR] = (bf16)f2bf(o[4 * g + 1] * iv.y);
            op[(8 * g + 2) * A_KVR] = (bf16)f2bf(o[4 * g + 2] * iv.z); op[(8 * g + 3) * A_KVR] = (bf16)f2bf(o[4 * g + 3] * iv.w); }
    }
}

__device__ __forceinline__ void ph_sb_attn(Frame& F, const bf16* qkv, bf16* o_out, unsigned* qctr) {
    LAS unsigned char* img = F.lds + F.wave * 8192;
    LAS unsigned char* qimg = F.lds + 65536 + F.wave * 8192;
    const int r = F.lane & 31, hf = F.lane >> 5;
    const float scale = 0.08838834764831845f;
    constexpr int NTASK8 = BATCH * B_HEADS * (SEQ / 32) / 8;
    const int myx = (int)(xb_xcc_id() & 7u);
    for (int qi = 0; qi < 8; ++qi) { const int qsel = (myx + qi) & 7;
    for (;;) {
        int task = 0;
        if (F.lane == 0) task = (int)__hip_atomic_fetch_add(qctr + 64 * qsel, 1u, __ATOMIC_RELAXED, __HIP_MEMORY_SCOPE_AGENT);
        task = __builtin_amdgcn_readfirstlane(task);
        if (task >= NTASK8) break;
        task += qsel * NTASK8;
        const int qt = task & 127, bh = task >> 7, h = bh & 15, b = bh >> 4, t0 = qt * 32;
        v4u Kr[8], Vr[8];
#pragma unroll
        for (int k = 0; k < 8; ++k) { const int n = F.lane + 64 * k; *(LAS v4u*)(qimg + offb(n >> 4, n & 15)) = *(const v4u*)(qkv + (size_t)(b * SEQ + t0 + (n >> 4)) * B_INC + h * B_HD + (n & 15) * 8); }
        {
#pragma unroll
          for (int k = 0; k < 8; ++k) { const int n = F.lane + 64 * k; const bf16* rp = qkv + (size_t)(b * SEQ + qt * 32 + (n >> 4)) * B_INC + h * B_HD + (n & 15) * 8; Kr[k] = *(const v4u*)(rp + DM); Vr[k] = *(const v4u*)(rp + 2 * DM); } }
        f32x16 o[4];
#pragma unroll
        for (int dt = 0; dt < 4; ++dt)
#pragma unroll
            for (int i = 0; i < 16; ++i) o[dt][i] = 0.f;
        float Rc = 1.f;
        for (int kt = qt; kt >= 0; --kt) {
            const int ll = relane(F.lane), r = ll & 31, hf = ll >> 5;
#pragma unroll
            for (int k = 0; k < 8; ++k) { const int n = ll + 64 * k; *(LAS v4u*)(img + offb(n >> 4, n & 15)) = Kr[k]; }
            f32x16 acc;
#pragma unroll
            for (int i = 0; i < 16; ++i) acc[i] = 0.f;
#pragma unroll
            for (int ks = 0; ks < 8; ++ks) acc = __builtin_amdgcn_mfma_f32_32x32x16_bf16(*(const LAS bf16x8*)(img + offb(r, 2 * ks + hf)), *(const LAS bf16x8*)(qimg + offb(r, 2 * ks + hf)), acc, 0, 0, 0);
            asm volatile("s_waitcnt lgkmcnt(0)" ::: "memory");
#pragma unroll
            for (int k = 0; k < 8; ++k) { const int n = ll + 64 * k; *(LAS v4u*)(img + offb(n >> 4, n & 15)) = Vr[k]; }
            float be[16], om[16];
            const bool diag = (kt == qt);
#pragma unroll
            for (int i = 0; i < 16; ++i) { const float z = fminf(acc[i] * scale, 80.f);
                const float e = __expf(z), rr = __builtin_amdgcn_rcpf(1.0f + e);
                be[i] = e * rr; om[i] = rr; }
            if (diag) {
#pragma unroll
                for (int i = 0; i < 16; ++i) { const int kap = 8 * (i >> 2) + 4 * hf + (i & 3); if (kap >= r) { be[i] = 0.f; om[i] = 1.f; } } }
            float sfx[16], Gt[4], Go[4];
#pragma unroll
            for (int g = 0; g < 4; ++g) { sfx[4 * g + 3] = 1.f; sfx[4 * g + 2] = om[4 * g + 3]; sfx[4 * g + 1] = sfx[4 * g + 2] * om[4 * g + 2]; sfx[4 * g + 0] = sfx[4 * g + 1] * om[4 * g + 1]; Gt[g] = sfx[4 * g + 0] * om[4 * g + 0]; }
#pragma unroll
            for (int g = 0; g < 4; ++g) Go[g] = shx(Gt[g], 32, ll);
            float SP[4]; SP[3] = 1.f; SP[2] = Gt[3] * Go[3]; SP[1] = SP[2] * (Gt[2] * Go[2]); SP[0] = SP[1] * (Gt[1] * Go[1]);
            float wgt[16];
#pragma unroll
            for (int g = 0; g < 4; ++g) { const float Rg = Rc * SP[g] * (hf == 0 ? Go[g] : 1.f);
#pragma unroll
                for (int j = 0; j < 4; ++j) wgt[4 * g + j] = be[4 * g + j] * (Rg * sfx[4 * g + j]); }
            Rc = Rc * (SP[0] * (Gt[0] * Go[0]));
            if (kt > 0) {
#pragma unroll
                for (int k = 0; k < 8; ++k) { const int n = F.lane + 64 * k; const bf16* rp = qkv + (size_t)(b * SEQ + (kt - 1) * 32 + (n >> 4)) * B_INC + h * B_HD + (n & 15) * 8; Kr[k] = *(const v4u*)(rp + DM); Vr[k] = *(const v4u*)(rp + 2 * DM); }
            }
            asm volatile("s_waitcnt lgkmcnt(0)" ::: "memory");
#pragma unroll
            for (int s2 = 0; s2 < 2; ++s2) {
                v4u pk; pk.x = pk2(wgt[8 * s2 + 0], wgt[8 * s2 + 1]); pk.y = pk2(wgt[8 * s2 + 2], wgt[8 * s2 + 3]); pk.z = pk2(wgt[8 * s2 + 4], wgt[8 * s2 + 5]); pk.w = pk2(wgt[8 * s2 + 6], wgt[8 * s2 + 7]);
                const bf16x8 pa = __builtin_bit_cast(bf16x8, pk);
#pragma unroll
                for (int dt = 0; dt < 4; ++dt) { const bf16x8 vb = tr_frag_at(img, tr_base_perm((unsigned)ll, (unsigned)dt, 0u), tr_base_perm((unsigned)ll, (unsigned)dt, 1u), (unsigned)s2);
                    o[dt] = __builtin_amdgcn_mfma_f32_32x32x16_bf16(pa, vb, o[dt], 0, 0, 0); }
            }
            if (__ballot(Rc >= 0x1p-40f) == 0ull) break;
        }
#pragma unroll
        for (int dt = 0; dt < 4; ++dt)
#pragma unroll
            for (int i = 0; i < 16; ++i) { const int qrow = 8 * (i >> 2) + 4 * hf + (i & 3);
                o_out[(size_t)(b * SEQ + t0 + qrow) * DM + h * B_HD + 32 * dt + r] = (bf16)f2bf(o[dt][i]); }
    }
    }
}

constexpr int PH_LAYER0 = 3, PH_PER_LAYER = 16, PH_END = PH_LAYER0 + DEPTH * PH_PER_LAYER;
typedef pg8::bf16_t gb16;
__device__ __forceinline__ bool relaunder(Frame& F) { int l_; asm volatile("v_mbcnt_lo_u32_b32 %0, -1, 0\n\tv_mbcnt_hi_u32_b32 %0, -1, %0" : "=v"(l_)); F.lane = l_; F.tid = F.wave * 64 + l_; return true; }
template <class Epi> __device__ __forceinline__ void run_gemm(Frame& F, const bf16* A, const bf16* Bt, int N, int K, int lda, int ldb, int acs, const Epi& E) {
    pg8::Gemm g{(const gb16*)A, (const gb16*)Bt, T, N, K, lda, ldb, acs}; pg8::StaticOrder S; S.init(T, N, F.G, (F.G == 256) ? (int)((blockIdx.x & 31) * 8 + (blockIdx.x >> 5)) : (int)blockIdx.x);
    pg8::gemm_phase<Epi, pg8::StaticOrder, true, true>(F.lds, g, S, E, F.tid);
}
__global__ void __launch_bounds__(NWAVES * 64, 2) fwd_kernel(Args args) {
    extern __shared__ __attribute__((aligned(16))) unsigned char lds_raw[];
    Frame F;
    F.lds = (LAS unsigned char*)lds_raw;
    F.tid = threadIdx.x; F.lane = F.tid & 63; F.wave = __builtin_amdgcn_readfirstlane(F.tid >> 6); F.G = gridDim.x;
    F.ap = (const CAS Args*)__builtin_amdgcn_kernarg_segment_ptr();
    F.out = args.out; F.ws = args.ws;
    volatile LAS unsigned* MISC = (volatile LAS unsigned*)(F.lds + MISC_OFF);
    if (F.tid < 64) MISC[F.tid] = 0u;
    __syncthreads();
    const int lo = args.ph_lo, hi = args.ph_hi;
    XcdBarrier bar; bar.bar = (unsigned*)(F.ws + WS_CTL) + CW_BAR; bar.x = 0; bar.st = nullptr;
    if (hi - lo > 1) { bar = xcd_barrier_post((unsigned*)(F.ws + WS_CTL) + CW_BAR, MISC + 8); xcd_barrier<true>(bar); }
#define IN(k) (lo <= (k) && (k) < hi && relaunder(F))
#define INR(k) (lo <= (k) && (k) < hi)
#define GRID_BAR() do { XcdBarrier b2_ = bar; b2_.x = (unsigned)__builtin_amdgcn_readfirstlane((int)bar.x); asm volatile("" : "+s"(b2_.bar), "+s"(b2_.x)); xcd_barrier<false>(b2_); } while (0)
#define SEAM(k) do { if (INR((k) + 1)) GRID_BAR(); } while (0)

    float* mod = WSP(float, WS_MOD);
    const float* normg = F.inp(IN_NORMG);
    bf16* Hb = WSP(bf16, WS_H);
    if (IN(0)) { ph_prologue(F); SEAM(0); }
    if (IN(1)) { ph_modreduce(F); SEAM(1); }
    if (IN(2)) { ph_post(F, nullptr, F.inp(IN_X), true, nullptr, false, nullptr, nullptr, Hb, normg + 0 * DM, mod + 0 * DM, mod + 1 * DM); SEAM(2); }

    for (int L = 0; L < DEPTH; ++L) {
        const int pb = PH_LAYER0 + PH_PER_LAYER * L, j = L >> 1;
        const float* modL = mod + (size_t)L * BATCH * MODW;
        const float* ng = normg + (size_t)L * 4 * DM;
        const bool lastL = (L == DEPTH - 1);
        bf16* XB = (bf16*)((unsigned char*)F.out + 128 * MiB); bf16* XL = WSP(bf16, WS_P + 128 * MiB);
        if ((L & 1) == 0) {
            float* proj = WSP(float, WS_P); bf16* qidx = WSP(bf16, WS_P + 128 * MiB); bf16* ob = WSP(bf16, WS_P);
            bf16* big = WSP(bf16, WS_BIG);
            bf16* qlat = WSP(bf16, WS_QLAT); bf16* ckv = WSP(bf16, WS_CKV); bf16* kidx = WSP(bf16, WS_KIDX); float* widx = WSP(float, WS_WIDX); int* idxb = WSP(int, WS_IDX);
            if (IN(pb + 0)) { pg8::EpiF32 E{proj, A_INP}; run_gemm(F, Hb, WSP(bf16, WS_WAIN) + (size_t)j * A_INP * DM, A_INP, DM, DM, DM, 0, E); SEAM(pb + 0); }
            if (IN(pb + 1)) { ph_dsa_norm(F, proj, F.inp(IN_AQN) + j * A_QR, F.inp(IN_AKVN) + j * A_KVR, F.inp(IN_AIKN) + j * IDX_D, qlat, ckv, kidx, widx); SEAM(pb + 1); }
            if (IN(pb + 2)) { pg8::EpiBf16<0> E{(gb16*)big, 8192, (gb16*)qidx, 2048, 8192}; run_gemm(F, qlat, WSP(bf16, WS_WQC) + (size_t)j * 10240 * 512, 10240, A_QR, A_QR, A_QR, 0, E); SEAM(pb + 2); }
            if (IN(pb + 3)) { ph_indexer(F, qidx, kidx, widx, idxb); SEAM(pb + 3); }
            if (IN(pb + 4)) { ph_sparse_attn(F, big, ckv, idxb, F.inp(IN_RELB)); SEAM(pb + 4); }
            if (IN(pb + 5)) { pg8::EpiBf16<0> E{(gb16*)ob, 4096, (gb16*)ob, 4096, 1 << 30}; run_gemm(F, big, WSP(bf16, WS_WUV) + (size_t)j * 4096 * 512, 4096, 512, 8192, 512, 512, E); SEAM(pb + 5); }
            if (IN(pb + 6)) { pg8::EpiBf16<0> E{(gb16*)big, DM, (gb16*)big, DM, 1 << 30}; run_gemm(F, ob, WSP(bf16, WS_WAOUT) + (size_t)j * DM * 4096, DM, 4096, 4096, 4096, 0, E); SEAM(pb + 6); }
        } else {
            bf16* qkv = WSP(bf16, WS_BIG); bf16* ob = WSP(bf16, WS_P); bf16* big = WSP(bf16, WS_BIG);
            if (IN(pb + 0)) { pg8::EpiBf16<0> E{(gb16*)qkv, B_INC, (gb16*)qkv, B_INC, 1 << 30}; run_gemm(F, Hb, WSP(bf16, WS_WBIN) + (size_t)j * B_INC * DM, B_INC, DM, DM, DM, 0, E); SEAM(pb + 0); }
            if (IN(pb + 1)) { ph_sb_attn(F, qkv, ob, (unsigned*)(F.ws + WS_CTL) + CW_SBQ + 512 * j); SEAM(pb + 1); }
            if (IN(pb + 2)) { pg8::EpiBf16<0> E{(gb16*)big, DM, (gb16*)big, DM, 1 << 30}; run_gemm(F, ob, WSP(bf16, WS_WBOUT) + (size_t)j * DM * DM, DM, DM, DM, DM, 0, E); if (INR(pb + 7)) GRID_BAR(); }
        }
        if (IN(pb + 7)) { ph_post(F, WSP(bf16, WS_BIG), (L == 0) ? (const void*)F.inp(IN_X) : (const void*)XB, L == 0, lastL ? (void*)XL : (void*)XB, false, modL + 2 * DM, ng + 1 * DM, Hb, ng + 2 * DM, modL + 3 * DM, modL + 4 * DM); SEAM(pb + 7); }
        if (IN(pb + 8)) { pg8::EpiBf16<1> E{(gb16*)WSP(bf16, WS_BIG), DFF, (gb16*)WSP(bf16, WS_BIG), DFF, 1 << 30}; run_gemm(F, Hb, WSP(bf16, WS_WM1) + (size_t)L * DFF * DM, DFF, DM, DM, DM, 0, E); SEAM(pb + 8); }
        if (IN(pb + 9)) { pg8::EpiBf16<0> E{(gb16*)WSP(bf16, WS_P), DM, (gb16*)WSP(bf16, WS_P), DM, 1 << 30}; run_gemm(F, WSP(bf16, WS_BIG), WSP(bf16, WS_WM2) + (size_t)L * DM * DFF, DM, DFF, DFF, DFF, 0, E); SEAM(pb + 9); }
        if (IN(pb + 10)) {
            const float* modN = mod + (size_t)(L + 1) * BATCH * MODW; const float* ngN = normg + (size_t)(L + 1) * 4 * DM;
            ph_post(F, WSP(bf16, WS_P), lastL ? (const void*)XL : (const void*)XB, false, lastL ? (void*)F.out : (void*)XB, lastL, modL + 5 * DM, ng + 3 * DM, lastL ? nullptr : Hb, ngN, modN + 0 * DM, modN + 1 * DM);
            if (!lastL && INR(pb + PH_PER_LAYER)) GRID_BAR();
        }
    }
#undef IN
#undef INR
#undef GRID_BAR
#undef SEAM
}

extern "C" void kernel_launch(void* const* d_in, const int* in_sizes, int n_in, void* d_out, int out_size, void* d_ws, size_t ws_size, hipStream_t stream) {
    static int grid = 0;
    if (grid == 0) {
        if (n_in != N_IN || out_size != T * DM || ws_size < WS_END) { fprintf(stderr, "kernel_launch: unexpected problem: n_in %d out %d ws %zu (need %zu); nothing launched\n", n_in, out_size, ws_size, (size_t)WS_END); grid = -1; return; }
        int dev = 0, cus = 0, per_cu = 0;
        if (hipGetDevice(&dev) != hipSuccess || hipDeviceGetAttribute(&cus, hipDeviceAttributeMultiprocessorCount, dev) != hipSuccess) { grid = -1; return; }
        if (hipFuncSetAttribute((const void*)fwd_kernel, hipFuncAttributeMaxDynamicSharedMemorySize, LDS_BYTES) != hipSuccess) { fprintf(stderr, "kernel_launch: hipFuncSetAttribute(%d B LDS) failed\n", LDS_BYTES); grid = -1; return; }
        if (hipOccupancyMaxActiveBlocksPerMultiprocessor(&per_cu, (const void*)fwd_kernel, NWAVES * 64, LDS_BYTES) != hipSuccess || per_cu < 1) { fprintf(stderr, "kernel_launch: occupancy query says %d workgroups per CU; nothing launched\n", per_cu); (void)hipGetLastError(); grid = -1; return; }
        grid = cus * (per_cu < 1 ? per_cu : 1);
    }
    if (grid < 0) return;
    (void)hipMemsetAsync((char*)d_ws + WS_CTL, 0, CTL_ZERO_BYTES, stream);
    Args a{};
    for (int i = 0; i < N_IN; ++i) a.in[i] = (const float*)d_in[i];
    a.out = (float*)d_out; a.ws = (unsigned char*)d_ws;
#if ONE_LAUNCH
    a.ph_lo = 0; a.ph_hi = PH_END;
    hipLaunchKernelGGL(fwd_kernel, dim3(grid), dim3(NWAVES * 64), LDS_BYTES, stream, a);
#else
    for (int p = 0; p < PH_END; ++p) {
        if (p >= PH_LAYER0) { const int L = (p - PH_LAYER0) / PH_PER_LAYER, r = (p - PH_LAYER0) % PH_PER_LAYER;
            if (r > 10) continue; if ((L & 1) && r >= 3 && r <= 6) continue; }
        a.ph_lo = p; a.ph_hi = p + 1;
        hipLaunchKernelGGL(fwd_kernel, dim3(grid), dim3(NWAVES * 64), LDS_BYTES, stream, a);
    }
#endif
}
```

```cpp
#include <hip/hip_runtime.h>
#include <cstdio>
#include <cstdint>
#ifndef ONE_LAUNCH
#define ONE_LAUNCH 1
#endif
namespace pg8 {
#define PG8_LAS __attribute__((address_space(3)))
typedef unsigned short bf16_t;
typedef short bf16x8 __attribute__((ext_vector_type(8)));
typedef float f32x4 __attribute__((ext_vector_type(4)));
typedef unsigned u32x4 __attribute__((ext_vector_type(4)));
constexpr int BM = 256, BK = 64, HALF = 128, HTB = HALF * BK * 2  , STAGE_BYTES = 8 * HTB, NXCD = 8, WGM = 4;

__host__ __device__ __forceinline__ int lds_byte(int r, int c) { return r * 128 + 16 * ((c >> 3) ^ ((r >> 1) & 7)) + (c & 7) * 2; }
__host__ __device__ __forceinline__ void stage_rc(int b, int& R, int& C) { R = b >> 7; C = (((b >> 4) & 7) ^ ((R >> 1) & 7)) * 8; }
__host__ __device__ __forceinline__ int perm32(int rho) { const int n = rho >> 4, i = rho & 15; return 8 * (i >> 2) + 4 * n + (i & 3); }

struct Unit { int pm, pn; };
struct Gemm { const bf16_t* A; const bf16_t* Bt; int M, N, K, lda, ldb, acs; };

struct StaticOrder {
    int nM, nN, nwg, G, c;
    __host__ __device__ void init(int M, int N, int G_, int c_) { nM = M / BM; nN = N / BM; nwg = nM * nN; G = G_; c = c_; }
    __host__ __device__ bool next(int i, Unit& u) const {
        const long L = (long)i * G + c; if (L >= nwg) return false;
        int wgid = (int)L; { const int q = nwg / NXCD, r = nwg % NXCD, xcd = wgid % NXCD, off = wgid / NXCD; wgid = (xcd < r ? xcd * (q + 1) : r * (q + 1) + (xcd - r) * q) + off; }
        const int nig = WGM * nN, gid = wgid / nig, fm = gid * WGM, gsz = (nM - fm) < WGM ? (nM - fm) : WGM;
        u.pm = fm + ((wgid % nig) % gsz); u.pn = (wgid % nig) / gsz; return true;
    }
    __device__ __forceinline__ void a_ready(const Unit&) const {}
    __device__ __forceinline__ void done(const Unit&) const {}
};


__device__ __forceinline__ float relu_f(float x) { float r; asm("v_max_f32 %0, 0, %1" : "=v"(r) : "v"(x)); return r; }
__device__ __forceinline__ unsigned cvt_pk_bf16(float lo, float hi) { unsigned r; asm("v_cvt_pk_bf16_f32 %0, %1, %2" : "=v"(r) : "v"(lo), "v"(hi)); return r; }
struct EpiF32 {
    static constexpr bool PERM = false, AFTER_DRAIN = false;
    float* C; int ldc;
    __device__ __forceinline__ void operator()(const f32x4 (&acc)[2][2][4][2], const Unit& u, int wr, int wc, int fr, int fq, PG8_LAS unsigned char* lds) const {
        PG8_LAS unsigned char* scr = lds + STAGE_BYTES + (wr * 4 + wc) * 2048;
        const int lane = fq * 16 + fr, rrow = lane >> 3, rch = lane & 7;
        PG8_LAS unsigned char* wp = scr + fr * 128 + 16 * (fq ^ (fr >> 1));
        const int wsw = ((fr >> 1) & 4) ? -64 : 64;
        const PG8_LAS unsigned char* rp = scr + rrow * 128 + 16 * (rch ^ ((rrow >> 1) & 7));
        const int rsw = (rch & 4) ? -64 : 64;
        float* gp = C + (size_t)(u.pm * BM + wr * 64 + rrow) * ldc + u.pn * BM + wc * 32 + 4 * rch;
#pragma unroll
        for (int ai = 0; ai < 2; ++ai)
#pragma unroll
            for (int m = 0; m < 4; ++m)
#pragma unroll
                for (int bj = 0; bj < 2; ++bj) {
#pragma unroll
                    for (int n = 0; n < 2; ++n) *(PG8_LAS f32x4*)(wp + (n ? wsw : 0)) = acc[ai][bj][m][n];
#pragma unroll
                    for (int s = 0; s < 2; ++s) { const f32x4 w = *(const PG8_LAS f32x4*)(rp + s * 1024 + (s ? rsw : 0));
                        *(f32x4*)(gp + (size_t)(ai * HALF + m * 16 + s * 8) * ldc + bj * HALF) = w; } }
    }
};
template <int ACT> struct EpiBf16 {
    static constexpr bool PERM = true, AFTER_DRAIN = false;
    bf16_t* O0; int ld0; bf16_t* O1; int ld1; int split_col;
    __device__ __forceinline__ void operator()(const f32x4 (&acc)[2][2][4][2], const Unit& u, int wr, int wc, int fr, int fq, PG8_LAS unsigned char* lds) const {
        int colt = u.pn * BM; bf16_t* base = O0; int ldc = ld0;
        if (colt >= split_col) { base = O1; ldc = ld1; colt -= split_col; }
        PG8_LAS unsigned char* scr = lds + STAGE_BYTES + (wr * 4 + wc) * 2048;
        const int lane = fq * 16 + fr, rrow = lane >> 3, rch = lane & 7;
        PG8_LAS unsigned char* wp = scr + fr * 128 + 16 * (fq ^ (fr >> 1));
        const int wsw = ((fr >> 1) & 4) ? -64 : 64;
        const PG8_LAS unsigned char* rp = scr + rrow * 128 + 16 * (rch ^ ((rrow >> 1) & 7));
        const int rsw = (rch & 4) ? -64 : 64;
        bf16_t* gp = base + (size_t)(u.pm * BM + wr * 64 + rrow) * ldc + colt + wc * 64 + 8 * rch;
        u32x4 rd[2];
#pragma unroll
        for (int it = 0; it < 8; ++it) { const int ai = it >> 2, m = it & 3;
#pragma unroll
            for (int bj = 0; bj < 2; ++bj) { f32x4 v0 = acc[ai][bj][m][0], v1 = acc[ai][bj][m][1];
                if (ACT == 1) {
#pragma unroll
                    for (int j = 0; j < 4; ++j) { const float a = relu_f(v0[j]), b = relu_f(v1[j]); v0[j] = a * a; v1[j] = b * b; } }
                u32x4 w; w.x = cvt_pk_bf16(v0[0], v0[1]); w.y = cvt_pk_bf16(v0[2], v0[3]); w.z = cvt_pk_bf16(v1[0], v1[1]); w.w = cvt_pk_bf16(v1[2], v1[3]);
                *(PG8_LAS u32x4*)(wp + (bj ? wsw : 0)) = w; }
            if (it > 0) { const int pa = (it - 1) >> 2, pm_ = (it - 1) & 3;
#pragma unroll
                for (int s = 0; s < 2; ++s) *(u32x4*)(gp + (size_t)(pa * HALF + pm_ * 16 + s * 8) * ldc) = rd[s]; }
#pragma unroll
            for (int s = 0; s < 2; ++s) rd[s] = *(const PG8_LAS u32x4*)(rp + s * 1024 + (s ? rsw : 0)); }
#pragma unroll
        for (int s = 0; s < 2; ++s) *(u32x4*)(gp + (size_t)(HALF + 3 * 16 + s * 8) * ldc) = rd[s];
    }
};

template <class Epi, class Sched, bool ALIGN_EPI = false, bool SP2 = false>
__device__ __forceinline__ void gemm_phase(PG8_LAS unsigned char* lds, const Gemm g, const Sched& S, const Epi& E, int tid_in) {
    int tid_l = tid_in; asm volatile("" : "+v"(tid_l));
    const int tid = tid_l, wid = __builtin_amdgcn_readfirstlane(tid >> 6), lane = tid & 63, wr = wid >> 2, wc = wid & 3, fr = lane & 15, fq = lane >> 4;
    const int K = g.K, nt = K / BK;
    unsigned voffA[2], voffB[2];
#pragma unroll
    for (int i = 0; i < 2; ++i) { int R, C; stage_rc(tid * 16 + i * 8192, R, C); const int Rb = Epi::PERM ? ((R >> 5) * 64 + perm32(R & 31)) : R;
        voffA[i] = (unsigned)(R * g.lda + C) * 2u; voffB[i] = (unsigned)(Rb * g.ldb + C) * 2u; }
    const size_t kstep = (size_t)(BK * 2);
    const size_t hstepA = (size_t)HALF * g.lda * 2, hstepB = (size_t)(Epi::PERM ? 32 : HALF) * g.ldb * 2;
    const size_t tstepA = 2 * hstepA, tstepB = (size_t)BM * g.ldb * 2, cstepA = (size_t)g.acs * 2;
    const unsigned ldsw = (unsigned)wid * 1024u;
    const int aoff = lds_byte(wr * 64 + fr, fq * 8), boff = lds_byte(wc * 32 + fr, fq * 8);
#define PG8_SA(b, h) (((b) * 2 + (h)) * HTB)
#define PG8_SB(b, h) ((4 + (b) * 2 + (h)) * HTB)
#define PG8_STAGE(bufoff, gbase, voff) do { _Pragma("unroll") for (int _i = 0; _i < 2; ++_i) \
        __builtin_amdgcn_global_load_lds((const unsigned*)((const char*)(gbase) + (voff)[_i]), (PG8_LAS unsigned*)(lds + (bufoff) + ldsw + _i * 8192), 16, 0, 0); } while (0)
#define PG8_LDA(dst, b, h) do { _Pragma("unroll") for (int m = 0; m < 4; ++m) _Pragma("unroll") for (int k = 0; k < 2; ++k) dst[m][k] = *(const PG8_LAS bf16x8*)(lds + PG8_SA(b, h) + (aoff ^ (k * 64)) + m * 2048); } while (0)
#define PG8_LDB(dst, b, h) do { _Pragma("unroll") for (int n = 0; n < 2; ++n) _Pragma("unroll") for (int k = 0; k < 2; ++k) dst[n][k] = *(const PG8_LAS bf16x8*)(lds + PG8_SB(b, h) + (boff ^ (k * 64)) + n * 2048); } while (0)
#define PG8_MMA(ai, bj, At, Bt) do { __builtin_amdgcn_s_setprio(1); _Pragma("unroll") for (int m = 0; m < 4; ++m) _Pragma("unroll") for (int n = 0; n < 2; ++n) _Pragma("unroll") for (int k = 0; k < 2; ++k) \
        acc[ai][bj][m][n] = __builtin_amdgcn_mfma_f32_16x16x32_bf16(Bt[n][k], At[m][k], acc[ai][bj][m][n], 0, 0, 0); __builtin_amdgcn_s_setprio(0); } while (0)
#define PG8_WAIT_V(n) asm volatile("s_waitcnt vmcnt(" #n ")" ::: "memory")
#define PG8_WAIT_L(n) asm volatile("s_waitcnt lgkmcnt(" #n ")" ::: "memory")
#define PG8_BAR __builtin_amdgcn_s_barrier()
#define PG8_SCHED __builtin_amdgcn_sched_barrier(0)
    Unit cur, nxt; int ui = 0;
    if (!S.next(0, cur)) return;
    f32x4 acc[2][2][4][2];
#pragma unroll
    for (int a = 0; a < 2; ++a)
#pragma unroll
        for (int b = 0; b < 2; ++b)
#pragma unroll
            for (int m = 0; m < 4; ++m)
#pragma unroll
                for (int n = 0; n < 2; ++n) acc[a][b][m][n] = (f32x4){0.f, 0.f, 0.f, 0.f};
    bf16x8 At[4][2], B0[2][2], B1[2][2];
    const char* cA = (const char*)g.A + (size_t)cur.pm * tstepA + (size_t)cur.pn * cstepA; const char* cB = (const char*)g.Bt + (size_t)cur.pn * tstepB;
    S.a_ready(cur);
    if constexpr (SP2) {
        PG8_STAGE(PG8_SB(0, 0), cB, voffB); PG8_STAGE(PG8_SB(0, 1), cB + hstepB, voffB); PG8_STAGE(PG8_SA(0, 0), cA, voffA); PG8_STAGE(PG8_SA(0, 1), cA + hstepA, voffA);
        if (wr == 1) PG8_BAR;
        PG8_WAIT_V(2); PG8_BAR;
        PG8_STAGE(PG8_SB(1, 0), cB + kstep, voffB); PG8_STAGE(PG8_SA(1, 0), cA + kstep, voffA); PG8_STAGE(PG8_SB(1, 1), cB + hstepB + kstep, voffB);
        PG8_WAIT_V(6); PG8_BAR;
    } else {
        PG8_STAGE(PG8_SB(0, 0), cB, voffB); PG8_STAGE(PG8_SA(0, 0), cA, voffA); PG8_STAGE(PG8_SB(0, 1), cB + hstepB, voffB); PG8_STAGE(PG8_SA(0, 1), cA + hstepA, voffA);
        if (wr == 1) PG8_BAR;
        PG8_WAIT_V(4); PG8_BAR;
        PG8_STAGE(PG8_SB(1, 0), cB + kstep, voffB); PG8_STAGE(PG8_SA(1, 0), cA + kstep, voffA); PG8_STAGE(PG8_SB(1, 1), cB + hstepB + kstep, voffB);
        PG8_WAIT_V(6); PG8_BAR;
    }
    for (;;) {
        const bool has_next = S.next(ui + 1, nxt);
        const char* nA = has_next ? (const char*)g.A + (size_t)nxt.pm * tstepA + (size_t)nxt.pn * cstepA : cA; const char* nB = has_next ? (const char*)g.Bt + (size_t)nxt.pn * tstepB : cB;
        for (int t = 0; t < nt; t += 2) {
            const bool last = (t == nt - 2);
            const char* a1 = cA + (size_t)(t + 1) * kstep;
            const char* a2 = last ? nA : cA + (size_t)(t + 2) * kstep; const char* b2 = last ? nB : cB + (size_t)(t + 2) * kstep;
            const char* a3 = a2 + kstep; const char* b3 = b2 + kstep;
            if (last && has_next) S.a_ready(nxt);
            if constexpr (SP2) {
            PG8_LDB(B0, 0, 0); PG8_LDB(B1, 0, 1); PG8_SCHED; PG8_LDA(At, 0, 0); PG8_STAGE(PG8_SA(1, 1), a1 + hstepA, voffA);
            PG8_WAIT_V(8); PG8_WAIT_L(0); PG8_BAR; PG8_MMA(0, 0, At, B0); PG8_MMA(0, 1, At, B1); PG8_BAR; PG8_SCHED;
            PG8_LDA(At, 0, 1); PG8_STAGE(PG8_SB(0, 0), b2, voffB); PG8_STAGE(PG8_SB(0, 1), b2 + hstepB, voffB); PG8_STAGE(PG8_SA(0, 0), a2, voffA);
            PG8_WAIT_V(8); PG8_WAIT_L(0); PG8_BAR; PG8_MMA(1, 0, At, B0); PG8_MMA(1, 1, At, B1); PG8_BAR; PG8_SCHED;
            PG8_LDB(B0, 1, 0); PG8_LDB(B1, 1, 1); PG8_SCHED; PG8_LDA(At, 1, 0); PG8_STAGE(PG8_SA(0, 1), a2 + hstepA, voffA);
            PG8_WAIT_V(8); PG8_WAIT_L(0); PG8_BAR; PG8_MMA(0, 0, At, B0); PG8_MMA(0, 1, At, B1); PG8_BAR; PG8_SCHED;
            PG8_LDA(At, 1, 1); PG8_STAGE(PG8_SB(1, 0), b3, voffB); PG8_STAGE(PG8_SB(1, 1), b3 + hstepB, voffB); PG8_STAGE(PG8_SA(1, 0), a3, voffA);
            PG8_WAIT_V(8); PG8_WAIT_L(0); PG8_BAR; PG8_MMA(1, 0, At, B0); PG8_MMA(1, 1, At, B1); PG8_BAR; PG8_SCHED;
            } else {
            PG8_LDB(B0, 0, 0); PG8_SCHED; PG8_LDA(At, 0, 0); PG8_STAGE(PG8_SA(1, 1), a1 + hstepA, voffA);
            PG8_WAIT_L(8); PG8_BAR; PG8_WAIT_L(0); PG8_MMA(0, 0, At, B0); PG8_BAR; PG8_SCHED;
            PG8_LDB(B1, 0, 1); PG8_STAGE(PG8_SB(0, 0), b2, voffB);
            PG8_BAR; PG8_WAIT_L(0); PG8_MMA(0, 1, At, B1); PG8_BAR;
            PG8_LDA(At, 0, 1); PG8_STAGE(PG8_SA(0, 0), a2, voffA);
            PG8_BAR; PG8_WAIT_L(0); PG8_MMA(1, 0, At, B0); PG8_BAR; PG8_SCHED;
            PG8_STAGE(PG8_SB(0, 1), b2 + hstepB, voffB);
            PG8_WAIT_V(6); PG8_BAR; PG8_MMA(1, 1, At, B1); PG8_BAR;
            PG8_LDB(B0, 1, 0); PG8_SCHED; PG8_LDA(At, 1, 0); PG8_STAGE(PG8_SA(0, 1), a2 + hstepA, voffA);
            PG8_WAIT_L(8); PG8_BAR; PG8_WAIT_L(0); PG8_MMA(0, 0, At, B0); PG8_BAR; PG8_SCHED;
            PG8_LDB(B1, 1, 1); PG8_STAGE(PG8_SB(1, 0), b3, voffB);
            PG8_BAR; PG8_WAIT_L(0); PG8_MMA(0, 1, At, B1); PG8_BAR;
            PG8_LDA(At, 1, 1); PG8_STAGE(PG8_SA(1, 0), a3, voffA);
            PG8_BAR; PG8_WAIT_L(0); PG8_MMA(1, 0, At, B0); PG8_BAR; PG8_SCHED;
            PG8_STAGE(PG8_SB(1, 1), b3 + hstepB, voffB);
            PG8_WAIT_V(6); PG8_BAR; PG8_MMA(1, 1, At, B1); PG8_BAR;
            }
        }
        if constexpr (ALIGN_EPI) { if (wr == 0) PG8_BAR; }
        if constexpr (!Epi::AFTER_DRAIN) { E(acc, cur, wr, wc, fr, fq, lds); S.done(cur); }
        if (!has_next) break;
#pragma unroll
        for (int a = 0; a < 2; ++a)
#pragma unroll
            for (int b = 0; b < 2; ++b)
#pragma unroll
                for (int m = 0; m < 4; ++m)
#pragma unroll
                    for (int n = 0; n < 2; ++n) acc[a][b][m][n] = (f32x4){0.f, 0.f, 0.f, 0.f};
        cur = nxt; cA = nA; cB = nB; ++ui;
        if constexpr (ALIGN_EPI) { if (wr == 1) PG8_BAR; }
    }
    PG8_WAIT_V(0);
    if constexpr (!ALIGN_EPI) { if (wr == 0) PG8_BAR; }
    PG8_BAR;
    if constexpr (Epi::AFTER_DRAIN) { E.fused(acc, cur, wr, wc, fr, fq, lds, wid, lane); S.done(cur); }
#undef PG8_SA
#undef PG8_SB
#undef PG8_STAGE
#undef PG8_LDA
#undef PG8_LDB
#undef PG8_MMA
#undef PG8_WAIT_V
#undef PG8_WAIT_L
#undef PG8_BAR
#undef PG8_SCHED
}
}

constexpr int NWAVES = 8;
constexpr int BATCH = 8, SEQ = 4096, DM = 2048, DEPTH = 4, DFF = 8192, T = BATCH * SEQ;
constexpr int A_HEADS = 32, A_QR = 512, A_KVR = 256, IDX_H = 16, IDX_D = 128, TOPK = 256, A_IN = 912, A_INP = 1024;
constexpr int B_HEADS = 16, B_HD = 128, B_INC = 3 * DM;
constexpr int MODW = 6 * DM;
constexpr float RMS_EPS = 1e-6f;
enum { IN_X = 0, IN_C, IN_RELB, IN_ADAW, IN_ADAB, IN_NORMG, IN_AWIN, IN_AQN, IN_AKVN, IN_AIKN, IN_AWQB, IN_AWIQB, IN_AWUK, IN_AWUV, IN_AWOUT, IN_BWIN, IN_BWOUT, IN_W1, IN_W2, N_IN };

constexpr size_t MiB = 1u << 20;
constexpr size_t WS_CTL = 0, CTL_ZERO_BYTES = 1 * MiB;
constexpr size_t WS_MOD = 1 * MiB;
constexpr size_t WS_MODP = 3 * MiB;
constexpr size_t WS_WAIN = 16 * MiB;
constexpr size_t WS_WQC = 24 * MiB;
constexpr size_t WS_WUV = 44 * MiB;
constexpr size_t WS_WAOUT = 52 * MiB;
constexpr size_t WS_WBIN = 84 * MiB;
constexpr size_t WS_WBOUT = 132 * MiB;
constexpr size_t WS_WM1 = 148 * MiB;
constexpr size_t WS_WM2 = 276 * MiB;
constexpr size_t WS_H = 404 * MiB;
constexpr size_t WS_P = 532 * MiB;
constexpr size_t WS_BIG = 788 * MiB;
constexpr size_t WS_QLAT = 1300 * MiB;
constexpr size_t WS_CKV = 1332 * MiB;
constexpr size_t WS_KIDX = 1348 * MiB;
constexpr size_t WS_WIDX = 1356 * MiB;
constexpr size_t WS_IDX = 1358 * MiB;
constexpr size_t WS_END = 1390 * MiB;
constexpr int CW_BAR = 4096;
constexpr int CW_SBQ = 8192;

constexpr int LDS_BYTES = 163840;
constexpr int MISC_OFF = LDS_BYTES - 256;

#define GAS __attribute__((address_space(1)))
#define LAS __attribute__((address_space(3)))
typedef unsigned short bf16;
typedef unsigned v4u __attribute__((ext_vector_type(4)));
typedef unsigned v2u __attribute__((ext_vector_type(2)));
typedef float f32x4 __attribute__((ext_vector_type(4)));
typedef float f32x2 __attribute__((ext_vector_type(2)));
typedef __bf16 bf16x2_t __attribute__((ext_vector_type(2)));
#define LDS_WAIT() asm volatile("s_waitcnt lgkmcnt(0)" ::: "memory")
#define VM_WAIT() asm volatile("s_waitcnt vmcnt(0)" ::: "memory")
__device__ __forceinline__ unsigned f2bf(float f) { unsigned u = __builtin_bit_cast(unsigned, f); return (u + 0x7fffu + ((u >> 16) & 1u)) >> 16; }
__device__ __forceinline__ unsigned pk2(float lo, float hi) { return f2bf(lo) | (f2bf(hi) << 16); }
__device__ __forceinline__ float bflo(unsigned u) { return __builtin_bit_cast(float, u << 16); }
__device__ __forceinline__ float bfhi(unsigned u) { return __builtin_bit_cast(float, u & 0xffff0000u); }
__device__ __forceinline__ float dot2bf(unsigned a, unsigned b, float c) { return __builtin_amdgcn_fdot2_f32_bf16(__builtin_bit_cast(bf16x2_t, a), __builtin_bit_cast(bf16x2_t, b), c, false); }
#define DPP_F(v, ctrl) __builtin_bit_cast(float, __builtin_amdgcn_update_dpp(0, __builtin_bit_cast(int, (v)), (ctrl), 0xf, 0xf, true))
#define RDL_F(v, l) __builtin_bit_cast(float, __builtin_amdgcn_readlane(__builtin_bit_cast(int, (v)), (l)))
__device__ __forceinline__ float wave_sum(float v, int) {
    v += DPP_F(v, 0xB1); v += DPP_F(v, 0x4E); v += DPP_F(v, 0x124); v += DPP_F(v, 0x128);
    return (RDL_F(v, 0) + RDL_F(v, 16)) + (RDL_F(v, 32) + RDL_F(v, 48));
}
__device__ __forceinline__ float wave_max(float v, int) {
    v = fmaxf(v, DPP_F(v, 0xB1)); v = fmaxf(v, DPP_F(v, 0x4E)); v = fmaxf(v, DPP_F(v, 0x124)); v = fmaxf(v, DPP_F(v, 0x128));
    return fmaxf(fmaxf(RDL_F(v, 0), RDL_F(v, 16)), fmaxf(RDL_F(v, 32), RDL_F(v, 48)));
}
__device__ __forceinline__ float shx(float v, int, int lane) {
    const unsigned u = __builtin_bit_cast(unsigned, v);
    auto r = __builtin_amdgcn_permlane32_swap(u, u, false, false);
    return __builtin_bit_cast(float, (lane & 32) ? r[0] : r[1]);
}

#define XB_TMO      128
#define XB_XCNT(j)  (256  + 64 * (j))
#define XB_XSUB(j)  (1280 + 64 * (j))
#define XB_XGEN(j)  (2304 + 64 * (j))
#define XB_TOP      3328
#define XB_TOPGEN   3392
#define XCD_BAR_WORDS 3456
#define XB_SPIN_CAP (1u << 22)

__device__ __forceinline__ unsigned xb_ld(unsigned* p)              { return __hip_atomic_load(p, __ATOMIC_RELAXED, __HIP_MEMORY_SCOPE_AGENT); }
__device__ __forceinline__ unsigned xb_add(unsigned* p, unsigned v) { return __hip_atomic_fetch_add(p, v, __ATOMIC_RELAXED, __HIP_MEMORY_SCOPE_AGENT); }
__device__ __forceinline__ unsigned xb_xcc_id() { return (unsigned)__builtin_amdgcn_s_getreg((3 << 11) | 20) & 0xFu; }
#define XB_SPIN(cond, bar) do { unsigned _sp = 0; while (cond) { __builtin_amdgcn_s_sleep(1); \
    if ((++_sp & 255u) == 0u) { if (xb_ld(&(bar)[XB_TMO])) break; if (_sp > XB_SPIN_CAP) { atomicAdd(&(bar)[XB_TMO], 1u); break; } } } } while (0)

struct XcdBarrier {
    unsigned* bar; unsigned x;
    volatile LAS unsigned* st;
};

__device__ __forceinline__ XcdBarrier xcd_barrier_post(unsigned* bar, volatile LAS unsigned* st) {
    XcdBarrier b; b.bar = bar; b.x = xb_xcc_id(); b.st = st;
    if (threadIdx.x == 0) (void)xb_add(&bar[XB_XCNT(b.x)], 1u);
    return b;
}
__device__ __forceinline__ void xcd_barrier_complete(unsigned* bar, unsigned x, unsigned& nloc, unsigned& nx) {
    const unsigned G = gridDim.x * gridDim.y * gridDim.z;
    unsigned sum, cnt, mine, sp = 0u;
    for (;;) {
        sum = 0u; cnt = 0u; mine = 0u;
#pragma unroll
        for (unsigned j = 0; j < 16; ++j) { const unsigned c = xb_ld(&bar[XB_XCNT(j)]); sum += c; cnt += (c > 0u) ? 1u : 0u; mine = (j == x) ? c : mine; }
        if (sum == G) break;
        __builtin_amdgcn_s_sleep(1);
        if ((++sp & 255u) == 0u) { if (xb_ld(&bar[XB_TMO])) break; if (sp > XB_SPIN_CAP) { atomicAdd(&bar[XB_TMO], 1u); break; } }
    }
    nloc = mine > 0u ? mine : 1u; nx = cnt > 0u ? cnt : 1u;
}

template <bool CENSUS> __device__ __forceinline__ void xcd_barrier(const XcdBarrier& b) {
    asm volatile("s_waitcnt vmcnt(0)" ::: "memory");
    __syncthreads();
    if (threadIdx.x == 0) {
        unsigned* bar = b.bar;
        __builtin_amdgcn_s_waitcnt(0);
        unsigned nloc = b.st[0], nx = b.st[1];
        if (CENSUS) { if (nloc == 0u) { xcd_barrier_complete(bar, b.x, nloc, nx); b.st[0] = nloc; b.st[1] = nx; } }
        const unsigned old = xb_add(&bar[XB_XSUB(b.x)], 1u);
        const unsigned gen = old / nloc;
        if (old + 1u == (gen + 1u) * nloc) {
            __builtin_amdgcn_fence(__ATOMIC_RELEASE, "agent");
            asm volatile("s_waitcnt vmcnt(0)" ::: "memory");
            const unsigned og = xb_add(&bar[XB_TOP], 1u);
            const unsigned tg = og / nx;
            if (og + 1u == (tg + 1u) * nx) xb_add(&bar[XB_TOPGEN], 1u);
            else XB_SPIN(xb_ld(&bar[XB_TOPGEN]) == tg, bar);
            __builtin_amdgcn_fence(__ATOMIC_ACQUIRE, "agent");
            xb_add(&bar[XB_XGEN(b.x)], 1u);
            asm volatile("s_waitcnt vmcnt(0)" ::: "memory");
        } else {
            XB_SPIN(xb_ld(&bar[XB_XGEN(b.x)]) == gen, bar);
            __builtin_amdgcn_fence(__ATOMIC_ACQUIRE, "agent");
            asm volatile("s_waitcnt vmcnt(0)" ::: "memory");
        }
    }
    __syncthreads();
}

struct Args { const float* in[N_IN]; float* out; unsigned char* ws; int ph_lo, ph_hi; };
#define CAS __attribute__((address_space(4)))
struct Frame {
    LAS unsigned char* lds;
    int tid, lane, wave, G;
    const CAS Args* ap;
    float* out; unsigned char* ws;
    __device__ __forceinline__ const float* inp(int i) const { return ap->in[i]; }
};
#define WSP(type, off) ((type*)(F.ws + (off)))

__device__ __forceinline__ void p0_transpose_item(const float* W, int Nsrc, bf16* dst, int ldo, LAS float* scr, int kb, int nb, int lane) {
    const int k0 = 64 * kb, n0 = 32 * nb, rsub = lane >> 3, c4 = lane & 7, nn = n0 + 4 * c4;
    f32x4 v[8];
#pragma unroll
    for (int i = 0; i < 8; ++i) v[i] = (nn < Nsrc) ? *(const f32x4*)(W + (size_t)(k0 + 8 * i + rsub) * Nsrc + nn) : (f32x4){0.f, 0.f, 0.f, 0.f};
#pragma unroll
    for (int i = 0; i < 8; ++i) { LAS float* d = scr + (8 * i + rsub) * 33 + 4 * c4; d[0] = v[i].x; d[1] = v[i].y; d[2] = v[i].z; d[3] = v[i].w; }
    LDS_WAIT(); asm volatile("" ::: "memory");
    const int c = lane & 7;
#pragma unroll
    for (int j = 0; j < 4; ++j) { const int n = (lane >> 3) + 8 * j; const LAS float* s = scr + (8 * c) * 33 + n;
        v4u o; o.x = pk2(s[0 * 33], s[1 * 33]); o.y = pk2(s[2 * 33], s[3 * 33]); o.z = pk2(s[4 * 33], s[5 * 33]); o.w = pk2(s[6 * 33], s[7 * 33]);
        *(v4u*)(dst + (size_t)(n0 + n) * ldo + k0 + 8 * c) = o; }
    LDS_WAIT(); asm volatile("" ::: "memory");
}
__device__ __forceinline__ void p0_tr_load(f32x4 (&v)[8], const float* W, int Nsrc, int kb, int nb, int lane) {
    const int k0 = 64 * kb, rsub = lane >> 3, nn = 32 * nb + 4 * (lane & 7);
#pragma unroll
    for (int i = 0; i < 8; ++i) v[i] = (nn < Nsrc) ? *(const f32x4*)(W + (size_t)(k0 + 8 * i + rsub) * Nsrc + nn) : (f32x4){0.f, 0.f, 0.f, 0.f};
}
__device__ __forceinline__ void p0_tr_store(const f32x4 (&v)[8], bf16* dst, int ldo, LAS float* scr, int kb, int nb, int lane) {
    const int k0 = 64 * kb, n0 = 32 * nb, rsub = lane >> 3, c4 = lane & 7;
#pragma unroll
    for (int i = 0; i < 8; ++i) { LAS float* d = scr + (8 * i + rsub) * 33 + 4 * c4; d[0] = v[i].x; d[1] = v[i].y; d[2] = v[i].z; d[3] = v[i].w; }
    LDS_WAIT(); asm volatile("" ::: "memory");
    const int c = lane & 7;
#pragma unroll
    for (int j = 0; j < 4; ++j) { const int n = (lane >> 3) + 8 * j; const LAS float* s = scr + (8 * c) * 33 + n;
        v4u o; o.x = pk2(s[0 * 33], s[1 * 33]); o.y = pk2(s[2 * 33], s[3 * 33]); o.z = pk2(s[4 * 33], s[5 * 33]); o.w = pk2(s[6 * 33], s[7 * 33]);
        *(v4u*)(dst + (size_t)(n0 + n) * ldo + k0 + 8 * c) = o; }
    LDS_WAIT(); asm volatile("" ::: "memory");
}
__device__ __forceinline__ void p0_transpose_job(Frame& F, const float* src, size_t sstride, int nmat, int K, int Nsrc, int Npad, bf16* dst, size_t dstride, int ldo) {
    LAS float* scr = (LAS float*)(F.lds + F.wave * 16384);
    const int gw = blockIdx.x * NWAVES + F.wave, NGW = F.G * NWAVES;
    const int nkb = K / 64, nnb = Npad / 32, per = nkb * nnb, tot = nmat * per;
    int it = gw;
    f32x4 v[8], vn[8];
    if (it < tot) { const int m = it / per, r = it % per; p0_tr_load(v, src + (size_t)m * sstride, Nsrc, r / nnb, r % nnb, F.lane); }
    while (it < tot) {
        const int nx = it + NGW;
        if (nx < tot) { const int m = nx / per, r = nx % per; p0_tr_load(vn, src + (size_t)m * sstride, Nsrc, r / nnb, r % nnb, F.lane); }
        { const int m = it / per, r = it % per; p0_tr_store(v, dst + (size_t)m * dstride, ldo, scr, r / nnb, r % nnb, F.lane); }
#pragma unroll
        for (int i = 0; i < 8; ++i) v[i] = vn[i];
        it = nx;
    }
}
__device__ __forceinline__ void ph_prologue(Frame& F) {
    {
        LAS float* sl = (LAS float*)(F.lds);
        LAS float* red = (LAS float*)(F.lds + 8192);
        const float* cin = F.inp(IN_C); const float* ada_w = F.inp(IN_ADAW); float* modp = WSP(float, WS_MODP);
        for (int u = blockIdx.x; u < 768; u += F.G) {
            const int l = u / 192, r = u % 192, ec = r >> 3, dc = r & 7;
            __syncthreads();
            for (int i = F.tid; i < 2048; i += 512) { const int rr = i >> 3, b = i & 7; const float v = cin[b * DM + dc * 256 + rr]; sl[rr * 8 + b] = v / (1.f + __expf(-v)); }
            __syncthreads();
            const int cq = F.tid & 127, dq = F.tid >> 7;
            f32x4 acc[8];
#pragma unroll
            for (int b = 0; b < 8; ++b) acc[b] = (f32x4){0.f, 0.f, 0.f, 0.f};
            const float* wp = ada_w + ((size_t)l * DM + dc * 256 + dq * 64) * MODW + ec * 512 + cq * 4;
#pragma unroll 8
            for (int i = 0; i < 64; ++i) {
                const f32x4 w = *(const f32x4*)(wp + (size_t)i * MODW);
                const f32x4 s0 = *(const LAS f32x4*)(sl + (dq * 64 + i) * 8), s1 = *(const LAS f32x4*)(sl + (dq * 64 + i) * 8 + 4);
                acc[0] += w * s0.x; acc[1] += w * s0.y; acc[2] += w * s0.z; acc[3] += w * s0.w;
                acc[4] += w * s1.x; acc[5] += w * s1.y; acc[6] += w * s1.z; acc[7] += w * s1.w;
            }
#pragma unroll
            for (int b = 0; b < 8; ++b) *(LAS f32x4*)(red + (dq * 8 + b) * 512 + cq * 4) = acc[b];
            __syncthreads();
            { const int b = F.tid >> 6, c0 = (F.tid & 63) * 8;
#pragma unroll
              for (int k = 0; k < 2; ++k) {
                  const f32x4 s = (*(const LAS f32x4*)(red + (0 * 8 + b) * 512 + c0 + 4 * k) + *(const LAS f32x4*)(red + (1 * 8 + b) * 512 + c0 + 4 * k))
                                + (*(const LAS f32x4*)(red + (2 * 8 + b) * 512 + c0 + 4 * k) + *(const LAS f32x4*)(red + (3 * 8 + b) * 512 + c0 + 4 * k));
                  *(f32x4*)(modp + (((size_t)dc * 4 + l) * 8 + b) * MODW + ec * 512 + c0 + 4 * k) = s; } }
        }
        __syncthreads();
    }
    {
        LAS float* Bs = (LAS float*)(F.lds);
        LAS float* As = (LAS float*)(F.lds + 256 * 132 * 4);
        const float* wqb = F.inp(IN_AWQB); const float* wuk = F.inp(IN_AWUK); bf16* wqc = WSP(bf16, WS_WQC);
        for (int u = blockIdx.x; u < 1024; u += F.G) {
            const int j = u >> 9, h = (u & 511) >> 4, rb = u & 15, r0 = rb * 32;
            __syncthreads();
            const float* bsrc = wuk + ((size_t)j * A_HEADS + h) * 256 * 128;
            for (int i = F.tid; i < 256 * 32; i += 512) { const int row = i >> 5, c4 = i & 31; *(LAS f32x4*)(Bs + row * 132 + c4 * 4) = *(const f32x4*)(bsrc + row * 128 + c4 * 4); }
            for (int i = F.tid; i < 32 * 32; i += 512) { const int row = i >> 5, c4 = i & 31; *(LAS f32x4*)(As + row * 128 + c4 * 4) = *(const f32x4*)(wqb + ((size_t)j * A_QR + r0 + row) * 4096 + h * 128 + c4 * 4); }
            __syncthreads();
            const int c = F.tid & 255, rh = F.tid >> 8;
            float acc[16];
#pragma unroll
            for (int q = 0; q < 16; ++q) acc[q] = 0.f;
            for (int d4 = 0; d4 < 32; ++d4) {
                const f32x4 bv = *(const LAS f32x4*)(Bs + c * 132 + d4 * 4);
#pragma unroll
                for (int q = 0; q < 16; ++q) { const f32x4 av = *(const LAS f32x4*)(As + (rh * 16 + q) * 128 + d4 * 4); acc[q] += (av.x * bv.x + av.y * bv.y) + (av.z * bv.z + av.w * bv.w); }
            }
            bf16* orow = wqc + ((size_t)j * 10240 + h * 256 + c) * 512 + r0 + rh * 16;
            v4u o0, o1;
            o0.x = pk2(acc[0], acc[1]); o0.y = pk2(acc[2], acc[3]); o0.z = pk2(acc[4], acc[5]); o0.w = pk2(acc[6], acc[7]);
            o1.x = pk2(acc[8], acc[9]); o1.y = pk2(acc[10], acc[11]); o1.z = pk2(acc[12], acc[13]); o1.w = pk2(acc[14], acc[15]);
            *(v4u*)(orow) = o0; *(v4u*)(orow + 8) = o1;
        }
        __syncthreads();
    }
    p0_transpose_job(F, F.inp(IN_AWIN), (size_t)DM * A_IN, 2, DM, A_IN, A_INP, WSP(bf16, WS_WAIN), (size_t)A_INP * DM, DM);
    p0_transpose_job(F, F.inp(IN_AWIQB), (size_t)A_QR * 2048, 2, A_QR, 2048, 2048, WSP(bf16, WS_WQC) + (size_t)8192 * 512, (size_t)10240 * 512, 512);
    p0_transpose_job(F, F.inp(IN_AWOUT), (size_t)4096 * DM, 2, 4096, DM, DM, WSP(bf16, WS_WAOUT), (size_t)DM * 4096, 4096);
    p0_transpose_job(F, F.inp(IN_BWIN), (size_t)DM * B_INC, 2, DM, B_INC, B_INC, WSP(bf16, WS_WBIN), (size_t)B_INC * DM, DM);
    p0_transpose_job(F, F.inp(IN_BWOUT), (size_t)DM * DM, 2, DM, DM, DM, WSP(bf16, WS_WBOUT), (size_t)DM * DM, DM);
    p0_transpose_job(F, F.inp(IN_W1), (size_t)DM * DFF, 4, DM, DFF, DFF, WSP(bf16, WS_WM1), (size_t)DFF * DM, DM);
    p0_transpose_job(F, F.inp(IN_W2), (size_t)DFF * DM, 4, DFF, DM, DM, WSP(bf16, WS_WM2), (size_t)DM * DFF, DFF);
    {
        LAS float* scr = (LAS float*)(F.lds + F.wave * 16384);
        const int gw = blockIdx.x * NWAVES + F.wave, NGW = F.G * NWAVES;
        const float* wuv = F.inp(IN_AWUV); bf16* d0 = WSP(bf16, WS_WUV);
        for (int it = gw; it < 64 * 16; it += NGW) {
            const int m = it >> 4, r = it & 15, j = m >> 5, h = m & 31;
            bf16* dst = d0 + (size_t)j * 4096 * 512 + (size_t)((h >> 1) * 256 + (h & 1) * 128) * 512 + (h & 1) * 256;
            p0_transpose_item(wuv + (size_t)m * 256 * 128, 128, dst, 512, scr, r >> 2, r & 3, F.lane);
        }
        const int gt = blockIdx.x * 512 + F.tid, NT = F.G * 512;
        for (int i = gt; i < 2 * 4096 * 32; i += NT) {
            const int row = i >> 5, ch = i & 31, hh = (row >> 7) & 1;
            *(v4u*)(d0 + (size_t)row * 512 + (1 - hh) * 256 + ch * 8) = (v4u){0u, 0u, 0u, 0u};
        }
    }
}
__device__ __forceinline__ void ph_modreduce(Frame& F) {
    const float* modp = WSP(float, WS_MODP); float* mod = WSP(float, WS_MOD); const float* ada_b = F.inp(IN_ADAB);
    const int gt = blockIdx.x * 512 + F.tid, NT = F.G * 512;
    for (int i = gt; i < DEPTH * BATCH * MODW / 4; i += NT) {
        const int e4 = i % (MODW / 4), lb = i / (MODW / 4), l = lb >> 3;
        f32x4 s = *(const f32x4*)(ada_b + (size_t)l * MODW + e4 * 4);
#pragma unroll
        for (int dc = 0; dc < 8; ++dc) s += *(const f32x4*)(modp + ((size_t)dc * 32 + lb) * MODW + e4 * 4);
        *(f32x4*)(mod + (size_t)lb * MODW + e4 * 4) = s;
    }
}

__device__ __forceinline__ void ph_post(Frame& F, const bf16* y, const void* xin_, bool xin_f32, void* xout_, bool xout_f32, const float* gate, const float* gy, bf16* hout, const float* gh, const float* shift, const float* scale) {
    LAS float* vec = (LAS float*)F.lds;
    const int rlo = (int)(((long long)blockIdx.x * T) / F.G), rhi = (int)(((long long)(blockIdx.x + 1) * T) / F.G);
    for (int seg = rlo; seg < rhi; ) {
        const int b = seg / SEQ; const int send = ((b + 1) * SEQ < rhi) ? (b + 1) * SEQ : rhi;
        __syncthreads();
        for (int i = F.tid; i < 5 * (DM / 4); i += NWAVES * 64) { const int v = i / (DM / 4), c4 = i % (DM / 4);
            const float* src = (v == 0) ? (y ? gate + (size_t)b * MODW : nullptr) : (v == 1) ? (y ? gy : nullptr) : (v == 2) ? (hout ? gh : nullptr) : (v == 3) ? (hout ? shift + (size_t)b * MODW : nullptr) : (hout ? scale + (size_t)b * MODW : nullptr);
            *(LAS f32x4*)(vec + v * DM + 4 * c4) = src ? *(const f32x4*)(src + 4 * c4) : (f32x4){0.f, 0.f, 0.f, 0.f}; }
        __syncthreads();
        constexpr int NR = 2;
        for (int r0 = seg + 2 * F.wave; r0 < send; r0 += NR * NWAVES) {
            const int r1 = (r0 + 1 < send) ? r0 + 1 : r0;
            int e0 = 4 * F.lane; asm volatile("" : "+v"(e0));
            f32x4 x[NR][8]; v2u yp[NR][8];
            if (xin_f32) { const float* xin = (const float*)xin_;
#pragma unroll
                for (int q = 0; q < NR; ++q) { const int row = q ? r1 : r0;
#pragma unroll
                    for (int j = 0; j < 8; ++j) x[q][j] = *(const f32x4*)(xin + (size_t)row * DM + e0 + 256 * j); }
                if (y) {
#pragma unroll
                    for (int q = 0; q < NR; ++q) { const int row = q ? r1 : r0;
#pragma unroll
                        for (int j = 0; j < 8; ++j) yp[q][j] = *(const v2u*)(y + (size_t)row * DM + e0 + 256 * j); } }
            } else { const bf16* xin = (const bf16*)xin_; v2u xp[NR][8];
#pragma unroll
                for (int q = 0; q < NR; ++q) { const int row = q ? r1 : r0;
#pragma unroll
                    for (int j = 0; j < 8; ++j) xp[q][j] = *(const v2u*)(xin + (size_t)row * DM + e0 + 256 * j); }
                if (y) {
#pragma unroll
                    for (int q = 0; q < NR; ++q) { const int row = q ? r1 : r0;
#pragma unroll
                        for (int j = 0; j < 8; ++j) yp[q][j] = *(const v2u*)(y + (size_t)row * DM + e0 + 256 * j); } }
#pragma unroll
                for (int q = 0; q < NR; ++q) {
#pragma unroll
                    for (int j = 0; j < 8; ++j) { const v2u p = xp[q][j]; x[q][j] = (f32x4){bflo(p.x), bfhi(p.x), bflo(p.y), bfhi(p.y)}; } }
            }
#pragma unroll
            for (int q = 0; q < NR; ++q) { const int row = q ? r1 : r0;
                if (y) {
                    f32x4 yv[8]; float ss = 0.f;
#pragma unroll
                    for (int j = 0; j < 8; ++j) { const v2u p = yp[q][j]; yv[j] = (f32x4){bflo(p.x), bfhi(p.x), bflo(p.y), bfhi(p.y)};
                        ss += (yv[j].x * yv[j].x + yv[j].y * yv[j].y) + (yv[j].z * yv[j].z + yv[j].w * yv[j].w); }
                    const float ry = 1.0f / sqrtf(wave_sum(ss, F.lane) * (1.f / DM) + RMS_EPS);
#pragma unroll
                    for (int j = 0; j < 8; ++j) { const f32x4 g = *(const LAS f32x4*)(vec + 1 * DM + e0 + 256 * j), gt = *(const LAS f32x4*)(vec + 0 * DM + e0 + 256 * j);
                        x[q][j] += gt * (yv[j] * ry * g); }
                    if (xout_f32) { float* xout = (float*)xout_;
#pragma unroll
                        for (int j = 0; j < 8; ++j) *(f32x4*)(xout + (size_t)row * DM + e0 + 256 * j) = x[q][j];
                    } else { bf16* xout = (bf16*)xout_;
#pragma unroll
                        for (int j = 0; j < 8; ++j) { v2u o; o.x = pk2(x[q][j].x, x[q][j].y); o.y = pk2(x[q][j].z, x[q][j].w); *(v2u*)(xout + (size_t)row * DM + e0 + 256 * j) = o; } }
                }
                if (hout) {
                    float ss = 0.f;
#pragma unroll
                    for (int j = 0; j < 8; ++j) ss += (x[q][j].x * x[q][j].x + x[q][j].y * x[q][j].y) + (x[q][j].z * x[q][j].z + x[q][j].w * x[q][j].w);
                    const float rx = 1.0f / sqrtf(wave_sum(ss, F.lane) * (1.f / DM) + RMS_EPS);
#pragma unroll
                    for (int j = 0; j < 8; ++j) { const f32x4 g = *(const LAS f32x4*)(vec + 2 * DM + e0 + 256 * j), sh = *(const LAS f32x4*)(vec + 3 * DM + e0 + 256 * j), sc = *(const LAS f32x4*)(vec + 4 * DM + e0 + 256 * j);
                        const f32x4 hv = (x[q][j] * rx * g) * (sc + 1.0f) + sh;
                        v2u o; o.x = pk2(hv.x, hv.y); o.y = pk2(hv.z, hv.w);
                        *(v2u*)(hout + (size_t)row * DM + e0 + 256 * j) = o; }
                }
            }
        }
        seg = send;
    }
}
__device__ __forceinline__ void ph_dsa_norm(Frame& F, const float* proj, const float* qn, const float* kvn, const float* ikn, bf16* qlat, bf16* ckv, bf16* kidx, float* widx) {
    const int gw = blockIdx.x * NWAVES + F.wave, NGW = F.G * NWAVES; const int e0 = 4 * F.lane;
    for (int row = gw; row < T; row += NGW) {
        f32x4 v[4];
#pragma unroll
        for (int j = 0; j < 4; ++j) v[j] = *(const f32x4*)(proj + (size_t)row * A_INP + e0 + 256 * j);
        float sq = 0.f;
#pragma unroll
        for (int j = 0; j < 2; ++j) sq += (v[j].x * v[j].x + v[j].y * v[j].y) + (v[j].z * v[j].z + v[j].w * v[j].w);
        const float rq = 1.0f / sqrtf(wave_sum(sq, F.lane) * (1.f / A_QR) + RMS_EPS);
#pragma unroll
        for (int j = 0; j < 2; ++j) { const f32x4 g = *(const f32x4*)(qn + e0 + 256 * j); const f32x4 o = v[j] * rq * g; v2u w; w.x = pk2(o.x, o.y); w.y = pk2(o.z, o.w);
            *(v2u*)(qlat + (size_t)row * A_QR + e0 + 256 * j) = w; }
        const float skv = (v[2].x * v[2].x + v[2].y * v[2].y) + (v[2].z * v[2].z + v[2].w * v[2].w);
        const float rkv = 1.0f / sqrtf(wave_sum(skv, F.lane) * (1.f / A_KVR) + RMS_EPS);
        { const f32x4 g = *(const f32x4*)(kvn + e0); const f32x4 o = v[2] * rkv * g; v2u w; w.x = pk2(o.x, o.y); w.y = pk2(o.z, o.w); *(v2u*)(ckv + (size_t)row * A_KVR + e0) = w; }
        const bool isk = F.lane < 32;
        const float s1 = isk ? (v[3].x + v[3].y) + (v[3].z + v[3].w) : 0.f;
        const float mean = wave_sum(s1, F.lane) * (1.f / IDX_D);
        const f32x4 dv = v[3] - mean;
        const float s2 = isk ? (dv.x * dv.x + dv.y * dv.y) + (dv.z * dv.z + dv.w * dv.w) : 0.f;
        const float rk = 1.0f / sqrtf(wave_sum(s2, F.lane) * (1.f / IDX_D) + RMS_EPS);
        if (isk) { const f32x4 g = *(const f32x4*)(ikn + e0); const f32x4 o = dv * rk * g; v2u w; w.x = pk2(o.x, o.y); w.y = pk2(o.z, o.w); *(v2u*)(kidx + (size_t)row * IDX_D + e0) = w; }
        else if (F.lane < 36) { *(f32x4*)(widx + (size_t)row * IDX_H + (e0 - 128)) = v[3] * 0.02209708691207961f; }
    }
}

__device__ __forceinline__ int wave_scan_incl(int v, int lane, int& total) {
    v += __builtin_amdgcn_update_dpp(0, v, 0x111, 0xf, 0xf, true); v += __builtin_amdgcn_update_dpp(0, v, 0x112, 0xf, 0xf, true);
    v += __builtin_amdgcn_update_dpp(0, v, 0x114, 0xf, 0xf, true); v += __builtin_amdgcn_update_dpp(0, v, 0x118, 0xf, 0xf, true);
    const int t0 = __builtin_amdgcn_readlane(v, 15), t1 = __builtin_amdgcn_readlane(v, 31), t2 = __builtin_amdgcn_readlane(v, 47), t3 = __builtin_amdgcn_readlane(v, 63);
    v += (lane >= 16 ? t0 : 0) + (lane >= 32 ? t1 : 0) + (lane >= 48 ? t2 : 0);
    total = (t0 + t1) + (t2 + t3);
    return v;
}
template <bool G, class SP> __device__ __forceinline__ void topk_select_row(SP sc, int t, int* out, int lane, LAS int* lst) {
    const int n = t + 1;
    if (n <= TOPK) { for (int i = lane; i < TOPK; i += 64) out[i] = (i < n) ? i : 0; return; }
    const int ni = G ? 2 * ((n + 127) >> 7) : (n + 63) >> 6;
#define TOPK_KEYIDX(i) (G ? 128 * ((i) >> 1) + 2 * lane + ((i) & 1) : 64 * (i) + lane)
    unsigned key[64];
#pragma unroll
    for (int g = 0; g < 8; ++g) {
        if (8 * g < ni) {
            if constexpr (G) {
#pragma unroll
                for (int j = 4 * g; j < 4 * g + 4; ++j) { const unsigned d = __hip_atomic_load((const unsigned*)sc + 64 * j + lane, __ATOMIC_RELAXED, __HIP_MEMORY_SCOPE_AGENT);
#pragma unroll
                    for (int e = 0; e < 2; ++e) { const int s = 128 * j + 2 * lane + e; const unsigned h = e ? (d >> 16) : (d & 0xffffu); const unsigned k = (h & 0x8000u) ? (~h & 0xffffu) : (h | 0x8000u); key[2 * j + e] = (s < n) ? k : 0u; } }
            } else {
#pragma unroll
                for (int i = 8 * g; i < 8 * g + 8; ++i) { const int s = 64 * i + lane; const unsigned h = sc[s < n ? s : n - 1]; const unsigned k = (h & 0x8000u) ? (~h & 0xffffu) : (h | 0x8000u); key[i] = (s < n) ? k : 0u; }
            }
        } else {
#pragma unroll
            for (int i = 8 * g; i < 8 * g + 8; ++i) key[i] = 0u;
        }
    }
    unsigned prefix = 0u;
    for (int bit = 15; bit >= 0; --bit) {
        const unsigned cand = prefix | (1u << bit); int cl = 0;
#pragma unroll
        for (int g = 0; g < 8; ++g) if (8 * g < ni) {
#pragma unroll
            for (int i = 8 * g; i < 8 * g + 8; ++i) cl += (key[i] >= cand) ? 1 : 0; }
        cl += __builtin_amdgcn_update_dpp(0, cl, 0xB1, 0xf, 0xf, true); cl += __builtin_amdgcn_update_dpp(0, cl, 0x4E, 0xf, 0xf, true);
        cl += __builtin_amdgcn_update_dpp(0, cl, 0x124, 0xf, 0xf, true); cl += __builtin_amdgcn_update_dpp(0, cl, 0x128, 0xf, 0xf, true);
        const int cnt = (__builtin_amdgcn_readlane(cl, 0) + __builtin_amdgcn_readlane(cl, 16)) + (__builtin_amdgcn_readlane(cl, 32) + __builtin_amdgcn_readlane(cl, 48));
        if (cnt >= TOPK) prefix = cand;
    }
    int cg = 0, ce = 0;
#pragma unroll
    for (int g = 0; g < 8; ++g) if (8 * g < ni) {
#pragma unroll
        for (int i = 8 * g; i < 8 * g + 8; ++i) { cg += (key[i] > prefix) ? 1 : 0; ce += (key[i] == prefix) ? 1 : 0; } }
    int tg, te;
    const int bg = wave_scan_incl(cg, lane, tg) - cg, be = wave_scan_incl(ce, lane, te) - ce;
    int quota = (TOPK - tg) - be; quota = quota < 0 ? 0 : (quota > ce ? ce : quota);
    int pg = bg, pe = tg + (be < TOPK - tg ? be : TOPK - tg);
    const int dummy = TOPK + lane;
#pragma unroll
    for (int g = 0; g < 8; ++g) if (8 * g < ni) {
#pragma unroll
        for (int i = 8 * g; i < 8 * g + 8; ++i) {
            const bool gt = key[i] > prefix, eq = (key[i] == prefix) && (quota > 0);
            const int pos = gt ? pg : (eq ? pe : dummy);
            lst[pos] = TOPK_KEYIDX(i);
            pg += gt ? 1 : 0; pe += eq ? 1 : 0; quota -= eq ? 1 : 0;
        } }
    asm volatile("s_waitcnt lgkmcnt(0)" ::: "memory");
    *(v4u*)(out + 4 * lane) = *(const LAS v4u*)(lst + 4 * lane);
#undef TOPK_KEYIDX
}
__device__ __forceinline__ int t5_bucket(int d) {
    if (d < 16) return d;
    int bkt = 16;
    bkt += (d >= 19) + (d >= 21) + (d >= 24) + (d >= 27) + (d >= 31) + (d >= 35) + (d >= 40) + (d >= 46) + (d >= 52) + (d >= 59) + (d >= 67) + (d >= 77) + (d >= 87) + (d >= 99) + (d >= 113);
    return bkt;
}

typedef short bf16x8 __attribute__((ext_vector_type(8)));
typedef short s16x4 __attribute__((ext_vector_type(4)));
typedef float f32x16 __attribute__((ext_vector_type(16)));
__device__ __forceinline__ unsigned offb(unsigned row, unsigned ch) { return 256u * row + 16u * (ch ^ (((row & 3u) << 2) | ((row >> 2) & 3u))); }
__device__ __forceinline__ unsigned tr_base_perm(unsigned lane, unsigned c, unsigned t) {
    const unsigned h = lane >> 5, blk = (lane >> 4) & 1u, q = (lane & 15u) >> 2, p = lane & 3u;
    return offb(8u * t + 4u * h + q, 4u * c + 2u * blk + (p >> 1)) + 8u * (p & 1u);
}
__device__ __forceinline__ bf16x8 tr_frag_at(LAS unsigned char* img, unsigned b0, unsigned b1, unsigned ks) {
    const s16x4 lo = __builtin_amdgcn_ds_read_tr16_b64_v4i16((LAS s16x4*)(img + b0 + 4096u * ks));
    const s16x4 hi = __builtin_amdgcn_ds_read_tr16_b64_v4i16((LAS s16x4*)(img + b1 + 4096u * ks));
    return __builtin_shufflevector(lo, hi, 0, 1, 2, 3, 4, 5, 6, 7);
}

__device__ __forceinline__ void ph_indexer(Frame& F, const bf16* qidx, const bf16* kidx, const float* widx, int* idxo) {
    constexpr int NQ = 8;
    LAS unsigned short* sc = (LAS unsigned short*)(F.lds);
    LAS float* wsh = (LAS float*)(F.lds + 65536);
    LAS unsigned char* ring = F.lds + 66560;
    const int r = F.lane & 31, hf = F.lane >> 5, rp = F.wave & 1, kq = F.wave >> 1;
    const int drow = 4 * F.wave + (F.lane >> 4), dch = (F.lane & 15) ^ (((F.lane >> 4) << 2) | (F.wave & 3));
    for (int u = blockIdx.x; u < BATCH * (SEQ / NQ); u += F.G) {
        const int b = u & 7, t0 = (u >> 3) * NQ;
        const int nt = (t0 + NQ + 31) >> 5, ns = (nt + 3) >> 2;
        const bf16* kbase = kidx + (size_t)(b * SEQ + drow) * IDX_D + dch * 8;
        __syncthreads();
#pragma unroll
        for (int j = 0; j < 4; ++j) __builtin_amdgcn_global_load_lds((const unsigned*)(kbase + (size_t)(j * 32) * IDX_D), (LAS unsigned*)(ring + j * 8192 + F.wave * 1024), 16, 0, 0);
        if (F.tid < NQ * 16) wsh[F.tid] = widx[(size_t)(b * SEQ + t0 + (F.tid >> 4)) * IDX_H + (F.tid & 15)];
        { const bf16* qb = qidx + (size_t)(b * SEQ + t0 + ((drow >> 2) & 1)) * 2048 + (4 * (drow >> 3) + (drow & 3)) * 128 + dch * 8;
#pragma unroll
          for (int j = 0; j < 4; ++j) __builtin_amdgcn_global_load_lds((const unsigned*)(qb + (size_t)(2 * j) * 2048), (LAS unsigned*)(ring + 32768 + j * 8192 + F.wave * 1024), 16, 0, 0); }
        bf16x8 Af[2][8];
        for (int s = 0; s < ns; ++s) {
            asm volatile("s_waitcnt vmcnt(0) lgkmcnt(0)" ::: "memory"); __builtin_amdgcn_s_barrier(); asm volatile("" ::: "memory");
            if (s == 0) {
#pragma unroll
                for (int rt = 0; rt < 2; ++rt)
#pragma unroll
                    for (int ks = 0; ks < 8; ++ks) Af[rt][ks] = *(const LAS bf16x8*)(ring + 32768 + (2 * rp + rt) * 8192 + offb((unsigned)r, (unsigned)(2 * ks + hf)));
                asm volatile("s_waitcnt lgkmcnt(0)" ::: "memory"); __builtin_amdgcn_s_barrier(); asm volatile("" ::: "memory");
            }
            if (s + 1 < ns) {
#pragma unroll
                for (int j = 0; j < 4; ++j) __builtin_amdgcn_global_load_lds((const unsigned*)(kbase + (size_t)((4 * (s + 1) + j) * 32) * IDX_D), (LAS unsigned*)(ring + ((s + 1) & 1) * 32768 + j * 8192 + F.wave * 1024), 16, 0, 0);
            }
            const int kt = 4 * s + kq;
            if (kt < nt) {
                LAS unsigned char* tile = ring + (s & 1) * 32768 + kq * 8192;
                bf16x8 Bf[8];
#pragma unroll
                for (int ks = 0; ks < 8; ++ks) Bf[ks] = *(const LAS bf16x8*)(tile + offb((unsigned)r, (unsigned)(2 * ks + hf)));
#pragma unroll
                for (int rt = 0; rt < 2; ++rt) {
                    f32x16 acc;
#pragma unroll
                    for (int i = 0; i < 16; ++i) acc[i] = 0.f;
#pragma unroll
                    for (int ks = 0; ks < 8; ++ks) acc = __builtin_amdgcn_mfma_f32_32x32x16_bf16(Af[rt][ks], Bf[ks], acc, 0, 0, 0);
                    float s0 = 0.f, s1 = 0.f;
#pragma unroll
                    for (int i4 = 0; i4 < 4; ++i4) { const f32x4 w4 = *(const LAS f32x4*)(wsh + (4 * rp + 2 * rt + hf) * 16 + 4 * i4);
                        s0 += w4.x * fmaxf(acc[4 * i4], 0.f) + w4.z * fmaxf(acc[4 * i4 + 2], 0.f); s1 += w4.y * fmaxf(acc[4 * i4 + 1], 0.f) + w4.w * fmaxf(acc[4 * i4 + 3], 0.f); }
                    sc[(4 * rp + 2 * rt + hf) * 4096 + kt * 32 + r] = __builtin_bit_cast(unsigned short, (_Float16)(s0 + s1));
                }
            }
        }
        __syncthreads();
        for (int q = F.wave; q < NQ; q += NWAVES) topk_select_row<false>(sc + q * 4096, t0 + q, idxo + (size_t)(b * SEQ + t0 + q) * TOPK, F.lane, (LAS int*)(F.lds + 132096) + F.wave * 320);
    }
}

#define LDS_BARRIER() do { asm volatile("s_waitcnt lgkmcnt(0)" ::: "memory"); __builtin_amdgcn_s_barrier(); asm volatile("" ::: "memory"); } while (0)
__device__ __forceinline__ int relane(int lane) { asm volatile("" : "+v"(lane)); return lane; }
__device__ __forceinline__ void ph_sparse_attn(Frame& F, bf16* qa_olat, const bf16* ckv, const int* idxi, const float* relb) {
    LAS unsigned char* KV = F.lds;
    LAS unsigned char* PF = F.lds + 131072;
    LAS float* wmax = (LAS float*)(F.lds + 147456);
    LAS float* wsum = wmax + 256;
    LAS unsigned char* bks = F.lds + 147456 + 2048;
    LAS float* relbs = (LAS float*)(F.lds + 147456 + 2048 + 512);
    LAS float* invw = (LAS float*)(F.lds + 147456 + 2048 + 512 + 4224);
    LAS unsigned char* blut = F.lds + 147456 + 2048 + 512 + 4224 + 1024;
    const float scale = 0.08838834764831845f;
    const int w = F.wave;
    __syncthreads();
    for (int i = F.tid; i < 1024; i += 512) relbs[i] = relb[i];
    if (F.tid < 32) relbs[1024 + F.tid] = -INFINITY;
    if (F.tid < 128) blut[F.tid] = (unsigned char)t5_bucket(F.tid);
    int u = blockIdx.x;
    if (u >= T) return;
    int idc[16]; int bid; v4u R[16]; v4u Qr[2];
    {
        const int cc = F.lane & 31, r = F.lane & 31, hf = F.lane >> 5;
        const int t = u % SEQ, b = u / SEQ;
        const int* ip = idxi + (size_t)u * TOPK + 32 * w + hf;
#pragma unroll
        for (int k = 0; k < 16; ++k) idc[k] = ip[2 * k];
        const bf16* kb = ckv + (size_t)b * SEQ * A_KVR + cc * 8;
#pragma unroll
        for (int k = 0; k < 16; ++k) R[k] = *(const v4u*)(kb + (size_t)idc[k] * A_KVR);
        if (F.tid < 256) { const int id = idxi[(size_t)u * TOPK + F.tid]; const int d = t - id; bks[F.tid] = (F.tid <= t) ? (unsigned char)t5_bucket(d > 0 ? d : 0) : (unsigned char)32; }
        const int u2 = (u + F.G < T) ? u + F.G : u;
        const int* ip2 = idxi + (size_t)u2 * TOPK + 32 * w + hf;
#pragma unroll
        for (int k = 0; k < 16; ++k) idc[k] = ip2[2 * k];
        bid = (F.tid < 256) ? idxi[(size_t)u2 * TOPK + F.tid] : -1;
        { const v4u* qp = (const v4u*)(qa_olat + (size_t)u * A_HEADS * A_KVR);
#pragma unroll
          for (int j = 0; j < 2; ++j) { const int id = 2 * w + j, head = 8 * (id & 3) + (F.lane & 7), pos = 8 * (id >> 2) + (F.lane >> 3); Qr[j] = qp[head * 32 + pos]; } }
    }
    unsigned wro[16], qwo[2], trb[2];
    { const unsigned r0 = F.lane & 31, hf0 = F.lane >> 5; const unsigned c0 = (r0 & 15u) ^ (4u * hf0);
#pragma unroll
      for (int k = 0; k < 16; ++k) wro[k] = (r0 >> 4) * 65536u + 256u * (32u * w + hf0) + 512u * k + 16u * (c0 ^ (unsigned)(8 * (k & 1) + ((k >> 1) & 3)));
#pragma unroll
      for (int j = 0; j < 2; ++j) { const int id = 2 * w + j, head = 8 * (id & 3) + (F.lane & 7), pos = 8 * (id >> 2) + (F.lane >> 3); qwo[j] = (pos >> 1) * 1024 + ((pos & 1) * 32 + head) * 16; }
      trb[0] = tr_base_perm((unsigned)F.lane, (unsigned)(w & 3), 0u); trb[1] = tr_base_perm((unsigned)F.lane, (unsigned)(w & 3), 1u); }
    unsigned rdo[16];
    { const unsigned r0 = F.lane & 31, hf0 = F.lane >> 5, row = 32u * w + r0, xr = ((row & 3u) << 2) | ((row >> 2) & 3u);
#pragma unroll
      for (int ks = 0; ks < 16; ++ks) rdo[ks] = 256u * row + (ks >> 3) * 65536u + 16u * ((unsigned)(2 * (ks & 7) + hf0) ^ xr); }
    for (int it = 0; u < T; u += F.G, ++it) {
        const int un = u + F.G, unn = u + 2 * F.G, par = it & 1;
        LDS_BARRIER();
        const int l2 = relane(F.lane), r = l2 & 31, hf = l2 >> 5;
        {
#pragma unroll
          for (int k = 0; k < 16; ++k) *(LAS v4u*)(KV + wro[k]) = R[k]; }
        *(LAS v4u*)(PF + qwo[0]) = Qr[0]; *(LAS v4u*)(PF + qwo[1]) = Qr[1];
        LDS_BARRIER();
        const int tid1 = w * 64 + l2;
        const int unb = (un < T) ? un : u; const int bn = unb / SEQ, tn = unb % SEQ;
        const bf16* kbn = ckv + (size_t)bn * SEQ * A_KVR + r * 8;
        f32x16 acc;
#pragma unroll
        for (int i = 0; i < 16; ++i) acc[i] = 0.f;
        {
#pragma unroll
          for (int ks = 0; ks < 16; ++ks) { const bf16x8 a = *(const LAS bf16x8*)(KV + rdo[ks]);
              acc = __builtin_amdgcn_mfma_f32_32x32x16_bf16(a, *(const LAS bf16x8*)(PF + ks * 1024 + l2 * 16), acc, 0, 0, 0);
              R[ks] = *(const v4u*)(kbn + (size_t)idc[ks] * A_KVR); } }
        if (tid1 < 256) { int d = tn - bid; d = d < 0 ? 0 : (d > 127 ? 127 : d); bks[(par ^ 1) * 256 + tid1] = (tid1 <= tn) ? blut[d] : (unsigned char)32; }
        { const v4u* qp = (const v4u*)(qa_olat + (size_t)unb * A_HEADS * A_KVR);
#pragma unroll
          for (int j = 0; j < 2; ++j) { const int id = 2 * w + j, head = 8 * (id & 3) + (l2 & 7), pos = 8 * (id >> 2) + (l2 >> 3); Qr[j] = qp[head * 32 + pos]; } }
        float lg[16]; float m = -INFINITY;
#pragma unroll
        for (int g = 0; g < 4; ++g) { const unsigned b4 = *(const LAS unsigned*)(bks + par * 256 + 32 * w + 8 * g + 4 * hf);
#pragma unroll
            for (int j = 0; j < 4; ++j) { const unsigned bk = (b4 >> (8 * j)) & 255u; const int i = 4 * g + j;
                lg[i] = acc[i] * scale + relbs[bk * 32 + r]; m = fmaxf(m, lg[i]); } }
        m = fmaxf(m, shx(m, 32, l2));
        if (hf == 0) wmax[r * 8 + w] = m;
        LDS_BARRIER();
        { const f32x4 m0 = *(const LAS f32x4*)(wmax + r * 8), m1 = *(const LAS f32x4*)(wmax + r * 8 + 4);
          m = fmaxf(fmaxf(fmaxf(m0.x, m0.y), fmaxf(m0.z, m0.w)), fmaxf(fmaxf(m1.x, m1.y), fmaxf(m1.z, m1.w))); }
        float s = 0.f;
#pragma unroll
        for (int i = 0; i < 16; ++i) { lg[i] = __expf(lg[i] - m); s += lg[i]; }
        s += shx(s, 32, l2);
        if (hf == 0) wsum[r * 8 + w] = s;
#pragma unroll
        for (int s2 = 0; s2 < 2; ++s2) { v4u pk; pk.x = pk2(lg[8 * s2 + 0], lg[8 * s2 + 1]); pk.y = pk2(lg[8 * s2 + 2], lg[8 * s2 + 3]); pk.z = pk2(lg[8 * s2 + 4], lg[8 * s2 + 5]); pk.w = pk2(lg[8 * s2 + 6], lg[8 * s2 + 7]);
            *(LAS v4u*)(PF + (2 * w + s2) * 1024 + l2 * 16) = pk; }
        LDS_BARRIER();
        const int l3 = relane(F.lane), r3 = l3 & 31, hf3 = l3 >> 5;
        if (hf3 == 0) { const f32x4 s0 = *(const LAS f32x4*)(wsum + r3 * 8), s1 = *(const LAS f32x4*)(wsum + r3 * 8 + 4);
            invw[w * 32 + r3] = 1.0f / (((s0.x + s0.y) + (s0.z + s0.w)) + ((s1.x + s1.y) + (s1.z + s1.w))); }
        f32x16 o;
#pragma unroll
        for (int i = 0; i < 16; ++i) o[i] = 0.f;
        LAS unsigned char* img = KV + (w >> 2) * 65536;
        const int unc = (unn < T) ? unn : u;
        const int* ip2 = idxi + (size_t)unc * TOPK + 32 * w + hf3;
        const unsigned tb0 = trb[0], tb1 = trb[1];
#pragma unroll
        for (int ks = 0; ks < 16; ++ks) { const bf16x8 a = *(const LAS bf16x8*)(PF + ks * 1024 + l3 * 16);
            const bf16x8 bb = tr_frag_at(img, tb0, tb1, (unsigned)ks);
            o = __builtin_amdgcn_mfma_f32_32x32x16_bf16(a, bb, o, 0, 0, 0);
            idc[ks] = ip2[2 * ks]; }
        if (w * 64 + l3 < 256) bid = idxi[(size_t)unc * TOPK + w * 64 + l3];
        bf16* op = qa_olat + ((size_t)u * A_HEADS + 4 * hf3) * A_KVR + 32 * w + r3;
#pragma unroll
        for (int g = 0; g < 4; ++g) { const f32x4 iv = *(const LAS f32x4*)(invw + w * 32 + 8 * g + 4 * hf3);
            op[(8 * g + 0) * A_KVR] = (bf16)f2bf(o[4 * g + 0] * iv.x); op[(8 * g + 1) * A_KVR] = (bf16)f2bf(o[4 * g + 1] * iv.y);
            op[(8 * g + 2) * A_KVR] = (bf16)f2bf(o[4 * g + 2] * iv.z); op[(8 * g + 3) * A_KVR] = (bf16)f2bf(o[4 * g + 3] * iv.w); }
    }
}

__device__ __forceinline__ void ph_sb_attn(Frame& F, const bf16* qkv, bf16* o_out, unsigned* qctr) {
    LAS unsigned char* img = F.lds + F.wave * 8192;
    LAS unsigned char* qimg = F.lds + 65536 + F.wave * 8192;
    const int r = F.lane & 31, hf = F.lane >> 5;
    const float scale = 0.08838834764831845f;
    constexpr int NTASK8 = BATCH * B_HEADS * (SEQ / 32) / 8;
    const int myx = (int)(xb_xcc_id() & 7u);
    for (int qi = 0; qi < 8; ++qi) { const int qsel = (myx + qi) & 7;
    for (;;) {
        int task = 0;
        if (F.lane == 0) task = (int)__hip_atomic_fetch_add(qctr + 64 * qsel, 1u, __ATOMIC_RELAXED, __HIP_MEMORY_SCOPE_AGENT);
        task = __builtin_amdgcn_readfirstlane(task);
        if (task >= NTASK8) break;
        task += qsel * NTASK8;
        const int qt = task & 127, bh = task >> 7, h = bh & 15, b = bh >> 4, t0 = qt * 32;
        v4u Kr[8], Vr[8];
#pragma unroll
        for (int k = 0; k < 8; ++k) { const int n = F.lane + 64 * k; *(LAS v4u*)(qimg + offb(n >> 4, n & 15)) = *(const v4u*)(qkv + (size_t)(b * SEQ + t0 + (n >> 4)) * B_INC + h * B_HD + (n & 15) * 8); }
        {
#pragma unroll
          for (int k = 0; k < 8; ++k) { const int n = F.lane + 64 * k; const bf16* rp = qkv + (size_t)(b * SEQ + qt * 32 + (n >> 4)) * B_INC + h * B_HD + (n & 15) * 8; Kr[k] = *(const v4u*)(rp + DM); Vr[k] = *(const v4u*)(rp + 2 * DM); } }
        f32x16 o[4];
#pragma unroll
        for (int dt = 0; dt < 4; ++dt)
#pragma unroll
            for (int i = 0; i < 16; ++i) o[dt][i] = 0.f;
        float Rc = 1.f;
        for (int kt = qt; kt >= 0; --kt) {
            const int ll = relane(F.lane), r = ll & 31, hf = ll >> 5;
#pragma unroll
            for (int k = 0; k < 8; ++k) { const int n = ll + 64 * k; *(LAS v4u*)(img + offb(n >> 4, n & 15)) = Kr[k]; }
            f32x16 acc;
#pragma unroll
            for (int i = 0; i < 16; ++i) acc[i] = 0.f;
#pragma unroll
            for (int ks = 0; ks < 8; ++ks) acc = __builtin_amdgcn_mfma_f32_32x32x16_bf16(*(const LAS bf16x8*)(img + offb(r, 2 * ks + hf)), *(const LAS bf16x8*)(qimg + offb(r, 2 * ks + hf)), acc, 0, 0, 0);
            asm volatile("s_waitcnt lgkmcnt(0)" ::: "memory");
#pragma unroll
            for (int k = 0; k < 8; ++k) { const int n = ll + 64 * k; *(LAS v4u*)(img + offb(n >> 4, n & 15)) = Vr[k]; }
            float be[16], om[16];
            const bool diag = (kt == qt);
#pragma unroll
            for (int i = 0; i < 16; ++i) { const float z = fminf(acc[i] * scale, 80.f);
                const float e = __expf(z), rr = __builtin_amdgcn_rcpf(1.0f + e);
                be[i] = e * rr; om[i] = rr; }
            if (diag) {
#pragma unroll
                for (int i = 0; i < 16; ++i) { const int kap = 8 * (i >> 2) + 4 * hf + (i & 3); if (kap >= r) { be[i] = 0.f; om[i] = 1.f; } } }
            float sfx[16], Gt[4], Go[4];
#pragma unroll
            for (int g = 0; g < 4; ++g) { sfx[4 * g + 3] = 1.f; sfx[4 * g + 2] = om[4 * g + 3]; sfx[4 * g + 1] = sfx[4 * g + 2] * om[4 * g + 2]; sfx[4 * g + 0] = sfx[4 * g + 1] * om[4 * g + 1]; Gt[g] = sfx[4 * g + 0] * om[4 * g + 0]; }
#pragma unroll
            for (int g = 0; g < 4; ++g) Go[g] = shx(Gt[g], 32, ll);
            float SP[4]; SP[3] = 1.f; SP[2] = Gt[3] * Go[3]; SP[1] = SP[2] * (Gt[2] * Go[2]); SP[0] = SP[1] * (Gt[1] * Go[1]);
            float wgt[16];
#pragma unroll
            for (int g = 0; g < 4; ++g) { const float Rg = Rc * SP[g] * (hf == 0 ? Go[g] : 1.f);
#pragma unroll
                for (int j = 0; j < 4; ++j) wgt[4 * g + j] = be[4 * g + j] * (Rg * sfx[4 * g + j]); }
            Rc = Rc * (SP[0] * (Gt[0] * Go[0]));
            if (kt > 0) {
#pragma unroll
                for (int k = 0; k < 8; ++k) { const int n = F.lane + 64 * k; const bf16* rp = qkv + (size_t)(b * SEQ + (kt - 1) * 32 + (n >> 4)) * B_INC + h * B_HD + (n & 15) * 8; Kr[k] = *(const v4u*)(rp + DM); Vr[k] = *(const v4u*)(rp + 2 * DM); }
            }
            asm volatile("s_waitcnt lgkmcnt(0)" ::: "memory");
#pragma unroll
            for (int s2 = 0; s2 < 2; ++s2) {
                v4u pk; pk.x = pk2(wgt[8 * s2 + 0], wgt[8 * s2 + 1]); pk.y = pk2(wgt[8 * s2 + 2], wgt[8 * s2 + 3]); pk.z = pk2(wgt[8 * s2 + 4], wgt[8 * s2 + 5]); pk.w = pk2(wgt[8 * s2 + 6], wgt[8 * s2 + 7]);
                const bf16x8 pa = __builtin_bit_cast(bf16x8, pk);
#pragma unroll
                for (int dt = 0; dt < 4; ++dt) { const bf16x8 vb = tr_frag_at(img, tr_base_perm((unsigned)ll, (unsigned)dt, 0u), tr_base_perm((unsigned)ll, (unsigned)dt, 1u), (unsigned)s2);
                    o[dt] = __builtin_amdgcn_mfma_f32_32x32x16_bf16(pa, vb, o[dt], 0, 0, 0); }
            }
            if (__ballot(Rc >= 0x1p-40f) == 0ull) break;
        }
#pragma unroll
        for (int dt = 0; dt < 4; ++dt)
#pragma unroll
            for (int i = 0; i < 16; ++i) { const int qrow = 8 * (i >> 2) + 4 * hf + (i & 3);
                o_out[(size_t)(b * SEQ + t0 + qrow) * DM + h * B_HD + 32 * dt + r] = (bf16)f2bf(o[dt][i]); }
    }
    }
}

constexpr int PH_LAYER0 = 3, PH_PER_LAYER = 16, PH_END = PH_LAYER0 + DEPTH * PH_PER_LAYER;
typedef pg8::bf16_t gb16;
__device__ __forceinline__ bool relaunder(Frame& F) { int l_; asm volatile("v_mbcnt_lo_u32_b32 %0, -1, 0\n\tv_mbcnt_hi_u32_b32 %0, -1, %0" : "=v"(l_)); F.lane = l_; F.tid = F.wave * 64 + l_; return true; }
template <class Epi> __device__ __forceinline__ void run_gemm(Frame& F, const bf16* A, const bf16* Bt, int N, int K, int lda, int ldb, int acs, const Epi& E) {
    pg8::Gemm g{(const gb16*)A, (const gb16*)Bt, T, N, K, lda, ldb, acs}; pg8::StaticOrder S; S.init(T, N, F.G, (F.G == 256) ? (int)((blockIdx.x & 31) * 8 + (blockIdx.x >> 5)) : (int)blockIdx.x);
    pg8::gemm_phase<Epi, pg8::StaticOrder, true, true>(F.lds, g, S, E, F.tid);
}
__global__ void __launch_bounds__(NWAVES * 64, 2) fwd_kernel(Args args) {
    extern __shared__ __attribute__((aligned(16))) unsigned char lds_raw[];
    Frame F;
    F.lds = (LAS unsigned char*)lds_raw;
    F.tid = threadIdx.x; F.lane = F.tid & 63; F.wave = __builtin_amdgcn_readfirstlane(F.tid >> 6); F.G = gridDim.x;
    F.ap = (const CAS Args*)__builtin_amdgcn_kernarg_segment_ptr();
    F.out = args.out; F.ws = args.ws;
    volatile LAS unsigned* MISC = (volatile LAS unsigned*)(F.lds + MISC_OFF);
    if (F.tid < 64) MISC[F.tid] = 0u;
    __syncthreads();
    const int lo = args.ph_lo, hi = args.ph_hi;
    XcdBarrier bar; bar.bar = (unsigned*)(F.ws + WS_CTL) + CW_BAR; bar.x = 0; bar.st = nullptr;
    if (hi - lo > 1) { bar = xcd_barrier_post((unsigned*)(F.ws + WS_CTL) + CW_BAR, MISC + 8); xcd_barrier<true>(bar); }
#define IN(k) (lo <= (k) && (k) < hi && relaunder(F))
#define INR(k) (lo <= (k) && (k) < hi)
#define GRID_BAR() do { XcdBarrier b2_ = bar; b2_.x = (unsigned)__builtin_amdgcn_readfirstlane((int)bar.x); asm volatile("" : "+s"(b2_.bar), "+s"(b2_.x)); xcd_barrier<false>(b2_); } while (0)
#define SEAM(k) do { if (INR((k) + 1)) GRID_BAR(); } while (0)

    float* mod = WSP(float, WS_MOD);
    const float* normg = F.inp(IN_NORMG);
    bf16* Hb = WSP(bf16, WS_H);
    if (IN(0)) { ph_prologue(F); SEAM(0); }
    if (IN(1)) { ph_modreduce(F); SEAM(1); }
    if (IN(2)) { ph_post(F, nullptr, F.inp(IN_X), true, nullptr, false, nullptr, nullptr, Hb, normg + 0 * DM, mod + 0 * DM, mod + 1 * DM); SEAM(2); }

    for (int L = 0; L < DEPTH; ++L) {
        const int pb = PH_LAYER0 + PH_PER_LAYER * L, j = L >> 1;
        const float* modL = mod + (size_t)L * BATCH * MODW;
        const float* ng = normg + (size_t)L * 4 * DM;
        const bool lastL = (L == DEPTH - 1);
        bf16* XB = (bf16*)((unsigned char*)F.out + 128 * MiB); bf16* XL = WSP(bf16, WS_P + 128 * MiB);
        if ((L & 1) == 0) {
            float* proj = WSP(float, WS_P); bf16* qidx = WSP(bf16, WS_P + 128 * MiB); bf16* ob = WSP(bf16, WS_P);
            bf16* big = WSP(bf16, WS_BIG);
            bf16* qlat = WSP(bf16, WS_QLAT); bf16* ckv = WSP(bf16, WS_CKV); bf16* kidx = WSP(bf16, WS_KIDX); float* widx = WSP(float, WS_WIDX); int* idxb = WSP(int, WS_IDX);
            if (IN(pb + 0)) { pg8::EpiF32 E{proj, A_INP}; run_gemm(F, Hb, WSP(bf16, WS_WAIN) + (size_t)j * A_INP * DM, A_INP, DM, DM, DM, 0, E); SEAM(pb + 0); }
            if (IN(pb + 1)) { ph_dsa_norm(F, proj, F.inp(IN_AQN) + j * A_QR, F.inp(IN_AKVN) + j * A_KVR, F.inp(IN_AIKN) + j * IDX_D, qlat, ckv, kidx, widx); SEAM(pb + 1); }
            if (IN(pb + 2)) { pg8::EpiBf16<0> E{(gb16*)big, 8192, (gb16*)qidx, 2048, 8192}; run_gemm(F, qlat, WSP(bf16, WS_WQC) + (size_t)j * 10240 * 512, 10240, A_QR, A_QR, A_QR, 0, E); SEAM(pb + 2); }
            if (IN(pb + 3)) { ph_indexer(F, qidx, kidx, widx, idxb); SEAM(pb + 3); }
            if (IN(pb + 4)) { ph_sparse_attn(F, big, ckv, idxb, F.inp(IN_RELB)); SEAM(pb + 4); }
            if (IN(pb + 5)) { pg8::EpiBf16<0> E{(gb16*)ob, 4096, (gb16*)ob, 4096, 1 << 30}; run_gemm(F, big, WSP(bf16, WS_WUV) + (size_t)j * 4096 * 512, 4096, 512, 8192, 512, 512, E); SEAM(pb + 5); }
            if (IN(pb + 6)) { pg8::EpiBf16<0> E{(gb16*)big, DM, (gb16*)big, DM, 1 << 30}; run_gemm(F, ob, WSP(bf16, WS_WAOUT) + (size_t)j * DM * 4096, DM, 4096, 4096, 4096, 0, E); SEAM(pb + 6); }
        } else {
            bf16* qkv = WSP(bf16, WS_BIG); bf16* ob = WSP(bf16, WS_P); bf16* big = WSP(bf16, WS_BIG);
            if (IN(pb + 0)) { pg8::EpiBf16<0> E{(gb16*)qkv, B_INC, (gb16*)qkv, B_INC, 1 << 30}; run_gemm(F, Hb, WSP(bf16, WS_WBIN) + (size_t)j * B_INC * DM, B_INC, DM, DM, DM, 0, E); SEAM(pb + 0); }
            if (IN(pb + 1)) { ph_sb_attn(F, qkv, ob, (unsigned*)(F.ws + WS_CTL) + CW_SBQ + 512 * j); SEAM(pb + 1); }
            if (IN(pb + 2)) { pg8::EpiBf16<0> E{(gb16*)big, DM, (gb16*)big, DM, 1 << 30}; run_gemm(F, ob, WSP(bf16, WS_WBOUT) + (size_t)j * DM * DM, DM, DM, DM, DM, 0, E); if (INR(pb + 7)) GRID_BAR(); }
        }
        if (IN(pb + 7)) { ph_post(F, WSP(bf16, WS_BIG), (L == 0) ? (const void*)F.inp(IN_X) : (const void*)XB, L == 0, lastL ? (void*)XL : (void*)XB, false, modL + 2 * DM, ng + 1 * DM, Hb, ng + 2 * DM, modL + 3 * DM, modL + 4 * DM); SEAM(pb + 7); }
        if (IN(pb + 8)) { pg8::EpiBf16<1> E{(gb16*)WSP(bf16, WS_BIG), DFF, (gb16*)WSP(bf16, WS_BIG), DFF, 1 << 30}; run_gemm(F, Hb, WSP(bf16, WS_WM1) + (size_t)L * DFF * DM, DFF, DM, DM, DM, 0, E); SEAM(pb + 8); }
        if (IN(pb + 9)) { pg8::EpiBf16<0> E{(gb16*)WSP(bf16, WS_P), DM, (gb16*)WSP(bf16, WS_P), DM, 1 << 30}; run_gemm(F, WSP(bf16, WS_BIG), WSP(bf16, WS_WM2) + (size_t)L * DM * DFF, DM, DFF, DFF, DFF, 0, E); SEAM(pb + 9); }
        if (IN(pb + 10)) {
            const float* modN = mod + (size_t)(L + 1) * BATCH * MODW; const float* ngN = normg + (size_t)(L + 1) * 4 * DM;
            ph_post(F, WSP(bf16, WS_P), lastL ? (const void*)XL : (const void*)XB, false, lastL ? (void*)F.out : (void*)XB, lastL, modL + 5 * DM, ng + 3 * DM, lastL ? nullptr : Hb, ngN, modN + 0 * DM, modN + 1 * DM);
            if (!lastL && INR(pb + PH_PER_LAYER)) GRID_BAR();
        }
    }
#undef IN
#undef INR
#undef GRID_BAR
#undef SEAM
}

extern "C" void kernel_launch(void* const* d_in, const int* in_sizes, int n_in, void* d_out, int out_size, void* d_ws, size_t ws_size, hipStream_t stream) {
    static int grid = 0;
    if (grid == 0) {
        if (n_in != N_IN || out_size != T * DM || ws_size < WS_END) { fprintf(stderr, "kernel_launch: unexpected problem: n_in %d out %d ws %zu (need %zu); nothing launched\n", n_in, out_size, ws_size, (size_t)WS_END); grid = -1; return; }
        int dev = 0, cus = 0, per_cu = 0;
        if (hipGetDevice(&dev) != hipSuccess || hipDeviceGetAttribute(&cus, hipDeviceAttributeMultiprocessorCount, dev) != hipSuccess) { grid = -1; return; }
        if (hipFuncSetAttribute((const void*)fwd_kernel, hipFuncAttributeMaxDynamicSharedMemorySize, LDS_BYTES) != hipSuccess) { fprintf(stderr, "kernel_launch: hipFuncSetAttribute(%d B LDS) failed\n", LDS_BYTES); grid = -1; return; }
        if (hipOccupancyMaxActiveBlocksPerMultiprocessor(&per_cu, (const void*)fwd_kernel, NWAVES * 64, LDS_BYTES) != hipSuccess || per_cu < 1) { fprintf(stderr, "kernel_launch: occupancy query says %d workgroups per CU; nothing launched\n", per_cu); (void)hipGetLastError(); grid = -1; return; }
        grid = cus * (per_cu < 1 ? per_cu : 1);
    }
    if (grid < 0) return;
    (void)hipMemsetAsync((char*)d_ws + WS_CTL, 0, CTL_ZERO_BYTES, stream);
    Args a{};
    for (int i = 0; i < N_IN; ++i) a.in[i] = (const float*)d_in[i];
    a.out = (float*)d_out; a.ws = (unsigned char*)d_ws;
#if ONE_LAUNCH
    a.ph_lo = 0; a.ph_hi = PH_END;
    hipLaunchKernelGGL(fwd_kernel, dim3(grid), dim3(NWAVES * 64), LDS_BYTES, stream, a);
#else
    for (int p = 0; p < PH_END; ++p) {
        if (p >= PH_LAYER0) { const int L = (p - PH_LAYER0) / PH_PER_LAYER, r = (p - PH_LAYER0) % PH_PER_LAYER;
            if (r > 10) continue; if ((L & 1) && r >= 3 && r <= 6) continue; }
        a.ph_lo = p; a.ph_hi = p + 1;
        hipLaunchKernelGGL(fwd_kernel, dim3(grid), dim3(NWAVES * 64), LDS_BYTES, stream, a);
    }
#endif
}
```

```cpp
#include <hip/hip_runtime.h>
#include <cstdio>
#include <cstdint>
#ifndef ONE_LAUNCH
#define ONE_LAUNCH 1
#endif
namespace pg8 {
#define PG8_LAS __attribute__((address_space(3)))
typedef unsigned short bf16_t;
typedef short bf16x8 __attribute__((ext_vector_type(8)));
typedef float f32x4 __attribute__((ext_vector_type(4)));
typedef unsigned u32x4 __attribute__((ext_vector_type(4)));
constexpr int BM = 256, BK = 64, HALF = 128, HTB = HALF * BK * 2  , STAGE_BYTES = 8 * HTB, NXCD = 8, WGM = 4;

__host__ __device__ __forceinline__ int lds_byte(int r, int c) { return r * 128 + 16 * ((c >> 3) ^ ((r >> 1) & 7)) + (c & 7) * 2; }
__host__ __device__ __forceinline__ void stage_rc(int b, int& R, int& C) { R = b >> 7; C = (((b >> 4) & 7) ^ ((R >> 1) & 7)) * 8; }
__host__ __device__ __forceinline__ int perm32(int rho) { const int n = rho >> 4, i = rho & 15; return 8 * (i >> 2) + 4 * n + (i & 3); }

struct Unit { int pm, pn; };
struct Gemm { const bf16_t* A; const bf16_t* Bt; int M, N, K, lda, ldb, acs; };

struct StaticOrder {
    int nM, nN, nwg, G, c;
    __host__ __device__ void init(int M, int N, int G_, int c_) { nM = M / BM; nN = N / BM; nwg = nM * nN; G = G_; c = c_; }
    __host__ __device__ bool next(int i, Unit& u) const {
        const long L = (long)i * G + c; if (L >= nwg) return false;
        int wgid = (int)L; { const int q = nwg / NXCD, r = nwg % NXCD, xcd = wgid % NXCD, off = wgid / NXCD; wgid = (xcd < r ? xcd * (q + 1) : r * (q + 1) + (xcd - r) * q) + off; }
        const int nig = WGM * nN, gid = wgid / nig, fm = gid * WGM, gsz = (nM - fm) < WGM ? (nM - fm) : WGM;
        u.pm = fm + ((wgid % nig) % gsz); u.pn = (wgid % nig) / gsz; return true;
    }
    __device__ __forceinline__ void a_ready(const Unit&) const {}
    __device__ __forceinline__ void done(const Unit&) const {}
};


__device__ __forceinline__ float relu_f(float x) { float r; asm("v_max_f32 %0, 0, %1" : "=v"(r) : "v"(x)); return r; }
__device__ __forceinline__ unsigned cvt_pk_bf16(float lo, float hi) { unsigned r; asm("v_cvt_pk_bf16_f32 %0, %1, %2" : "=v"(r) : "v"(lo), "v"(hi)); return r; }
struct EpiF32 {
    static constexpr bool PERM = false, AFTER_DRAIN = false;
    float* C; int ldc;
    __device__ __forceinline__ void operator()(const f32x4 (&acc)[2][2][4][2], const Unit& u, int wr, int wc, int fr, int fq, PG8_LAS unsigned char* lds) const {
        PG8_LAS unsigned char* scr = lds + STAGE_BYTES + (wr * 4 + wc) * 2048;
        const int lane = fq * 16 + fr, rrow = lane >> 3, rch = lane & 7;
        PG8_LAS unsigned char* wp = scr + fr * 128 + 16 * (fq ^ (fr >> 1));
        const int wsw = ((fr >> 1) & 4) ? -64 : 64;
        const PG8_LAS unsigned char* rp = scr + rrow * 128 + 16 * (rch ^ ((rrow >> 1) & 7));
        const int rsw = (rch & 4) ? -64 : 64;
        float* gp = C + (size_t)(u.pm * BM + wr * 64 + rrow) * ldc + u.pn * BM + wc * 32 + 4 * rch;
#pragma unroll
        for (int ai = 0; ai < 2; ++ai)
#pragma unroll
            for (int m = 0; m < 4; ++m)
#pragma unroll
                for (int bj = 0; bj < 2; ++bj) {
#pragma unroll
                    for (int n = 0; n < 2; ++n) *(PG8_LAS f32x4*)(wp + (n ? wsw : 0)) = acc[ai][bj][m][n];
#pragma unroll
                    for (int s = 0; s < 2; ++s) { const f32x4 w = *(const PG8_LAS f32x4*)(rp + s * 1024 + (s ? rsw : 0));
                        *(f32x4*)(gp + (size_t)(ai * HALF + m * 16 + s * 8) * ldc + bj * HALF) = w; } }
    }
};
template <int ACT> struct EpiBf16 {
    static constexpr bool PERM = true, AFTER_DRAIN = false;
    bf16_t* O0; int ld0; bf16_t* O1; int ld1; int split_col;
    __device__ __forceinline__ void operator()(const f32x4 (&acc)[2][2][4][2], const Unit& u, int wr, int wc, int fr, int fq, PG8_LAS unsigned char* lds) const {
        int colt = u.pn * BM; bf16_t* base = O0; int ldc = ld0;
        if (colt >= split_col) { base = O1; ldc = ld1; colt -= split_col; }
        PG8_LAS unsigned char* scr = lds + STAGE_BYTES + (wr * 4 + wc) * 2048;
        const int lane = fq * 16 + fr, rrow = lane >> 3, rch = lane & 7;
        PG8_LAS unsigned char* wp = scr + fr * 128 + 16 * (fq ^ (fr >> 1));
        const int wsw = ((fr >> 1) & 4) ? -64 : 64;
        const PG8_LAS unsigned char* rp = scr + rrow * 128 + 16 * (rch ^ ((rrow >> 1) & 7));
        const int rsw = (rch & 4) ? -64 : 64;
        bf16_t* gp = base + (size_t)(u.pm * BM + wr * 64 + rrow) * ldc + colt + wc * 64 + 8 * rch;
        u32x4 rd[2];
#pragma unroll
        for (int it = 0; it < 8; ++it) { const int ai = it >> 2, m = it & 3;
#pragma unroll
            for (int bj = 0; bj < 2; ++bj) { f32x4 v0 = acc[ai][bj][m][0], v1 = acc[ai][bj][m][1];
                if (ACT == 1) {
#pragma unroll
                    for (int j = 0; j < 4; ++j) { const float a = relu_f(v0[j]), b = relu_f(v1[j]); v0[j] = a * a; v1[j] = b * b; } }
                u32x4 w; w.x = cvt_pk_bf16(v0[0], v0[1]); w.y = cvt_pk_bf16(v0[2], v0[3]); w.z = cvt_pk_bf16(v1[0], v1[1]); w.w = cvt_pk_bf16(v1[2], v1[3]);
                *(PG8_LAS u32x4*)(wp + (bj ? wsw : 0)) = w; }
            if (it > 0) { const int pa = (it - 1) >> 2, pm_ = (it - 1) & 3;
#pragma unroll
                for (int s = 0; s < 2; ++s) *(u32x4*)(gp + (size_t)(pa * HALF + pm_ * 16 + s * 8) * ldc) = rd[s]; }
#pragma unroll
            for (int s = 0; s < 2; ++s) rd[s] = *(const PG8_LAS u32x4*)(rp + s * 1024 + (s ? rsw : 0)); }
#pragma unroll
        for (int s = 0; s < 2; ++s) *(u32x4*)(gp + (size_t)(HALF + 3 * 16 + s * 8) * ldc) = rd[s];
    }
};

template <class Epi, class Sched, bool ALIGN_EPI = false, bool SP2 = false>
__device__ __forceinline__ void gemm_phase(PG8_LAS unsigned char* lds, const Gemm g, const Sched& S, const Epi& E, int tid_in) {
    int tid_l = tid_in; asm volatile("" : "+v"(tid_l));
    const int tid = tid_l, wid = __builtin_amdgcn_readfirstlane(tid >> 6), lane = tid & 63, wr = wid >> 2, wc = wid & 3, fr = lane & 15, fq = lane >> 4;
    const int K = g.K, nt = K / BK;
    unsigned voffA[2], voffB[2];
#pragma unroll
    for (int i = 0; i < 2; ++i) { int R, C; stage_rc(tid * 16 + i * 8192, R, C); const int Rb = Epi::PERM ? ((R >> 5) * 64 + perm32(R & 31)) : R;
        voffA[i] = (unsigned)(R * g.lda + C) * 2u; voffB[i] = (unsigned)(Rb * g.ldb + C) * 2u; }
    const size_t kstep = (size_t)(BK * 2);
    const size_t hstepA = (size_t)HALF * g.lda * 2, hstepB = (size_t)(Epi::PERM ? 32 : HALF) * g.ldb * 2;
    const size_t tstepA = 2 * hstepA, tstepB = (size_t)BM * g.ldb * 2, cstepA = (size_t)g.acs * 2;
    const unsigned ldsw = (unsigned)wid * 1024u;
    const int aoff = lds_byte(wr * 64 + fr, fq * 8), boff = lds_byte(wc * 32 + fr, fq * 8);
#define PG8_SA(b, h) (((b) * 2 + (h)) * HTB)
#define PG8_SB(b, h) ((4 + (b) * 2 + (h)) * HTB)
#define PG8_STAGE(bufoff, gbase, voff) do { _Pragma("unroll") for (int _i = 0; _i < 2; ++_i) \
        __builtin_amdgcn_global_load_lds((const unsigned*)((const char*)(gbase) + (voff)[_i]), (PG8_LAS unsigned*)(lds + (bufoff) + ldsw + _i * 8192), 16, 0, 0); } while (0)
#define PG8_LDA(dst, b, h) do { _Pragma("unroll") for (int m = 0; m < 4; ++m) _Pragma("unroll") for (int k = 0; k < 2; ++k) dst[m][k] = *(const PG8_LAS bf16x8*)(lds + PG8_SA(b, h) + (aoff ^ (k * 64)) + m * 2048); } while (0)
#define PG8_LDB(dst, b, h) do { _Pragma("unroll") for (int n = 0; n < 2; ++n) _Pragma("unroll") for (int k = 0; k < 2; ++k) dst[n][k] = *(const PG8_LAS bf16x8*)(lds + PG8_SB(b, h) + (boff ^ (k * 64)) + n * 2048); } while (0)
#define PG8_MMA(ai, bj, At, Bt) do { __builtin_amdgcn_s_setprio(1); _Pragma("unroll") for (int m = 0; m < 4; ++m) _Pragma("unroll") for (int n = 0; n < 2; ++n) _Pragma("unroll") for (int k = 0; k < 2; ++k) \
        acc[ai][bj][m][n] = __builtin_amdgcn_mfma_f32_16x16x32_bf16(Bt[n][k], At[m][k], acc[ai][bj][m][n], 0, 0, 0); __builtin_amdgcn_s_setprio(0); } while (0)
#define PG8_WAIT_V(n) asm volatile("s_waitcnt vmcnt(" #n ")" ::: "memory")
#define PG8_WAIT_L(n) asm volatile("s_waitcnt lgkmcnt(" #n ")" ::: "memory")
#define PG8_BAR __builtin_amdgcn_s_barrier()
#define PG8_SCHED __builtin_amdgcn_sched_barrier(0)
    Unit cur, nxt; int ui = 0;
    if (!S.next(0, cur)) return;
    f32x4 acc[2][2][4][2];
#pragma unroll
    for (int a = 0; a < 2; ++a)
#pragma unroll
        for (int b = 0; b < 2; ++b)
#pragma unroll
            for (int m = 0; m < 4; ++m)
#pragma unroll
                for (int n = 0; n < 2; ++n) acc[a][b][m][n] = (f32x4){0.f, 0.f, 0.f, 0.f};
    bf16x8 At[4][2], B0[2][2], B1[2][2];
    const char* cA = (const char*)g.A + (size_t)cur.pm * tstepA + (size_t)cur.pn * cstepA; const char* cB = (const char*)g.Bt + (size_t)cur.pn * tstepB;
    S.a_ready(cur);
    if constexpr (SP2) {
        PG8_STAGE(PG8_SB(0, 0), cB, voffB); PG8_STAGE(PG8_SB(0, 1), cB + hstepB, voffB); PG8_STAGE(PG8_SA(0, 0), cA, voffA); PG8_STAGE(PG8_SA(0, 1), cA + hstepA, voffA);
        if (wr == 1) PG8_BAR;
        PG8_WAIT_V(2); PG8_BAR;
        PG8_STAGE(PG8_SB(1, 0), cB + kstep, voffB); PG8_STAGE(PG8_SA(1, 0), cA + kstep, voffA); PG8_STAGE(PG8_SB(1, 1), cB + hstepB + kstep, voffB);
        PG8_WAIT_V(6); PG8_BAR;
    } else {
        PG8_STAGE(PG8_SB(0, 0), cB, voffB); PG8_STAGE(PG8_SA(0, 0), cA, voffA); PG8_STAGE(PG8_SB(0, 1), cB + hstepB, voffB); PG8_STAGE(PG8_SA(0, 1), cA + hstepA, voffA);
        if (wr == 1) PG8_BAR;
        PG8_WAIT_V(4); PG8_BAR;
        PG8_STAGE(PG8_SB(1, 0), cB + kstep, voffB); PG8_STAGE(PG8_SA(1, 0), cA + kstep, voffA); PG8_STAGE(PG8_SB(1, 1), cB + hstepB + kstep, voffB);
        PG8_WAIT_V(6); PG8_BAR;
    }
    for (;;) {
        const bool has_next = S.next(ui + 1, nxt);
        const char* nA = has_next ? (const char*)g.A + (size_t)nxt.pm * tstepA + (size_t)nxt.pn * cstepA : cA; const char* nB = has_next ? (const char*)g.Bt + (size_t)nxt.pn * tstepB : cB;
        for (int t = 0; t < nt; t += 2) {
            const bool last = (t == nt - 2);
            const char* a1 = cA + (size_t)(t + 1) * kstep;
            const char* a2 = last ? nA : cA + (size_t)(t + 2) * kstep; const char* b2 = last ? nB : cB + (size_t)(t + 2) * kstep;
            const char* a3 = a2 + kstep; const char* b3 = b2 + kstep;
            if (last && has_next) S.a_ready(nxt);
            if constexpr (SP2) {
            PG8_LDB(B0, 0, 0); PG8_LDB(B1, 0, 1); PG8_SCHED; PG8_LDA(At, 0, 0); PG8_STAGE(PG8_SA(1, 1), a1 + hstepA, voffA);
            PG8_WAIT_V(8); PG8_WAIT_L(0); PG8_BAR; PG8_MMA(0, 0, At, B0); PG8_MMA(0, 1, At, B1); PG8_BAR; PG8_SCHED;
            PG8_LDA(At, 0, 1); PG8_STAGE(PG8_SB(0, 0), b2, voffB); PG8_STAGE(PG8_SB(0, 1), b2 + hstepB, voffB); PG8_STAGE(PG8_SA(0, 0), a2, voffA);
            PG8_WAIT_V(8); PG8_WAIT_L(0); PG8_BAR; PG8_MMA(1, 0, At, B0); PG8_MMA(1, 1, At, B1); PG8_BAR; PG8_SCHED;
            PG8_LDB(B0, 1, 0); PG8_LDB(B1, 1, 1); PG8_SCHED; PG8_LDA(At, 1, 0); PG8_STAGE(PG8_SA(0, 1), a2 + hstepA, voffA);
            PG8_WAIT_V(8); PG8_WAIT_L(0); PG8_BAR; PG8_MMA(0, 0, At, B0); PG8_MMA(0, 1, At, B1); PG8_BAR; PG8_SCHED;
            PG8_LDA(At, 1, 1); PG8_STAGE(PG8_SB(1, 0), b3, voffB); PG8_STAGE(PG8_SB(1, 1), b3 + hstepB, voffB); PG8_STAGE(PG8_SA(1, 0), a3, voffA);
            PG8_WAIT_V(8); PG8_WAIT_L(0); PG8_BAR; PG8_MMA(1, 0, At, B0); PG8_MMA(1, 1, At, B1); PG8_BAR; PG8_SCHED;
            } else {
            PG8_LDB(B0, 0, 0); PG8_SCHED; PG8_LDA(At, 0, 0); PG8_STAGE(PG8_SA(1, 1), a1 + hstepA, voffA);
            PG8_WAIT_L(8); PG8_BAR; PG8_WAIT_L(0); PG8_MMA(0, 0, At, B0); PG8_BAR; PG8_SCHED;
            PG8_LDB(B1, 0, 1); PG8_STAGE(PG8_SB(0, 0), b2, voffB);
            PG8_BAR; PG8_WAIT_L(0); PG8_MMA(0, 1, At, B1); PG8_BAR;
            PG8_LDA(At, 0, 1); PG8_STAGE(PG8_SA(0, 0), a2, voffA);
            PG8_BAR; PG8_WAIT_L(0); PG8_MMA(1, 0, At, B0); PG8_BAR; PG8_SCHED;
            PG8_STAGE(PG8_SB(0, 1), b2 + hstepB, voffB);
            PG8_WAIT_V(6); PG8_BAR; PG8_MMA(1, 1, At, B1); PG8_BAR;
            PG8_LDB(B0, 1, 0); PG8_SCHED; PG8_LDA(At, 1, 0); PG8_STAGE(PG8_SA(0, 1), a2 + hstepA, voffA);
            PG8_WAIT_L(8); PG8_BAR; PG8_WAIT_L(0); PG8_MMA(0, 0, At, B0); PG8_BAR; PG8_SCHED;
            PG8_LDB(B1, 1, 1); PG8_STAGE(PG8_SB(1, 0), b3, voffB);
            PG8_BAR; PG8_WAIT_L(0); PG8_MMA(0, 1, At, B1); PG8_BAR;
            PG8_LDA(At, 1, 1); PG8_STAGE(PG8_SA(1, 0), a3, voffA);
            PG8_BAR; PG8_WAIT_L(0); PG8_MMA(1, 0, At, B0); PG8_BAR; PG8_SCHED;
            PG8_STAGE(PG8_SB(1, 1), b3 + hstepB, voffB);
            PG8_WAIT_V(6); PG8_BAR; PG8_MMA(1, 1, At, B1); PG8_BAR;
            }
        }
        if constexpr (ALIGN_EPI) { if (wr == 0) PG8_BAR; }
        if constexpr (!Epi::AFTER_DRAIN) { E(acc, cur, wr, wc, fr, fq, lds); S.done(cur); }
        if (!has_next) break;
#pragma unroll
        for (int a = 0; a < 2; ++a)
#pragma unroll
            for (int b = 0; b < 2; ++b)
#pragma unroll
                for (int m = 0; m < 4; ++m)
#pragma unroll
                    for (int n = 0; n < 2; ++n) acc[a][b][m][n] = (f32x4){0.f, 0.f, 0.f, 0.f};
        cur = nxt; cA = nA; cB = nB; ++ui;
        if constexpr (ALIGN_EPI) { if (wr == 1) PG8_BAR; }
    }
    PG8_WAIT_V(0);
    if constexpr (!ALIGN_EPI) { if (wr == 0) PG8_BAR; }
    PG8_BAR;
    if constexpr (Epi::AFTER_DRAIN) { E.fused(acc, cur, wr, wc, fr, fq, lds, wid, lane); S.done(cur); }
#undef PG8_SA
#undef PG8_SB
#undef PG8_STAGE
#undef PG8_LDA
#undef PG8_LDB
#undef PG8_MMA
#undef PG8_WAIT_V
#undef PG8_WAIT_L
#undef PG8_BAR
#undef PG8_SCHED
}
}

constexpr int NWAVES = 8;
constexpr int BATCH = 8, SEQ = 4096, DM = 2048, DEPTH = 4, DFF = 8192, T = BATCH * SEQ;
constexpr int A_HEADS = 32, A_QR = 512, A_KVR = 256, IDX_H = 16, IDX_D = 128, TOPK = 256, A_IN = 912, A_INP = 1024;
constexpr int B_HEADS = 16, B_HD = 128, B_INC = 3 * DM;
constexpr int MODW = 6 * DM;
constexpr float RMS_EPS = 1e-6f;
enum { IN_X = 0, IN_C, IN_RELB, IN_ADAW, IN_ADAB, IN_NORMG, IN_AWIN, IN_AQN, IN_AKVN, IN_AIKN, IN_AWQB, IN_AWIQB, IN_AWUK, IN_AWUV, IN_AWOUT, IN_BWIN, IN_BWOUT, IN_W1, IN_W2, N_IN };

constexpr size_t MiB = 1u << 20;
constexpr size_t WS_CTL = 0, CTL_ZERO_BYTES = 1 * MiB;
constexpr size_t WS_MOD = 1 * MiB;
constexpr size_t WS_MODP = 3 * MiB;
constexpr size_t WS_WAIN = 16 * MiB;
constexpr size_t WS_WQC = 24 * MiB;
constexpr size_t WS_WUV = 44 * MiB;
constexpr size_t WS_WAOUT = 52 * MiB;
constexpr size_t WS_WBIN = 84 * MiB;
constexpr size_t WS_WBOUT = 132 * MiB;
constexpr size_t WS_WM1 = 148 * MiB;
constexpr size_t WS_WM2 = 276 * MiB;
constexpr size_t WS_H = 404 * MiB;
constexpr size_t WS_P = 532 * MiB;
constexpr size_t WS_BIG = 788 * MiB;
constexpr size_t WS_QLAT = 1300 * MiB;
constexpr size_t WS_CKV = 1332 * MiB;
constexpr size_t WS_KIDX = 1348 * MiB;
constexpr size_t WS_WIDX = 1356 * MiB;
constexpr size_t WS_IDX = 1358 * MiB;
constexpr size_t WS_END = 1390 * MiB;
constexpr int CW_BAR = 4096;
constexpr int CW_SBQ = 8192;

constexpr int LDS_BYTES = 163840;
constexpr int MISC_OFF = LDS_BYTES - 256;

#define GAS __attribute__((address_space(1)))
#define LAS __attribute__((address_space(3)))
typedef unsigned short bf16;
typedef unsigned v4u __attribute__((ext_vector_type(4)));
typedef unsigned v2u __attribute__((ext_vector_type(2)));
typedef float f32x4 __attribute__((ext_vector_type(4)));
typedef float f32x2 __attribute__((ext_vector_type(2)));
typedef __bf16 bf16x2_t __attribute__((ext_vector_type(2)));
#define LDS_WAIT() asm volatile("s_waitcnt lgkmcnt(0)" ::: "memory")
#define VM_WAIT() asm volatile("s_waitcnt vmcnt(0)" ::: "memory")
__device__ __forceinline__ unsigned f2bf(float f) { unsigned u = __builtin_bit_cast(unsigned, f); return (u + 0x7fffu + ((u >> 16) & 1u)) >> 16; }
__device__ __forceinline__ unsigned pk2(float lo, float hi) { return f2bf(lo) | (f2bf(hi) << 16); }
__device__ __forceinline__ float bflo(unsigned u) { return __builtin_bit_cast(float, u << 16); }
__device__ __forceinline__ float bfhi(unsigned u) { return __builtin_bit_cast(float, u & 0xffff0000u); }
__device__ __forceinline__ float dot2bf(unsigned a, unsigned b, float c) { return __builtin_amdgcn_fdot2_f32_bf16(__builtin_bit_cast(bf16x2_t, a), __builtin_bit_cast(bf16x2_t, b), c, false); }
#define DPP_F(v, ctrl) __builtin_bit_cast(float, __builtin_amdgcn_update_dpp(0, __builtin_bit_cast(int, (v)), (ctrl), 0xf, 0xf, true))
#define RDL_F(v, l) __builtin_bit_cast(float, __builtin_amdgcn_readlane(__builtin_bit_cast(int, (v)), (l)))
__device__ __forceinline__ float wave_sum(float v, int) {
    v += DPP_F(v, 0xB1); v += DPP_F(v, 0x4E); v += DPP_F(v, 0x124); v += DPP_F(v, 0x128);
    return (RDL_F(v, 0) + RDL_F(v, 16)) + (RDL_F(v, 32) + RDL_F(v, 48));
}
__device__ __forceinline__ float wave_max(float v, int) {
    v = fmaxf(v, DPP_F(v, 0xB1)); v = fmaxf(v, DPP_F(v, 0x4E)); v = fmaxf(v, DPP_F(v, 0x124)); v = fmaxf(v, DPP_F(v, 0x128));
    return fmaxf(fmaxf(RDL_F(v, 0), RDL_F(v, 16)), fmaxf(RDL_F(v, 32), RDL_F(v, 48)));
}
__device__ __forceinline__ float shx(float v, int, int lane) {
    const unsigned u = __builtin_bit_cast(unsigned, v);
    auto r = __builtin_amdgcn_permlane32_swap(u, u, false, false);
    return __builtin_bit_cast(float, (lane & 32) ? r[0] : r[1]);
}

#define XB_TMO      128
#define XB_XCNT(j)  (256  + 64 * (j))
#define XB_XSUB(j)  (1280 + 64 * (j))
#define XB_XGEN(j)  (2304 + 64 * (j))
#define XB_TOP      3328
#define XB_TOPGEN   3392
#define XCD_BAR_WORDS 3456
#define XB_SPIN_CAP (1u << 22)

__device__ __forceinline__ unsigned xb_ld(unsigned* p)              { return __hip_atomic_load(p, __ATOMIC_RELAXED, __HIP_MEMORY_SCOPE_AGENT); }
__device__ __forceinline__ unsigned xb_add(unsigned* p, unsigned v) { return __hip_atomic_fetch_add(p, v, __ATOMIC_RELAXED, __HIP_MEMORY_SCOPE_AGENT); }
__device__ __forceinline__ unsigned xb_xcc_id() { return (unsigned)__builtin_amdgcn_s_getreg((3 << 11) | 20) & 0xFu; }
#define XB_SPIN(cond, bar) do { unsigned _sp = 0; while (cond) { __builtin_amdgcn_s_sleep(1); \
    if ((++_sp & 255u) == 0u) { if (xb_ld(&(bar)[XB_TMO])) break; if (_sp > XB_SPIN_CAP) { atomicAdd(&(bar)[XB_TMO], 1u); break; } } } } while (0)

struct XcdBarrier {
    unsigned* bar; unsigned x;
    volatile LAS unsigned* st;
};

__device__ __forceinline__ XcdBarrier xcd_barrier_post(unsigned* bar, volatile LAS unsigned* st) {
    XcdBarrier b; b.bar = bar; b.x = xb_xcc_id(); b.st = st;
    if (threadIdx.x == 0) (void)xb_add(&bar[XB_XCNT(b.x)], 1u);
    return b;
}
__device__ __forceinline__ void xcd_barrier_complete(unsigned* bar, unsigned x, unsigned& nloc, unsigned& nx) {
    const unsigned G = gridDim.x * gridDim.y * gridDim.z;
    unsigned sum, cnt, mine, sp = 0u;
    for (;;) {
        sum = 0u; cnt = 0u; mine = 0u;
#pragma unroll
        for (unsigned j = 0; j < 16; ++j) { const unsigned c = xb_ld(&bar[XB_XCNT(j)]); sum += c; cnt += (c > 0u) ? 1u : 0u; mine = (j == x) ? c : mine; }
        if (sum == G) break;
        __builtin_amdgcn_s_sleep(1);
        if ((++sp & 255u) == 0u) { if (xb_ld(&bar[XB_TMO])) break; if (sp > XB_SPIN_CAP) { atomicAdd(&bar[XB_TMO], 1u); break; } }
    }
    nloc = mine > 0u ? mine : 1u; nx = cnt > 0u ? cnt : 1u;
}

template <bool CENSUS> __device__ __forceinline__ void xcd_barrier(const XcdBarrier& b) {
    asm volatile("s_waitcnt vmcnt(0)" ::: "memory");
    __syncthreads();
    if (threadIdx.x == 0) {
        unsigned* bar = b.bar;
        __builtin_amdgcn_s_waitcnt(0);
        unsigned nloc = b.st[0], nx = b.st[1];
        if (CENSUS) { if (nloc == 0u) { xcd_barrier_complete(bar, b.x, nloc, nx); b.st[0] = nloc; b.st[1] = nx; } }
        const unsigned old = xb_add(&bar[XB_XSUB(b.x)], 1u);
        const unsigned gen = old / nloc;
        if (old + 1u == (gen + 1u) * nloc) {
            __builtin_amdgcn_fence(__ATOMIC_RELEASE, "agent");
            asm volatile("s_waitcnt vmcnt(0)" ::: "memory");
            const unsigned og = xb_add(&bar[XB_TOP], 1u);
            const unsigned tg = og / nx;
            if (og + 1u == (tg + 1u) * nx) xb_add(&bar[XB_TOPGEN], 1u);
            else XB_SPIN(xb_ld(&bar[XB_TOPGEN]) == tg, bar);
            __builtin_amdgcn_fence(__ATOMIC_ACQUIRE, "agent");
            xb_add(&bar[XB_XGEN(b.x)], 1u);
            asm volatile("s_waitcnt vmcnt(0)" ::: "memory");
        } else {
            XB_SPIN(xb_ld(&bar[XB_XGEN(b.x)]) == gen, bar);
            __builtin_amdgcn_fence(__ATOMIC_ACQUIRE, "agent");
            asm volatile("s_waitcnt vmcnt(0)" ::: "memory");
        }
    }
    __syncthreads();
}

struct Args { const float* in[N_IN]; float* out; unsigned char* ws; int ph_lo, ph_hi; };
#define CAS __attribute__((address_space(4)))
struct Frame {
    LAS unsigned char* lds;
    int tid, lane, wave, G;
    const CAS Args* ap;
    float* out; unsigned char* ws;
    __device__ __forceinline__ const float* inp(int i) const { return ap->in[i]; }
};
#define WSP(type, off) ((type*)(F.ws + (off)))

__device__ __forceinline__ void p0_transpose_item(const float* W, int Nsrc, bf16* dst, int ldo, LAS float* scr, int kb, int nb, int lane) {
    const int k0 = 64 * kb, n0 = 32 * nb, rsub = lane >> 3, c4 = lane & 7, nn = n0 + 4 * c4;
    f32x4 v[8];
#pragma unroll
    for (int i = 0; i < 8; ++i) v[i] = (nn < Nsrc) ? *(const f32x4*)(W + (size_t)(k0 + 8 * i + rsub) * Nsrc + nn) : (f32x4){0.f, 0.f, 0.f, 0.f};
#pragma unroll
    for (int i = 0; i < 8; ++i) { LAS float* d = scr + (8 * i + rsub) * 33 + 4 * c4; d[0] = v[i].x; d[1] = v[i].y; d[2] = v[i].z; d[3] = v[i].w; }
    LDS_WAIT(); asm volatile("" ::: "memory");
    const int c = lane & 7;
#pragma unroll
    for (int j = 0; j < 4; ++j) { const int n = (lane >> 3) + 8 * j; const LAS float* s = scr + (8 * c) * 33 + n;
        v4u o; o.x = pk2(s[0 * 33], s[1 * 33]); o.y = pk2(s[2 * 33], s[3 * 33]); o.z = pk2(s[4 * 33], s[5 * 33]); o.w = pk2(s[6 * 33], s[7 * 33]);
        *(v4u*)(dst + (size_t)(n0 + n) * ldo + k0 + 8 * c) = o; }
    LDS_WAIT(); asm volatile("" ::: "memory");
}
__device__ __forceinline__ void p0_tr_load(f32x4 (&v)[8], const float* W, int Nsrc, int kb, int nb, int lane) {
    const int k0 = 64 * kb, rsub = lane >> 3, nn = 32 * nb + 4 * (lane & 7);
#pragma unroll
    for (int i = 0; i < 8; ++i) v[i] = (nn < Nsrc) ? *(const f32x4*)(W + (size_t)(k0 + 8 * i + rsub) * Nsrc + nn) : (f32x4){0.f, 0.f, 0.f, 0.f};
}
__device__ __forceinline__ void p0_tr_store(const f32x4 (&v)[8], bf16* dst, int ldo, LAS float* scr, int kb, int nb, int lane) {
    const int k0 = 64 * kb, n0 = 32 * nb, rsub = lane >> 3, c4 = lane & 7;
#pragma unroll
    for (int i = 0; i < 8; ++i) { LAS float* d = scr + (8 * i + rsub) * 33 + 4 * c4; d[0] = v[i].x; d[1] = v[i].y; d[2] = v[i].z; d[3] = v[i].w; }
    LDS_WAIT(); asm volatile("" ::: "memory");
    const int c = lane & 7;
#pragma unroll
    for (int j = 0; j < 4; ++j) { const int n = (lane >> 3) + 8 * j; const LAS float* s = scr + (8 * c) * 33 + n;
        v4u o; o.x = pk2(s[0 * 33], s[1 * 33]); o.y = pk2(s[2 * 33], s[3 * 33]); o.z = pk2(s[4 * 33], s[5 * 33]); o.w = pk2(s[6 * 33], s[7 * 33]);
        *(v4u*)(dst + (size_t)(n0 + n) * ldo + k0 + 8 * c) = o; }
    LDS_WAIT(); asm volatile("" ::: "memory");
}
__device__ __forceinline__ void p0_transpose_job(Frame& F, const float* src, size_t sstride, int nmat, int K, int Nsrc, int Npad, bf16* dst, size_t dstride, int ldo) {
    LAS float* scr = (LAS float*)(F.lds + F.wave * 16384);
    const int gw = blockIdx.x * NWAVES + F.wave, NGW = F.G * NWAVES;
    const int nkb = K / 64, nnb = Npad / 32, per = nkb * nnb, tot = nmat * per;
    int it = gw;
    f32x4 v[8], vn[8];
    if (it < tot) { const int m = it / per, r = it % per; p0_tr_load(v, src + (size_t)m * sstride, Nsrc, r / nnb, r % nnb, F.lane); }
    while (it < tot) {
        const int nx = it + NGW;
        if (nx < tot) { const int m = nx / per, r = nx % per; p0_tr_load(vn, src + (size_t)m * sstride, Nsrc, r / nnb, r % nnb, F.lane); }
        { const int m = it / per, r = it % per; p0_tr_store(v, dst + (size_t)m * dstride, ldo, scr, r / nnb, r % nnb, F.lane); }
#pragma unroll
        for (int i = 0; i < 8; ++i) v[i] = vn[i];
        it = nx;
    }
}
__device__ __forceinline__ void ph_prologue(Frame& F) {
    {
        LAS float* sl = (LAS float*)(F.lds);
        LAS float* red = (LAS float*)(F.lds + 8192);
        const float* cin = F.inp(IN_C); const float* ada_w = F.inp(IN_ADAW); float* modp = WSP(float, WS_MODP);
        for (int u = blockIdx.x; u < 768; u += F.G) {
            const int l = u / 192, r = u % 192, ec = r >> 3, dc = r & 7;
            __syncthreads();
            for (int i = F.tid; i < 2048; i += 512) { const int rr = i >> 3, b = i & 7; const float v = cin[b * DM + dc * 256 + rr]; sl[rr * 8 + b] = v / (1.f + __expf(-v)); }
            __syncthreads();
            const int cq = F.tid & 127, dq = F.tid >> 7;
            f32x4 acc[8];
#pragma unroll
            for (int b = 0; b < 8; ++b) acc[b] = (f32x4){0.f, 0.f, 0.f, 0.f};
            const float* wp = ada_w + ((size_t)l * DM + dc * 256 + dq * 64) * MODW + ec * 512 + cq * 4;
#pragma unroll 8
            for (int i = 0; i < 64; ++i) {
                const f32x4 w = *(const f32x4*)(wp + (size_t)i * MODW);
                const f32x4 s0 = *(const LAS f32x4*)(sl + (dq * 64 + i) * 8), s1 = *(const LAS f32x4*)(sl + (dq * 64 + i) * 8 + 4);
                acc[0] += w * s0.x; acc[1] += w * s0.y; acc[2] += w * s0.z; acc[3] += w * s0.w;
                acc[4] += w * s1.x; acc[5] += w * s1.y; acc[6] += w * s1.z; acc[7] += w * s1.w;
            }
#pragma unroll
            for (int b = 0; b < 8; ++b) *(LAS f32x4*)(red + (dq * 8 + b) * 512 + cq * 4) = acc[b];
            __syncthreads();
            { const int b = F.tid >> 6, c0 = (F.tid & 63) * 8;
#pragma unroll
              for (int k = 0; k < 2; ++k) {
                  const f32x4 s = (*(const LAS f32x4*)(red + (0 * 8 + b) * 512 + c0 + 4 * k) + *(const LAS f32x4*)(red + (1 * 8 + b) * 512 + c0 + 4 * k))
                                + (*(const LAS f32x4*)(red + (2 * 8 + b) * 512 + c0 + 4 * k) + *(const LAS f32x4*)(red + (3 * 8 + b) * 512 + c0 + 4 * k));
                  *(f32x4*)(modp + (((size_t)dc * 4 + l) * 8 + b) * MODW + ec * 512 + c0 + 4 * k) = s; } }
        }
        __syncthreads();
    }
    {
        LAS float* Bs = (LAS float*)(F.lds);
        LAS float* As = (LAS float*)(F.lds + 256 * 132 * 4);
        const float* wqb = F.inp(IN_AWQB); const float* wuk = F.inp(IN_AWUK); bf16* wqc = WSP(bf16, WS_WQC);
        for (int u = blockIdx.x; u < 1024; u += F.G) {
            const int j = u >> 9, h = (u & 511) >> 4, rb = u & 15, r0 = rb * 32;
            __syncthreads();
            const float* bsrc = wuk + ((size_t)j * A_HEADS + h) * 256 * 128;
            for (int i = F.tid; i < 256 * 32; i += 512) { const int row = i >> 5, c4 = i & 31; *(LAS f32x4*)(Bs + row * 132 + c4 * 4) = *(const f32x4*)(bsrc + row * 128 + c4 * 4); }
            for (int i = F.tid; i < 32 * 32; i += 512) { const int row = i >> 5, c4 = i & 31; *(LAS f32x4*)(As + row * 128 + c4 * 4) = *(const f32x4*)(wqb + ((size_t)j * A_QR + r0 + row) * 4096 + h * 128 + c4 * 4); }
            __syncthreads();
            const int c = F.tid & 255, rh = F.tid >> 8;
            float acc[16];
#pragma unroll
            for (int q = 0; q < 16; ++q) acc[q] = 0.f;
            for (int d4 = 0; d4 < 32; ++d4) {
                const f32x4 bv = *(const LAS f32x4*)(Bs + c * 132 + d4 * 4);
#pragma unroll
                for (int q = 0; q < 16; ++q) { const f32x4 av = *(const LAS f32x4*)(As + (rh * 16 + q) * 128 + d4 * 4); acc[q] += (av.x * bv.x + av.y * bv.y) + (av.z * bv.z + av.w * bv.w); }
            }
            bf16* orow = wqc + ((size_t)j * 10240 + h * 256 + c) * 512 + r0 + rh * 16;
            v4u o0, o1;
            o0.x = pk2(acc[0], acc[1]); o0.y = pk2(acc[2], acc[3]); o0.z = pk2(acc[4], acc[5]); o0.w = pk2(acc[6], acc[7]);
            o1.x = pk2(acc[8], acc[9]); o1.y = pk2(acc[10], acc[11]); o1.z = pk2(acc[12], acc[13]); o1.w = pk2(acc[14], acc[15]);
            *(v4u*)(orow) = o0; *(v4u*)(orow + 8) = o1;
        }
        __syncthreads();
    }
    p0_transpose_job(F, F.inp(IN_AWIN), (size_t)DM * A_IN, 2, DM, A_IN, A_INP, WSP(bf16, WS_WAIN), (size_t)A_INP * DM, DM);
    p0_transpose_job(F, F.inp(IN_AWIQB), (size_t)A_QR * 2048, 2, A_QR, 2048, 2048, WSP(bf16, WS_WQC) + (size_t)8192 * 512, (size_t)10240 * 512, 512);
    p0_transpose_job(F, F.inp(IN_AWOUT), (size_t)4096 * DM, 2, 4096, DM, DM, WSP(bf16, WS_WAOUT), (size_t)DM * 4096, 4096);
    p0_transpose_job(F, F.inp(IN_BWIN), (size_t)DM * B_INC, 2, DM, B_INC, B_INC, WSP(bf16, WS_WBIN), (size_t)B_INC * DM, DM);
    p0_transpose_job(F, F.inp(IN_BWOUT), (size_t)DM * DM, 2, DM, DM, DM, WSP(bf16, WS_WBOUT), (size_t)DM * DM, DM);
    p0_transpose_job(F, F.inp(IN_W1), (size_t)DM * DFF, 4, DM, DFF, DFF, WSP(bf16, WS_WM1), (size_t)DFF * DM, DM);
    p0_transpose_job(F, F.inp(IN_W2), (size_t)DFF * DM, 4, DFF, DM, DM, WSP(bf16, WS_WM2), (size_t)DM * DFF, DFF);
    {
        LAS float* scr = (LAS float*)(F.lds + F.wave * 16384);
        const int gw = blockIdx.x * NWAVES + F.wave, NGW = F.G * NWAVES;
        const float* wuv = F.inp(IN_AWUV); bf16* d0 = WSP(bf16, WS_WUV);
        for (int it = gw; it < 64 * 16; it += NGW) {
            const int m = it >> 4, r = it & 15, j = m >> 5, h = m & 31;
            bf16* dst = d0 + (size_t)j * 4096 * 512 + (size_t)((h >> 1) * 256 + (h & 1) * 128) * 512 + (h & 1) * 256;
            p0_transpose_item(wuv + (size_t)m * 256 * 128, 128, dst, 512, scr, r >> 2, r & 3, F.lane);
        }
        const int gt = blockIdx.x * 512 + F.tid, NT = F.G * 512;
        for (int i = gt; i < 2 * 4096 * 32; i += NT) {
            const int row = i >> 5, ch = i & 31, hh = (row >> 7) & 1;
            *(v4u*)(d0 + (size_t)row * 512 + (1 - hh) * 256 + ch * 8) = (v4u){0u, 0u, 0u, 0u};
        }
    }
}
__device__ __forceinline__ void ph_modreduce(Frame& F) {
    const float* modp = WSP(float, WS_MODP); float* mod = WSP(float, WS_MOD); const float* ada_b = F.inp(IN_ADAB);
    const int gt = blockIdx.x * 512 + F.tid, NT = F.G * 512;
    for (int i = gt; i < DEPTH * BATCH * MODW / 4; i += NT) {
        const int e4 = i % (MODW / 4), lb = i / (MODW / 4), l = lb >> 3;
        f32x4 s = *(const f32x4*)(ada_b + (size_t)l * MODW + e4 * 4);
#pragma unroll
        for (int dc = 0; dc < 8; ++dc) s += *(const f32x4*)(modp + ((size_t)dc * 32 + lb) * MODW + e4 * 4);
        *(f32x4*)(mod + (size_t)lb * MODW + e4 * 4) = s;
    }
}

__device__ __forceinline__ void ph_post(Frame& F, const bf16* y, const void* xin_, bool xin_f32, void* xout_, bool xout_f32, const float* gate, const float* gy, bf16* hout, const float* gh, const float* shift, const float* scale) {
    LAS float* vec = (LAS float*)F.lds;
    const int rlo = (int)(((long long)blockIdx.x * T) / F.G), rhi = (int)(((long long)(blockIdx.x + 1) * T) / F.G);
    for (int seg = rlo; seg < rhi; ) {
        const int b = seg / SEQ; const int send = ((b + 1) * SEQ < rhi) ? (b + 1) * SEQ : rhi;
        __syncthreads();
        for (int i = F.tid; i < 5 * (DM / 4); i += NWAVES * 64) { const int v = i / (DM / 4), c4 = i % (DM / 4);
            const float* src = (v == 0) ? (y ? gate + (size_t)b * MODW : nullptr) : (v == 1) ? (y ? gy : nullptr) : (v == 2) ? (hout ? gh : nullptr) : (v == 3) ? (hout ? shift + (size_t)b * MODW : nullptr) : (hout ? scale + (size_t)b * MODW : nullptr);
            *(LAS f32x4*)(vec + v * DM + 4 * c4) = src ? *(const f32x4*)(src + 4 * c4) : (f32x4){0.f, 0.f, 0.f, 0.f}; }
        __syncthreads();
        constexpr int NR = 2;
        for (int r0 = seg + 2 * F.wave; r0 < send; r0 += NR * NWAVES) {
            const int r1 = (r0 + 1 < send) ? r0 + 1 : r0;
            int e0 = 4 * F.lane; asm volatile("" : "+v"(e0));
            f32x4 x[NR][8]; v2u yp[NR][8];
            if (xin_f32) { const float* xin = (const float*)xin_;
#pragma unroll
                for (int q = 0; q < NR; ++q) { const int row = q ? r1 : r0;
#pragma unroll
                    for (int j = 0; j < 8; ++j) x[q][j] = *(const f32x4*)(xin + (size_t)row * DM + e0 + 256 * j); }
                if (y) {
#pragma unroll
                    for (int q = 0; q < NR; ++q) { const int row = q ? r1 : r0;
#pragma unroll
                        for (int j = 0; j < 8; ++j) yp[q][j] = *(const v2u*)(y + (size_t)row * DM + e0 + 256 * j); } }
            } else { const bf16* xin = (const bf16*)xin_; v2u xp[NR][8];
#pragma unroll
                for (int q = 0; q < NR; ++q) { const int row = q ? r1 : r0;
#pragma unroll
                    for (int j = 0; j < 8; ++j) xp[q][j] = *(const v2u*)(xin + (size_t)row * DM + e0 + 256 * j); }
                if (y) {
#pragma unroll
                    for (int q = 0; q < NR; ++q) { const int row = q ? r1 : r0;
#pragma unroll
                        for (int j = 0; j < 8; ++j) yp[q][j] = *(const v2u*)(y + (size_t)row * DM + e0 + 256 * j); } }
#pragma unroll
                for (int q = 0; q < NR; ++q) {
#pragma unroll
                    for (int j = 0; j < 8; ++j) { const v2u p = xp[q][j]; x[q][j] = (f32x4){bflo(p.x), bfhi(p.x), bflo(p.y), bfhi(p.y)}; } }
            }
#pragma unroll
            for (int q = 0; q < NR; ++q) { const int row = q ? r1 : r0;
                if (y) {
                    f32x4 yv[8]; float ss = 0.f;
#pragma unroll
                    for (int j = 0; j < 8; ++j) { const v2u p = yp[q][j]; yv[j] = (f32x4){bflo(p.x), bfhi(p.x), bflo(p.y), bfhi(p.y)};
                        ss += (yv[j].x * yv[j].x + yv[j].y * yv[j].y) + (yv[j].z * yv[j].z + yv[j].w * yv[j].w); }
                    const float ry = 1.0f / sqrtf(wave_sum(ss, F.lane) * (1.f / DM) + RMS_EPS);
#pragma unroll
                    for (int j = 0; j < 8; ++j) { const f32x4 g = *(const LAS f32x4*)(vec + 1 * DM + e0 + 256 * j), gt = *(const LAS f32x4*)(vec + 0 * DM + e0 + 256 * j);
                        x[q][j] += gt * (yv[j] * ry * g); }
                    if (xout_f32) { float* xout = (float*)xout_;
#pragma unroll
                        for (int j = 0; j < 8; ++j) *(f32x4*)(xout + (size_t)row * DM + e0 + 256 * j) = x[q][j];
                    } else { bf16* xout = (bf16*)xout_;
#pragma unroll
                        for (int j = 0; j < 8; ++j) { v2u o; o.x = pk2(x[q][j].x, x[q][j].y); o.y = pk2(x[q][j].z, x[q][j].w); *(v2u*)(xout + (size_t)row * DM + e0 + 256 * j) = o; } }
                }
                if (hout) {
                    float ss = 0.f;
#pragma unroll
                    for (int j = 0; j < 8; ++j) ss += (x[q][j].x * x[q][j].x + x[q][j].y * x[q][j].y) + (x[q][j].z * x[q][j].z + x[q][j].w * x[q][j].w);
                    const float rx = 1.0f / sqrtf(wave_sum(ss, F.lane) * (1.f / DM) + RMS_EPS);
#pragma unroll
                    for (int j = 0; j < 8; ++j) { const f32x4 g = *(const LAS f32x4*)(vec + 2 * DM + e0 + 256 * j), sh = *(const LAS f32x4*)(vec + 3 * DM + e0 + 256 * j), sc = *(const LAS f32x4*)(vec + 4 * DM + e0 + 256 * j);
                        const f32x4 hv = (x[q][j] * rx * g) * (sc + 1.0f) + sh;
                        v2u o; o.x = pk2(hv.x, hv.y); o.y = pk2(hv.z, hv.w);
                        *(v2u*)(hout + (size_t)row * DM + e0 + 256 * j) = o; }
                }
            }
        }
        seg = send;
    }
}
__device__ __forceinline__ void ph_dsa_norm(Frame& F, const float* proj, const float* qn, const float* kvn, const float* ikn, bf16* qlat, bf16* ckv, bf16* kidx, float* widx) {
    const int gw = blockIdx.x * NWAVES + F.wave, NGW = F.G * NWAVES; const int e0 = 4 * F.lane;
    for (int row = gw; row < T; row += NGW) {
        f32x4 v[4];
#pragma unroll
        for (int j = 0; j < 4; ++j) v[j] = *(const f32x4*)(proj + (size_t)row * A_INP + e0 + 256 * j);
        float sq = 0.f;
#pragma unroll
        for (int j = 0; j < 2; ++j) sq += (v[j].x * v[j].x + v[j].y * v[j].y) + (v[j].z * v[j].z + v[j].w * v[j].w);
        const float rq = 1.0f / sqrtf(wave_sum(sq, F.lane) * (1.f / A_QR) + RMS_EPS);
#pragma unroll
        for (int j = 0; j < 2; ++j) { const f32x4 g = *(const f32x4*)(qn + e0 + 256 * j); const f32x4 o = v[j] * rq * g; v2u w; w.x = pk2(o.x, o.y); w.y = pk2(o.z, o.w);
            *(v2u*)(qlat + (size_t)row * A_QR + e0 + 256 * j) = w; }
        const float skv = (v[2].x * v[2].x + v[2].y * v[2].y) + (v[2].z * v[2].z + v[2].w * v[2].w);
        const float rkv = 1.0f / sqrtf(wave_sum(skv, F.lane) * (1.f / A_KVR) + RMS_EPS);
        { const f32x4 g = *(const f32x4*)(kvn + e0); const f32x4 o = v[2] * rkv * g; v2u w; w.x = pk2(o.x, o.y); w.y = pk2(o.z, o.w); *(v2u*)(ckv + (size_t)row * A_KVR + e0) = w; }
        const bool isk = F.lane < 32;
        const float s1 = isk ? (v[3].x + v[3].y) + (v[3].z + v[3].w) : 0.f;
        const float mean = wave_sum(s1, F.lane) * (1.f / IDX_D);
        const f32x4 dv = v[3] - mean;
        const float s2 = isk ? (dv.x * dv.x + dv.y * dv.y) + (dv.z * dv.z + dv.w * dv.w) : 0.f;
        const float rk = 1.0f / sqrtf(wave_sum(s2, F.lane) * (1.f / IDX_D) + RMS_EPS);
        if (isk) { const f32x4 g = *(const f32x4*)(ikn + e0); const f32x4 o = dv * rk * g; v2u w; w.x = pk2(o.x, o.y); w.y = pk2(o.z, o.w); *(v2u*)(kidx + (size_t)row * IDX_D + e0) = w; }
        else if (F.lane < 36) { *(f32x4*)(widx + (size_t)row * IDX_H + (e0 - 128)) = v[3] * 0.02209708691207961f; }
    }
}

__device__ __forceinline__ int wave_scan_incl(int v, int lane, int& total) {
    v += __builtin_amdgcn_update_dpp(0, v, 0x111, 0xf, 0xf, true); v += __builtin_amdgcn_update_dpp(0, v, 0x112, 0xf, 0xf, true);
    v += __builtin_amdgcn_update_dpp(0, v, 0x114, 0xf, 0xf, true); v += __builtin_amdgcn_update_dpp(0, v, 0x118, 0xf, 0xf, true);
    const int t0 = __builtin_amdgcn_readlane(v, 15), t1 = __builtin_amdgcn_readlane(v, 31), t2 = __builtin_amdgcn_readlane(v, 47), t3 = __builtin_amdgcn_readlane(v, 63);
    v += (lane >= 16 ? t0 : 0) + (lane >= 32 ? t1 : 0) + (lane >= 48 ? t2 : 0);
    total = (t0 + t1) + (t2 + t3);
    return v;
}
template <bool G, class SP> __device__ __forceinline__ void topk_select_row(SP sc, int t, int* out, int lane, LAS int* lst) {
    const int n = t + 1;
    if (n <= TOPK) { for (int i = lane; i < TOPK; i += 64) out[i] = (i < n) ? i : 0; return; }
    const int ni = G ? 2 * ((n + 127) >> 7) : (n + 63) >> 6;
#define TOPK_KEYIDX(i) (G ? 128 * ((i) >> 1) + 2 * lane + ((i) & 1) : 64 * (i) + lane)
    unsigned key[64];
#pragma unroll
    for (int g = 0; g < 8; ++g) {
        if (8 * g < ni) {
            if constexpr (G) {
#pragma unroll
                for (int j = 4 * g; j < 4 * g + 4; ++j) { const unsigned d = __hip_atomic_load((const unsigned*)sc + 64 * j + lane, __ATOMIC_RELAXED, __HIP_MEMORY_SCOPE_AGENT);
#pragma unroll
                    for (int e = 0; e < 2; ++e) { const int s = 128 * j + 2 * lane + e; const unsigned h = e ? (d >> 16) : (d & 0xffffu); const unsigned k = (h & 0x8000u) ? (~h & 0xffffu) : (h | 0x8000u); key[2 * j + e] = (s < n) ? k : 0u; } }
            } else {
#pragma unroll
                for (int i = 8 * g; i < 8 * g + 8; ++i) { const int s = 64 * i + lane; const unsigned h = sc[s < n ? s : n - 1]; const unsigned k = (h & 0x8000u) ? (~h & 0xffffu) : (h | 0x8000u); key[i] = (s < n) ? k : 0u; }
            }
        } else {
#pragma unroll
            for (int i = 8 * g; i < 8 * g + 8; ++i) key[i] = 0u;
        }
    }
    unsigned prefix = 0u;
    for (int bit = 15; bit >= 0; --bit) {
        const unsigned cand = prefix | (1u << bit); int cl = 0;
#pragma unroll
        for (int g = 0; g < 8; ++g) if (8 * g < ni) {
#pragma unroll
            for (int i = 8 * g; i < 8 * g + 8; ++i) cl += (key[i] >= cand) ? 1 : 0; }
        cl += __builtin_amdgcn_update_dpp(0, cl, 0xB1, 0xf, 0xf, true); cl += __builtin_amdgcn_update_dpp(0, cl, 0x4E, 0xf, 0xf, true);
        cl += __builtin_amdgcn_update_dpp(0, cl, 0x124, 0xf, 0xf, true); cl += __builtin_amdgcn_update_dpp(0, cl, 0x128, 0xf, 0xf, true);
        const int cnt = (__builtin_amdgcn_readlane(cl, 0) + __builtin_amdgcn_readlane(cl, 16)) + (__builtin_amdgcn_readlane(cl, 32) + __builtin_amdgcn_readlane(cl, 48));
        if (cnt >= TOPK) prefix = cand;
    }
    int cg = 0, ce = 0;
#pragma unroll
    for (int g = 0; g < 8; ++g) if (8 * g < ni) {
#pragma unroll
        for (int i = 8 * g; i < 8 * g + 8; ++i) { cg += (key[i] > prefix) ? 1 : 0; ce += (key[i] == prefix) ? 1 : 0; } }
    int tg, te;
    const int bg = wave_scan_incl(cg, lane, tg) - cg, be = wave_scan_incl(ce, lane, te) - ce;
    int quota = (TOPK - tg) - be; quota = quota < 0 ? 0 : (quota > ce ? ce : quota);
    int pg = bg, pe = tg + (be < TOPK - tg ? be : TOPK - tg);
    const int dummy = TOPK + lane;
#pragma unroll
    for (int g = 0; g < 8; ++g) if (8 * g < ni) {
#pragma unroll
        for (int i = 8 * g; i < 8 * g + 8; ++i) {
            const bool gt = key[i] > prefix, eq = (key[i] == prefix) && (quota > 0);
            const int pos = gt ? pg : (eq ? pe : dummy);
            lst[pos] = TOPK_KEYIDX(i);
            pg += gt ? 1 : 0; pe += eq ? 1 : 0; quota -= eq ? 1 : 0;
        } }
    asm volatile("s_waitcnt lgkmcnt(0)" ::: "memory");
    *(v4u*)(out + 4 * lane) = *(const LAS v4u*)(lst + 4 * lane);
#undef TOPK_KEYIDX
}
template <class SP> __device__ __forceinline__ void topk_select_planes(SP sc, int t, int* out, int lane, LAS int* lst) {
    const int n = t + 1;
    if (n <= TOPK) { for (int i = lane; i < TOPK; i += 64) out[i] = (i < n) ? i : 0; return; }
    typedef short s16x2_ __attribute__((ext_vector_type(2)));
    unsigned W[32];
#pragma unroll
    for (int j = 0; j < 32; ++j) { const unsigned h2 = (unsigned)sc[128 * j + lane] | ((unsigned)sc[128 * j + 64 + lane] << 16);
        const s16x2_ sg = __builtin_bit_cast(s16x2_, h2) >> (s16x2_){15, 15};
        W[j] = h2 ^ (__builtin_bit_cast(unsigned, sg) | 0x80008000u); }
    {
        unsigned ml = 0x0000ffffu;
#pragma unroll
        for (int j = 16; j != 0; j >>= 1) { const unsigned mh = ml << j;
#pragma unroll
            for (int k = 0; k < 32; k = (k + j + 1) & ~j) { const unsigned a = W[k], b = W[k + j];
                W[k] = (a & ~mh) | ((b << j) & mh); W[k + j] = (b & ~ml) | ((a >> j) & ml); }
            ml ^= ml << (j >> 1); }
    }
    const int c = (n - lane + 63) >> 6;
    const int ce_ = (c + 1) >> 1, co_ = c >> 1;
    unsigned aE = ce_ >= 32 ? 0xffffffffu : ((1u << ce_) - 1u), aO = co_ >= 32 ? 0xffffffffu : ((1u << co_) - 1u);
    unsigned gE = 0u, gO = 0u; int cnt_gt = 0;
#pragma unroll
    for (int b = 15; b >= 0; --b) {
        const unsigned cE = aE & W[b], cO = aO & W[16 + b];
        int cl = __builtin_popcount(cE) + __builtin_popcount(cO);
        cl += __builtin_amdgcn_update_dpp(0, cl, 0xB1, 0xf, 0xf, true); cl += __builtin_amdgcn_update_dpp(0, cl, 0x4E, 0xf, 0xf, true);
        cl += __builtin_amdgcn_update_dpp(0, cl, 0x124, 0xf, 0xf, true); cl += __builtin_amdgcn_update_dpp(0, cl, 0x128, 0xf, 0xf, true);
        const int cnt = (__builtin_amdgcn_readlane(cl, 0) + __builtin_amdgcn_readlane(cl, 16)) + (__builtin_amdgcn_readlane(cl, 32) + __builtin_amdgcn_readlane(cl, 48));
        const bool take = (cnt_gt + cnt >= TOPK);
        gE = take ? gE : (gE | cE); gO = take ? gO : (gO | cO);
        aE = take ? cE : (aE ^ cE); aO = take ? cO : (aO ^ cO);
        cnt_gt += take ? 0 : cnt;
    }
    const int cg = __builtin_popcount(gE) + __builtin_popcount(gO), ce = __builtin_popcount(aE) + __builtin_popcount(aO);
    int tg, te;
    const int bg = wave_scan_incl(cg, lane, tg) - cg, be = wave_scan_incl(ce, lane, te) - ce;
    int quota = (TOPK - tg) - be; quota = quota < 0 ? 0 : (quota > ce ? ce : quota);
    int pg = bg, pe = tg + (be < TOPK - tg ? be : TOPK - tg);
    for (unsigned m = gE; m; m &= m - 1u) lst[pg++] = 128 * __builtin_ctz(m) + lane;
    for (unsigned m = gO; m; m &= m - 1u) lst[pg++] = 128 * __builtin_ctz(m) + 64 + lane;
    for (unsigned m = aE; m && quota > 0; m &= m - 1u, --quota) lst[pe++] = 128 * __builtin_ctz(m) + lane;
    for (unsigned m = aO; m && quota > 0; m &= m - 1u, --quota) lst[pe++] = 128 * __builtin_ctz(m) + 64 + lane;
    asm volatile("s_waitcnt lgkmcnt(0)" ::: "memory");
    *(v4u*)(out + 4 * lane) = *(const LAS v4u*)(lst + 4 * lane);
}
__device__ __forceinline__ int t5_bucket(int d) {
    if (d < 16) return d;
    int bkt = 16;
    bkt += (d >= 19) + (d >= 21) + (d >= 24) + (d >= 27) + (d >= 31) + (d >= 35) + (d >= 40) + (d >= 46) + (d >= 52) + (d >= 59) + (d >= 67) + (d >= 77) + (d >= 87) + (d >= 99) + (d >= 113);
    return bkt;
}

typedef short bf16x8 __attribute__((ext_vector_type(8)));
typedef short s16x4 __attribute__((ext_vector_type(4)));
typedef float f32x16 __attribute__((ext_vector_type(16)));
__device__ __forceinline__ unsigned offb(unsigned row, unsigned ch) { return 256u * row + 16u * (ch ^ (((row & 3u) << 2) | ((row >> 2) & 3u))); }
__device__ __forceinline__ unsigned tr_base_perm(unsigned lane, unsigned c, unsigned t) {
    const unsigned h = lane >> 5, blk = (lane >> 4) & 1u, q = (lane & 15u) >> 2, p = lane & 3u;
    return offb(8u * t + 4u * h + q, 4u * c + 2u * blk + (p >> 1)) + 8u * (p & 1u);
}
__device__ __forceinline__ bf16x8 tr_frag_at(LAS unsigned char* img, unsigned b0, unsigned b1, unsigned ks) {
    const s16x4 lo = __builtin_amdgcn_ds_read_tr16_b64_v4i16((LAS s16x4*)(img + b0 + 4096u * ks));
    const s16x4 hi = __builtin_amdgcn_ds_read_tr16_b64_v4i16((LAS s16x4*)(img + b1 + 4096u * ks));
    return __builtin_shufflevector(lo, hi, 0, 1, 2, 3, 4, 5, 6, 7);
}

__device__ __forceinline__ void ph_indexer(Frame& F, const bf16* qidx, const bf16* kidx, const float* widx, int* idxo) {
    constexpr int NQ = 8;
    LAS unsigned short* sc = (LAS unsigned short*)(F.lds);
    LAS float* wsh = (LAS float*)(F.lds + 65536);
    LAS unsigned char* ring = F.lds + 66560;
    const int r = F.lane & 31, hf = F.lane >> 5, rp = F.wave & 1, kq = F.wave >> 1;
    const int drow = 4 * F.wave + (F.lane >> 4), dch = (F.lane & 15) ^ (((F.lane >> 4) << 2) | (F.wave & 3));
    for (int u = blockIdx.x; u < BATCH * (SEQ / NQ); u += F.G) {
        const int b = u & 7, t0 = (u >> 3) * NQ;
        const int nt = (t0 + NQ + 31) >> 5, ns = (nt + 3) >> 2;
        const bf16* kbase = kidx + (size_t)(b * SEQ + drow) * IDX_D + dch * 8;
        __syncthreads();
#pragma unroll
        for (int j = 0; j < 4; ++j) __builtin_amdgcn_global_load_lds((const unsigned*)(kbase + (size_t)(j * 32) * IDX_D), (LAS unsigned*)(ring + j * 8192 + F.wave * 1024), 16, 0, 0);
        if (F.tid < NQ * 16) wsh[F.tid] = widx[(size_t)(b * SEQ + t0 + (F.tid >> 4)) * IDX_H + (F.tid & 15)];
        { const bf16* qb = qidx + (size_t)(b * SEQ + t0 + ((drow >> 2) & 1)) * 2048 + (4 * (drow >> 3) + (drow & 3)) * 128 + dch * 8;
#pragma unroll
          for (int j = 0; j < 4; ++j) __builtin_amdgcn_global_load_lds((const unsigned*)(qb + (size_t)(2 * j) * 2048), (LAS unsigned*)(ring + 32768 + j * 8192 + F.wave * 1024), 16, 0, 0); }
        bf16x8 Af[2][8];
        for (int s = 0; s < ns; ++s) {
            asm volatile("s_waitcnt vmcnt(0) lgkmcnt(0)" ::: "memory"); __builtin_amdgcn_s_barrier(); asm volatile("" ::: "memory");
            if (s == 0) {
#pragma unroll
                for (int rt = 0; rt < 2; ++rt)
#pragma unroll
                    for (int ks = 0; ks < 8; ++ks) Af[rt][ks] = *(const LAS bf16x8*)(ring + 32768 + (2 * rp + rt) * 8192 + offb((unsigned)r, (unsigned)(2 * ks + hf)));
                asm volatile("s_waitcnt lgkmcnt(0)" ::: "memory"); __builtin_amdgcn_s_barrier(); asm volatile("" ::: "memory");
            }
            if (s + 1 < ns) {
#pragma unroll
                for (int j = 0; j < 4; ++j) __builtin_amdgcn_global_load_lds((const unsigned*)(kbase + (size_t)((4 * (s + 1) + j) * 32) * IDX_D), (LAS unsigned*)(ring + ((s + 1) & 1) * 32768 + j * 8192 + F.wave * 1024), 16, 0, 0);
            }
            const int kt = 4 * s + kq;
            if (kt < nt) {
                LAS unsigned char* tile = ring + (s & 1) * 32768 + kq * 8192;
                bf16x8 Bf[8];
#pragma unroll
                for (int ks = 0; ks < 8; ++ks) Bf[ks] = *(const LAS bf16x8*)(tile + offb((unsigned)r, (unsigned)(2 * ks + hf)));
#pragma unroll
                for (int rt = 0; rt < 2; ++rt) {
                    f32x16 acc;
#pragma unroll
                    for (int i = 0; i < 16; ++i) acc[i] = 0.f;
#pragma unroll
                    for (int ks = 0; ks < 8; ++ks) acc = __builtin_amdgcn_mfma_f32_32x32x16_bf16(Af[rt][ks], Bf[ks], acc, 0, 0, 0);
                    float s0 = 0.f, s1 = 0.f;
#pragma unroll
                    for (int i4 = 0; i4 < 4; ++i4) { const f32x4 w4 = *(const LAS f32x4*)(wsh + (4 * rp + 2 * rt + hf) * 16 + 4 * i4);
                        s0 += w4.x * fmaxf(acc[4 * i4], 0.f) + w4.z * fmaxf(acc[4 * i4 + 2], 0.f); s1 += w4.y * fmaxf(acc[4 * i4 + 1], 0.f) + w4.w * fmaxf(acc[4 * i4 + 3], 0.f); }
                    sc[(4 * rp + 2 * rt + hf) * 4096 + kt * 32 + r] = __builtin_bit_cast(unsigned short, (_Float16)(s0 + s1));
                }
            }
        }
        __syncthreads();
        for (int q = F.wave; q < NQ; q += NWAVES) topk_select_planes(sc + q * 4096, t0 + q, idxo + (size_t)(b * SEQ + t0 + q) * TOPK, F.lane, (LAS int*)(F.lds + 132096) + F.wave * 320);
    }
}

#define LDS_BARRIER() do { asm volatile("s_waitcnt lgkmcnt(0)" ::: "memory"); __builtin_amdgcn_s_barrier(); asm volatile("" ::: "memory"); } while (0)
__device__ __forceinline__ int relane(int lane) { asm volatile("" : "+v"(lane)); return lane; }
__device__ __forceinline__ void ph_sparse_attn(Frame& F, bf16* qa_olat, const bf16* ckv, const int* idxi, const float* relb) {
    LAS unsigned char* KV = F.lds;
    LAS unsigned char* PF = F.lds + 131072;
    LAS float* wmax = (LAS float*)(F.lds + 147456);
    LAS float* wsum = wmax + 256;
    LAS unsigned char* bks = F.lds + 147456 + 2048;
    LAS float* relbs = (LAS float*)(F.lds + 147456 + 2048 + 512);
    LAS float* invw = (LAS float*)(F.lds + 147456 + 2048 + 512 + 4224);
    LAS unsigned char* blut = F.lds + 147456 + 2048 + 512 + 4224 + 1024;
    const float scale = 0.08838834764831845f;
    const int w = F.wave;
    __syncthreads();
    for (int i = F.tid; i < 1024; i += 512) relbs[i] = relb[i];
    if (F.tid < 32) relbs[1024 + F.tid] = -INFINITY;
    if (F.tid < 128) blut[F.tid] = (unsigned char)t5_bucket(F.tid);
    int u = blockIdx.x;
    if (u >= T) return;
    int idc[16]; int bid; v4u R[16]; v4u Qr[2];
    {
        const int cc = F.lane & 31, r = F.lane & 31, hf = F.lane >> 5;
        const int t = u % SEQ, b = u / SEQ;
        const int* ip = idxi + (size_t)u * TOPK + 32 * w + hf;
#pragma unroll
        for (int k = 0; k < 16; ++k) idc[k] = ip[2 * k];
        const bf16* kb = ckv + (size_t)b * SEQ * A_KVR + cc * 8;
#pragma unroll
        for (int k = 0; k < 16; ++k) R[k] = *(const v4u*)(kb + (size_t)idc[k] * A_KVR);
        if (F.tid < 256) { const int id = idxi[(size_t)u * TOPK + F.tid]; const int d = t - id; bks[F.tid] = (F.tid <= t) ? (unsigned char)t5_bucket(d > 0 ? d : 0) : (unsigned char)32; }
        const int u2 = (u + F.G < T) ? u + F.G : u;
        const int* ip2 = idxi + (size_t)u2 * TOPK + 32 * w + hf;
#pragma unroll
        for (int k = 0; k < 16; ++k) idc[k] = ip2[2 * k];
        bid = (F.tid < 256) ? idxi[(size_t)u2 * TOPK + F.tid] : -1;
        { const v4u* qp = (const v4u*)(qa_olat + (size_t)u * A_HEADS * A_KVR);
#pragma unroll
          for (int j = 0; j < 2; ++j) { const int id = 2 * w + j, head = 8 * (id & 3) + (F.lane & 7), pos = 8 * (id >> 2) + (F.lane >> 3); Qr[j] = qp[head * 32 + pos]; } }
    }
    unsigned wro[16], qwo[2], trb[2];
    { const unsigned r0 = F.lane & 31, hf0 = F.lane >> 5; const unsigned c0 = (r0 & 15u) ^ (4u * hf0);
#pragma unroll
      for (int k = 0; k < 16; ++k) wro[k] = (r0 >> 4) * 65536u + 256u * (32u * w + hf0) + 512u * k + 16u * (c0 ^ (unsigned)(8 * (k & 1) + ((k >> 1) & 3)));
#pragma unroll
      for (int j = 0; j < 2; ++j) { const int id = 2 * w + j, head = 8 * (id & 3) + (F.lane & 7), pos = 8 * (id >> 2) + (F.lane >> 3); qwo[j] = (pos >> 1) * 1024 + ((pos & 1) * 32 + head) * 16; }
      trb[0] = tr_base_perm((unsigned)F.lane, (unsigned)(w & 3), 0u); trb[1] = tr_base_perm((unsigned)F.lane, (unsigned)(w & 3), 1u); }
    unsigned rdo[16];
    { const unsigned r0 = F.lane & 31, hf0 = F.lane >> 5, row = 32u * w + r0, xr = ((row & 3u) << 2) | ((row >> 2) & 3u);
#pragma unroll
      for (int ks = 0; ks < 16; ++ks) rdo[ks] = 256u * row + (ks >> 3) * 65536u + 16u * ((unsigned)(2 * (ks & 7) + hf0) ^ xr); }
    for (int it = 0; u < T; u += F.G, ++it) {
        const int un = u + F.G, unn = u + 2 * F.G, par = it & 1;
        LDS_BARRIER();
        const int l2 = relane(F.lane), r = l2 & 31, hf = l2 >> 5;
        {
#pragma unroll
          for (int k = 0; k < 16; ++k) *(LAS v4u*)(KV + wro[k]) = R[k]; }
        *(LAS v4u*)(PF + qwo[0]) = Qr[0]; *(LAS v4u*)(PF + qwo[1]) = Qr[1];
        LDS_BARRIER();
        const int tid1 = w * 64 + l2;
        const int unb = (un < T) ? un : u; const int bn = unb / SEQ, tn = unb % SEQ;
        const bf16* kbn = ckv + (size_t)bn * SEQ * A_KVR + r * 8;
        f32x16 acc;
#pragma unroll
        for (int i = 0; i < 16; ++i) acc[i] = 0.f;
        {
#pragma unroll
          for (int ks = 0; ks < 16; ++ks) { const bf16x8 a = *(const LAS bf16x8*)(KV + rdo[ks]);
              acc = __builtin_amdgcn_mfma_f32_32x32x16_bf16(a, *(const LAS bf16x8*)(PF + ks * 1024 + l2 * 16), acc, 0, 0, 0);
              R[ks] = *(const v4u*)(kbn + (size_t)idc[ks] * A_KVR); } }
        if (tid1 < 256) { int d = tn - bid; d = d < 0 ? 0 : (d > 127 ? 127 : d); bks[(par ^ 1) * 256 + tid1] = (tid1 <= tn) ? blut[d] : (unsigned char)32; }
        { const v4u* qp = (const v4u*)(qa_olat + (size_t)unb * A_HEADS * A_KVR);
#pragma unroll
          for (int j = 0; j < 2; ++j) { const int id = 2 * w + j, head = 8 * (id & 3) + (l2 & 7), pos = 8 * (id >> 2) + (l2 >> 3); Qr[j] = qp[head * 32 + pos]; } }
        float lg[16]; float m = -INFINITY;
#pragma unroll
        for (int g = 0; g < 4; ++g) { const unsigned b4 = *(const LAS unsigned*)(bks + par * 256 + 32 * w + 8 * g + 4 * hf);
#pragma unroll
            for (int j = 0; j < 4; ++j) { const unsigned bk = (b4 >> (8 * j)) & 255u; const int i = 4 * g + j;
                lg[i] = acc[i] * scale + relbs[bk * 32 + r]; m = fmaxf(m, lg[i]); } }
        m = fmaxf(m, shx(m, 32, l2));
        if (hf == 0) wmax[r * 8 + w] = m;
        LDS_BARRIER();
        { const f32x4 m0 = *(const LAS f32x4*)(wmax + r * 8), m1 = *(const LAS f32x4*)(wmax + r * 8 + 4);
          m = fmaxf(fmaxf(fmaxf(m0.x, m0.y), fmaxf(m0.z, m0.w)), fmaxf(fmaxf(m1.x, m1.y), fmaxf(m1.z, m1.w))); }
        float s = 0.f;
#pragma unroll
        for (int i = 0; i < 16; ++i) { lg[i] = __expf(lg[i] - m); s += lg[i]; }
        s += shx(s, 32, l2);
        if (hf == 0) wsum[r * 8 + w] = s;
#pragma unroll
        for (int s2 = 0; s2 < 2; ++s2) { v4u pk; pk.x = pk2(lg[8 * s2 + 0], lg[8 * s2 + 1]); pk.y = pk2(lg[8 * s2 + 2], lg[8 * s2 + 3]); pk.z = pk2(lg[8 * s2 + 4], lg[8 * s2 + 5]); pk.w = pk2(lg[8 * s2 + 6], lg[8 * s2 + 7]);
            *(LAS v4u*)(PF + (2 * w + s2) * 1024 + l2 * 16) = pk; }
        LDS_BARRIER();
        const int l3 = relane(F.lane), r3 = l3 & 31, hf3 = l3 >> 5;
        if (hf3 == 0) { const f32x4 s0 = *(const LAS f32x4*)(wsum + r3 * 8), s1 = *(const LAS f32x4*)(wsum + r3 * 8 + 4);
            invw[w * 32 + r3] = 1.0f / (((s0.x + s0.y) + (s0.z + s0.w)) + ((s1.x + s1.y) + (s1.z + s1.w))); }
        f32x16 o;
#pragma unroll
        for (int i = 0; i < 16; ++i) o[i] = 0.f;
        LAS unsigned char* img = KV + (w >> 2) * 65536;
        const int unc = (unn < T) ? unn : u;
        const int* ip2 = idxi + (size_t)unc * TOPK + 32 * w + hf3;
        const unsigned tb0 = trb[0], tb1 = trb[1];
#pragma unroll
        for (int ks = 0; ks < 16; ++ks) { const bf16x8 a = *(const LAS bf16x8*)(PF + ks * 1024 + l3 * 16);
            const bf16x8 bb = tr_frag_at(img, tb0, tb1, (unsigned)ks);
            o = __builtin_amdgcn_mfma_f32_32x32x16_bf16(a, bb, o, 0, 0, 0);
            idc[ks] = ip2[2 * ks]; }
        if (w * 64 + l3 < 256) bid = idxi[(size_t)unc * TOPK + w * 64 + l3];
        bf16* op = qa_olat + ((size_t)u * A_HEADS + 4 * hf3) * A_KVR + 32 * w + r3;
#pragma unroll
        for (int g = 0; g < 4; ++g) { const f32x4 iv = *(const LAS f32x4*)(invw + w * 32 + 8 * g + 4 * hf3);
            op[(8 * g + 0) * A_KVR] = (bf16)f2bf(o[4 * g + 0] * iv.x); op[(8 * g + 1) * A_KVR] = (bf16)f2bf(o[4 * g + 1] * iv.y);
            op[(8 * g + 2) * A_KVR] = (bf16)f2bf(o[4 * g + 2] * iv.z); op[(8 * g + 3) * A_KVR] = (bf16)f2bf(o[4 * g + 3] * iv.w); }
    }
}

__device__ __forceinline__ void ph_sb_attn(Frame& F, const bf16* qkv, bf16* o_out, unsigned* qctr) {
    LAS unsigned char* img = F.lds + F.wave * 8192;
    LAS unsigned char* qimg = F.lds + 65536 + F.wave * 8192;
    const int r = F.lane & 31, hf = F.lane >> 5;
    const float scale = 0.08838834764831845f;
    constexpr int NTASK8 = BATCH * B_HEADS * (SEQ / 32) / 8;
    const int myx = (int)(xb_xcc_id() & 7u);
    for (int qi = 0; qi < 8; ++qi) { const int qsel = (myx + qi) & 7;
    for (;;) {
        int task = 0;
        if (F.lane == 0) task = (int)__hip_atomic_fetch_add(qctr + 64 * qsel, 1u, __ATOMIC_RELAXED, __HIP_MEMORY_SCOPE_AGENT);
        task = __builtin_amdgcn_readfirstlane(task);
        if (task >= NTASK8) break;
        task += qsel * NTASK8;
        const int qt = task & 127, bh = task >> 7, h = bh & 15, b = bh >> 4, t0 = qt * 32;
        v4u Kr[8], Vr[8];
#pragma unroll
        for (int k = 0; k < 8; ++k) { const int n = F.lane + 64 * k; *(LAS v4u*)(qimg + offb(n >> 4, n & 15)) = *(const v4u*)(qkv + (size_t)(b * SEQ + t0 + (n >> 4)) * B_INC + h * B_HD + (n & 15) * 8); }
        {
#pragma unroll
          for (int k = 0; k < 8; ++k) { const int n = F.lane + 64 * k; const bf16* rp = qkv + (size_t)(b * SEQ + qt * 32 + (n >> 4)) * B_INC + h * B_HD + (n & 15) * 8; Kr[k] = *(const v4u*)(rp + DM); Vr[k] = *(const v4u*)(rp + 2 * DM); } }
        f32x16 o[4];
#pragma unroll
        for (int dt = 0; dt < 4; ++dt)
#pragma unroll
            for (int i = 0; i < 16; ++i) o[dt][i] = 0.f;
        float Rc = 1.f;
        for (int kt = qt; kt >= 0; --kt) {
            const int ll = relane(F.lane), r = ll & 31, hf = ll >> 5;
#pragma unroll
            for (int k = 0; k < 8; ++k) { const int n = ll + 64 * k; *(LAS v4u*)(img + offb(n >> 4, n & 15)) = Kr[k]; }
            f32x16 acc;
#pragma unroll
            for (int i = 0; i < 16; ++i) acc[i] = 0.f;
#pragma unroll
            for (int ks = 0; ks < 8; ++ks) acc = __builtin_amdgcn_mfma_f32_32x32x16_bf16(*(const LAS bf16x8*)(img + offb(r, 2 * ks + hf)), *(const LAS bf16x8*)(qimg + offb(r, 2 * ks + hf)), acc, 0, 0, 0);
            asm volatile("s_waitcnt lgkmcnt(0)" ::: "memory");
#pragma unroll
            for (int k = 0; k < 8; ++k) { const int n = ll + 64 * k; *(LAS v4u*)(img + offb(n >> 4, n & 15)) = Vr[k]; }
            float be[16], om[16];
            const bool diag = (kt == qt);
#pragma unroll
            for (int i = 0; i < 16; ++i) { const float z = fminf(acc[i] * scale, 80.f);
                const float e = __expf(z), rr = __builtin_amdgcn_rcpf(1.0f + e);
                be[i] = e * rr; om[i] = rr; }
            if (diag) {
#pragma unroll
                for (int i = 0; i < 16; ++i) { const int kap = 8 * (i >> 2) + 4 * hf + (i & 3); if (kap >= r) { be[i] = 0.f; om[i] = 1.f; } } }
            float sfx[16], Gt[4], Go[4];
#pragma unroll
            for (int g = 0; g < 4; ++g) { sfx[4 * g + 3] = 1.f; sfx[4 * g + 2] = om[4 * g + 3]; sfx[4 * g + 1] = sfx[4 * g + 2] * om[4 * g + 2]; sfx[4 * g + 0] = sfx[4 * g + 1] * om[4 * g + 1]; Gt[g] = sfx[4 * g + 0] * om[4 * g + 0]; }
#pragma unroll
            for (int g = 0; g < 4; ++g) Go[g] = shx(Gt[g], 32, ll);
            float SP[4]; SP[3] = 1.f; SP[2] = Gt[3] * Go[3]; SP[1] = SP[2] * (Gt[2] * Go[2]); SP[0] = SP[1] * (Gt[1] * Go[1]);
            float wgt[16];
#pragma unroll
            for (int g = 0; g < 4; ++g) { const float Rg = Rc * SP[g] * (hf == 0 ? Go[g] : 1.f);
#pragma unroll
                for (int j = 0; j < 4; ++j) wgt[4 * g + j] = be[4 * g + j] * (Rg * sfx[4 * g + j]); }
            Rc = Rc * (SP[0] * (Gt[0] * Go[0]));
            if (kt > 0) {
#pragma unroll
                for (int k = 0; k < 8; ++k) { const int n = F.lane + 64 * k; const bf16* rp = qkv + (size_t)(b * SEQ + (kt - 1) * 32 + (n >> 4)) * B_INC + h * B_HD + (n & 15) * 8; Kr[k] = *(const v4u*)(rp + DM); Vr[k] = *(const v4u*)(rp + 2 * DM); }
            }
            asm volatile("s_waitcnt lgkmcnt(0)" ::: "memory");
#pragma unroll
            for (int s2 = 0; s2 < 2; ++s2) {
                v4u pk; pk.x = pk2(wgt[8 * s2 + 0], wgt[8 * s2 + 1]); pk.y = pk2(wgt[8 * s2 + 2], wgt[8 * s2 + 3]); pk.z = pk2(wgt[8 * s2 + 4], wgt[8 * s2 + 5]); pk.w = pk2(wgt[8 * s2 + 6], wgt[8 * s2 + 7]);
                const bf16x8 pa = __builtin_bit_cast(bf16x8, pk);
#pragma unroll
                for (int dt = 0; dt < 4; ++dt) { const bf16x8 vb = tr_frag_at(img, tr_base_perm((unsigned)ll, (unsigned)dt, 0u), tr_base_perm((unsigned)ll, (unsigned)dt, 1u), (unsigned)s2);
                    o[dt] = __builtin_amdgcn_mfma_f32_32x32x16_bf16(pa, vb, o[dt], 0, 0, 0); }
            }
            if (__ballot(Rc >= 0x1p-40f) == 0ull) break;
        }
#pragma unroll
        for (int dt = 0; dt < 4; ++dt)
#pragma unroll
            for (int i = 0; i < 16; ++i) { const int qrow = 8 * (i >> 2) + 4 * hf + (i & 3);
                o_out[(size_t)(b * SEQ + t0 + qrow) * DM + h * B_HD + 32 * dt + r] = (bf16)f2bf(o[dt][i]); }
    }
    }
}

constexpr int PH_LAYER0 = 3, PH_PER_LAYER = 16, PH_END = PH_LAYER0 + DEPTH * PH_PER_LAYER;
typedef pg8::bf16_t gb16;
__device__ __forceinline__ bool relaunder(Frame& F) { int l_; asm volatile("v_mbcnt_lo_u32_b32 %0, -1, 0\n\tv_mbcnt_hi_u32_b32 %0, -1, %0" : "=v"(l_)); F.lane = l_; F.tid = F.wave * 64 + l_; return true; }
template <class Epi> __device__ __forceinline__ void run_gemm(Frame& F, const bf16* A, const bf16* Bt, int N, int K, int lda, int ldb, int acs, const Epi& E) {
    pg8::Gemm g{(const gb16*)A, (const gb16*)Bt, T, N, K, lda, ldb, acs}; pg8::StaticOrder S; S.init(T, N, F.G, (F.G == 256) ? (int)((blockIdx.x & 31) * 8 + (blockIdx.x >> 5)) : (int)blockIdx.x);
    pg8::gemm_phase<Epi, pg8::StaticOrder, true, true>(F.lds, g, S, E, F.tid);
}
__global__ void __launch_bounds__(NWAVES * 64, 2) fwd_kernel(Args args) {
    extern __shared__ __attribute__((aligned(16))) unsigned char lds_raw[];
    Frame F;
    F.lds = (LAS unsigned char*)lds_raw;
    F.tid = threadIdx.x; F.lane = F.tid & 63; F.wave = __builtin_amdgcn_readfirstlane(F.tid >> 6); F.G = gridDim.x;
    F.ap = (const CAS Args*)__builtin_amdgcn_kernarg_segment_ptr();
    F.out = args.out; F.ws = args.ws;
    volatile LAS unsigned* MISC = (volatile LAS unsigned*)(F.lds + MISC_OFF);
    if (F.tid < 64) MISC[F.tid] = 0u;
    __syncthreads();
    const int lo = args.ph_lo, hi = args.ph_hi;
    XcdBarrier bar; bar.bar = (unsigned*)(F.ws + WS_CTL) + CW_BAR; bar.x = 0; bar.st = nullptr;
    if (hi - lo > 1) { bar = xcd_barrier_post((unsigned*)(F.ws + WS_CTL) + CW_BAR, MISC + 8); xcd_barrier<true>(bar); }
#define IN(k) (lo <= (k) && (k) < hi && relaunder(F))
#define INR(k) (lo <= (k) && (k) < hi)
#define GRID_BAR() do { XcdBarrier b2_ = bar; b2_.x = (unsigned)__builtin_amdgcn_readfirstlane((int)bar.x); asm volatile("" : "+s"(b2_.bar), "+s"(b2_.x)); xcd_barrier<false>(b2_); } while (0)
#define SEAM(k) do { if (INR((k) + 1)) GRID_BAR(); } while (0)

    float* mod = WSP(float, WS_MOD);
    const float* normg = F.inp(IN_NORMG);
    bf16* Hb = WSP(bf16, WS_H);
    if (IN(0)) { ph_prologue(F); SEAM(0); }
    if (IN(1)) { ph_modreduce(F); SEAM(1); }
    if (IN(2)) { ph_post(F, nullptr, F.inp(IN_X), true, nullptr, false, nullptr, nullptr, Hb, normg + 0 * DM, mod + 0 * DM, mod + 1 * DM); SEAM(2); }

    for (int L = 0; L < DEPTH; ++L) {
        const int pb = PH_LAYER0 + PH_PER_LAYER * L, j = L >> 1;
        const float* modL = mod + (size_t)L * BATCH * MODW;
        const float* ng = normg + (size_t)L * 4 * DM;
        const bool lastL = (L == DEPTH - 1);
        bf16* XB = (bf16*)((unsigned char*)F.out + 128 * MiB); bf16* XL = WSP(bf16, WS_P + 128 * MiB);
        if ((L & 1) == 0) {
            float* proj = WSP(float, WS_P); bf16* qidx = WSP(bf16, WS_P + 128 * MiB); bf16* ob = WSP(bf16, WS_P);
            bf16* big = WSP(bf16, WS_BIG);
            bf16* qlat = WSP(bf16, WS_QLAT); bf16* ckv = WSP(bf16, WS_CKV); bf16* kidx = WSP(bf16, WS_KIDX); float* widx = WSP(float, WS_WIDX); int* idxb = WSP(int, WS_IDX);
            if (IN(pb + 0)) { pg8::EpiF32 E{proj, A_INP}; run_gemm(F, Hb, WSP(bf16, WS_WAIN) + (size_t)j * A_INP * DM, A_INP, DM, DM, DM, 0, E); SEAM(pb + 0); }
            if (IN(pb + 1)) { ph_dsa_norm(F, proj, F.inp(IN_AQN) + j * A_QR, F.inp(IN_AKVN) + j * A_KVR, F.inp(IN_AIKN) + j * IDX_D, qlat, ckv, kidx, widx); SEAM(pb + 1); }
            if (IN(pb + 2)) { pg8::EpiBf16<0> E{(gb16*)big, 8192, (gb16*)qidx, 2048, 8192}; run_gemm(F, qlat, WSP(bf16, WS_WQC) + (size_t)j * 10240 * 512, 10240, A_QR, A_QR, A_QR, 0, E); SEAM(pb + 2); }
            if (IN(pb + 3)) { ph_indexer(F, qidx, kidx, widx, idxb); SEAM(pb + 3); }
            if (IN(pb + 4)) { ph_sparse_attn(F, big, ckv, idxb, F.inp(IN_RELB)); SEAM(pb + 4); }
            if (IN(pb + 5)) { pg8::EpiBf16<0> E{(gb16*)ob, 4096, (gb16*)ob, 4096, 1 << 30}; run_gemm(F, big, WSP(bf16, WS_WUV) + (size_t)j * 4096 * 512, 4096, 512, 8192, 512, 512, E); SEAM(pb + 5); }
            if (IN(pb + 6)) { pg8::EpiBf16<0> E{(gb16*)big, DM, (gb16*)big, DM, 1 << 30}; run_gemm(F, ob, WSP(bf16, WS_WAOUT) + (size_t)j * DM * 4096, DM, 4096, 4096, 4096, 0, E); SEAM(pb + 6); }
        } else {
            bf16* qkv = WSP(bf16, WS_BIG); bf16* ob = WSP(bf16, WS_P); bf16* big = WSP(bf16, WS_BIG);
            if (IN(pb + 0)) { pg8::EpiBf16<0> E{(gb16*)qkv, B_INC, (gb16*)qkv, B_INC, 1 << 30}; run_gemm(F, Hb, WSP(bf16, WS_WBIN) + (size_t)j * B_INC * DM, B_INC, DM, DM, DM, 0, E); SEAM(pb + 0); }
            if (IN(pb + 1)) { ph_sb_attn(F, qkv, ob, (unsigned*)(F.ws + WS_CTL) + CW_SBQ + 512 * j); SEAM(pb + 1); }
            if (IN(pb + 2)) { pg8::EpiBf16<0> E{(gb16*)big, DM, (gb16*)big, DM, 1 << 30}; run_gemm(F, ob, WSP(bf16, WS_WBOUT) + (size_t)j * DM * DM, DM, DM, DM, DM, 0, E); if (INR(pb + 7)) GRID_BAR(); }
        }
        if (IN(pb + 7)) { ph_post(F, WSP(bf16, WS_BIG), (L == 0) ? (const void*)F.inp(IN_X) : (const void*)XB, L == 0, lastL ? (void*)XL : (void*)XB, false, modL + 2 * DM, ng + 1 * DM, Hb, ng + 2 * DM, modL + 3 * DM, modL + 4 * DM); SEAM(pb + 7); }
        if (IN(pb + 8)) { pg8::EpiBf16<1> E{(gb16*)WSP(bf16, WS_BIG), DFF, (gb16*)WSP(bf16, WS_BIG), DFF, 1 << 30}; run_gemm(F, Hb, WSP(bf16, WS_WM1) + (size_t)L * DFF * DM, DFF, DM, DM, DM, 0, E); SEAM(pb + 8); }
        if (IN(pb + 9)) { pg8::EpiBf16<0> E{(gb16*)WSP(bf16, WS_P), DM, (gb16*)WSP(bf16, WS_P), DM, 1 << 30}; run_gemm(F, WSP(bf16, WS_BIG), WSP(bf16, WS_WM2) + (size_t)L * DM * DFF, DM, DFF, DFF, DFF, 0, E); SEAM(pb + 9); }
        if (IN(pb + 10)) {
            const float* modN = mod + (size_t)(L + 1) * BATCH * MODW; const float* ngN = normg + (size_t)(L + 1) * 4 * DM;
            ph_post(F, WSP(bf16, WS_P), lastL ? (const void*)XL : (const void*)XB, false, lastL ? (void*)F.out : (void*)XB, lastL, modL + 5 * DM, ng + 3 * DM, lastL ? nullptr : Hb, ngN, modN + 0 * DM, modN + 1 * DM);
            if (!lastL && INR(pb + PH_PER_LAYER)) GRID_BAR();
        }
    }
#undef IN
#undef INR
#undef GRID_BAR
#undef SEAM
}

extern "C" void kernel_launch(void* const* d_in, const int* in_sizes, int n_in, void* d_out, int out_size, void* d_ws, size_t ws_size, hipStream_t stream) {
    static int grid = 0;
    if (grid == 0) {
        if (n_in != N_IN || out_size != T * DM || ws_size < WS_END) { fprintf(stderr, "kernel_launch: unexpected problem: n_in %d out %d ws %zu (need %zu); nothing launched\n", n_in, out_size, ws_size, (size_t)WS_END); grid = -1; return; }
        int dev = 0, cus = 0, per_cu = 0;
        if (hipGetDevice(&dev) != hipSuccess || hipDeviceGetAttribute(&cus, hipDeviceAttributeMultiprocessorCount, dev) != hipSuccess) { grid = -1; return; }
        if (hipFuncSetAttribute((const void*)fwd_kernel, hipFuncAttributeMaxDynamicSharedMemorySize, LDS_BYTES) != hipSuccess) { fprintf(stderr, "kernel_launch: hipFuncSetAttribute(%d B LDS) failed\n", LDS_BYTES); grid = -1; return; }
        if (hipOccupancyMaxActiveBlocksPerMultiprocessor(&per_cu, (const void*)fwd_kernel, NWAVES * 64, LDS_BYTES) != hipSuccess || per_cu < 1) { fprintf(stderr, "kernel_launch: occupancy query says %d workgroups per CU; nothing launched\n", per_cu); (void)hipGetLastError(); grid = -1; return; }
        grid = cus * (per_cu < 1 ? per_cu : 1);
    }
    if (grid < 0) return;
    (void)hipMemsetAsync((char*)d_ws + WS_CTL, 0, CTL_ZERO_BYTES, stream);
    Args a{};
    for (int i = 0; i < N_IN; ++i) a.in[i] = (const float*)d_in[i];
    a.out = (float*)d_out; a.ws = (unsigned char*)d_ws;
#if ONE_LAUNCH
    a.ph_lo = 0; a.ph_hi = PH_END;
    hipLaunchKernelGGL(fwd_kernel, dim3(grid), dim3(NWAVES * 64), LDS_BYTES, stream, a);
#else
    for (int p = 0; p < PH_END; ++p) {
        if (p >= PH_LAYER0) { const int L = (p - PH_LAYER0) / PH_PER_LAYER, r = (p - PH_LAYER0) % PH_PER_LAYER;
            if (r > 10) continue; if ((L & 1) && r >= 3 && r <= 6) continue; }
        a.ph_lo = p; a.ph_hi = p + 1;
        hipLaunchKernelGGL(fwd_kernel, dim3(grid), dim3(NWAVES * 64), LDS_BYTES, stream, a);
    }
#endif
}
```

```cpp
#include <hip/hip_runtime.h>
#include <cstdio>
#include <cstdint>
#ifndef ONE_LAUNCH
#define ONE_LAUNCH 1
#endif
namespace pg8 {
#define PG8_LAS __attribute__((address_space(3)))
typedef unsigned short bf16_t;
typedef short bf16x8 __attribute__((ext_vector_type(8)));
typedef float f32x4 __attribute__((ext_vector_type(4)));
typedef unsigned u32x4 __attribute__((ext_vector_type(4)));
constexpr int BM = 256, BK = 64, HALF = 128, HTB = HALF * BK * 2  , STAGE_BYTES = 8 * HTB, NXCD = 8, WGM = 4;

__host__ __device__ __forceinline__ int lds_byte(int r, int c) { return r * 128 + 16 * ((c >> 3) ^ ((r >> 1) & 7)) + (c & 7) * 2; }
__host__ __device__ __forceinline__ void stage_rc(int b, int& R, int& C) { R = b >> 7; C = (((b >> 4) & 7) ^ ((R >> 1) & 7)) * 8; }
__host__ __device__ __forceinline__ int perm32(int rho) { const int n = rho >> 4, i = rho & 15; return 8 * (i >> 2) + 4 * n + (i & 3); }

struct Unit { int pm, pn; };
struct Gemm { const bf16_t* A; const bf16_t* Bt; int M, N, K, lda, ldb, acs; };

struct StaticOrder {
    int nM, nN, nwg, G, c;
    __host__ __device__ void init(int M, int N, int G_, int c_) { nM = M / BM; nN = N / BM; nwg = nM * nN; G = G_; c = c_; }
    __host__ __device__ bool next(int i, Unit& u) const {
        const long L = (long)i * G + c; if (L >= nwg) return false;
        int wgid = (int)L; { const int q = nwg / NXCD, r = nwg % NXCD, xcd = wgid % NXCD, off = wgid / NXCD; wgid = (xcd < r ? xcd * (q + 1) : r * (q + 1) + (xcd - r) * q) + off; }
        const int nig = WGM * nN, gid = wgid / nig, fm = gid * WGM, gsz = (nM - fm) < WGM ? (nM - fm) : WGM;
        u.pm = fm + ((wgid % nig) % gsz); u.pn = (wgid % nig) / gsz; return true;
    }
    __device__ __forceinline__ void a_ready(const Unit&) const {}
    __device__ __forceinline__ void done(const Unit&) const {}
};


__device__ __forceinline__ float relu_f(float x) { const int i = __builtin_bit_cast(int, x); return __builtin_bit_cast(float, i > 0 ? i : 0); }
__device__ __forceinline__ unsigned cvt_pk_bf16(float lo, float hi) { unsigned r; asm("v_cvt_pk_bf16_f32 %0, %1, %2" : "=v"(r) : "v"(lo), "v"(hi)); return r; }
struct EpiF32 {
    static constexpr bool PERM = false, AFTER_DRAIN = false;
    float* C; int ldc;
    __device__ __forceinline__ void operator()(const f32x4 (&acc)[2][2][4][2], const Unit& u, int wr, int wc, int fr, int fq, PG8_LAS unsigned char* lds) const {
        PG8_LAS unsigned char* scr = lds + STAGE_BYTES + (wr * 4 + wc) * 2048;
        const int lane = fq * 16 + fr, rrow = lane >> 3, rch = lane & 7;
        PG8_LAS unsigned char* wp = scr + fr * 128 + 16 * (fq ^ (fr >> 1));
        const int wsw = ((fr >> 1) & 4) ? -64 : 64;
        const PG8_LAS unsigned char* rp = scr + rrow * 128 + 16 * (rch ^ ((rrow >> 1) & 7));
        const int rsw = (rch & 4) ? -64 : 64;
        float* gp = C + (size_t)(u.pm * BM + wr * 64 + rrow) * ldc + u.pn * BM + wc * 32 + 4 * rch;
#pragma unroll
        for (int ai = 0; ai < 2; ++ai)
#pragma unroll
            for (int m = 0; m < 4; ++m)
#pragma unroll
                for (int bj = 0; bj < 2; ++bj) {
#pragma unroll
                    for (int n = 0; n < 2; ++n) *(PG8_LAS f32x4*)(wp + (n ? wsw : 0)) = acc[ai][bj][m][n];
#pragma unroll
                    for (int s = 0; s < 2; ++s) { const f32x4 w = *(const PG8_LAS f32x4*)(rp + s * 1024 + (s ? rsw : 0));
                        *(f32x4*)(gp + (size_t)(ai * HALF + m * 16 + s * 8) * ldc + bj * HALF) = w; } }
    }
};
template <int ACT> struct EpiBf16 {
    static constexpr bool PERM = true, AFTER_DRAIN = false;
    bf16_t* O0; int ld0; bf16_t* O1; int ld1; int split_col;
    __device__ __forceinline__ void operator()(const f32x4 (&acc)[2][2][4][2], const Unit& u, int wr, int wc, int fr, int fq, PG8_LAS unsigned char* lds) const {
        int colt = u.pn * BM; bf16_t* base = O0; int ldc = ld0;
        if (colt >= split_col) { base = O1; ldc = ld1; colt -= split_col; }
        PG8_LAS unsigned char* scr = lds + STAGE_BYTES + (wr * 4 + wc) * 2048;
        const int lane = fq * 16 + fr, rrow = lane >> 3, rch = lane & 7;
        PG8_LAS unsigned char* wp = scr + fr * 128 + 16 * (fq ^ (fr >> 1));
        const int wsw = ((fr >> 1) & 4) ? -64 : 64;
        const PG8_LAS unsigned char* rp = scr + rrow * 128 + 16 * (rch ^ ((rrow >> 1) & 7));
        const int rsw = (rch & 4) ? -64 : 64;
        bf16_t* gp = base + (size_t)(u.pm * BM + wr * 64 + rrow) * ldc + colt + wc * 64 + 8 * rch;
        u32x4 rd[2];
#pragma unroll
        for (int it = 0; it < 8; ++it) { const int ai = it >> 2, m = it & 3;
#pragma unroll
            for (int bj = 0; bj < 2; ++bj) { f32x4 v0 = acc[ai][bj][m][0], v1 = acc[ai][bj][m][1];
                if (ACT == 1) {
#pragma unroll
                    for (int j = 0; j < 4; ++j) { const float a = relu_f(v0[j]), b = relu_f(v1[j]); v0[j] = a * a; v1[j] = b * b; } }
                u32x4 w; w.x = cvt_pk_bf16(v0[0], v0[1]); w.y = cvt_pk_bf16(v0[2], v0[3]); w.z = cvt_pk_bf16(v1[0], v1[1]); w.w = cvt_pk_bf16(v1[2], v1[3]);
                *(PG8_LAS u32x4*)(wp + (bj ? wsw : 0)) = w; }
            if (it > 0) { const int pa = (it - 1) >> 2, pm_ = (it - 1) & 3;
#pragma unroll
                for (int s = 0; s < 2; ++s) *(u32x4*)(gp + (size_t)(pa * HALF + pm_ * 16 + s * 8) * ldc) = rd[s]; }
#pragma unroll
            for (int s = 0; s < 2; ++s) rd[s] = *(const PG8_LAS u32x4*)(rp + s * 1024 + (s ? rsw : 0)); }
#pragma unroll
        for (int s = 0; s < 2; ++s) *(u32x4*)(gp + (size_t)(HALF + 3 * 16 + s * 8) * ldc) = rd[s];
    }
};

template <class Epi, class Sched, bool ALIGN_EPI = false, bool SP2 = false>
__device__ __forceinline__ void gemm_phase(PG8_LAS unsigned char* lds, const Gemm g, const Sched& S, const Epi& E, int tid_in) {
    int tid_l = tid_in; asm volatile("" : "+v"(tid_l));
    const int tid = tid_l, wid = __builtin_amdgcn_readfirstlane(tid >> 6), lane = tid & 63, wr = wid >> 2, wc = wid & 3, fr = lane & 15, fq = lane >> 4;
    const int K = g.K, nt = K / BK;
    unsigned voffA[2], voffB[2];
#pragma unroll
    for (int i = 0; i < 2; ++i) { int R, C; stage_rc(tid * 16 + i * 8192, R, C); const int Rb = Epi::PERM ? ((R >> 5) * 64 + perm32(R & 31)) : R;
        voffA[i] = (unsigned)(R * g.lda + C) * 2u; voffB[i] = (unsigned)(Rb * g.ldb + C) * 2u; }
    const size_t kstep = (size_t)(BK * 2);
    const size_t hstepA = (size_t)HALF * g.lda * 2, hstepB = (size_t)(Epi::PERM ? 32 : HALF) * g.ldb * 2;
    const size_t tstepA = 2 * hstepA, tstepB = (size_t)BM * g.ldb * 2, cstepA = (size_t)g.acs * 2;
    const unsigned ldsw = (unsigned)wid * 1024u;
    const int aoff = lds_byte(wr * 64 + fr, fq * 8), boff = lds_byte(wc * 32 + fr, fq * 8);
#define PG8_SA(b, h) (((b) * 2 + (h)) * HTB)
#define PG8_SB(b, h) ((4 + (b) * 2 + (h)) * HTB)
#define PG8_STAGE(bufoff, gbase, voff) do { _Pragma("unroll") for (int _i = 0; _i < 2; ++_i) \
        __builtin_amdgcn_global_load_lds((const unsigned*)((const char*)(gbase) + (voff)[_i]), (PG8_LAS unsigned*)(lds + (bufoff) + ldsw + _i * 8192), 16, 0, 0); } while (0)
#define PG8_LDA(dst, b, h) do { _Pragma("unroll") for (int m = 0; m < 4; ++m) _Pragma("unroll") for (int k = 0; k < 2; ++k) dst[m][k] = *(const PG8_LAS bf16x8*)(lds + PG8_SA(b, h) + (aoff ^ (k * 64)) + m * 2048); } while (0)
#define PG8_LDB(dst, b, h) do { _Pragma("unroll") for (int n = 0; n < 2; ++n) _Pragma("unroll") for (int k = 0; k < 2; ++k) dst[n][k] = *(const PG8_LAS bf16x8*)(lds + PG8_SB(b, h) + (boff ^ (k * 64)) + n * 2048); } while (0)
#define PG8_MMA(ai, bj, At, Bt) do { __builtin_amdgcn_s_setprio(1); _Pragma("unroll") for (int m = 0; m < 4; ++m) _Pragma("unroll") for (int n = 0; n < 2; ++n) _Pragma("unroll") for (int k = 0; k < 2; ++k) \
        acc[ai][bj][m][n] = __builtin_amdgcn_mfma_f32_16x16x32_bf16(Bt[n][k], At[m][k], acc[ai][bj][m][n], 0, 0, 0); __builtin_amdgcn_s_setprio(0); } while (0)
#define PG8_WAIT_V(n) asm volatile("s_waitcnt vmcnt(" #n ")" ::: "memory")
#define PG8_WAIT_L(n) asm volatile("s_waitcnt lgkmcnt(" #n ")" ::: "memory")
#define PG8_BAR __builtin_amdgcn_s_barrier()
#define PG8_SCHED __builtin_amdgcn_sched_barrier(0)
    Unit cur, nxt; int ui = 0;
    if (!S.next(0, cur)) return;
    f32x4 acc[2][2][4][2];
#pragma unroll
    for (int a = 0; a < 2; ++a)
#pragma unroll
        for (int b = 0; b < 2; ++b)
#pragma unroll
            for (int m = 0; m < 4; ++m)
#pragma unroll
                for (int n = 0; n < 2; ++n) acc[a][b][m][n] = (f32x4){0.f, 0.f, 0.f, 0.f};
    bf16x8 At[4][2], B0[2][2], B1[2][2];
    const char* cA = (const char*)g.A + (size_t)cur.pm * tstepA + (size_t)cur.pn * cstepA; const char* cB = (const char*)g.Bt + (size_t)cur.pn * tstepB;
    S.a_ready(cur);
    if constexpr (SP2) {
        PG8_STAGE(PG8_SB(0, 0), cB, voffB); PG8_STAGE(PG8_SB(0, 1), cB + hstepB, voffB); PG8_STAGE(PG8_SA(0, 0), cA, voffA); PG8_STAGE(PG8_SA(0, 1), cA + hstepA, voffA);
        if (wr == 1) PG8_BAR;
        PG8_WAIT_V(2); PG8_BAR;
        PG8_STAGE(PG8_SB(1, 0), cB + kstep, voffB); PG8_STAGE(PG8_SA(1, 0), cA + kstep, voffA); PG8_STAGE(PG8_SB(1, 1), cB + hstepB + kstep, voffB);
        PG8_WAIT_V(6); PG8_BAR;
    } else {
        PG8_STAGE(PG8_SB(0, 0), cB, voffB); PG8_STAGE(PG8_SA(0, 0), cA, voffA); PG8_STAGE(PG8_SB(0, 1), cB + hstepB, voffB); PG8_STAGE(PG8_SA(0, 1), cA + hstepA, voffA);
        if (wr == 1) PG8_BAR;
        PG8_WAIT_V(4); PG8_BAR;
        PG8_STAGE(PG8_SB(1, 0), cB + kstep, voffB); PG8_STAGE(PG8_SA(1, 0), cA + kstep, voffA); PG8_STAGE(PG8_SB(1, 1), cB + hstepB + kstep, voffB);
        PG8_WAIT_V(6); PG8_BAR;
    }
    for (;;) {
        const bool has_next = S.next(ui + 1, nxt);
        const char* nA = has_next ? (const char*)g.A + (size_t)nxt.pm * tstepA + (size_t)nxt.pn * cstepA : cA; const char* nB = has_next ? (const char*)g.Bt + (size_t)nxt.pn * tstepB : cB;
        for (int t = 0; t < nt; t += 2) {
            const bool last = (t == nt - 2);
            const char* a1 = cA + (size_t)(t + 1) * kstep;
            const char* a2 = last ? nA : cA + (size_t)(t + 2) * kstep; const char* b2 = last ? nB : cB + (size_t)(t + 2) * kstep;
            const char* a3 = a2 + kstep; const char* b3 = b2 + kstep;
            if (last && has_next) S.a_ready(nxt);
            if constexpr (SP2) {
            PG8_LDB(B0, 0, 0); PG8_LDB(B1, 0, 1); PG8_SCHED; PG8_LDA(At, 0, 0); PG8_STAGE(PG8_SA(1, 1), a1 + hstepA, voffA);
            PG8_WAIT_V(8); PG8_WAIT_L(0); PG8_BAR; PG8_MMA(0, 0, At, B0); PG8_MMA(0, 1, At, B1); PG8_BAR; PG8_SCHED;
            PG8_LDA(At, 0, 1); PG8_STAGE(PG8_SB(0, 0), b2, voffB); PG8_STAGE(PG8_SB(0, 1), b2 + hstepB, voffB); PG8_STAGE(PG8_SA(0, 0), a2, voffA);
            PG8_WAIT_V(8); PG8_WAIT_L(0); PG8_BAR; PG8_MMA(1, 0, At, B0); PG8_MMA(1, 1, At, B1); PG8_BAR; PG8_SCHED;
            PG8_LDB(B0, 1, 0); PG8_LDB(B1, 1, 1); PG8_SCHED; PG8_LDA(At, 1, 0); PG8_STAGE(PG8_SA(0, 1), a2 + hstepA, voffA);
            PG8_WAIT_V(8); PG8_WAIT_L(0); PG8_BAR; PG8_MMA(0, 0, At, B0); PG8_MMA(0, 1, At, B1); PG8_BAR; PG8_SCHED;
            PG8_LDA(At, 1, 1); PG8_STAGE(PG8_SB(1, 0), b3, voffB); PG8_STAGE(PG8_SB(1, 1), b3 + hstepB, voffB); PG8_STAGE(PG8_SA(1, 0), a3, voffA);
            PG8_WAIT_V(8); PG8_WAIT_L(0); PG8_BAR; PG8_MMA(1, 0, At, B0); PG8_MMA(1, 1, At, B1); PG8_BAR; PG8_SCHED;
            } else {
            PG8_LDB(B0, 0, 0); PG8_SCHED; PG8_LDA(At, 0, 0); PG8_STAGE(PG8_SA(1, 1), a1 + hstepA, voffA);
            PG8_WAIT_L(8); PG8_BAR; PG8_WAIT_L(0); PG8_MMA(0, 0, At, B0); PG8_BAR; PG8_SCHED;
            PG8_LDB(B1, 0, 1); PG8_STAGE(PG8_SB(0, 0), b2, voffB);
            PG8_BAR; PG8_WAIT_L(0); PG8_MMA(0, 1, At, B1); PG8_BAR;
            PG8_LDA(At, 0, 1); PG8_STAGE(PG8_SA(0, 0), a2, voffA);
            PG8_BAR; PG8_WAIT_L(0); PG8_MMA(1, 0, At, B0); PG8_BAR; PG8_SCHED;
            PG8_STAGE(PG8_SB(0, 1), b2 + hstepB, voffB);
            PG8_WAIT_V(6); PG8_BAR; PG8_MMA(1, 1, At, B1); PG8_BAR;
            PG8_LDB(B0, 1, 0); PG8_SCHED; PG8_LDA(At, 1, 0); PG8_STAGE(PG8_SA(0, 1), a2 + hstepA, voffA);
            PG8_WAIT_L(8); PG8_BAR; PG8_WAIT_L(0); PG8_MMA(0, 0, At, B0); PG8_BAR; PG8_SCHED;
            PG8_LDB(B1, 1, 1); PG8_STAGE(PG8_SB(1, 0), b3, voffB);
            PG8_BAR; PG8_WAIT_L(0); PG8_MMA(0, 1, At, B1); PG8_BAR;
            PG8_LDA(At, 1, 1); PG8_STAGE(PG8_SA(1, 0), a3, voffA);
            PG8_BAR; PG8_WAIT_L(0); PG8_MMA(1, 0, At, B0); PG8_BAR; PG8_SCHED;
            PG8_STAGE(PG8_SB(1, 1), b3 + hstepB, voffB);
            PG8_WAIT_V(6); PG8_BAR; PG8_MMA(1, 1, At, B1); PG8_BAR;
            }
        }
        if constexpr (ALIGN_EPI) { if (wr == 0) PG8_BAR; }
        if constexpr (!Epi::AFTER_DRAIN) { E(acc, cur, wr, wc, fr, fq, lds); S.done(cur); }
        if (!has_next) break;
#pragma unroll
        for (int a = 0; a < 2; ++a)
#pragma unroll
            for (int b = 0; b < 2; ++b)
#pragma unroll
                for (int m = 0; m < 4; ++m)
#pragma unroll
                    for (int n = 0; n < 2; ++n) acc[a][b][m][n] = (f32x4){0.f, 0.f, 0.f, 0.f};
        cur = nxt; cA = nA; cB = nB; ++ui;
        if constexpr (ALIGN_EPI) { if (wr == 1) PG8_BAR; }
    }
    PG8_WAIT_V(0);
    if constexpr (!ALIGN_EPI) { if (wr == 0) PG8_BAR; }
    PG8_BAR;
    if constexpr (Epi::AFTER_DRAIN) { E.fused(acc, cur, wr, wc, fr, fq, lds, wid, lane); S.done(cur); }
#undef PG8_SA
#undef PG8_SB
#undef PG8_STAGE
#undef PG8_LDA
#undef PG8_LDB
#undef PG8_MMA
#undef PG8_WAIT_V
#undef PG8_WAIT_L
#undef PG8_BAR
#undef PG8_SCHED
}
}

constexpr int NWAVES = 8;
constexpr int BATCH = 8, SEQ = 4096, DM = 2048, DEPTH = 4, DFF = 8192, T = BATCH * SEQ;
constexpr int A_HEADS = 32, A_QR = 512, A_KVR = 256, IDX_H = 16, IDX_D = 128, TOPK = 256, A_IN = 912, A_INP = 1024;
constexpr int B_HEADS = 16, B_HD = 128, B_INC = 3 * DM;
constexpr int MODW = 6 * DM;
constexpr float RMS_EPS = 1e-6f;
enum { IN_X = 0, IN_C, IN_RELB, IN_ADAW, IN_ADAB, IN_NORMG, IN_AWIN, IN_AQN, IN_AKVN, IN_AIKN, IN_AWQB, IN_AWIQB, IN_AWUK, IN_AWUV, IN_AWOUT, IN_BWIN, IN_BWOUT, IN_W1, IN_W2, N_IN };

constexpr size_t MiB = 1u << 20;
constexpr size_t WS_CTL = 0, CTL_ZERO_BYTES = 1 * MiB;
constexpr size_t WS_MOD = 1 * MiB;
constexpr size_t WS_MODP = 3 * MiB;
constexpr size_t WS_WAIN = 16 * MiB;
constexpr size_t WS_WQC = 24 * MiB;
constexpr size_t WS_WUV = 44 * MiB;
constexpr size_t WS_WAOUT = 52 * MiB;
constexpr size_t WS_WBIN = 84 * MiB;
constexpr size_t WS_WBOUT = 132 * MiB;
constexpr size_t WS_WM1 = 148 * MiB;
constexpr size_t WS_WM2 = 276 * MiB;
constexpr size_t WS_H = 404 * MiB;
constexpr size_t WS_P = 532 * MiB;
constexpr size_t WS_BIG = 788 * MiB;
constexpr size_t WS_QLAT = 1300 * MiB;
constexpr size_t WS_CKV = 1332 * MiB;
constexpr size_t WS_KIDX = 1348 * MiB;
constexpr size_t WS_WIDX = 1356 * MiB;
constexpr size_t WS_IDX = 1358 * MiB;
constexpr size_t WS_END = 1390 * MiB;
constexpr int CW_BAR = 4096;
constexpr int CW_SBQ = 8192;

constexpr int LDS_BYTES = 163840;
constexpr int MISC_OFF = LDS_BYTES - 256;

#define GAS __attribute__((address_space(1)))
#define LAS __attribute__((address_space(3)))
typedef unsigned short bf16;
typedef unsigned v4u __attribute__((ext_vector_type(4)));
typedef unsigned v2u __attribute__((ext_vector_type(2)));
typedef float f32x4 __attribute__((ext_vector_type(4)));
typedef float f32x2 __attribute__((ext_vector_type(2)));
typedef __bf16 bf16x2_t __attribute__((ext_vector_type(2)));
#define LDS_WAIT() asm volatile("s_waitcnt lgkmcnt(0)" ::: "memory")
#define VM_WAIT() asm volatile("s_waitcnt vmcnt(0)" ::: "memory")
__device__ __forceinline__ unsigned f2bf(float f) { unsigned u = __builtin_bit_cast(unsigned, f); return (u + 0x7fffu + ((u >> 16) & 1u)) >> 16; }
__device__ __forceinline__ unsigned pk2(float lo, float hi) { return f2bf(lo) | (f2bf(hi) << 16); }
__device__ __forceinline__ float bflo(unsigned u) { return __builtin_bit_cast(float, u << 16); }
__device__ __forceinline__ float bfhi(unsigned u) { return __builtin_bit_cast(float, u & 0xffff0000u); }
__device__ __forceinline__ float dot2bf(unsigned a, unsigned b, float c) { return __builtin_amdgcn_fdot2_f32_bf16(__builtin_bit_cast(bf16x2_t, a), __builtin_bit_cast(bf16x2_t, b), c, false); }
#define DPP_F(v, ctrl) __builtin_bit_cast(float, __builtin_amdgcn_update_dpp(0, __builtin_bit_cast(int, (v)), (ctrl), 0xf, 0xf, true))
#define RDL_F(v, l) __builtin_bit_cast(float, __builtin_amdgcn_readlane(__builtin_bit_cast(int, (v)), (l)))
__device__ __forceinline__ float wave_sum(float v, int) {
    v += DPP_F(v, 0xB1); v += DPP_F(v, 0x4E); v += DPP_F(v, 0x124); v += DPP_F(v, 0x128);
    return (RDL_F(v, 0) + RDL_F(v, 16)) + (RDL_F(v, 32) + RDL_F(v, 48));
}
__device__ __forceinline__ float wave_max(float v, int) {
    v = fmaxf(v, DPP_F(v, 0xB1)); v = fmaxf(v, DPP_F(v, 0x4E)); v = fmaxf(v, DPP_F(v, 0x124)); v = fmaxf(v, DPP_F(v, 0x128));
    return fmaxf(fmaxf(RDL_F(v, 0), RDL_F(v, 16)), fmaxf(RDL_F(v, 32), RDL_F(v, 48)));
}
__device__ __forceinline__ float shx(float v, int, int lane) {
    const unsigned u = __builtin_bit_cast(unsigned, v);
    auto r = __builtin_amdgcn_permlane32_swap(u, u, false, false);
    return __builtin_bit_cast(float, (lane & 32) ? r[0] : r[1]);
}

#define XB_TMO      128
#define XB_XCNT(j)  (256  + 64 * (j))
#define XB_XSUB(j)  (1280 + 64 * (j))
#define XB_XGEN(j)  (2304 + 64 * (j))
#define XB_TOP      3328
#define XB_TOPGEN   3392
#define XCD_BAR_WORDS 3456
#define XB_SPIN_CAP (1u << 22)

__device__ __forceinline__ unsigned xb_ld(unsigned* p)              { return __hip_atomic_load(p, __ATOMIC_RELAXED, __HIP_MEMORY_SCOPE_AGENT); }
__device__ __forceinline__ unsigned xb_add(unsigned* p, unsigned v) { return __hip_atomic_fetch_add(p, v, __ATOMIC_RELAXED, __HIP_MEMORY_SCOPE_AGENT); }
__device__ __forceinline__ unsigned xb_xcc_id() { return (unsigned)__builtin_amdgcn_s_getreg((3 << 11) | 20) & 0xFu; }
#define XB_SPIN(cond, bar) do { unsigned _sp = 0; while (cond) { __builtin_amdgcn_s_sleep(1); \
    if ((++_sp & 255u) == 0u) { if (xb_ld(&(bar)[XB_TMO])) break; if (_sp > XB_SPIN_CAP) { atomicAdd(&(bar)[XB_TMO], 1u); break; } } } } while (0)

struct XcdBarrier {
    unsigned* bar; unsigned x;
    volatile LAS unsigned* st;
};

__device__ __forceinline__ XcdBarrier xcd_barrier_post(unsigned* bar, volatile LAS unsigned* st) {
    XcdBarrier b; b.bar = bar; b.x = xb_xcc_id(); b.st = st;
    if (threadIdx.x == 0) (void)xb_add(&bar[XB_XCNT(b.x)], 1u);
    return b;
}
__device__ __forceinline__ void xcd_barrier_complete(unsigned* bar, unsigned x, unsigned& nloc, unsigned& nx) {
    const unsigned G = gridDim.x * gridDim.y * gridDim.z;
    unsigned sum, cnt, mine, sp = 0u;
    for (;;) {
        sum = 0u; cnt = 0u; mine = 0u;
#pragma unroll
        for (unsigned j = 0; j < 16; ++j) { const unsigned c = xb_ld(&bar[XB_XCNT(j)]); sum += c; cnt += (c > 0u) ? 1u : 0u; mine = (j == x) ? c : mine; }
        if (sum == G) break;
        __builtin_amdgcn_s_sleep(1);
        if ((++sp & 255u) == 0u) { if (xb_ld(&bar[XB_TMO])) break; if (sp > XB_SPIN_CAP) { atomicAdd(&bar[XB_TMO], 1u); break; } }
    }
    nloc = mine > 0u ? mine : 1u; nx = cnt > 0u ? cnt : 1u;
}

template <bool CENSUS> __device__ __forceinline__ void xcd_barrier(const XcdBarrier& b) {
    asm volatile("s_waitcnt vmcnt(0)" ::: "memory");
    __syncthreads();
    if (threadIdx.x == 0) {
        unsigned* bar = b.bar;
        __builtin_amdgcn_s_waitcnt(0);
        unsigned nloc = b.st[0], nx = b.st[1];
        if (CENSUS) { if (nloc == 0u) { xcd_barrier_complete(bar, b.x, nloc, nx); b.st[0] = nloc; b.st[1] = nx; } }
        const unsigned old = xb_add(&bar[XB_XSUB(b.x)], 1u);
        const unsigned gen = old / nloc;
        if (old + 1u == (gen + 1u) * nloc) {
            __builtin_amdgcn_fence(__ATOMIC_RELEASE, "agent");
            asm volatile("s_waitcnt vmcnt(0)" ::: "memory");
            const unsigned og = xb_add(&bar[XB_TOP], 1u);
            const unsigned tg = og / nx;
            if (og + 1u == (tg + 1u) * nx) xb_add(&bar[XB_TOPGEN], 1u);
            else XB_SPIN(xb_ld(&bar[XB_TOPGEN]) == tg, bar);
            __builtin_amdgcn_fence(__ATOMIC_ACQUIRE, "agent");
            xb_add(&bar[XB_XGEN(b.x)], 1u);
            asm volatile("s_waitcnt vmcnt(0)" ::: "memory");
        } else {
            XB_SPIN(xb_ld(&bar[XB_XGEN(b.x)]) == gen, bar);
            __builtin_amdgcn_fence(__ATOMIC_ACQUIRE, "agent");
            asm volatile("s_waitcnt vmcnt(0)" ::: "memory");
        }
    }
    __syncthreads();
}

struct Args { const float* in[N_IN]; float* out; unsigned char* ws; int ph_lo, ph_hi; };
#define CAS __attribute__((address_space(4)))
struct Frame {
    LAS unsigned char* lds;
    int tid, lane, wave, G;
    const CAS Args* ap;
    float* out; unsigned char* ws;
    __device__ __forceinline__ const float* inp(int i) const { return ap->in[i]; }
};
#define WSP(type, off) ((type*)(F.ws + (off)))

__device__ __forceinline__ void p0_transpose_item(const float* W, int Nsrc, bf16* dst, int ldo, LAS float* scr, int kb, int nb, int lane) {
    const int k0 = 64 * kb, n0 = 32 * nb, rsub = lane >> 3, c4 = lane & 7, nn = n0 + 4 * c4;
    f32x4 v[8];
#pragma unroll
    for (int i = 0; i < 8; ++i) v[i] = (nn < Nsrc) ? *(const f32x4*)(W + (size_t)(k0 + 8 * i + rsub) * Nsrc + nn) : (f32x4){0.f, 0.f, 0.f, 0.f};
#pragma unroll
    for (int i = 0; i < 8; ++i) { LAS float* d = scr + (8 * i + rsub) * 33 + 4 * c4; d[0] = v[i].x; d[1] = v[i].y; d[2] = v[i].z; d[3] = v[i].w; }
    LDS_WAIT(); asm volatile("" ::: "memory");
    const int c = lane & 7;
#pragma unroll
    for (int j = 0; j < 4; ++j) { const int n = (lane >> 3) + 8 * j; const LAS float* s = scr + (8 * c) * 33 + n;
        v4u o; o.x = pk2(s[0 * 33], s[1 * 33]); o.y = pk2(s[2 * 33], s[3 * 33]); o.z = pk2(s[4 * 33], s[5 * 33]); o.w = pk2(s[6 * 33], s[7 * 33]);
        *(v4u*)(dst + (size_t)(n0 + n) * ldo + k0 + 8 * c) = o; }
    LDS_WAIT(); asm volatile("" ::: "memory");
}
__device__ __forceinline__ void p0_tr_load(f32x4 (&v)[8], const float* W, int Nsrc, int kb, int nb, int lane) {
    const int k0 = 64 * kb, rsub = lane >> 3, nn = 32 * nb + 4 * (lane & 7);
#pragma unroll
    for (int i = 0; i < 8; ++i) v[i] = (nn < Nsrc) ? *(const f32x4*)(W + (size_t)(k0 + 8 * i + rsub) * Nsrc + nn) : (f32x4){0.f, 0.f, 0.f, 0.f};
}
__device__ __forceinline__ void p0_tr_store(const f32x4 (&v)[8], bf16* dst, int ldo, LAS float* scr, int kb, int nb, int lane) {
    const int k0 = 64 * kb, n0 = 32 * nb, rsub = lane >> 3, c4 = lane & 7;
#pragma unroll
    for (int i = 0; i < 8; ++i) { LAS float* d = scr + (8 * i + rsub) * 33 + 4 * c4; d[0] = v[i].x; d[1] = v[i].y; d[2] = v[i].z; d[3] = v[i].w; }
    LDS_WAIT(); asm volatile("" ::: "memory");
    const int c = lane & 7;
#pragma unroll
    for (int j = 0; j < 4; ++j) { const int n = (lane >> 3) + 8 * j; const LAS float* s = scr + (8 * c) * 33 + n;
        v4u o; o.x = pk2(s[0 * 33], s[1 * 33]); o.y = pk2(s[2 * 33], s[3 * 33]); o.z = pk2(s[4 * 33], s[5 * 33]); o.w = pk2(s[6 * 33], s[7 * 33]);
        *(v4u*)(dst + (size_t)(n0 + n) * ldo + k0 + 8 * c) = o; }
    LDS_WAIT(); asm volatile("" ::: "memory");
}
__device__ __forceinline__ void p0_transpose_job(Frame& F, const float* src, size_t sstride, int nmat, int K, int Nsrc, int Npad, bf16* dst, size_t dstride, int ldo) {
    LAS float* scr = (LAS float*)(F.lds + F.wave * 16384);
    const int gw = blockIdx.x * NWAVES + F.wave, NGW = F.G * NWAVES;
    const int nkb = K / 64, nnb = Npad / 32, per = nkb * nnb, tot = nmat * per;
    int it = gw;
    f32x4 v[8], vn[8];
    if (it < tot) { const int m = it / per, r = it % per; p0_tr_load(v, src + (size_t)m * sstride, Nsrc, r / nnb, r % nnb, F.lane); }
    while (it < tot) {
        const int nx = it + NGW;
        if (nx < tot) { const int m = nx / per, r = nx % per; p0_tr_load(vn, src + (size_t)m * sstride, Nsrc, r / nnb, r % nnb, F.lane); }
        { const int m = it / per, r = it % per; p0_tr_store(v, dst + (size_t)m * dstride, ldo, scr, r / nnb, r % nnb, F.lane); }
#pragma unroll
        for (int i = 0; i < 8; ++i) v[i] = vn[i];
        it = nx;
    }
}
__device__ __forceinline__ void ph_prologue(Frame& F) {
    {
        LAS float* sl = (LAS float*)(F.lds);
        LAS float* red = (LAS float*)(F.lds + 8192);
        const float* cin = F.inp(IN_C); const float* ada_w = F.inp(IN_ADAW); float* modp = WSP(float, WS_MODP);
        for (int u = blockIdx.x; u < 768; u += F.G) {
            const int l = u / 192, r = u % 192, ec = r >> 3, dc = r & 7;
            __syncthreads();
            for (int i = F.tid; i < 2048; i += 512) { const int rr = i >> 3, b = i & 7; const float v = cin[b * DM + dc * 256 + rr]; sl[rr * 8 + b] = v / (1.f + __expf(-v)); }
            __syncthreads();
            const int cq = F.tid & 127, dq = F.tid >> 7;
            f32x4 acc[8];
#pragma unroll
            for (int b = 0; b < 8; ++b) acc[b] = (f32x4){0.f, 0.f, 0.f, 0.f};
            const float* wp = ada_w + ((size_t)l * DM + dc * 256 + dq * 64) * MODW + ec * 512 + cq * 4;
#pragma unroll 8
            for (int i = 0; i < 64; ++i) {
                const f32x4 w = *(const f32x4*)(wp + (size_t)i * MODW);
                const f32x4 s0 = *(const LAS f32x4*)(sl + (dq * 64 + i) * 8), s1 = *(const LAS f32x4*)(sl + (dq * 64 + i) * 8 + 4);
                acc[0] += w * s0.x; acc[1] += w * s0.y; acc[2] += w * s0.z; acc[3] += w * s0.w;
                acc[4] += w * s1.x; acc[5] += w * s1.y; acc[6] += w * s1.z; acc[7] += w * s1.w;
            }
#pragma unroll
            for (int b = 0; b < 8; ++b) *(LAS f32x4*)(red + (dq * 8 + b) * 512 + cq * 4) = acc[b];
            __syncthreads();
            { const int b = F.tid >> 6, c0 = (F.tid & 63) * 8;
#pragma unroll
              for (int k = 0; k < 2; ++k) {
                  const f32x4 s = (*(const LAS f32x4*)(red + (0 * 8 + b) * 512 + c0 + 4 * k) + *(const LAS f32x4*)(red + (1 * 8 + b) * 512 + c0 + 4 * k))
                                + (*(const LAS f32x4*)(red + (2 * 8 + b) * 512 + c0 + 4 * k) + *(const LAS f32x4*)(red + (3 * 8 + b) * 512 + c0 + 4 * k));
                  *(f32x4*)(modp + (((size_t)dc * 4 + l) * 8 + b) * MODW + ec * 512 + c0 + 4 * k) = s; } }
        }
        __syncthreads();
    }
    {
        LAS float* Bs = (LAS float*)(F.lds);
        LAS float* As = (LAS float*)(F.lds + 256 * 132 * 4);
        const float* wqb = F.inp(IN_AWQB); const float* wuk = F.inp(IN_AWUK); bf16* wqc = WSP(bf16, WS_WQC);
        for (int u = blockIdx.x; u < 1024; u += F.G) {
            const int j = u >> 9, h = (u & 511) >> 4, rb = u & 15, r0 = rb * 32;
            __syncthreads();
            const float* bsrc = wuk + ((size_t)j * A_HEADS + h) * 256 * 128;
            for (int i = F.tid; i < 256 * 32; i += 512) { const int row = i >> 5, c4 = i & 31; *(LAS f32x4*)(Bs + row * 132 + c4 * 4) = *(const f32x4*)(bsrc + row * 128 + c4 * 4); }
            for (int i = F.tid; i < 32 * 32; i += 512) { const int row = i >> 5, c4 = i & 31; *(LAS f32x4*)(As + row * 128 + c4 * 4) = *(const f32x4*)(wqb + ((size_t)j * A_QR + r0 + row) * 4096 + h * 128 + c4 * 4); }
            __syncthreads();
            const int c = F.tid & 255, rh = F.tid >> 8;
            float acc[16];
#pragma unroll
            for (int q = 0; q < 16; ++q) acc[q] = 0.f;
            for (int d4 = 0; d4 < 32; ++d4) {
                const f32x4 bv = *(const LAS f32x4*)(Bs + c * 132 + d4 * 4);
#pragma unroll
                for (int q = 0; q < 16; ++q) { const f32x4 av = *(const LAS f32x4*)(As + (rh * 16 + q) * 128 + d4 * 4); acc[q] += (av.x * bv.x + av.y * bv.y) + (av.z * bv.z + av.w * bv.w); }
            }
            bf16* orow = wqc + ((size_t)j * 10240 + h * 256 + c) * 512 + r0 + rh * 16;
            v4u o0, o1;
            o0.x = pk2(acc[0], acc[1]); o0.y = pk2(acc[2], acc[3]); o0.z = pk2(acc[4], acc[5]); o0.w = pk2(acc[6], acc[7]);
            o1.x = pk2(acc[8], acc[9]); o1.y = pk2(acc[10], acc[11]); o1.z = pk2(acc[12], acc[13]); o1.w = pk2(acc[14], acc[15]);
            *(v4u*)(orow) = o0; *(v4u*)(orow + 8) = o1;
        }
        __syncthreads();
    }
    p0_transpose_job(F, F.inp(IN_AWIN), (size_t)DM * A_IN, 2, DM, A_IN, A_INP, WSP(bf16, WS_WAIN), (size_t)A_INP * DM, DM);
    p0_transpose_job(F, F.inp(IN_AWIQB), (size_t)A_QR * 2048, 2, A_QR, 2048, 2048, WSP(bf16, WS_WQC) + (size_t)8192 * 512, (size_t)10240 * 512, 512);
    p0_transpose_job(F, F.inp(IN_AWOUT), (size_t)4096 * DM, 2, 4096, DM, DM, WSP(bf16, WS_WAOUT), (size_t)DM * 4096, 4096);
    p0_transpose_job(F, F.inp(IN_BWIN), (size_t)DM * B_INC, 2, DM, B_INC, B_INC, WSP(bf16, WS_WBIN), (size_t)B_INC * DM, DM);
    p0_transpose_job(F, F.inp(IN_BWOUT), (size_t)DM * DM, 2, DM, DM, DM, WSP(bf16, WS_WBOUT), (size_t)DM * DM, DM);
    p0_transpose_job(F, F.inp(IN_W1), (size_t)DM * DFF, 4, DM, DFF, DFF, WSP(bf16, WS_WM1), (size_t)DFF * DM, DM);
    p0_transpose_job(F, F.inp(IN_W2), (size_t)DFF * DM, 4, DFF, DM, DM, WSP(bf16, WS_WM2), (size_t)DM * DFF, DFF);
    {
        LAS float* scr = (LAS float*)(F.lds + F.wave * 16384);
        const int gw = blockIdx.x * NWAVES + F.wave, NGW = F.G * NWAVES;
        const float* wuv = F.inp(IN_AWUV); bf16* d0 = WSP(bf16, WS_WUV);
        for (int it = gw; it < 64 * 16; it += NGW) {
            const int m = it >> 4, r = it & 15, j = m >> 5, h = m & 31;
            bf16* dst = d0 + (size_t)j * 4096 * 512 + (size_t)((h >> 1) * 256 + (h & 1) * 128) * 512 + (h & 1) * 256;
            p0_transpose_item(wuv + (size_t)m * 256 * 128, 128, dst, 512, scr, r >> 2, r & 3, F.lane);
        }
        const int gt = blockIdx.x * 512 + F.tid, NT = F.G * 512;
        for (int i = gt; i < 2 * 4096 * 32; i += NT) {
            const int row = i >> 5, ch = i & 31, hh = (row >> 7) & 1;
            *(v4u*)(d0 + (size_t)row * 512 + (1 - hh) * 256 + ch * 8) = (v4u){0u, 0u, 0u, 0u};
        }
    }
}
__device__ __forceinline__ void ph_modreduce(Frame& F) {
    const float* modp = WSP(float, WS_MODP); float* mod = WSP(float, WS_MOD); const float* ada_b = F.inp(IN_ADAB);
    const int gt = blockIdx.x * 512 + F.tid, NT = F.G * 512;
    for (int i = gt; i < DEPTH * BATCH * MODW / 4; i += NT) {
        const int e4 = i % (MODW / 4), lb = i / (MODW / 4), l = lb >> 3;
        f32x4 s = *(const f32x4*)(ada_b + (size_t)l * MODW + e4 * 4);
#pragma unroll
        for (int dc = 0; dc < 8; ++dc) s += *(const f32x4*)(modp + ((size_t)dc * 32 + lb) * MODW + e4 * 4);
        *(f32x4*)(mod + (size_t)lb * MODW + e4 * 4) = s;
    }
}

__device__ __forceinline__ void ph_post(Frame& F, const bf16* y, const void* xin_, bool xin_f32, void* xout_, bool xout_f32, const float* gate, const float* gy, bf16* hout, const float* gh, const float* shift, const float* scale) {
    LAS float* vec = (LAS float*)F.lds;
    const int rlo = (int)(((long long)blockIdx.x * T) / F.G), rhi = (int)(((long long)(blockIdx.x + 1) * T) / F.G);
    for (int seg = rlo; seg < rhi; ) {
        const int b = seg / SEQ; const int send = ((b + 1) * SEQ < rhi) ? (b + 1) * SEQ : rhi;
        __syncthreads();
        for (int i = F.tid; i < 5 * (DM / 4); i += NWAVES * 64) { const int v = i / (DM / 4), c4 = i % (DM / 4);
            const float* src = (v == 0) ? (y ? gate + (size_t)b * MODW : nullptr) : (v == 1) ? (y ? gy : nullptr) : (v == 2) ? (hout ? gh : nullptr) : (v == 3) ? (hout ? shift + (size_t)b * MODW : nullptr) : (hout ? scale + (size_t)b * MODW : nullptr);
            *(LAS f32x4*)(vec + v * DM + 4 * c4) = src ? *(const f32x4*)(src + 4 * c4) : (f32x4){0.f, 0.f, 0.f, 0.f}; }
        __syncthreads();
        constexpr int NR = 2;
        for (int r0 = seg + 2 * F.wave; r0 < send; r0 += NR * NWAVES) {
            const int r1 = (r0 + 1 < send) ? r0 + 1 : r0;
            int e0 = 4 * F.lane; asm volatile("" : "+v"(e0));
            f32x4 x[NR][8]; v2u yp[NR][8];
            if (xin_f32) { const float* xin = (const float*)xin_;
#pragma unroll
                for (int q = 0; q < NR; ++q) { const int row = q ? r1 : r0;
#pragma unroll
                    for (int j = 0; j < 8; ++j) x[q][j] = *(const f32x4*)(xin + (size_t)row * DM + e0 + 256 * j); }
                if (y) {
#pragma unroll
                    for (int q = 0; q < NR; ++q) { const int row = q ? r1 : r0;
#pragma unroll
                        for (int j = 0; j < 8; ++j) yp[q][j] = *(const v2u*)(y + (size_t)row * DM + e0 + 256 * j); } }
            } else { const bf16* xin = (const bf16*)xin_; v2u xp[NR][8];
#pragma unroll
                for (int q = 0; q < NR; ++q) { const int row = q ? r1 : r0;
#pragma unroll
                    for (int j = 0; j < 8; ++j) xp[q][j] = *(const v2u*)(xin + (size_t)row * DM + e0 + 256 * j); }
                if (y) {
#pragma unroll
                    for (int q = 0; q < NR; ++q) { const int row = q ? r1 : r0;
#pragma unroll
                        for (int j = 0; j < 8; ++j) yp[q][j] = *(const v2u*)(y + (size_t)row * DM + e0 + 256 * j); } }
#pragma unroll
                for (int q = 0; q < NR; ++q) {
#pragma unroll
                    for (int j = 0; j < 8; ++j) { const v2u p = xp[q][j]; x[q][j] = (f32x4){bflo(p.x), bfhi(p.x), bflo(p.y), bfhi(p.y)}; } }
            }
#pragma unroll
            for (int q = 0; q < NR; ++q) { const int row = q ? r1 : r0;
                if (y) {
                    f32x4 yv[8]; float ss = 0.f;
#pragma unroll
                    for (int j = 0; j < 8; ++j) { const v2u p = yp[q][j]; yv[j] = (f32x4){bflo(p.x), bfhi(p.x), bflo(p.y), bfhi(p.y)};
                        ss += (yv[j].x * yv[j].x + yv[j].y * yv[j].y) + (yv[j].z * yv[j].z + yv[j].w * yv[j].w); }
                    const float ry = 1.0f / sqrtf(wave_sum(ss, F.lane) * (1.f / DM) + RMS_EPS);
#pragma unroll
                    for (int j = 0; j < 8; ++j) { const f32x4 g = *(const LAS f32x4*)(vec + 1 * DM + e0 + 256 * j), gt = *(const LAS f32x4*)(vec + 0 * DM + e0 + 256 * j);
                        x[q][j] += gt * (yv[j] * ry * g); }
                    if (xout_f32) { float* xout = (float*)xout_;
#pragma unroll
                        for (int j = 0; j < 8; ++j) *(f32x4*)(xout + (size_t)row * DM + e0 + 256 * j) = x[q][j];
                    } else { bf16* xout = (bf16*)xout_;
#pragma unroll
                        for (int j = 0; j < 8; ++j) { v2u o; o.x = pk2(x[q][j].x, x[q][j].y); o.y = pk2(x[q][j].z, x[q][j].w); *(v2u*)(xout + (size_t)row * DM + e0 + 256 * j) = o; } }
                }
                if (hout) {
                    float ss = 0.f;
#pragma unroll
                    for (int j = 0; j < 8; ++j) ss += (x[q][j].x * x[q][j].x + x[q][j].y * x[q][j].y) + (x[q][j].z * x[q][j].z + x[q][j].w * x[q][j].w);
                    const float rx = 1.0f / sqrtf(wave_sum(ss, F.lane) * (1.f / DM) + RMS_EPS);
#pragma unroll
                    for (int j = 0; j < 8; ++j) { const f32x4 g = *(const LAS f32x4*)(vec + 2 * DM + e0 + 256 * j), sh = *(const LAS f32x4*)(vec + 3 * DM + e0 + 256 * j), sc = *(const LAS f32x4*)(vec + 4 * DM + e0 + 256 * j);
                        const f32x4 hv = (x[q][j] * rx * g) * (sc + 1.0f) + sh;
                        v2u o; o.x = pk2(hv.x, hv.y); o.y = pk2(hv.z, hv.w);
                        *(v2u*)(hout + (size_t)row * DM + e0 + 256 * j) = o; }
                }
            }
        }
        seg = send;
    }
}
__device__ __forceinline__ void ph_dsa_norm(Frame& F, const float* proj, const float* qn, const float* kvn, const float* ikn, bf16* qlat, bf16* ckv, bf16* kidx, float* widx) {
    const int gw = blockIdx.x * NWAVES + F.wave, NGW = F.G * NWAVES; const int e0 = 4 * F.lane;
    for (int row = gw; row < T; row += NGW) {
        f32x4 v[4];
#pragma unroll
        for (int j = 0; j < 4; ++j) v[j] = *(const f32x4*)(proj + (size_t)row * A_INP + e0 + 256 * j);
        float sq = 0.f;
#pragma unroll
        for (int j = 0; j < 2; ++j) sq += (v[j].x * v[j].x + v[j].y * v[j].y) + (v[j].z * v[j].z + v[j].w * v[j].w);
        const float rq = 1.0f / sqrtf(wave_sum(sq, F.lane) * (1.f / A_QR) + RMS_EPS);
#pragma unroll
        for (int j = 0; j < 2; ++j) { const f32x4 g = *(const f32x4*)(qn + e0 + 256 * j); const f32x4 o = v[j] * rq * g; v2u w; w.x = pk2(o.x, o.y); w.y = pk2(o.z, o.w);
            *(v2u*)(qlat + (size_t)row * A_QR + e0 + 256 * j) = w; }
        const float skv = (v[2].x * v[2].x + v[2].y * v[2].y) + (v[2].z * v[2].z + v[2].w * v[2].w);
        const float rkv = 1.0f / sqrtf(wave_sum(skv, F.lane) * (1.f / A_KVR) + RMS_EPS);
        { const f32x4 g = *(const f32x4*)(kvn + e0); const f32x4 o = v[2] * rkv * g; v2u w; w.x = pk2(o.x, o.y); w.y = pk2(o.z, o.w); *(v2u*)(ckv + (size_t)row * A_KVR + e0) = w; }
        const bool isk = F.lane < 32;
        const float s1 = isk ? (v[3].x + v[3].y) + (v[3].z + v[3].w) : 0.f;
        const float mean = wave_sum(s1, F.lane) * (1.f / IDX_D);
        const f32x4 dv = v[3] - mean;
        const float s2 = isk ? (dv.x * dv.x + dv.y * dv.y) + (dv.z * dv.z + dv.w * dv.w) : 0.f;
        const float rk = 1.0f / sqrtf(wave_sum(s2, F.lane) * (1.f / IDX_D) + RMS_EPS);
        if (isk) { const f32x4 g = *(const f32x4*)(ikn + e0); const f32x4 o = dv * rk * g; v2u w; w.x = pk2(o.x, o.y); w.y = pk2(o.z, o.w); *(v2u*)(kidx + (size_t)row * IDX_D + e0) = w; }
        else if (F.lane < 36) { *(f32x4*)(widx + (size_t)row * IDX_H + (e0 - 128)) = v[3] * 0.02209708691207961f; }
    }
}

__device__ __forceinline__ int wave_scan_incl(int v, int lane, int& total) {
    v += __builtin_amdgcn_update_dpp(0, v, 0x111, 0xf, 0xf, true); v += __builtin_amdgcn_update_dpp(0, v, 0x112, 0xf, 0xf, true);
    v += __builtin_amdgcn_update_dpp(0, v, 0x114, 0xf, 0xf, true); v += __builtin_amdgcn_update_dpp(0, v, 0x118, 0xf, 0xf, true);
    const int t0 = __builtin_amdgcn_readlane(v, 15), t1 = __builtin_amdgcn_readlane(v, 31), t2 = __builtin_amdgcn_readlane(v, 47), t3 = __builtin_amdgcn_readlane(v, 63);
    v += (lane >= 16 ? t0 : 0) + (lane >= 32 ? t1 : 0) + (lane >= 48 ? t2 : 0);
    total = (t0 + t1) + (t2 + t3);
    return v;
}
template <bool G, class SP> __device__ __forceinline__ void topk_select_row(SP sc, int t, int* out, int lane, LAS int* lst) {
    const int n = t + 1;
    if (n <= TOPK) { for (int i = lane; i < TOPK; i += 64) out[i] = (i < n) ? i : 0; return; }
    const int ni = G ? 2 * ((n + 127) >> 7) : (n + 63) >> 6;
#define TOPK_KEYIDX(i) (G ? 128 * ((i) >> 1) + 2 * lane + ((i) & 1) : 64 * (i) + lane)
    unsigned key[64];
#pragma unroll
    for (int g = 0; g < 8; ++g) {
        if (8 * g < ni) {
            if constexpr (G) {
#pragma unroll
                for (int j = 4 * g; j < 4 * g + 4; ++j) { const unsigned d = __hip_atomic_load((const unsigned*)sc + 64 * j + lane, __ATOMIC_RELAXED, __HIP_MEMORY_SCOPE_AGENT);
#pragma unroll
                    for (int e = 0; e < 2; ++e) { const int s = 128 * j + 2 * lane + e; const unsigned h = e ? (d >> 16) : (d & 0xffffu); const unsigned k = (h & 0x8000u) ? (~h & 0xffffu) : (h | 0x8000u); key[2 * j + e] = (s < n) ? k : 0u; } }
            } else {
#pragma unroll
                for (int i = 8 * g; i < 8 * g + 8; ++i) { const int s = 64 * i + lane; const unsigned h = sc[s < n ? s : n - 1]; const unsigned k = (h & 0x8000u) ? (~h & 0xffffu) : (h | 0x8000u); key[i] = (s < n) ? k : 0u; }
            }
        } else {
#pragma unroll
            for (int i = 8 * g; i < 8 * g + 8; ++i) key[i] = 0u;
        }
    }
    unsigned prefix = 0u;
    for (int bit = 15; bit >= 0; --bit) {
        const unsigned cand = prefix | (1u << bit); int cl = 0;
#pragma unroll
        for (int g = 0; g < 8; ++g) if (8 * g < ni) {
#pragma unroll
            for (int i = 8 * g; i < 8 * g + 8; ++i) cl += (key[i] >= cand) ? 1 : 0; }
        cl += __builtin_amdgcn_update_dpp(0, cl, 0xB1, 0xf, 0xf, true); cl += __builtin_amdgcn_update_dpp(0, cl, 0x4E, 0xf, 0xf, true);
        cl += __builtin_amdgcn_update_dpp(0, cl, 0x124, 0xf, 0xf, true); cl += __builtin_amdgcn_update_dpp(0, cl, 0x128, 0xf, 0xf, true);
        const int cnt = (__builtin_amdgcn_readlane(cl, 0) + __builtin_amdgcn_readlane(cl, 16)) + (__builtin_amdgcn_readlane(cl, 32) + __builtin_amdgcn_readlane(cl, 48));
        if (cnt >= TOPK) prefix = cand;
    }
    int cg = 0, ce = 0;
#pragma unroll
    for (int g = 0; g < 8; ++g) if (8 * g < ni) {
#pragma unroll
        for (int i = 8 * g; i < 8 * g + 8; ++i) { cg += (key[i] > prefix) ? 1 : 0; ce += (key[i] == prefix) ? 1 : 0; } }
    int tg, te;
    const int bg = wave_scan_incl(cg, lane, tg) - cg, be = wave_scan_incl(ce, lane, te) - ce;
    int quota = (TOPK - tg) - be; quota = quota < 0 ? 0 : (quota > ce ? ce : quota);
    int pg = bg, pe = tg + (be < TOPK - tg ? be : TOPK - tg);
    const int dummy = TOPK + lane;
#pragma unroll
    for (int g = 0; g < 8; ++g) if (8 * g < ni) {
#pragma unroll
        for (int i = 8 * g; i < 8 * g + 8; ++i) {
            const bool gt = key[i] > prefix, eq = (key[i] == prefix) && (quota > 0);
            const int pos = gt ? pg : (eq ? pe : dummy);
            lst[pos] = TOPK_KEYIDX(i);
            pg += gt ? 1 : 0; pe += eq ? 1 : 0; quota -= eq ? 1 : 0;
        } }
    asm volatile("s_waitcnt lgkmcnt(0)" ::: "memory");
    *(v4u*)(out + 4 * lane) = *(const LAS v4u*)(lst + 4 * lane);
#undef TOPK_KEYIDX
}
template <class SP> __device__ __forceinline__ void topk_select_planes(SP sc, int t, int* out, int lane, LAS int* lst) {
    const int n = t + 1;
    if (n <= TOPK) { for (int i = lane; i < TOPK; i += 64) out[i] = (i < n) ? i : 0; return; }
    typedef short s16x2_ __attribute__((ext_vector_type(2)));
    unsigned W[32];
#pragma unroll
    for (int j = 0; j < 32; ++j) { const unsigned h2 = (unsigned)sc[128 * j + lane] | ((unsigned)sc[128 * j + 64 + lane] << 16);
        const s16x2_ sg = __builtin_bit_cast(s16x2_, h2) >> (s16x2_){15, 15};
        W[j] = h2 ^ (__builtin_bit_cast(unsigned, sg) | 0x80008000u); }
    {
        unsigned ml = 0x0000ffffu;
#pragma unroll
        for (int j = 16; j != 0; j >>= 1) { const unsigned mh = ml << j;
#pragma unroll
            for (int k = 0; k < 32; k = (k + j + 1) & ~j) { const unsigned a = W[k], b = W[k + j];
                W[k] = (a & ~mh) | ((b << j) & mh); W[k + j] = (b & ~ml) | ((a >> j) & ml); }
            ml ^= ml << (j >> 1); }
    }
    const int c = (n - lane + 63) >> 6;
    const int ce_ = (c + 1) >> 1, co_ = c >> 1;
    unsigned aE = ce_ >= 32 ? 0xffffffffu : ((1u << ce_) - 1u), aO = co_ >= 32 ? 0xffffffffu : ((1u << co_) - 1u);
    unsigned gE = 0u, gO = 0u; int cnt_gt = 0;
#pragma unroll
    for (int b = 15; b >= 0; --b) {
        const unsigned cE = aE & W[b], cO = aO & W[16 + b];
        int cl = __builtin_popcount(cE) + __builtin_popcount(cO);
        cl += __builtin_amdgcn_update_dpp(0, cl, 0xB1, 0xf, 0xf, true); cl += __builtin_amdgcn_update_dpp(0, cl, 0x4E, 0xf, 0xf, true);
        cl += __builtin_amdgcn_update_dpp(0, cl, 0x124, 0xf, 0xf, true); cl += __builtin_amdgcn_update_dpp(0, cl, 0x128, 0xf, 0xf, true);
        const int cnt = (__builtin_amdgcn_readlane(cl, 0) + __builtin_amdgcn_readlane(cl, 16)) + (__builtin_amdgcn_readlane(cl, 32) + __builtin_amdgcn_readlane(cl, 48));
        const bool take = (cnt_gt + cnt >= TOPK);
        gE = take ? gE : (gE | cE); gO = take ? gO : (gO | cO);
        aE = take ? cE : (aE ^ cE); aO = take ? cO : (aO ^ cO);
        cnt_gt += take ? 0 : cnt;
    }
    const int cg = __builtin_popcount(gE) + __builtin_popcount(gO), ce = __builtin_popcount(aE) + __builtin_popcount(aO);
    int tg, te;
    const int bg = wave_scan_incl(cg, lane, tg) - cg, be = wave_scan_incl(ce, lane, te) - ce;
    int quota = (TOPK - tg) - be; quota = quota < 0 ? 0 : (quota > ce ? ce : quota);
    int pg = bg, pe = tg + (be < TOPK - tg ? be : TOPK - tg);
    for (unsigned m = gE; m; m &= m - 1u) lst[pg++] = 128 * __builtin_ctz(m) + lane;
    for (unsigned m = gO; m; m &= m - 1u) lst[pg++] = 128 * __builtin_ctz(m) + 64 + lane;
    for (unsigned m = aE; m && quota > 0; m &= m - 1u, --quota) lst[pe++] = 128 * __builtin_ctz(m) + lane;
    for (unsigned m = aO; m && quota > 0; m &= m - 1u, --quota) lst[pe++] = 128 * __builtin_ctz(m) + 64 + lane;
    asm volatile("s_waitcnt lgkmcnt(0)" ::: "memory");
    *(v4u*)(out + 4 * lane) = *(const LAS v4u*)(lst + 4 * lane);
}
__device__ __forceinline__ int t5_bucket(int d) {
    if (d < 16) return d;
    int bkt = 16;
    bkt += (d >= 19) + (d >= 21) + (d >= 24) + (d >= 27) + (d >= 31) + (d >= 35) + (d >= 40) + (d >= 46) + (d >= 52) + (d >= 59) + (d >= 67) + (d >= 77) + (d >= 87) + (d >= 99) + (d >= 113);
    return bkt;
}

typedef short bf16x8 __attribute__((ext_vector_type(8)));
typedef short s16x4 __attribute__((ext_vector_type(4)));
typedef float f32x16 __attribute__((ext_vector_type(16)));
__device__ __forceinline__ unsigned offb(unsigned row, unsigned ch) { return 256u * row + 16u * (ch ^ (((row & 3u) << 2) | ((row >> 2) & 3u))); }
__device__ __forceinline__ unsigned tr_base_perm(unsigned lane, unsigned c, unsigned t) {
    const unsigned h = lane >> 5, blk = (lane >> 4) & 1u, q = (lane & 15u) >> 2, p = lane & 3u;
    return offb(8u * t + 4u * h + q, 4u * c + 2u * blk + (p >> 1)) + 8u * (p & 1u);
}
__device__ __forceinline__ bf16x8 tr_frag_at(LAS unsigned char* img, unsigned b0, unsigned b1, unsigned ks) {
    const s16x4 lo = __builtin_amdgcn_ds_read_tr16_b64_v4i16((LAS s16x4*)(img + b0 + 4096u * ks));
    const s16x4 hi = __builtin_amdgcn_ds_read_tr16_b64_v4i16((LAS s16x4*)(img + b1 + 4096u * ks));
    return __builtin_shufflevector(lo, hi, 0, 1, 2, 3, 4, 5, 6, 7);
}

__device__ __forceinline__ float relu1(float x) { const int i = __builtin_bit_cast(int, x); return __builtin_bit_cast(float, i > 0 ? i : 0); }
__device__ __forceinline__ void ph_indexer(Frame& F, const bf16* qidx, const bf16* kidx, const float* widx, int* idxo) {
    constexpr int NQ = 8;
    LAS unsigned short* sc = (LAS unsigned short*)(F.lds);
    LAS float* wsh = (LAS float*)(F.lds + 65536);
    LAS unsigned char* ring = F.lds + 66560;
    const int r = F.lane & 31, hf = F.lane >> 5, rp = F.wave & 1, kq = F.wave >> 1;
    const int drow = 4 * F.wave + (F.lane >> 4), dch = (F.lane & 15) ^ (((F.lane >> 4) << 2) | (F.wave & 3));
    for (int u = blockIdx.x; u < BATCH * (SEQ / NQ); u += F.G) {
        const int b = u & 7, t0 = (u >> 3) * NQ;
        const int nt = (t0 + NQ + 31) >> 5, ns = (nt + 3) >> 2;
        const bf16* kbase = kidx + (size_t)(b * SEQ + drow) * IDX_D + dch * 8;
        __syncthreads();
#pragma unroll
        for (int j = 0; j < 4; ++j) __builtin_amdgcn_global_load_lds((const unsigned*)(kbase + (size_t)(j * 32) * IDX_D), (LAS unsigned*)(ring + j * 8192 + F.wave * 1024), 16, 0, 0);
        if (F.tid < NQ * 16) wsh[F.tid] = widx[(size_t)(b * SEQ + t0 + (F.tid >> 4)) * IDX_H + (F.tid & 15)];
        { const bf16* qb = qidx + (size_t)(b * SEQ + t0 + ((drow >> 2) & 1)) * 2048 + (4 * (drow >> 3) + (drow & 3)) * 128 + dch * 8;
#pragma unroll
          for (int j = 0; j < 4; ++j) __builtin_amdgcn_global_load_lds((const unsigned*)(qb + (size_t)(2 * j) * 2048), (LAS unsigned*)(ring + 32768 + j * 8192 + F.wave * 1024), 16, 0, 0); }
        bf16x8 Af[2][8];
        for (int s = 0; s < ns; ++s) {
            asm volatile("s_waitcnt vmcnt(0) lgkmcnt(0)" ::: "memory"); __builtin_amdgcn_s_barrier(); asm volatile("" ::: "memory");
            if (s == 0) {
#pragma unroll
                for (int rt = 0; rt < 2; ++rt)
#pragma unroll
                    for (int ks = 0; ks < 8; ++ks) Af[rt][ks] = *(const LAS bf16x8*)(ring + 32768 + (2 * rp + rt) * 8192 + offb((unsigned)r, (unsigned)(2 * ks + hf)));
                asm volatile("s_waitcnt lgkmcnt(0)" ::: "memory"); __builtin_amdgcn_s_barrier(); asm volatile("" ::: "memory");
            }
            if (s + 1 < ns) {
#pragma unroll
                for (int j = 0; j < 4; ++j) __builtin_amdgcn_global_load_lds((const unsigned*)(kbase + (size_t)((4 * (s + 1) + j) * 32) * IDX_D), (LAS unsigned*)(ring + ((s + 1) & 1) * 32768 + j * 8192 + F.wave * 1024), 16, 0, 0);
            }
            const int kt = 4 * s + kq;
            if (kt < nt) {
                LAS unsigned char* tile = ring + (s & 1) * 32768 + kq * 8192;
                bf16x8 Bf[8];
#pragma unroll
                for (int ks = 0; ks < 8; ++ks) Bf[ks] = *(const LAS bf16x8*)(tile + offb((unsigned)r, (unsigned)(2 * ks + hf)));
#pragma unroll
                for (int rt = 0; rt < 2; ++rt) {
                    f32x16 acc;
#pragma unroll
                    for (int i = 0; i < 16; ++i) acc[i] = 0.f;
#pragma unroll
                    for (int ks = 0; ks < 8; ++ks) acc = __builtin_amdgcn_mfma_f32_32x32x16_bf16(Af[rt][ks], Bf[ks], acc, 0, 0, 0);
                    float s0 = 0.f, s1 = 0.f;
#pragma unroll
                    for (int i4 = 0; i4 < 4; ++i4) { const f32x4 w4 = *(const LAS f32x4*)(wsh + (4 * rp + 2 * rt + hf) * 16 + 4 * i4);
                        s0 += w4.x * relu1(acc[4 * i4]) + w4.z * relu1(acc[4 * i4 + 2]); s1 += w4.y * relu1(acc[4 * i4 + 1]) + w4.w * relu1(acc[4 * i4 + 3]); }
                    sc[(4 * rp + 2 * rt + hf) * 4096 + kt * 32 + r] = __builtin_bit_cast(unsigned short, (_Float16)(s0 + s1));
                }
            }
        }
        __syncthreads();
        for (int q = F.wave; q < NQ; q += NWAVES) topk_select_planes(sc + q * 4096, t0 + q, idxo + (size_t)(b * SEQ + t0 + q) * TOPK, F.lane, (LAS int*)(F.lds + 132096) + F.wave * 320);
    }
}

#define LDS_BARRIER() do { asm volatile("s_waitcnt lgkmcnt(0)" ::: "memory"); __builtin_amdgcn_s_barrier(); asm volatile("" ::: "memory"); } while (0)
__device__ __forceinline__ int relane(int lane) { asm volatile("" : "+v"(lane)); return lane; }
__device__ __forceinline__ void ph_sparse_attn(Frame& F, bf16* qa_olat, const bf16* ckv, const int* idxi, const float* relb) {
    LAS unsigned char* KV = F.lds;
    LAS unsigned char* PF = F.lds + 131072;
    LAS float* wmax = (LAS float*)(F.lds + 147456);
    LAS float* wsum = wmax + 256;
    LAS unsigned char* bks = F.lds + 147456 + 2048;
    LAS float* relbs = (LAS float*)(F.lds + 147456 + 2048 + 512);
    LAS float* invw = (LAS float*)(F.lds + 147456 + 2048 + 512 + 4224);
    LAS unsigned char* blut = F.lds + 147456 + 2048 + 512 + 4224 + 1024;
    const float scale = 0.08838834764831845f;
    const int w = F.wave;
    __syncthreads();
    for (int i = F.tid; i < 1024; i += 512) relbs[i] = relb[i];
    if (F.tid < 32) relbs[1024 + F.tid] = -INFINITY;
    if (F.tid < 128) blut[F.tid] = (unsigned char)t5_bucket(F.tid);
    int u = blockIdx.x;
    if (u >= T) return;
    int idc[16]; int bid; v4u R[16]; v4u Qr[2];
    {
        const int cc = F.lane & 31, r = F.lane & 31, hf = F.lane >> 5;
        const int t = u % SEQ, b = u / SEQ;
        const int* ip = idxi + (size_t)u * TOPK + 32 * w + hf;
#pragma unroll
        for (int k = 0; k < 16; ++k) idc[k] = ip[2 * k];
        const bf16* kb = ckv + (size_t)b * SEQ * A_KVR + cc * 8;
#pragma unroll
        for (int k = 0; k < 16; ++k) R[k] = *(const v4u*)(kb + (size_t)idc[k] * A_KVR);
        if (F.tid < 256) { const int id = idxi[(size_t)u * TOPK + F.tid]; const int d = t - id; bks[F.tid] = (F.tid <= t) ? (unsigned char)t5_bucket(d > 0 ? d : 0) : (unsigned char)32; }
        const int u2 = (u + F.G < T) ? u + F.G : u;
        const int* ip2 = idxi + (size_t)u2 * TOPK + 32 * w + hf;
#pragma unroll
        for (int k = 0; k < 16; ++k) idc[k] = ip2[2 * k];
        bid = (F.tid < 256) ? idxi[(size_t)u2 * TOPK + F.tid] : -1;
        { const v4u* qp = (const v4u*)(qa_olat + (size_t)u * A_HEADS * A_KVR);
#pragma unroll
          for (int j = 0; j < 2; ++j) { const int id = 2 * w + j, head = 8 * (id & 3) + (F.lane & 7), pos = 8 * (id >> 2) + (F.lane >> 3); Qr[j] = qp[head * 32 + pos]; } }
    }
    unsigned wro[16], qwo[2], trb[2];
    { const unsigned r0 = F.lane & 31, hf0 = F.lane >> 5; const unsigned c0 = (r0 & 15u) ^ (4u * hf0);
#pragma unroll
      for (int k = 0; k < 16; ++k) wro[k] = (r0 >> 4) * 65536u + 256u * (32u * w + hf0) + 512u * k + 16u * (c0 ^ (unsigned)(8 * (k & 1) + ((k >> 1) & 3)));
#pragma unroll
      for (int j = 0; j < 2; ++j) { const int id = 2 * w + j, head = 8 * (id & 3) + (F.lane & 7), pos = 8 * (id >> 2) + (F.lane >> 3); qwo[j] = (pos >> 1) * 1024 + ((pos & 1) * 32 + head) * 16; }
      trb[0] = tr_base_perm((unsigned)F.lane, (unsigned)(w & 3), 0u); trb[1] = tr_base_perm((unsigned)F.lane, (unsigned)(w & 3), 1u); }
    unsigned rdo[16];
    { const unsigned r0 = F.lane & 31, hf0 = F.lane >> 5, row = 32u * w + r0, xr = ((row & 3u) << 2) | ((row >> 2) & 3u);
#pragma unroll
      for (int ks = 0; ks < 16; ++ks) rdo[ks] = 256u * row + (ks >> 3) * 65536u + 16u * ((unsigned)(2 * (ks & 7) + hf0) ^ xr); }
    for (int it = 0; u < T; u += F.G, ++it) {
        const int un = u + F.G, unn = u + 2 * F.G, par = it & 1;
        LDS_BARRIER();
        const int l2 = relane(F.lane), r = l2 & 31, hf = l2 >> 5;
        {
#pragma unroll
          for (int k = 0; k < 16; ++k) *(LAS v4u*)(KV + wro[k]) = R[k]; }
        *(LAS v4u*)(PF + qwo[0]) = Qr[0]; *(LAS v4u*)(PF + qwo[1]) = Qr[1];
        LDS_BARRIER();
        const int tid1 = w * 64 + l2;
        const int unb = (un < T) ? un : u; const int bn = unb / SEQ, tn = unb % SEQ;
        const bf16* kbn = ckv + (size_t)bn * SEQ * A_KVR + r * 8;
        f32x16 acc;
#pragma unroll
        for (int i = 0; i < 16; ++i) acc[i] = 0.f;
        {
#pragma unroll
          for (int ks = 0; ks < 16; ++ks) { const bf16x8 a = *(const LAS bf16x8*)(KV + rdo[ks]);
              acc = __builtin_amdgcn_mfma_f32_32x32x16_bf16(a, *(const LAS bf16x8*)(PF + ks * 1024 + l2 * 16), acc, 0, 0, 0);
              R[ks] = *(const v4u*)(kbn + (size_t)idc[ks] * A_KVR); } }
        if (tid1 < 256) { int d = tn - bid; d = d < 0 ? 0 : (d > 127 ? 127 : d); bks[(par ^ 1) * 256 + tid1] = (tid1 <= tn) ? blut[d] : (unsigned char)32; }
        { const v4u* qp = (const v4u*)(qa_olat + (size_t)unb * A_HEADS * A_KVR);
#pragma unroll
          for (int j = 0; j < 2; ++j) { const int id = 2 * w + j, head = 8 * (id & 3) + (l2 & 7), pos = 8 * (id >> 2) + (l2 >> 3); Qr[j] = qp[head * 32 + pos]; } }
        float lg[16]; float m = -INFINITY;
#pragma unroll
        for (int g = 0; g < 4; ++g) { const unsigned b4 = *(const LAS unsigned*)(bks + par * 256 + 32 * w + 8 * g + 4 * hf);
#pragma unroll
            for (int j = 0; j < 4; ++j) { const unsigned bk = (b4 >> (8 * j)) & 255u; const int i = 4 * g + j;
                lg[i] = acc[i] * scale + relbs[bk * 32 + r]; m = fmaxf(m, lg[i]); } }
        m = fmaxf(m, shx(m, 32, l2));
        if (hf == 0) wmax[r * 8 + w] = m;
        LDS_BARRIER();
        { const f32x4 m0 = *(const LAS f32x4*)(wmax + r * 8), m1 = *(const LAS f32x4*)(wmax + r * 8 + 4);
          m = fmaxf(fmaxf(fmaxf(m0.x, m0.y), fmaxf(m0.z, m0.w)), fmaxf(fmaxf(m1.x, m1.y), fmaxf(m1.z, m1.w))); }
        float s = 0.f;
#pragma unroll
        for (int i = 0; i < 16; ++i) { lg[i] = __expf(lg[i] - m); s += lg[i]; }
        s += shx(s, 32, l2);
        if (hf == 0) wsum[r * 8 + w] = s;
#pragma unroll
        for (int s2 = 0; s2 < 2; ++s2) { v4u pk; pk.x = pk2(lg[8 * s2 + 0], lg[8 * s2 + 1]); pk.y = pk2(lg[8 * s2 + 2], lg[8 * s2 + 3]); pk.z = pk2(lg[8 * s2 + 4], lg[8 * s2 + 5]); pk.w = pk2(lg[8 * s2 + 6], lg[8 * s2 + 7]);
            *(LAS v4u*)(PF + (2 * w + s2) * 1024 + l2 * 16) = pk; }
        LDS_BARRIER();
        const int l3 = relane(F.lane), r3 = l3 & 31, hf3 = l3 >> 5;
        if (hf3 == 0) { const f32x4 s0 = *(const LAS f32x4*)(wsum + r3 * 8), s1 = *(const LAS f32x4*)(wsum + r3 * 8 + 4);
            invw[w * 32 + r3] = 1.0f / (((s0.x + s0.y) + (s0.z + s0.w)) + ((s1.x + s1.y) + (s1.z + s1.w))); }
        f32x16 o;
#pragma unroll
        for (int i = 0; i < 16; ++i) o[i] = 0.f;
        LAS unsigned char* img = KV + (w >> 2) * 65536;
        const int unc = (unn < T) ? unn : u;
        const int* ip2 = idxi + (size_t)unc * TOPK + 32 * w + hf3;
        const unsigned tb0 = trb[0], tb1 = trb[1];
#pragma unroll
        for (int ks = 0; ks < 16; ++ks) { const bf16x8 a = *(const LAS bf16x8*)(PF + ks * 1024 + l3 * 16);
            const bf16x8 bb = tr_frag_at(img, tb0, tb1, (unsigned)ks);
            o = __builtin_amdgcn_mfma_f32_32x32x16_bf16(a, bb, o, 0, 0, 0);
            idc[ks] = ip2[2 * ks]; }
        if (w * 64 + l3 < 256) bid = idxi[(size_t)unc * TOPK + w * 64 + l3];
        bf16* op = qa_olat + ((size_t)u * A_HEADS + 4 * hf3) * A_KVR + 32 * w + r3;
#pragma unroll
        for (int g = 0; g < 4; ++g) { const f32x4 iv = *(const LAS f32x4*)(invw + w * 32 + 8 * g + 4 * hf3);
            op[(8 * g + 0) * A_KVR] = (bf16)f2bf(o[4 * g + 0] * iv.x); op[(8 * g + 1) * A_KVR] = (bf16)f2bf(o[4 * g + 1] * iv.y);
            op[(8 * g + 2) * A_KVR] = (bf16)f2bf(o[4 * g + 2] * iv.z); op[(8 * g + 3) * A_KVR] = (bf16)f2bf(o[4 * g + 3] * iv.w); }
    }
}

__device__ __forceinline__ void ph_sb_attn(Frame& F, const bf16* qkv, bf16* o_out, unsigned* qctr) {
    LAS unsigned char* img = F.lds + F.wave * 8192;
    LAS unsigned char* qimg = F.lds + 65536 + F.wave * 8192;
    const int r = F.lane & 31, hf = F.lane >> 5;
    const float scale = 0.08838834764831845f;
    constexpr int NTASK8 = BATCH * B_HEADS * (SEQ / 32) / 8;
    const int myx = (int)(xb_xcc_id() & 7u);
    for (int qi = 0; qi < 8; ++qi) { const int qsel = (myx + qi) & 7;
    for (;;) {
        int task = 0;
        if (F.lane == 0) task = (int)__hip_atomic_fetch_add(qctr + 64 * qsel, 1u, __ATOMIC_RELAXED, __HIP_MEMORY_SCOPE_AGENT);
        task = __builtin_amdgcn_readfirstlane(task);
        if (task >= NTASK8) break;
        task += qsel * NTASK8;
        const int qt = task & 127, bh = task >> 7, h = bh & 15, b = bh >> 4, t0 = qt * 32;
        v4u Kr[8], Vr[8];
#pragma unroll
        for (int k = 0; k < 8; ++k) { const int n = F.lane + 64 * k; *(LAS v4u*)(qimg + offb(n >> 4, n & 15)) = *(const v4u*)(qkv + (size_t)(b * SEQ + t0 + (n >> 4)) * B_INC + h * B_HD + (n & 15) * 8); }
        {
#pragma unroll
          for (int k = 0; k < 8; ++k) { const int n = F.lane + 64 * k; const bf16* rp = qkv + (size_t)(b * SEQ + qt * 32 + (n >> 4)) * B_INC + h * B_HD + (n & 15) * 8; Kr[k] = *(const v4u*)(rp + DM); Vr[k] = *(const v4u*)(rp + 2 * DM); } }
        f32x16 o[4];
#pragma unroll
        for (int dt = 0; dt < 4; ++dt)
#pragma unroll
            for (int i = 0; i < 16; ++i) o[dt][i] = 0.f;
        float Rc = 1.f;
        for (int kt = qt; kt >= 0; --kt) {
            const int ll = relane(F.lane), r = ll & 31, hf = ll >> 5;
#pragma unroll
            for (int k = 0; k < 8; ++k) { const int n = ll + 64 * k; *(LAS v4u*)(img + offb(n >> 4, n & 15)) = Kr[k]; }
            f32x16 acc;
#pragma unroll
            for (int i = 0; i < 16; ++i) acc[i] = 0.f;
#pragma unroll
            for (int ks = 0; ks < 8; ++ks) acc = __builtin_amdgcn_mfma_f32_32x32x16_bf16(*(const LAS bf16x8*)(img + offb(r, 2 * ks + hf)), *(const LAS bf16x8*)(qimg + offb(r, 2 * ks + hf)), acc, 0, 0, 0);
            asm volatile("s_waitcnt lgkmcnt(0)" ::: "memory");
#pragma unroll
            for (int k = 0; k < 8; ++k) { const int n = ll + 64 * k; *(LAS v4u*)(img + offb(n >> 4, n & 15)) = Vr[k]; }
            float be[16], om[16];
            const bool diag = (kt == qt);
#pragma unroll
            for (int i = 0; i < 16; ++i) { const float z = fminf(acc[i] * scale, 80.f);
                const float e = __expf(z), rr = __builtin_amdgcn_rcpf(1.0f + e);
                be[i] = e * rr; om[i] = rr; }
            if (diag) {
#pragma unroll
                for (int i = 0; i < 16; ++i) { const int kap = 8 * (i >> 2) + 4 * hf + (i & 3); if (kap >= r) { be[i] = 0.f; om[i] = 1.f; } } }
            float sfx[16], Gt[4], Go[4];
#pragma unroll
            for (int g = 0; g < 4; ++g) { sfx[4 * g + 3] = 1.f; sfx[4 * g + 2] = om[4 * g + 3]; sfx[4 * g + 1] = sfx[4 * g + 2] * om[4 * g + 2]; sfx[4 * g + 0] = sfx[4 * g + 1] * om[4 * g + 1]; Gt[g] = sfx[4 * g + 0] * om[4 * g + 0]; }
#pragma unroll
            for (int g = 0; g < 4; ++g) Go[g] = shx(Gt[g], 32, ll);
            float SP[4]; SP[3] = 1.f; SP[2] = Gt[3] * Go[3]; SP[1] = SP[2] * (Gt[2] * Go[2]); SP[0] = SP[1] * (Gt[1] * Go[1]);
            float wgt[16];
#pragma unroll
            for (int g = 0; g < 4; ++g) { const float Rg = Rc * SP[g] * (hf == 0 ? Go[g] : 1.f);
#pragma unroll
                for (int j = 0; j < 4; ++j) wgt[4 * g + j] = be[4 * g + j] * (Rg * sfx[4 * g + j]); }
            Rc = Rc * (SP[0] * (Gt[0] * Go[0]));
            if (kt > 0) {
#pragma unroll
                for (int k = 0; k < 8; ++k) { const int n = F.lane + 64 * k; const bf16* rp = qkv + (size_t)(b * SEQ + (kt - 1) * 32 + (n >> 4)) * B_INC + h * B_HD + (n & 15) * 8; Kr[k] = *(const v4u*)(rp + DM); Vr[k] = *(const v4u*)(rp + 2 * DM); }
            }
            asm volatile("s_waitcnt lgkmcnt(0)" ::: "memory");
#pragma unroll
            for (int s2 = 0; s2 < 2; ++s2) {
                v4u pk; pk.x = pk2(wgt[8 * s2 + 0], wgt[8 * s2 + 1]); pk.y = pk2(wgt[8 * s2 + 2], wgt[8 * s2 + 3]); pk.z = pk2(wgt[8 * s2 + 4], wgt[8 * s2 + 5]); pk.w = pk2(wgt[8 * s2 + 6], wgt[8 * s2 + 7]);
                const bf16x8 pa = __builtin_bit_cast(bf16x8, pk);
#pragma unroll
                for (int dt = 0; dt < 4; ++dt) { const bf16x8 vb = tr_frag_at(img, tr_base_perm((unsigned)ll, (unsigned)dt, 0u), tr_base_perm((unsigned)ll, (unsigned)dt, 1u), (unsigned)s2);
                    o[dt] = __builtin_amdgcn_mfma_f32_32x32x16_bf16(pa, vb, o[dt], 0, 0, 0); }
            }
            if (__ballot(Rc >= 0x1p-40f) == 0ull) break;
        }
#pragma unroll
        for (int dt = 0; dt < 4; ++dt)
#pragma unroll
            for (int i = 0; i < 16; ++i) { const int qrow = 8 * (i >> 2) + 4 * hf + (i & 3);
                o_out[(size_t)(b * SEQ + t0 + qrow) * DM + h * B_HD + 32 * dt + r] = (bf16)f2bf(o[dt][i]); }
    }
    }
}

constexpr int PH_LAYER0 = 3, PH_PER_LAYER = 16, PH_END = PH_LAYER0 + DEPTH * PH_PER_LAYER;
typedef pg8::bf16_t gb16;
__device__ __forceinline__ bool relaunder(Frame& F) { int l_; asm volatile("v_mbcnt_lo_u32_b32 %0, -1, 0\n\tv_mbcnt_hi_u32_b32 %0, -1, %0" : "=v"(l_)); F.lane = l_; F.tid = F.wave * 64 + l_; return true; }
template <class Epi> __device__ __forceinline__ void run_gemm(Frame& F, const bf16* A, const bf16* Bt, int N, int K, int lda, int ldb, int acs, const Epi& E) {
    pg8::Gemm g{(const gb16*)A, (const gb16*)Bt, T, N, K, lda, ldb, acs}; pg8::StaticOrder S; S.init(T, N, F.G, (F.G == 256) ? (int)((blockIdx.x & 31) * 8 + (blockIdx.x >> 5)) : (int)blockIdx.x);
    pg8::gemm_phase<Epi, pg8::StaticOrder, true, true>(F.lds, g, S, E, F.tid);
}
__global__ void __launch_bounds__(NWAVES * 64, 2) fwd_kernel(Args args) {
    extern __shared__ __attribute__((aligned(16))) unsigned char lds_raw[];
    Frame F;
    F.lds = (LAS unsigned char*)lds_raw;
    F.tid = threadIdx.x; F.lane = F.tid & 63; F.wave = __builtin_amdgcn_readfirstlane(F.tid >> 6); F.G = gridDim.x;
    F.ap = (const CAS Args*)__builtin_amdgcn_kernarg_segment_ptr();
    F.out = args.out; F.ws = args.ws;
    volatile LAS unsigned* MISC = (volatile LAS unsigned*)(F.lds + MISC_OFF);
    if (F.tid < 64) MISC[F.tid] = 0u;
    __syncthreads();
    const int lo = args.ph_lo, hi = args.ph_hi;
    XcdBarrier bar; bar.bar = (unsigned*)(F.ws + WS_CTL) + CW_BAR; bar.x = 0; bar.st = nullptr;
    if (hi - lo > 1) { bar = xcd_barrier_post((unsigned*)(F.ws + WS_CTL) + CW_BAR, MISC + 8); xcd_barrier<true>(bar); }
#define IN(k) (lo <= (k) && (k) < hi && relaunder(F))
#define INR(k) (lo <= (k) && (k) < hi)
#define GRID_BAR() do { XcdBarrier b2_ = bar; b2_.x = (unsigned)__builtin_amdgcn_readfirstlane((int)bar.x); asm volatile("" : "+s"(b2_.bar), "+s"(b2_.x)); xcd_barrier<false>(b2_); } while (0)
#define SEAM(k) do { if (INR((k) + 1)) GRID_BAR(); } while (0)

    float* mod = WSP(float, WS_MOD);
    const float* normg = F.inp(IN_NORMG);
    bf16* Hb = WSP(bf16, WS_H);
    if (IN(0)) { ph_prologue(F); SEAM(0); }
    if (IN(1)) { ph_modreduce(F); SEAM(1); }
    if (IN(2)) { ph_post(F, nullptr, F.inp(IN_X), true, nullptr, false, nullptr, nullptr, Hb, normg + 0 * DM, mod + 0 * DM, mod + 1 * DM); SEAM(2); }

    for (int L = 0; L < DEPTH; ++L) {
        const int pb = PH_LAYER0 + PH_PER_LAYER * L, j = L >> 1;
        const float* modL = mod + (size_t)L * BATCH * MODW;
        const float* ng = normg + (size_t)L * 4 * DM;
        const bool lastL = (L == DEPTH - 1);
        bf16* XB = (bf16*)((unsigned char*)F.out + 128 * MiB); bf16* XL = WSP(bf16, WS_P + 128 * MiB);
        if ((L & 1) == 0) {
            float* proj = WSP(float, WS_P); bf16* qidx = WSP(bf16, WS_P + 128 * MiB); bf16* ob = WSP(bf16, WS_P);
            bf16* big = WSP(bf16, WS_BIG);
            bf16* qlat = WSP(bf16, WS_QLAT); bf16* ckv = WSP(bf16, WS_CKV); bf16* kidx = WSP(bf16, WS_KIDX); float* widx = WSP(float, WS_WIDX); int* idxb = WSP(int, WS_IDX);
            if (IN(pb + 0)) { pg8::EpiF32 E{proj, A_INP}; run_gemm(F, Hb, WSP(bf16, WS_WAIN) + (size_t)j * A_INP * DM, A_INP, DM, DM, DM, 0, E); SEAM(pb + 0); }
            if (IN(pb + 1)) { ph_dsa_norm(F, proj, F.inp(IN_AQN) + j * A_QR, F.inp(IN_AKVN) + j * A_KVR, F.inp(IN_AIKN) + j * IDX_D, qlat, ckv, kidx, widx); SEAM(pb + 1); }
            if (IN(pb + 2)) { pg8::EpiBf16<0> E{(gb16*)big, 8192, (gb16*)qidx, 2048, 8192}; run_gemm(F, qlat, WSP(bf16, WS_WQC) + (size_t)j * 10240 * 512, 10240, A_QR, A_QR, A_QR, 0, E); SEAM(pb + 2); }
            if (IN(pb + 3)) { ph_indexer(F, qidx, kidx, widx, idxb); SEAM(pb + 3); }
            if (IN(pb + 4)) { ph_sparse_attn(F, big, ckv, idxb, F.inp(IN_RELB)); SEAM(pb + 4); }
            if (IN(pb + 5)) { pg8::EpiBf16<0> E{(gb16*)ob, 4096, (gb16*)ob, 4096, 1 << 30}; run_gemm(F, big, WSP(bf16, WS_WUV) + (size_t)j * 4096 * 512, 4096, 512, 8192, 512, 512, E); SEAM(pb + 5); }
            if (IN(pb + 6)) { pg8::EpiBf16<0> E{(gb16*)big, DM, (gb16*)big, DM, 1 << 30}; run_gemm(F, ob, WSP(bf16, WS_WAOUT) + (size_t)j * DM * 4096, DM, 4096, 4096, 4096, 0, E); SEAM(pb + 6); }
        } else {
            bf16* qkv = WSP(bf16, WS_BIG); bf16* ob = WSP(bf16, WS_P); bf16* big = WSP(bf16, WS_BIG);
            if (IN(pb + 0)) { pg8::EpiBf16<0> E{(gb16*)qkv, B_INC, (gb16*)qkv, B_INC, 1 << 30}; run_gemm(F, Hb, WSP(bf16, WS_WBIN) + (size_t)j * B_INC * DM, B_INC, DM, DM, DM, 0, E); SEAM(pb + 0); }
            if (IN(pb + 1)) { ph_sb_attn(F, qkv, ob, (unsigned*)(F.ws + WS_CTL) + CW_SBQ + 512 * j); SEAM(pb + 1); }
            if (IN(pb + 2)) { pg8::EpiBf16<0> E{(gb16*)big, DM, (gb16*)big, DM, 1 << 30}; run_gemm(F, ob, WSP(bf16, WS_WBOUT) + (size_t)j * DM * DM, DM, DM, DM, DM, 0, E); if (INR(pb + 7)) GRID_BAR(); }
        }
        if (IN(pb + 7)) { ph_post(F, WSP(bf16, WS_BIG), (L == 0) ? (const void*)F.inp(IN_X) : (const void*)XB, L == 0, lastL ? (void*)XL : (void*)XB, false, modL + 2 * DM, ng + 1 * DM, Hb, ng + 2 * DM, modL + 3 * DM, modL + 4 * DM); SEAM(pb + 7); }
        if (IN(pb + 8)) { pg8::EpiBf16<1> E{(gb16*)WSP(bf16, WS_BIG), DFF, (gb16*)WSP(bf16, WS_BIG), DFF, 1 << 30}; run_gemm(F, Hb, WSP(bf16, WS_WM1) + (size_t)L * DFF * DM, DFF, DM, DM, DM, 0, E); SEAM(pb + 8); }
        if (IN(pb + 9)) { pg8::EpiBf16<0> E{(gb16*)WSP(bf16, WS_P), DM, (gb16*)WSP(bf16, WS_P), DM, 1 << 30}; run_gemm(F, WSP(bf16, WS_BIG), WSP(bf16, WS_WM2) + (size_t)L * DM * DFF, DM, DFF, DFF, DFF, 0, E); SEAM(pb + 9); }
        if (IN(pb + 10)) {
            const float* modN = mod + (size_t)(L + 1) * BATCH * MODW; const float* ngN = normg + (size_t)(L + 1) * 4 * DM;
            ph_post(F, WSP(bf16, WS_P), lastL ? (const void*)XL : (const void*)XB, false, lastL ? (void*)F.out : (void*)XB, lastL, modL + 5 * DM, ng + 3 * DM, lastL ? nullptr : Hb, ngN, modN + 0 * DM, modN + 1 * DM);
            if (!lastL && INR(pb + PH_PER_LAYER)) GRID_BAR();
        }
    }
#undef IN
#undef INR
#undef GRID_BAR
#undef SEAM
}

extern "C" void kernel_launch(void* const* d_in, const int* in_sizes, int n_in, void* d_out, int out_size, void* d_ws, size_t ws_size, hipStream_t stream) {
    static int grid = 0;
    if (grid == 0) {
        if (n_in != N_IN || out_size != T * DM || ws_size < WS_END) { fprintf(stderr, "kernel_launch: unexpected problem: n_in %d out %d ws %zu (need %zu); nothing launched\n", n_in, out_size, ws_size, (size_t)WS_END); grid = -1; return; }
        int dev = 0, cus = 0, per_cu = 0;
        if (hipGetDevice(&dev) != hipSuccess || hipDeviceGetAttribute(&cus, hipDeviceAttributeMultiprocessorCount, dev) != hipSuccess) { grid = -1; return; }
        if (hipFuncSetAttribute((const void*)fwd_kernel, hipFuncAttributeMaxDynamicSharedMemorySize, LDS_BYTES) != hipSuccess) { fprintf(stderr, "kernel_launch: hipFuncSetAttribute(%d B LDS) failed\n", LDS_BYTES); grid = -1; return; }
        if (hipOccupancyMaxActiveBlocksPerMultiprocessor(&per_cu, (const void*)fwd_kernel, NWAVES * 64, LDS_BYTES) != hipSuccess || per_cu < 1) { fprintf(stderr, "kernel_launch: occupancy query says %d workgroups per CU; nothing launched\n", per_cu); (void)hipGetLastError(); grid = -1; return; }
        grid = cus * (per_cu < 1 ? per_cu : 1);
    }
    if (grid < 0) return;
    (void)hipMemsetAsync((char*)d_ws + WS_CTL, 0, CTL_ZERO_BYTES, stream);
    Args a{};
    for (int i = 0; i < N_IN; ++i) a.in[i] = (const float*)d_in[i];
    a.out = (float*)d_out; a.ws = (unsigned char*)d_ws;
#if ONE_LAUNCH
    a.ph_lo = 0; a.ph_hi = PH_END;
    hipLaunchKernelGGL(fwd_kernel, dim3(grid), dim3(NWAVES * 64), LDS_BYTES, stream, a);
#else
    for (int p = 0; p < PH_END; ++p) {
        if (p >= PH_LAYER0) { const int L = (p - PH_LAYER0) / PH_PER_LAYER, r = (p - PH_LAYER0) % PH_PER_LAYER;
            if (r > 10) continue; if ((L & 1) && r >= 3 && r <= 6) continue; }
        a.ph_lo = p; a.ph_hi = p + 1;
        hipLaunchKernelGGL(fwd_kernel, dim3(grid), dim3(NWAVES * 64), LDS_BYTES, stream, a);
    }
#endif
}
```

```cpp
#include <hip/hip_runtime.h>
#include <cstdio>
#include <cstdint>
#ifndef ONE_LAUNCH
#define ONE_LAUNCH 1
#endif
namespace pg8 {
#define PG8_LAS __attribute__((address_space(3)))
typedef unsigned short bf16_t;
typedef short bf16x8 __attribute__((ext_vector_type(8)));
typedef float f32x4 __attribute__((ext_vector_type(4)));
typedef unsigned u32x4 __attribute__((ext_vector_type(4)));
constexpr int BM = 256, BK = 64, HALF = 128, HTB = HALF * BK * 2  , STAGE_BYTES = 8 * HTB, NXCD = 8, WGM = 4;

__host__ __device__ __forceinline__ int lds_byte(int r, int c) { return r * 128 + 16 * ((c >> 3) ^ ((r >> 1) & 7)) + (c & 7) * 2; }
__host__ __device__ __forceinline__ void stage_rc(int b, int& R, int& C) { R = b >> 7; C = (((b >> 4) & 7) ^ ((R >> 1) & 7)) * 8; }
__host__ __device__ __forceinline__ int perm32(int rho) { const int n = rho >> 4, i = rho & 15; return 8 * (i >> 2) + 4 * n + (i & 3); }

struct Unit { int pm, pn; };
struct Gemm { const bf16_t* A; const bf16_t* Bt; int M, N, K, lda, ldb, acs; };

struct StaticOrder {
    int nM, nN, nwg, G, c;
    __host__ __device__ void init(int M, int N, int G_, int c_) { nM = M / BM; nN = N / BM; nwg = nM * nN; G = G_; c = c_; }
    __host__ __device__ bool next(int i, Unit& u) const {
        const long L = (long)i * G + c; if (L >= nwg) return false;
        int wgid = (int)L; { const int q = nwg / NXCD, r = nwg % NXCD, xcd = wgid % NXCD, off = wgid / NXCD; wgid = (xcd < r ? xcd * (q + 1) : r * (q + 1) + (xcd - r) * q) + off; }
        const int nig = WGM * nN, gid = wgid / nig, fm = gid * WGM, gsz = (nM - fm) < WGM ? (nM - fm) : WGM;
        u.pm = fm + ((wgid % nig) % gsz); u.pn = (wgid % nig) / gsz; return true;
    }
    __device__ __forceinline__ void a_ready(const Unit&) const {}
    __device__ __forceinline__ void done(const Unit&) const {}
};


__device__ __forceinline__ float relu_f(float x) { const int i = __builtin_bit_cast(int, x); return __builtin_bit_cast(float, i > 0 ? i : 0); }
typedef float f32x2_cv __attribute__((ext_vector_type(2))); typedef __bf16 bf16x2_cv __attribute__((ext_vector_type(2)));
__device__ __forceinline__ unsigned cvt_pk_bf16(float lo, float hi) { return __builtin_bit_cast(unsigned, __builtin_convertvector((f32x2_cv){lo, hi}, bf16x2_cv)); }
struct EpiF32 {
    static constexpr bool PERM = false, AFTER_DRAIN = false;
    float* C; int ldc;
    __device__ __forceinline__ void operator()(const f32x4 (&acc)[2][2][4][2], const Unit& u, int wr, int wc, int fr, int fq, PG8_LAS unsigned char* lds) const {
        PG8_LAS unsigned char* scr = lds + STAGE_BYTES + (wr * 4 + wc) * 2048;
        const int lane = fq * 16 + fr, rrow = lane >> 3, rch = lane & 7;
        PG8_LAS unsigned char* wp = scr + fr * 128 + 16 * (fq ^ (fr >> 1));
        const int wsw = ((fr >> 1) & 4) ? -64 : 64;
        const PG8_LAS unsigned char* rp = scr + rrow * 128 + 16 * (rch ^ ((rrow >> 1) & 7));
        const int rsw = (rch & 4) ? -64 : 64;
        float* gp = C + (size_t)(u.pm * BM + wr * 64 + rrow) * ldc + u.pn * BM + wc * 32 + 4 * rch;
#pragma unroll
        for (int ai = 0; ai < 2; ++ai)
#pragma unroll
            for (int m = 0; m < 4; ++m)
#pragma unroll
                for (int bj = 0; bj < 2; ++bj) {
#pragma unroll
                    for (int n = 0; n < 2; ++n) *(PG8_LAS f32x4*)(wp + (n ? wsw : 0)) = acc[ai][bj][m][n];
#pragma unroll
                    for (int s = 0; s < 2; ++s) { const f32x4 w = *(const PG8_LAS f32x4*)(rp + s * 1024 + (s ? rsw : 0));
                        *(f32x4*)(gp + (size_t)(ai * HALF + m * 16 + s * 8) * ldc + bj * HALF) = w; } }
    }
};
template <int ACT> struct EpiBf16 {
    static constexpr bool PERM = true, AFTER_DRAIN = false;
    bf16_t* O0; int ld0; bf16_t* O1; int ld1; int split_col;
    __device__ __forceinline__ void operator()(const f32x4 (&acc)[2][2][4][2], const Unit& u, int wr, int wc, int fr, int fq, PG8_LAS unsigned char* lds) const {
        int colt = u.pn * BM; bf16_t* base = O0; int ldc = ld0;
        if (colt >= split_col) { base = O1; ldc = ld1; colt -= split_col; }
        PG8_LAS unsigned char* scr = lds + STAGE_BYTES + (wr * 4 + wc) * 2048;
        const int lane = fq * 16 + fr, rrow = lane >> 3, rch = lane & 7;
        PG8_LAS unsigned char* wp = scr + fr * 128 + 16 * (fq ^ (fr >> 1));
        const int wsw = ((fr >> 1) & 4) ? -64 : 64;
        const PG8_LAS unsigned char* rp = scr + rrow * 128 + 16 * (rch ^ ((rrow >> 1) & 7));
        const int rsw = (rch & 4) ? -64 : 64;
        bf16_t* gp = base + (size_t)(u.pm * BM + wr * 64 + rrow) * ldc + colt + wc * 64 + 8 * rch;
        u32x4 rd[2];
#pragma unroll
        for (int it = 0; it < 8; ++it) { const int ai = it >> 2, m = it & 3;
#pragma unroll
            for (int bj = 0; bj < 2; ++bj) { f32x4 v0 = acc[ai][bj][m][0], v1 = acc[ai][bj][m][1];
                if (ACT == 1) {
#pragma unroll
                    for (int j = 0; j < 4; ++j) { const float a = relu_f(v0[j]), b = relu_f(v1[j]); v0[j] = a * a; v1[j] = b * b; } }
                u32x4 w; w.x = cvt_pk_bf16(v0[0], v0[1]); w.y = cvt_pk_bf16(v0[2], v0[3]); w.z = cvt_pk_bf16(v1[0], v1[1]); w.w = cvt_pk_bf16(v1[2], v1[3]);
                *(PG8_LAS u32x4*)(wp + (bj ? wsw : 0)) = w; }
            if (it > 0) { const int pa = (it - 1) >> 2, pm_ = (it - 1) & 3;
#pragma unroll
                for (int s = 0; s < 2; ++s) *(u32x4*)(gp + (size_t)(pa * HALF + pm_ * 16 + s * 8) * ldc) = rd[s]; }
#pragma unroll
            for (int s = 0; s < 2; ++s) rd[s] = *(const PG8_LAS u32x4*)(rp + s * 1024 + (s ? rsw : 0)); }
#pragma unroll
        for (int s = 0; s < 2; ++s) *(u32x4*)(gp + (size_t)(HALF + 3 * 16 + s * 8) * ldc) = rd[s];
    }
};

template <class Epi, class Sched, bool ALIGN_EPI = false, bool SP2 = false>
__device__ __forceinline__ void gemm_phase(PG8_LAS unsigned char* lds, const Gemm g, const Sched& S, const Epi& E, int tid_in) {
    int tid_l = tid_in; asm volatile("" : "+v"(tid_l));
    const int tid = tid_l, wid = __builtin_amdgcn_readfirstlane(tid >> 6), lane = tid & 63, wr = wid >> 2, wc = wid & 3, fr = lane & 15, fq = lane >> 4;
    const int K = g.K, nt = K / BK;
    unsigned voffA[2], voffB[2];
#pragma unroll
    for (int i = 0; i < 2; ++i) { int R, C; stage_rc(tid * 16 + i * 8192, R, C); const int Rb = Epi::PERM ? ((R >> 5) * 64 + perm32(R & 31)) : R;
        voffA[i] = (unsigned)(R * g.lda + C) * 2u; voffB[i] = (unsigned)(Rb * g.ldb + C) * 2u; }
    const size_t kstep = (size_t)(BK * 2);
    const size_t hstepA = (size_t)HALF * g.lda * 2, hstepB = (size_t)(Epi::PERM ? 32 : HALF) * g.ldb * 2;
    const size_t tstepA = 2 * hstepA, tstepB = (size_t)BM * g.ldb * 2, cstepA = (size_t)g.acs * 2;
    const unsigned ldsw = (unsigned)wid * 1024u;
    const int aoff = lds_byte(wr * 64 + fr, fq * 8), boff = lds_byte(wc * 32 + fr, fq * 8);
#define PG8_SA(b, h) (((b) * 2 + (h)) * HTB)
#define PG8_SB(b, h) ((4 + (b) * 2 + (h)) * HTB)
#define PG8_STAGE(bufoff, gbase, voff) do { _Pragma("unroll") for (int _i = 0; _i < 2; ++_i) \
        __builtin_amdgcn_global_load_lds((const unsigned*)((const char*)(gbase) + (voff)[_i]), (PG8_LAS unsigned*)(lds + (bufoff) + ldsw + _i * 8192), 16, 0, 0); } while (0)
#define PG8_LDA(dst, b, h) do { _Pragma("unroll") for (int m = 0; m < 4; ++m) _Pragma("unroll") for (int k = 0; k < 2; ++k) dst[m][k] = *(const PG8_LAS bf16x8*)(lds + PG8_SA(b, h) + (aoff ^ (k * 64)) + m * 2048); } while (0)
#define PG8_LDB(dst, b, h) do { _Pragma("unroll") for (int n = 0; n < 2; ++n) _Pragma("unroll") for (int k = 0; k < 2; ++k) dst[n][k] = *(const PG8_LAS bf16x8*)(lds + PG8_SB(b, h) + (boff ^ (k * 64)) + n * 2048); } while (0)
#define PG8_MMA(ai, bj, At, Bt) do { __builtin_amdgcn_s_setprio(1); _Pragma("unroll") for (int m = 0; m < 4; ++m) _Pragma("unroll") for (int n = 0; n < 2; ++n) _Pragma("unroll") for (int k = 0; k < 2; ++k) \
        acc[ai][bj][m][n] = __builtin_amdgcn_mfma_f32_16x16x32_bf16(Bt[n][k], At[m][k], acc[ai][bj][m][n], 0, 0, 0); __builtin_amdgcn_s_setprio(0); } while (0)
#define PG8_WAIT_V(n) asm volatile("s_waitcnt vmcnt(" #n ")" ::: "memory")
#define PG8_WAIT_L(n) asm volatile("s_waitcnt lgkmcnt(" #n ")" ::: "memory")
#define PG8_BAR __builtin_amdgcn_s_barrier()
#define PG8_SCHED __builtin_amdgcn_sched_barrier(0)
    Unit cur, nxt; int ui = 0;
    if (!S.next(0, cur)) return;
    f32x4 acc[2][2][4][2];
#pragma unroll
    for (int a = 0; a < 2; ++a)
#pragma unroll
        for (int b = 0; b < 2; ++b)
#pragma unroll
            for (int m = 0; m < 4; ++m)
#pragma unroll
                for (int n = 0; n < 2; ++n) acc[a][b][m][n] = (f32x4){0.f, 0.f, 0.f, 0.f};
    bf16x8 At[4][2], B0[2][2], B1[2][2];
    const char* cA = (const char*)g.A + (size_t)cur.pm * tstepA + (size_t)cur.pn * cstepA; const char* cB = (const char*)g.Bt + (size_t)cur.pn * tstepB;
    S.a_ready(cur);
    if constexpr (SP2) {
        PG8_STAGE(PG8_SB(0, 0), cB, voffB); PG8_STAGE(PG8_SB(0, 1), cB + hstepB, voffB); PG8_STAGE(PG8_SA(0, 0), cA, voffA); PG8_STAGE(PG8_SA(0, 1), cA + hstepA, voffA);
        if (wr == 1) PG8_BAR;
        PG8_WAIT_V(2); PG8_BAR;
        PG8_STAGE(PG8_SB(1, 0), cB + kstep, voffB); PG8_STAGE(PG8_SA(1, 0), cA + kstep, voffA); PG8_STAGE(PG8_SB(1, 1), cB + hstepB + kstep, voffB);
        PG8_WAIT_V(6); PG8_BAR;
    } else {
        PG8_STAGE(PG8_SB(0, 0), cB, voffB); PG8_STAGE(PG8_SA(0, 0), cA, voffA); PG8_STAGE(PG8_SB(0, 1), cB + hstepB, voffB); PG8_STAGE(PG8_SA(0, 1), cA + hstepA, voffA);
        if (wr == 1) PG8_BAR;
        PG8_WAIT_V(4); PG8_BAR;
        PG8_STAGE(PG8_SB(1, 0), cB + kstep, voffB); PG8_STAGE(PG8_SA(1, 0), cA + kstep, voffA); PG8_STAGE(PG8_SB(1, 1), cB + hstepB + kstep, voffB);
        PG8_WAIT_V(6); PG8_BAR;
    }
    for (;;) {
        const bool has_next = S.next(ui + 1, nxt);
        const char* nA = has_next ? (const char*)g.A + (size_t)nxt.pm * tstepA + (size_t)nxt.pn * cstepA : cA; const char* nB = has_next ? (const char*)g.Bt + (size_t)nxt.pn * tstepB : cB;
        for (int t = 0; t < nt; t += 2) {
            const bool last = (t == nt - 2);
            const char* a1 = cA + (size_t)(t + 1) * kstep;
            const char* a2 = last ? nA : cA + (size_t)(t + 2) * kstep; const char* b2 = last ? nB : cB + (size_t)(t + 2) * kstep;
            const char* a3 = a2 + kstep; const char* b3 = b2 + kstep;
            if (last && has_next) S.a_ready(nxt);
            if constexpr (SP2) {
            PG8_LDB(B0, 0, 0); PG8_LDB(B1, 0, 1); PG8_SCHED; PG8_LDA(At, 0, 0); PG8_STAGE(PG8_SA(1, 1), a1 + hstepA, voffA);
            PG8_WAIT_V(8); PG8_WAIT_L(0); PG8_BAR; PG8_MMA(0, 0, At, B0); PG8_MMA(0, 1, At, B1); PG8_BAR; PG8_SCHED;
            PG8_LDA(At, 0, 1); PG8_STAGE(PG8_SB(0, 0), b2, voffB); PG8_STAGE(PG8_SB(0, 1), b2 + hstepB, voffB); PG8_STAGE(PG8_SA(0, 0), a2, voffA);
            PG8_WAIT_V(8); PG8_WAIT_L(0); PG8_BAR; PG8_MMA(1, 0, At, B0); PG8_MMA(1, 1, At, B1); PG8_BAR; PG8_SCHED;
            PG8_LDB(B0, 1, 0); PG8_LDB(B1, 1, 1); PG8_SCHED; PG8_LDA(At, 1, 0); PG8_STAGE(PG8_SA(0, 1), a2 + hstepA, voffA);
            PG8_WAIT_V(8); PG8_WAIT_L(0); PG8_BAR; PG8_MMA(0, 0, At, B0); PG8_MMA(0, 1, At, B1); PG8_BAR; PG8_SCHED;
            PG8_LDA(At, 1, 1); PG8_STAGE(PG8_SB(1, 0), b3, voffB); PG8_STAGE(PG8_SB(1, 1), b3 + hstepB, voffB); PG8_STAGE(PG8_SA(1, 0), a3, voffA);
            PG8_WAIT_V(8); PG8_WAIT_L(0); PG8_BAR; PG8_MMA(1, 0, At, B0); PG8_MMA(1, 1, At, B1); PG8_BAR; PG8_SCHED;
            } else {
            PG8_LDB(B0, 0, 0); PG8_SCHED; PG8_LDA(At, 0, 0); PG8_STAGE(PG8_SA(1, 1), a1 + hstepA, voffA);
            PG8_WAIT_L(8); PG8_BAR; PG8_WAIT_L(0); PG8_MMA(0, 0, At, B0); PG8_BAR; PG8_SCHED;
            PG8_LDB(B1, 0, 1); PG8_STAGE(PG8_SB(0, 0), b2, voffB);
            PG8_BAR; PG8_WAIT_L(0); PG8_MMA(0, 1, At, B1); PG8_BAR;
            PG8_LDA(At, 0, 1); PG8_STAGE(PG8_SA(0, 0), a2, voffA);
            PG8_BAR; PG8_WAIT_L(0); PG8_MMA(1, 0, At, B0); PG8_BAR; PG8_SCHED;
            PG8_STAGE(PG8_SB(0, 1), b2 + hstepB, voffB);
            PG8_WAIT_V(6); PG8_BAR; PG8_MMA(1, 1, At, B1); PG8_BAR;
            PG8_LDB(B0, 1, 0); PG8_SCHED; PG8_LDA(At, 1, 0); PG8_STAGE(PG8_SA(0, 1), a2 + hstepA, voffA);
            PG8_WAIT_L(8); PG8_BAR; PG8_WAIT_L(0); PG8_MMA(0, 0, At, B0); PG8_BAR; PG8_SCHED;
            PG8_LDB(B1, 1, 1); PG8_STAGE(PG8_SB(1, 0), b3, voffB);
            PG8_BAR; PG8_WAIT_L(0); PG8_MMA(0, 1, At, B1); PG8_BAR;
            PG8_LDA(At, 1, 1); PG8_STAGE(PG8_SA(1, 0), a3, voffA);
            PG8_BAR; PG8_WAIT_L(0); PG8_MMA(1, 0, At, B0); PG8_BAR; PG8_SCHED;
            PG8_STAGE(PG8_SB(1, 1), b3 + hstepB, voffB);
            PG8_WAIT_V(6); PG8_BAR; PG8_MMA(1, 1, At, B1); PG8_BAR;
            }
        }
        if constexpr (ALIGN_EPI) { if (wr == 0) PG8_BAR; }
        if constexpr (!Epi::AFTER_DRAIN) { E(acc, cur, wr, wc, fr, fq, lds); S.done(cur); }
        if (!has_next) break;
#pragma unroll
        for (int a = 0; a < 2; ++a)
#pragma unroll
            for (int b = 0; b < 2; ++b)
#pragma unroll
                for (int m = 0; m < 4; ++m)
#pragma unroll
                    for (int n = 0; n < 2; ++n) acc[a][b][m][n] = (f32x4){0.f, 0.f, 0.f, 0.f};
        cur = nxt; cA = nA; cB = nB; ++ui;
        if constexpr (ALIGN_EPI) { if (wr == 1) PG8_BAR; }
    }
    PG8_WAIT_V(0);
    if constexpr (!ALIGN_EPI) { if (wr == 0) PG8_BAR; }
    PG8_BAR;
    if constexpr (Epi::AFTER_DRAIN) { E.fused(acc, cur, wr, wc, fr, fq, lds, wid, lane); S.done(cur); }
#undef PG8_SA
#undef PG8_SB
#undef PG8_STAGE
#undef PG8_LDA
#undef PG8_LDB
#undef PG8_MMA
#undef PG8_WAIT_V
#undef PG8_WAIT_L
#undef PG8_BAR
#undef PG8_SCHED
}
}

constexpr int NWAVES = 8;
constexpr int BATCH = 8, SEQ = 4096, DM = 2048, DEPTH = 4, DFF = 8192, T = BATCH * SEQ;
constexpr int A_HEADS = 32, A_QR = 512, A_KVR = 256, IDX_H = 16, IDX_D = 128, TOPK = 256, A_IN = 912, A_INP = 1024;
constexpr int B_HEADS = 16, B_HD = 128, B_INC = 3 * DM;
constexpr int MODW = 6 * DM;
constexpr float RMS_EPS = 1e-6f;
enum { IN_X = 0, IN_C, IN_RELB, IN_ADAW, IN_ADAB, IN_NORMG, IN_AWIN, IN_AQN, IN_AKVN, IN_AIKN, IN_AWQB, IN_AWIQB, IN_AWUK, IN_AWUV, IN_AWOUT, IN_BWIN, IN_BWOUT, IN_W1, IN_W2, N_IN };

constexpr size_t MiB = 1u << 20;
constexpr size_t WS_CTL = 0, CTL_ZERO_BYTES = 1 * MiB;
constexpr size_t WS_MOD = 1 * MiB;
constexpr size_t WS_MODP = 3 * MiB;
constexpr size_t WS_WAIN = 16 * MiB;
constexpr size_t WS_WQC = 24 * MiB;
constexpr size_t WS_WUV = 44 * MiB;
constexpr size_t WS_WAOUT = 52 * MiB;
constexpr size_t WS_WBIN = 84 * MiB;
constexpr size_t WS_WBOUT = 132 * MiB;
constexpr size_t WS_WM1 = 148 * MiB;
constexpr size_t WS_WM2 = 276 * MiB;
constexpr size_t WS_H = 404 * MiB;
constexpr size_t WS_P = 532 * MiB;
constexpr size_t WS_BIG = 788 * MiB;
constexpr size_t WS_QLAT = 1300 * MiB;
constexpr size_t WS_CKV = 1332 * MiB;
constexpr size_t WS_KIDX = 1348 * MiB;
constexpr size_t WS_WIDX = 1356 * MiB;
constexpr size_t WS_IDX = 1358 * MiB;
constexpr size_t WS_END = 1390 * MiB;
constexpr int CW_BAR = 4096;
constexpr int CW_SBQ = 8192;

constexpr int LDS_BYTES = 163840;
constexpr int MISC_OFF = LDS_BYTES - 256;

#define GAS __attribute__((address_space(1)))
#define LAS __attribute__((address_space(3)))
typedef unsigned short bf16;
typedef unsigned v4u __attribute__((ext_vector_type(4)));
typedef unsigned v2u __attribute__((ext_vector_type(2)));
typedef float f32x4 __attribute__((ext_vector_type(4)));
typedef float f32x2 __attribute__((ext_vector_type(2)));
typedef __bf16 bf16x2_t __attribute__((ext_vector_type(2)));
#define LDS_WAIT() asm volatile("s_waitcnt lgkmcnt(0)" ::: "memory")
#define VM_WAIT() asm volatile("s_waitcnt vmcnt(0)" ::: "memory")
typedef float f32x2_cv __attribute__((ext_vector_type(2))); typedef __bf16 bf16x2_cv __attribute__((ext_vector_type(2)));
__device__ __forceinline__ unsigned pk2(float lo, float hi) { return __builtin_bit_cast(unsigned, __builtin_convertvector((f32x2_cv){lo, hi}, bf16x2_cv)); }
__device__ __forceinline__ unsigned f2bf(float f) { return pk2(f, 0.f) & 0xffffu; }
__device__ __forceinline__ float bflo(unsigned u) { return __builtin_bit_cast(float, u << 16); }
__device__ __forceinline__ float bfhi(unsigned u) { return __builtin_bit_cast(float, u & 0xffff0000u); }
__device__ __forceinline__ float dot2bf(unsigned a, unsigned b, float c) { return __builtin_amdgcn_fdot2_f32_bf16(__builtin_bit_cast(bf16x2_t, a), __builtin_bit_cast(bf16x2_t, b), c, false); }
#define DPP_F(v, ctrl) __builtin_bit_cast(float, __builtin_amdgcn_update_dpp(0, __builtin_bit_cast(int, (v)), (ctrl), 0xf, 0xf, true))
#define RDL_F(v, l) __builtin_bit_cast(float, __builtin_amdgcn_readlane(__builtin_bit_cast(int, (v)), (l)))
__device__ __forceinline__ float wave_sum(float v, int) {
    v += DPP_F(v, 0xB1); v += DPP_F(v, 0x4E); v += DPP_F(v, 0x124); v += DPP_F(v, 0x128);
    return (RDL_F(v, 0) + RDL_F(v, 16)) + (RDL_F(v, 32) + RDL_F(v, 48));
}
__device__ __forceinline__ float wave_max(float v, int) {
    v = fmaxf(v, DPP_F(v, 0xB1)); v = fmaxf(v, DPP_F(v, 0x4E)); v = fmaxf(v, DPP_F(v, 0x124)); v = fmaxf(v, DPP_F(v, 0x128));
    return fmaxf(fmaxf(RDL_F(v, 0), RDL_F(v, 16)), fmaxf(RDL_F(v, 32), RDL_F(v, 48)));
}
__device__ __forceinline__ float shx(float v, int, int lane) {
    const unsigned u = __builtin_bit_cast(unsigned, v);
    auto r = __builtin_amdgcn_permlane32_swap(u, u, false, false);
    return __builtin_bit_cast(float, (lane & 32) ? r[0] : r[1]);
}

#define XB_TMO      128
#define XB_XCNT(j)  (256  + 64 * (j))
#define XB_XSUB(j)  (1280 + 64 * (j))
#define XB_XGEN(j)  (2304 + 64 * (j))
#define XB_TOP      3328
#define XB_TOPGEN   3392
#define XCD_BAR_WORDS 3456
#define XB_SPIN_CAP (1u << 22)

__device__ __forceinline__ unsigned xb_ld(unsigned* p)              { return __hip_atomic_load(p, __ATOMIC_RELAXED, __HIP_MEMORY_SCOPE_AGENT); }
__device__ __forceinline__ unsigned xb_add(unsigned* p, unsigned v) { return __hip_atomic_fetch_add(p, v, __ATOMIC_RELAXED, __HIP_MEMORY_SCOPE_AGENT); }
__device__ __forceinline__ unsigned xb_xcc_id() { return (unsigned)__builtin_amdgcn_s_getreg((3 << 11) | 20) & 0xFu; }
#define XB_SPIN(cond, bar) do { unsigned _sp = 0; while (cond) { __builtin_amdgcn_s_sleep(1); \
    if ((++_sp & 255u) == 0u) { if (xb_ld(&(bar)[XB_TMO])) break; if (_sp > XB_SPIN_CAP) { atomicAdd(&(bar)[XB_TMO], 1u); break; } } } } while (0)

struct XcdBarrier {
    unsigned* bar; unsigned x;
    volatile LAS unsigned* st;
};

__device__ __forceinline__ XcdBarrier xcd_barrier_post(unsigned* bar, volatile LAS unsigned* st) {
    XcdBarrier b; b.bar = bar; b.x = xb_xcc_id(); b.st = st;
    if (threadIdx.x == 0) (void)xb_add(&bar[XB_XCNT(b.x)], 1u);
    return b;
}
__device__ __forceinline__ void xcd_barrier_complete(unsigned* bar, unsigned x, unsigned& nloc, unsigned& nx) {
    const unsigned G = gridDim.x * gridDim.y * gridDim.z;
    unsigned sum, cnt, mine, sp = 0u;
    for (;;) {
        sum = 0u; cnt = 0u; mine = 0u;
#pragma unroll
        for (unsigned j = 0; j < 16; ++j) { const unsigned c = xb_ld(&bar[XB_XCNT(j)]); sum += c; cnt += (c > 0u) ? 1u : 0u; mine = (j == x) ? c : mine; }
        if (sum == G) break;
        __builtin_amdgcn_s_sleep(1);
        if ((++sp & 255u) == 0u) { if (xb_ld(&bar[XB_TMO])) break; if (sp > XB_SPIN_CAP) { atomicAdd(&bar[XB_TMO], 1u); break; } }
    }
    nloc = mine > 0u ? mine : 1u; nx = cnt > 0u ? cnt : 1u;
}

template <bool CENSUS> __device__ __forceinline__ void xcd_barrier(const XcdBarrier& b) {
    asm volatile("s_waitcnt vmcnt(0)" ::: "memory");
    __syncthreads();
    if (threadIdx.x == 0) {
        unsigned* bar = b.bar;
        __builtin_amdgcn_s_waitcnt(0);
        unsigned nloc = b.st[0], nx = b.st[1];
        if (CENSUS) { if (nloc == 0u) { xcd_barrier_complete(bar, b.x, nloc, nx); b.st[0] = nloc; b.st[1] = nx; } }
        const unsigned old = xb_add(&bar[XB_XSUB(b.x)], 1u);
        const unsigned gen = old / nloc;
        if (old + 1u == (gen + 1u) * nloc) {
            __builtin_amdgcn_fence(__ATOMIC_RELEASE, "agent");
            asm volatile("s_waitcnt vmcnt(0)" ::: "memory");
            const unsigned og = xb_add(&bar[XB_TOP], 1u);
            const unsigned tg = og / nx;
            if (og + 1u == (tg + 1u) * nx) xb_add(&bar[XB_TOPGEN], 1u);
            else XB_SPIN(xb_ld(&bar[XB_TOPGEN]) == tg, bar);
            __builtin_amdgcn_fence(__ATOMIC_ACQUIRE, "agent");
            xb_add(&bar[XB_XGEN(b.x)], 1u);
            asm volatile("s_waitcnt vmcnt(0)" ::: "memory");
        } else {
            XB_SPIN(xb_ld(&bar[XB_XGEN(b.x)]) == gen, bar);
            __builtin_amdgcn_fence(__ATOMIC_ACQUIRE, "agent");
            asm volatile("s_waitcnt vmcnt(0)" ::: "memory");
        }
    }
    __syncthreads();
}

struct Args { const float* in[N_IN]; float* out; unsigned char* ws; int ph_lo, ph_hi; };
#define CAS __attribute__((address_space(4)))
struct Frame {
    LAS unsigned char* lds;
    int tid, lane, wave, G;
    const CAS Args* ap;
    float* out; unsigned char* ws;
    __device__ __forceinline__ const float* inp(int i) const { return ap->in[i]; }
};
#define WSP(type, off) ((type*)(F.ws + (off)))

__device__ __forceinline__ void p0_transpose_item(const float* W, int Nsrc, bf16* dst, int ldo, LAS float* scr, int kb, int nb, int lane) {
    const int k0 = 64 * kb, n0 = 32 * nb, rsub = lane >> 3, c4 = lane & 7, nn = n0 + 4 * c4;
    f32x4 v[8];
#pragma unroll
    for (int i = 0; i < 8; ++i) v[i] = (nn < Nsrc) ? *(const f32x4*)(W + (size_t)(k0 + 8 * i + rsub) * Nsrc + nn) : (f32x4){0.f, 0.f, 0.f, 0.f};
#pragma unroll
    for (int i = 0; i < 8; ++i) { LAS float* d = scr + (8 * i + rsub) * 33 + 4 * c4; d[0] = v[i].x; d[1] = v[i].y; d[2] = v[i].z; d[3] = v[i].w; }
    LDS_WAIT(); asm volatile("" ::: "memory");
    const int c = lane & 7;
#pragma unroll
    for (int j = 0; j < 4; ++j) { const int n = (lane >> 3) + 8 * j; const LAS float* s = scr + (8 * c) * 33 + n;
        v4u o; o.x = pk2(s[0 * 33], s[1 * 33]); o.y = pk2(s[2 * 33], s[3 * 33]); o.z = pk2(s[4 * 33], s[5 * 33]); o.w = pk2(s[6 * 33], s[7 * 33]);
        *(v4u*)(dst + (size_t)(n0 + n) * ldo + k0 + 8 * c) = o; }
    LDS_WAIT(); asm volatile("" ::: "memory");
}
__device__ __forceinline__ void p0_tr_load(f32x4 (&v)[8], const float* W, int Nsrc, int kb, int nb, int lane) {
    const int k0 = 64 * kb, rsub = lane >> 3, nn = 32 * nb + 4 * (lane & 7);
#pragma unroll
    for (int i = 0; i < 8; ++i) v[i] = (nn < Nsrc) ? *(const f32x4*)(W + (size_t)(k0 + 8 * i + rsub) * Nsrc + nn) : (f32x4){0.f, 0.f, 0.f, 0.f};
}
__device__ __forceinline__ void p0_tr_store(const f32x4 (&v)[8], bf16* dst, int ldo, LAS float* scr, int kb, int nb, int lane) {
    const int k0 = 64 * kb, n0 = 32 * nb, rsub = lane >> 3, c4 = lane & 7;
#pragma unroll
    for (int i = 0; i < 8; ++i) { LAS float* d = scr + (8 * i + rsub) * 33 + 4 * c4; d[0] = v[i].x; d[1] = v[i].y; d[2] = v[i].z; d[3] = v[i].w; }
    LDS_WAIT(); asm volatile("" ::: "memory");
    const int c = lane & 7;
#pragma unroll
    for (int j = 0; j < 4; ++j) { const int n = (lane >> 3) + 8 * j; const LAS float* s = scr + (8 * c) * 33 + n;
        v4u o; o.x = pk2(s[0 * 33], s[1 * 33]); o.y = pk2(s[2 * 33], s[3 * 33]); o.z = pk2(s[4 * 33], s[5 * 33]); o.w = pk2(s[6 * 33], s[7 * 33]);
        *(v4u*)(dst + (size_t)(n0 + n) * ldo + k0 + 8 * c) = o; }
    LDS_WAIT(); asm volatile("" ::: "memory");
}
__device__ __forceinline__ void p0_transpose_job(Frame& F, const float* src, size_t sstride, int nmat, int K, int Nsrc, int Npad, bf16* dst, size_t dstride, int ldo) {
    LAS float* scr = (LAS float*)(F.lds + F.wave * 16384);
    const int gw = blockIdx.x * NWAVES + F.wave, NGW = F.G * NWAVES;
    const int nkb = K / 64, nnb = Npad / 32, per = nkb * nnb, tot = nmat * per;
    int it = gw;
    f32x4 v[8], vn[8];
    if (it < tot) { const int m = it / per, r = it % per; p0_tr_load(v, src + (size_t)m * sstride, Nsrc, r / nnb, r % nnb, F.lane); }
    while (it < tot) {
        const int nx = it + NGW;
        if (nx < tot) { const int m = nx / per, r = nx % per; p0_tr_load(vn, src + (size_t)m * sstride, Nsrc, r / nnb, r % nnb, F.lane); }
        { const int m = it / per, r = it % per; p0_tr_store(v, dst + (size_t)m * dstride, ldo, scr, r / nnb, r % nnb, F.lane); }
#pragma unroll
        for (int i = 0; i < 8; ++i) v[i] = vn[i];
        it = nx;
    }
}
__device__ __forceinline__ void ph_prologue(Frame& F) {
    {
        LAS float* sl = (LAS float*)(F.lds);
        LAS float* red = (LAS float*)(F.lds + 8192);
        const float* cin = F.inp(IN_C); const float* ada_w = F.inp(IN_ADAW); float* modp = WSP(float, WS_MODP);
        for (int u = blockIdx.x; u < 768; u += F.G) {
            const int l = u / 192, r = u % 192, ec = r >> 3, dc = r & 7;
            __syncthreads();
            for (int i = F.tid; i < 2048; i += 512) { const int rr = i >> 3, b = i & 7; const float v = cin[b * DM + dc * 256 + rr]; sl[rr * 8 + b] = v / (1.f + __expf(-v)); }
            __syncthreads();
            const int cq = F.tid & 127, dq = F.tid >> 7;
            f32x4 acc[8];
#pragma unroll
            for (int b = 0; b < 8; ++b) acc[b] = (f32x4){0.f, 0.f, 0.f, 0.f};
            const float* wp = ada_w + ((size_t)l * DM + dc * 256 + dq * 64) * MODW + ec * 512 + cq * 4;
#pragma unroll 8
            for (int i = 0; i < 64; ++i) {
                const f32x4 w = *(const f32x4*)(wp + (size_t)i * MODW);
                const f32x4 s0 = *(const LAS f32x4*)(sl + (dq * 64 + i) * 8), s1 = *(const LAS f32x4*)(sl + (dq * 64 + i) * 8 + 4);
                acc[0] += w * s0.x; acc[1] += w * s0.y; acc[2] += w * s0.z; acc[3] += w * s0.w;
                acc[4] += w * s1.x; acc[5] += w * s1.y; acc[6] += w * s1.z; acc[7] += w * s1.w;
            }
#pragma unroll
            for (int b = 0; b < 8; ++b) *(LAS f32x4*)(red + (dq * 8 + b) * 512 + cq * 4) = acc[b];
            __syncthreads();
            { const int b = F.tid >> 6, c0 = (F.tid & 63) * 8;
#pragma unroll
              for (int k = 0; k < 2; ++k) {
                  const f32x4 s = (*(const LAS f32x4*)(red + (0 * 8 + b) * 512 + c0 + 4 * k) + *(const LAS f32x4*)(red + (1 * 8 + b) * 512 + c0 + 4 * k))
                                + (*(const LAS f32x4*)(red + (2 * 8 + b) * 512 + c0 + 4 * k) + *(const LAS f32x4*)(red + (3 * 8 + b) * 512 + c0 + 4 * k));
                  *(f32x4*)(modp + (((size_t)dc * 4 + l) * 8 + b) * MODW + ec * 512 + c0 + 4 * k) = s; } }
        }
        __syncthreads();
    }
    {
        LAS float* Bs = (LAS float*)(F.lds);
        LAS float* As = (LAS float*)(F.lds + 256 * 132 * 4);
        const float* wqb = F.inp(IN_AWQB); const float* wuk = F.inp(IN_AWUK); bf16* wqc = WSP(bf16, WS_WQC);
        for (int u = blockIdx.x; u < 1024; u += F.G) {
            const int j = u >> 9, h = (u & 511) >> 4, rb = u & 15, r0 = rb * 32;
            __syncthreads();
            const float* bsrc = wuk + ((size_t)j * A_HEADS + h) * 256 * 128;
            for (int i = F.tid; i < 256 * 32; i += 512) { const int row = i >> 5, c4 = i & 31; *(LAS f32x4*)(Bs + row * 132 + c4 * 4) = *(const f32x4*)(bsrc + row * 128 + c4 * 4); }
            for (int i = F.tid; i < 32 * 32; i += 512) { const int row = i >> 5, c4 = i & 31; *(LAS f32x4*)(As + row * 128 + c4 * 4) = *(const f32x4*)(wqb + ((size_t)j * A_QR + r0 + row) * 4096 + h * 128 + c4 * 4); }
            __syncthreads();
            const int c = F.tid & 255, rh = F.tid >> 8;
            float acc[16];
#pragma unroll
            for (int q = 0; q < 16; ++q) acc[q] = 0.f;
            for (int d4 = 0; d4 < 32; ++d4) {
                const f32x4 bv = *(const LAS f32x4*)(Bs + c * 132 + d4 * 4);
#pragma unroll
                for (int q = 0; q < 16; ++q) { const f32x4 av = *(const LAS f32x4*)(As + (rh * 16 + q) * 128 + d4 * 4); acc[q] += (av.x * bv.x + av.y * bv.y) + (av.z * bv.z + av.w * bv.w); }
            }
            bf16* orow = wqc + ((size_t)j * 10240 + h * 256 + c) * 512 + r0 + rh * 16;
            v4u o0, o1;
            o0.x = pk2(acc[0], acc[1]); o0.y = pk2(acc[2], acc[3]); o0.z = pk2(acc[4], acc[5]); o0.w = pk2(acc[6], acc[7]);
            o1.x = pk2(acc[8], acc[9]); o1.y = pk2(acc[10], acc[11]); o1.z = pk2(acc[12], acc[13]); o1.w = pk2(acc[14], acc[15]);
            *(v4u*)(orow) = o0; *(v4u*)(orow + 8) = o1;
        }
        __syncthreads();
    }
    p0_transpose_job(F, F.inp(IN_AWIN), (size_t)DM * A_IN, 2, DM, A_IN, A_INP, WSP(bf16, WS_WAIN), (size_t)A_INP * DM, DM);
    p0_transpose_job(F, F.inp(IN_AWIQB), (size_t)A_QR * 2048, 2, A_QR, 2048, 2048, WSP(bf16, WS_WQC) + (size_t)8192 * 512, (size_t)10240 * 512, 512);
    p0_transpose_job(F, F.inp(IN_AWOUT), (size_t)4096 * DM, 2, 4096, DM, DM, WSP(bf16, WS_WAOUT), (size_t)DM * 4096, 4096);
    p0_transpose_job(F, F.inp(IN_BWIN), (size_t)DM * B_INC, 2, DM, B_INC, B_INC, WSP(bf16, WS_WBIN), (size_t)B_INC * DM, DM);
    p0_transpose_job(F, F.inp(IN_BWOUT), (size_t)DM * DM, 2, DM, DM, DM, WSP(bf16, WS_WBOUT), (size_t)DM * DM, DM);
    p0_transpose_job(F, F.inp(IN_W1), (size_t)DM * DFF, 4, DM, DFF, DFF, WSP(bf16, WS_WM1), (size_t)DFF * DM, DM);
    p0_transpose_job(F, F.inp(IN_W2), (size_t)DFF * DM, 4, DFF, DM, DM, WSP(bf16, WS_WM2), (size_t)DM * DFF, DFF);
    {
        LAS float* scr = (LAS float*)(F.lds + F.wave * 16384);
        const int gw = blockIdx.x * NWAVES + F.wave, NGW = F.G * NWAVES;
        const float* wuv = F.inp(IN_AWUV); bf16* d0 = WSP(bf16, WS_WUV);
        for (int it = gw; it < 64 * 16; it += NGW) {
            const int m = it >> 4, r = it & 15, j = m >> 5, h = m & 31;
            bf16* dst = d0 + (size_t)j * 4096 * 512 + (size_t)((h >> 1) * 256 + (h & 1) * 128) * 512 + (h & 1) * 256;
            p0_transpose_item(wuv + (size_t)m * 256 * 128, 128, dst, 512, scr, r >> 2, r & 3, F.lane);
        }
        const int gt = blockIdx.x * 512 + F.tid, NT = F.G * 512;
        for (int i = gt; i < 2 * 4096 * 32; i += NT) {
            const int row = i >> 5, ch = i & 31, hh = (row >> 7) & 1;
            *(v4u*)(d0 + (size_t)row * 512 + (1 - hh) * 256 + ch * 8) = (v4u){0u, 0u, 0u, 0u};
        }
    }
}
__device__ __forceinline__ void ph_modreduce(Frame& F) {
    const float* modp = WSP(float, WS_MODP); float* mod = WSP(float, WS_MOD); const float* ada_b = F.inp(IN_ADAB);
    const int gt = blockIdx.x * 512 + F.tid, NT = F.G * 512;
    for (int i = gt; i < DEPTH * BATCH * MODW / 4; i += NT) {
        const int e4 = i % (MODW / 4), lb = i / (MODW / 4), l = lb >> 3;
        f32x4 s = *(const f32x4*)(ada_b + (size_t)l * MODW + e4 * 4);
#pragma unroll
        for (int dc = 0; dc < 8; ++dc) s += *(const f32x4*)(modp + ((size_t)dc * 32 + lb) * MODW + e4 * 4);
        *(f32x4*)(mod + (size_t)lb * MODW + e4 * 4) = s;
    }
}

__device__ __forceinline__ void ph_post(Frame& F, const bf16* y, const void* xin_, bool xin_f32, void* xout_, bool xout_f32, const float* gate, const float* gy, bf16* hout, const float* gh, const float* shift, const float* scale) {
    LAS float* vec = (LAS float*)F.lds;
    const int rlo = (int)(((long long)blockIdx.x * T) / F.G), rhi = (int)(((long long)(blockIdx.x + 1) * T) / F.G);
    for (int seg = rlo; seg < rhi; ) {
        const int b = seg / SEQ; const int send = ((b + 1) * SEQ < rhi) ? (b + 1) * SEQ : rhi;
        __syncthreads();
        for (int i = F.tid; i < 5 * (DM / 4); i += NWAVES * 64) { const int v = i / (DM / 4), c4 = i % (DM / 4);
            const float* src = (v == 0) ? (y ? gate + (size_t)b * MODW : nullptr) : (v == 1) ? (y ? gy : nullptr) : (v == 2) ? (hout ? gh : nullptr) : (v == 3) ? (hout ? shift + (size_t)b * MODW : nullptr) : (hout ? scale + (size_t)b * MODW : nullptr);
            *(LAS f32x4*)(vec + v * DM + 4 * c4) = src ? *(const f32x4*)(src + 4 * c4) : (f32x4){0.f, 0.f, 0.f, 0.f}; }
        __syncthreads();
        constexpr int NR = 2;
        for (int r0 = seg + 2 * F.wave; r0 < send; r0 += NR * NWAVES) {
            const int r1 = (r0 + 1 < send) ? r0 + 1 : r0;
            int e0 = 4 * F.lane; asm volatile("" : "+v"(e0));
            f32x4 x[NR][8]; v2u yp[NR][8];
            if (xin_f32) { const float* xin = (const float*)xin_;
#pragma unroll
                for (int q = 0; q < NR; ++q) { const int row = q ? r1 : r0;
#pragma unroll
                    for (int j = 0; j < 8; ++j) x[q][j] = *(const f32x4*)(xin + (size_t)row * DM + e0 + 256 * j); }
                if (y) {
#pragma unroll
                    for (int q = 0; q < NR; ++q) { const int row = q ? r1 : r0;
#pragma unroll
                        for (int j = 0; j < 8; ++j) yp[q][j] = *(const v2u*)(y + (size_t)row * DM + e0 + 256 * j); } }
            } else { const bf16* xin = (const bf16*)xin_; v2u xp[NR][8];
#pragma unroll
                for (int q = 0; q < NR; ++q) { const int row = q ? r1 : r0;
#pragma unroll
                    for (int j = 0; j < 8; ++j) xp[q][j] = *(const v2u*)(xin + (size_t)row * DM + e0 + 256 * j); }
                if (y) {
#pragma unroll
                    for (int q = 0; q < NR; ++q) { const int row = q ? r1 : r0;
#pragma unroll
                        for (int j = 0; j < 8; ++j) yp[q][j] = *(const v2u*)(y + (size_t)row * DM + e0 + 256 * j); } }
#pragma unroll
                for (int q = 0; q < NR; ++q) {
#pragma unroll
                    for (int j = 0; j < 8; ++j) { const v2u p = xp[q][j]; x[q][j] = (f32x4){bflo(p.x), bfhi(p.x), bflo(p.y), bfhi(p.y)}; } }
            }
#pragma unroll
            for (int q = 0; q < NR; ++q) { const int row = q ? r1 : r0;
                if (y) {
                    f32x4 yv[8]; float ss = 0.f;
#pragma unroll
                    for (int j = 0; j < 8; ++j) { const v2u p = yp[q][j]; yv[j] = (f32x4){bflo(p.x), bfhi(p.x), bflo(p.y), bfhi(p.y)};
                        ss += (yv[j].x * yv[j].x + yv[j].y * yv[j].y) + (yv[j].z * yv[j].z + yv[j].w * yv[j].w); }
                    const float ry = 1.0f / sqrtf(wave_sum(ss, F.lane) * (1.f / DM) + RMS_EPS);
#pragma unroll
                    for (int j = 0; j < 8; ++j) { const f32x4 g = *(const LAS f32x4*)(vec + 1 * DM + e0 + 256 * j), gt = *(const LAS f32x4*)(vec + 0 * DM + e0 + 256 * j);
                        x[q][j] += gt * (yv[j] * ry * g); }
                    if (xout_f32) { float* xout = (float*)xout_;
#pragma unroll
                        for (int j = 0; j < 8; ++j) *(f32x4*)(xout + (size_t)row * DM + e0 + 256 * j) = x[q][j];
                    } else { bf16* xout = (bf16*)xout_;
#pragma unroll
                        for (int j = 0; j < 8; ++j) { v2u o; o.x = pk2(x[q][j].x, x[q][j].y); o.y = pk2(x[q][j].z, x[q][j].w); *(v2u*)(xout + (size_t)row * DM + e0 + 256 * j) = o; } }
                }
                if (hout) {
                    float ss = 0.f;
#pragma unroll
                    for (int j = 0; j < 8; ++j) ss += (x[q][j].x * x[q][j].x + x[q][j].y * x[q][j].y) + (x[q][j].z * x[q][j].z + x[q][j].w * x[q][j].w);
                    const float rx = 1.0f / sqrtf(wave_sum(ss, F.lane) * (1.f / DM) + RMS_EPS);
#pragma unroll
                    for (int j = 0; j < 8; ++j) { const f32x4 g = *(const LAS f32x4*)(vec + 2 * DM + e0 + 256 * j), sh = *(const LAS f32x4*)(vec + 3 * DM + e0 + 256 * j), sc = *(const LAS f32x4*)(vec + 4 * DM + e0 + 256 * j);
                        const f32x4 hv = (x[q][j] * rx * g) * (sc + 1.0f) + sh;
                        v2u o; o.x = pk2(hv.x, hv.y); o.y = pk2(hv.z, hv.w);
                        *(v2u*)(hout + (size_t)row * DM + e0 + 256 * j) = o; }
                }
            }
        }
        seg = send;
    }
}
__device__ __forceinline__ void ph_dsa_norm(Frame& F, const float* proj, const float* qn, const float* kvn, const float* ikn, bf16* qlat, bf16* ckv, bf16* kidx, float* widx) {
    const int gw = blockIdx.x * NWAVES + F.wave, NGW = F.G * NWAVES; const int e0 = 4 * F.lane;
    for (int row = gw; row < T; row += NGW) {
        f32x4 v[4];
#pragma unroll
        for (int j = 0; j < 4; ++j) v[j] = *(const f32x4*)(proj + (size_t)row * A_INP + e0 + 256 * j);
        float sq = 0.f;
#pragma unroll
        for (int j = 0; j < 2; ++j) sq += (v[j].x * v[j].x + v[j].y * v[j].y) + (v[j].z * v[j].z + v[j].w * v[j].w);
        const float rq = 1.0f / sqrtf(wave_sum(sq, F.lane) * (1.f / A_QR) + RMS_EPS);
#pragma unroll
        for (int j = 0; j < 2; ++j) { const f32x4 g = *(const f32x4*)(qn + e0 + 256 * j); const f32x4 o = v[j] * rq * g; v2u w; w.x = pk2(o.x, o.y); w.y = pk2(o.z, o.w);
            *(v2u*)(qlat + (size_t)row * A_QR + e0 + 256 * j) = w; }
        const float skv = (v[2].x * v[2].x + v[2].y * v[2].y) + (v[2].z * v[2].z + v[2].w * v[2].w);
        const float rkv = 1.0f / sqrtf(wave_sum(skv, F.lane) * (1.f / A_KVR) + RMS_EPS);
        { const f32x4 g = *(const f32x4*)(kvn + e0); const f32x4 o = v[2] * rkv * g; v2u w; w.x = pk2(o.x, o.y); w.y = pk2(o.z, o.w); *(v2u*)(ckv + (size_t)row * A_KVR + e0) = w; }
        const bool isk = F.lane < 32;
        const float s1 = isk ? (v[3].x + v[3].y) + (v[3].z + v[3].w) : 0.f;
        const float mean = wave_sum(s1, F.lane) * (1.f / IDX_D);
        const f32x4 dv = v[3] - mean;
        const float s2 = isk ? (dv.x * dv.x + dv.y * dv.y) + (dv.z * dv.z + dv.w * dv.w) : 0.f;
        const float rk = 1.0f / sqrtf(wave_sum(s2, F.lane) * (1.f / IDX_D) + RMS_EPS);
        if (isk) { const f32x4 g = *(const f32x4*)(ikn + e0); const f32x4 o = dv * rk * g; v2u w; w.x = pk2(o.x, o.y); w.y = pk2(o.z, o.w); *(v2u*)(kidx + (size_t)row * IDX_D + e0) = w; }
        else if (F.lane < 36) { *(f32x4*)(widx + (size_t)row * IDX_H + (e0 - 128)) = v[3] * 0.02209708691207961f; }
    }
}

__device__ __forceinline__ int wave_scan_incl(int v, int lane, int& total) {
    v += __builtin_amdgcn_update_dpp(0, v, 0x111, 0xf, 0xf, true); v += __builtin_amdgcn_update_dpp(0, v, 0x112, 0xf, 0xf, true);
    v += __builtin_amdgcn_update_dpp(0, v, 0x114, 0xf, 0xf, true); v += __builtin_amdgcn_update_dpp(0, v, 0x118, 0xf, 0xf, true);
    const int t0 = __builtin_amdgcn_readlane(v, 15), t1 = __builtin_amdgcn_readlane(v, 31), t2 = __builtin_amdgcn_readlane(v, 47), t3 = __builtin_amdgcn_readlane(v, 63);
    v += (lane >= 16 ? t0 : 0) + (lane >= 32 ? t1 : 0) + (lane >= 48 ? t2 : 0);
    total = (t0 + t1) + (t2 + t3);
    return v;
}
template <bool G, class SP> __device__ __forceinline__ void topk_select_row(SP sc, int t, int* out, int lane, LAS int* lst) {
    const int n = t + 1;
    if (n <= TOPK) { for (int i = lane; i < TOPK; i += 64) out[i] = (i < n) ? i : 0; return; }
    const int ni = G ? 2 * ((n + 127) >> 7) : (n + 63) >> 6;
#define TOPK_KEYIDX(i) (G ? 128 * ((i) >> 1) + 2 * lane + ((i) & 1) : 64 * (i) + lane)
    unsigned key[64];
#pragma unroll
    for (int g = 0; g < 8; ++g) {
        if (8 * g < ni) {
            if constexpr (G) {
#pragma unroll
                for (int j = 4 * g; j < 4 * g + 4; ++j) { const unsigned d = __hip_atomic_load((const unsigned*)sc + 64 * j + lane, __ATOMIC_RELAXED, __HIP_MEMORY_SCOPE_AGENT);
#pragma unroll
                    for (int e = 0; e < 2; ++e) { const int s = 128 * j + 2 * lane + e; const unsigned h = e ? (d >> 16) : (d & 0xffffu); const unsigned k = (h & 0x8000u) ? (~h & 0xffffu) : (h | 0x8000u); key[2 * j + e] = (s < n) ? k : 0u; } }
            } else {
#pragma unroll
                for (int i = 8 * g; i < 8 * g + 8; ++i) { const int s = 64 * i + lane; const unsigned h = sc[s < n ? s : n - 1]; const unsigned k = (h & 0x8000u) ? (~h & 0xffffu) : (h | 0x8000u); key[i] = (s < n) ? k : 0u; }
            }
        } else {
#pragma unroll
            for (int i = 8 * g; i < 8 * g + 8; ++i) key[i] = 0u;
        }
    }
    unsigned prefix = 0u;
    for (int bit = 15; bit >= 0; --bit) {
        const unsigned cand = prefix | (1u << bit); int cl = 0;
#pragma unroll
        for (int g = 0; g < 8; ++g) if (8 * g < ni) {
#pragma unroll
            for (int i = 8 * g; i < 8 * g + 8; ++i) cl += (key[i] >= cand) ? 1 : 0; }
        cl += __builtin_amdgcn_update_dpp(0, cl, 0xB1, 0xf, 0xf, true); cl += __builtin_amdgcn_update_dpp(0, cl, 0x4E, 0xf, 0xf, true);
        cl += __builtin_amdgcn_update_dpp(0, cl, 0x124, 0xf, 0xf, true); cl += __builtin_amdgcn_update_dpp(0, cl, 0x128, 0xf, 0xf, true);
        const int cnt = (__builtin_amdgcn_readlane(cl, 0) + __builtin_amdgcn_readlane(cl, 16)) + (__builtin_amdgcn_readlane(cl, 32) + __builtin_amdgcn_readlane(cl, 48));
        if (cnt >= TOPK) prefix = cand;
    }
    int cg = 0, ce = 0;
#pragma unroll
    for (int g = 0; g < 8; ++g) if (8 * g < ni) {
#pragma unroll
        for (int i = 8 * g; i < 8 * g + 8; ++i) { cg += (key[i] > prefix) ? 1 : 0; ce += (key[i] == prefix) ? 1 : 0; } }
    int tg, te;
    const int bg = wave_scan_incl(cg, lane, tg) - cg, be = wave_scan_incl(ce, lane, te) - ce;
    int quota = (TOPK - tg) - be; quota = quota < 0 ? 0 : (quota > ce ? ce : quota);
    int pg = bg, pe = tg + (be < TOPK - tg ? be : TOPK - tg);
    const int dummy = TOPK + lane;
#pragma unroll
    for (int g = 0; g < 8; ++g) if (8 * g < ni) {
#pragma unroll
        for (int i = 8 * g; i < 8 * g + 8; ++i) {
            const bool gt = key[i] > prefix, eq = (key[i] == prefix) && (quota > 0);
            const int pos = gt ? pg : (eq ? pe : dummy);
            lst[pos] = TOPK_KEYIDX(i);
            pg += gt ? 1 : 0; pe += eq ? 1 : 0; quota -= eq ? 1 : 0;
        } }
    asm volatile("s_waitcnt lgkmcnt(0)" ::: "memory");
    *(v4u*)(out + 4 * lane) = *(const LAS v4u*)(lst + 4 * lane);
#undef TOPK_KEYIDX
}
template <class SP> __device__ __forceinline__ void topk_select_planes(SP sc, int t, int* out, int lane, LAS int* lst) {
    const int n = t + 1;
    if (n <= TOPK) { for (int i = lane; i < TOPK; i += 64) out[i] = (i < n) ? i : 0; return; }
    typedef short s16x2_ __attribute__((ext_vector_type(2)));
    unsigned W[32];
#pragma unroll
    for (int j = 0; j < 32; ++j) { const unsigned h2 = (unsigned)sc[128 * j + lane] | ((unsigned)sc[128 * j + 64 + lane] << 16);
        const s16x2_ sg = __builtin_bit_cast(s16x2_, h2) >> (s16x2_){15, 15};
        W[j] = h2 ^ (__builtin_bit_cast(unsigned, sg) | 0x80008000u); }
    {
        unsigned ml = 0x0000ffffu;
#pragma unroll
        for (int j = 16; j != 0; j >>= 1) { const unsigned mh = ml << j;
#pragma unroll
            for (int k = 0; k < 32; k = (k + j + 1) & ~j) { const unsigned a = W[k], b = W[k + j];
                W[k] = (a & ~mh) | ((b << j) & mh); W[k + j] = (b & ~ml) | ((a >> j) & ml); }
            ml ^= ml << (j >> 1); }
    }
    const int c = (n - lane + 63) >> 6;
    const int ce_ = (c + 1) >> 1, co_ = c >> 1;
    unsigned aE = ce_ >= 32 ? 0xffffffffu : ((1u << ce_) - 1u), aO = co_ >= 32 ? 0xffffffffu : ((1u << co_) - 1u);
    unsigned gE = 0u, gO = 0u; int cnt_gt = 0;
#pragma unroll
    for (int b = 15; b >= 0; --b) {
        const unsigned cE = aE & W[b], cO = aO & W[16 + b];
        int cl = __builtin_popcount(cE) + __builtin_popcount(cO);
        cl += __builtin_amdgcn_update_dpp(0, cl, 0xB1, 0xf, 0xf, true); cl += __builtin_amdgcn_update_dpp(0, cl, 0x4E, 0xf, 0xf, true);
        cl += __builtin_amdgcn_update_dpp(0, cl, 0x124, 0xf, 0xf, true); cl += __builtin_amdgcn_update_dpp(0, cl, 0x128, 0xf, 0xf, true);
        const int cnt = (__builtin_amdgcn_readlane(cl, 0) + __builtin_amdgcn_readlane(cl, 16)) + (__builtin_amdgcn_readlane(cl, 32) + __builtin_amdgcn_readlane(cl, 48));
        const bool take = (cnt_gt + cnt >= TOPK);
        gE = take ? gE : (gE | cE); gO = take ? gO : (gO | cO);
        aE = take ? cE : (aE ^ cE); aO = take ? cO : (aO ^ cO);
        cnt_gt += take ? 0 : cnt;
    }
    const int cg = __builtin_popcount(gE) + __builtin_popcount(gO), ce = __builtin_popcount(aE) + __builtin_popcount(aO);
    int tg, te;
    const int bg = wave_scan_incl(cg, lane, tg) - cg, be = wave_scan_incl(ce, lane, te) - ce;
    int quota = (TOPK - tg) - be; quota = quota < 0 ? 0 : (quota > ce ? ce : quota);
    int pg = bg, pe = tg + (be < TOPK - tg ? be : TOPK - tg);
    for (unsigned m = gE; m; m &= m - 1u) lst[pg++] = 128 * __builtin_ctz(m) + lane;
    for (unsigned m = gO; m; m &= m - 1u) lst[pg++] = 128 * __builtin_ctz(m) + 64 + lane;
    for (unsigned m = aE; m && quota > 0; m &= m - 1u, --quota) lst[pe++] = 128 * __builtin_ctz(m) + lane;
    for (unsigned m = aO; m && quota > 0; m &= m - 1u, --quota) lst[pe++] = 128 * __builtin_ctz(m) + 64 + lane;
    asm volatile("s_waitcnt lgkmcnt(0)" ::: "memory");
    *(v4u*)(out + 4 * lane) = *(const LAS v4u*)(lst + 4 * lane);
}
__device__ __forceinline__ int t5_bucket(int d) {
    if (d < 16) return d;
    int bkt = 16;
    bkt += (d >= 19) + (d >= 21) + (d >= 24) + (d >= 27) + (d >= 31) + (d >= 35) + (d >= 40) + (d >= 46) + (d >= 52) + (d >= 59) + (d >= 67) + (d >= 77) + (d >= 87) + (d >= 99) + (d >= 113);
    return bkt;
}

typedef short bf16x8 __attribute__((ext_vector_type(8)));
typedef short s16x4 __attribute__((ext_vector_type(4)));
typedef float f32x16 __attribute__((ext_vector_type(16)));
__device__ __forceinline__ unsigned offb(unsigned row, unsigned ch) { return 256u * row + 16u * (ch ^ (((row & 3u) << 2) | ((row >> 2) & 3u))); }
__device__ __forceinline__ unsigned tr_base_perm(unsigned lane, unsigned c, unsigned t) {
    const unsigned h = lane >> 5, blk = (lane >> 4) & 1u, q = (lane & 15u) >> 2, p = lane & 3u;
    return offb(8u * t + 4u * h + q, 4u * c + 2u * blk + (p >> 1)) + 8u * (p & 1u);
}
__device__ __forceinline__ bf16x8 tr_frag_at(LAS unsigned char* img, unsigned b0, unsigned b1, unsigned ks) {
    const s16x4 lo = __builtin_amdgcn_ds_read_tr16_b64_v4i16((LAS s16x4*)(img + b0 + 4096u * ks));
    const s16x4 hi = __builtin_amdgcn_ds_read_tr16_b64_v4i16((LAS s16x4*)(img + b1 + 4096u * ks));
    return __builtin_shufflevector(lo, hi, 0, 1, 2, 3, 4, 5, 6, 7);
}

__device__ __forceinline__ float relu1(float x) { const int i = __builtin_bit_cast(int, x); return __builtin_bit_cast(float, i > 0 ? i : 0); }
__device__ __forceinline__ void ph_indexer(Frame& F, const bf16* qidx, const bf16* kidx, const float* widx, int* idxo) {
    constexpr int NQ = 8;
    LAS unsigned short* sc = (LAS unsigned short*)(F.lds);
    LAS float* wsh = (LAS float*)(F.lds + 65536);
    LAS unsigned char* ring = F.lds + 66560;
    const int r = F.lane & 31, hf = F.lane >> 5, rp = F.wave & 1, kq = F.wave >> 1;
    const int drow = 4 * F.wave + (F.lane >> 4), dch = (F.lane & 15) ^ (((F.lane >> 4) << 2) | (F.wave & 3));
    for (int u = blockIdx.x; u < BATCH * (SEQ / NQ); u += F.G) {
        const int b = u & 7, t0 = (u >> 3) * NQ;
        const int nt = (t0 + NQ + 31) >> 5, ns = (nt + 3) >> 2;
        const bf16* kbase = kidx + (size_t)(b * SEQ + drow) * IDX_D + dch * 8;
        __syncthreads();
#pragma unroll
        for (int j = 0; j < 4; ++j) __builtin_amdgcn_global_load_lds((const unsigned*)(kbase + (size_t)(j * 32) * IDX_D), (LAS unsigned*)(ring + j * 8192 + F.wave * 1024), 16, 0, 0);
        if (F.tid < NQ * 16) wsh[F.tid] = widx[(size_t)(b * SEQ + t0 + (F.tid >> 4)) * IDX_H + (F.tid & 15)];
        { const bf16* qb = qidx + (size_t)(b * SEQ + t0 + ((drow >> 2) & 1)) * 2048 + (4 * (drow >> 3) + (drow & 3)) * 128 + dch * 8;
#pragma unroll
          for (int j = 0; j < 4; ++j) __builtin_amdgcn_global_load_lds((const unsigned*)(qb + (size_t)(2 * j) * 2048), (LAS unsigned*)(ring + 32768 + j * 8192 + F.wave * 1024), 16, 0, 0); }
        bf16x8 Af[2][8];
        for (int s = 0; s < ns; ++s) {
            asm volatile("s_waitcnt vmcnt(0) lgkmcnt(0)" ::: "memory"); __builtin_amdgcn_s_barrier(); asm volatile("" ::: "memory");
            if (s == 0) {
#pragma unroll
                for (int rt = 0; rt < 2; ++rt)
#pragma unroll
                    for (int ks = 0; ks < 8; ++ks) Af[rt][ks] = *(const LAS bf16x8*)(ring + 32768 + (2 * rp + rt) * 8192 + offb((unsigned)r, (unsigned)(2 * ks + hf)));
                asm volatile("s_waitcnt lgkmcnt(0)" ::: "memory"); __builtin_amdgcn_s_barrier(); asm volatile("" ::: "memory");
            }
            if (s + 1 < ns) {
#pragma unroll
                for (int j = 0; j < 4; ++j) __builtin_amdgcn_global_load_lds((const unsigned*)(kbase + (size_t)((4 * (s + 1) + j) * 32) * IDX_D), (LAS unsigned*)(ring + ((s + 1) & 1) * 32768 + j * 8192 + F.wave * 1024), 16, 0, 0);
            }
            const int kt = 4 * s + kq;
            if (kt < nt) {
                LAS unsigned char* tile = ring + (s & 1) * 32768 + kq * 8192;
                bf16x8 Bf[8];
#pragma unroll
                for (int ks = 0; ks < 8; ++ks) Bf[ks] = *(const LAS bf16x8*)(tile + offb((unsigned)r, (unsigned)(2 * ks + hf)));
#pragma unroll
                for (int rt = 0; rt < 2; ++rt) {
                    f32x16 acc;
#pragma unroll
                    for (int i = 0; i < 16; ++i) acc[i] = 0.f;
#pragma unroll
                    for (int ks = 0; ks < 8; ++ks) acc = __builtin_amdgcn_mfma_f32_32x32x16_bf16(Af[rt][ks], Bf[ks], acc, 0, 0, 0);
                    float s0 = 0.f, s1 = 0.f;
#pragma unroll
                    for (int i4 = 0; i4 < 4; ++i4) { const f32x4 w4 = *(const LAS f32x4*)(wsh + (4 * rp + 2 * rt + hf) * 16 + 4 * i4);
                        s0 += w4.x * relu1(acc[4 * i4]) + w4.z * relu1(acc[4 * i4 + 2]); s1 += w4.y * relu1(acc[4 * i4 + 1]) + w4.w * relu1(acc[4 * i4 + 3]); }
                    sc[(4 * rp + 2 * rt + hf) * 4096 + kt * 32 + r] = __builtin_bit_cast(unsigned short, (_Float16)(s0 + s1));
                }
            }
        }
        __syncthreads();
        for (int q = F.wave; q < NQ; q += NWAVES) topk_select_planes(sc + q * 4096, t0 + q, idxo + (size_t)(b * SEQ + t0 + q) * TOPK, F.lane, (LAS int*)(F.lds + 132096) + F.wave * 320);
    }
}

#define LDS_BARRIER() do { asm volatile("s_waitcnt lgkmcnt(0)" ::: "memory"); __builtin_amdgcn_s_barrier(); asm volatile("" ::: "memory"); } while (0)
__device__ __forceinline__ int relane(int lane) { asm volatile("" : "+v"(lane)); return lane; }
__device__ __forceinline__ void ph_sparse_attn(Frame& F, bf16* qa_olat, const bf16* ckv, const int* idxi, const float* relb) {
    LAS unsigned char* KV = F.lds;
    LAS unsigned char* PF = F.lds + 131072;
    LAS float* wmax = (LAS float*)(F.lds + 147456);
    LAS float* wsum = wmax + 256;
    LAS unsigned char* bks = F.lds + 147456 + 2048;
    LAS float* relbs = (LAS float*)(F.lds + 147456 + 2048 + 512);
    LAS float* invw = (LAS float*)(F.lds + 147456 + 2048 + 512 + 4224);
    LAS unsigned char* blut = F.lds + 147456 + 2048 + 512 + 4224 + 1024;
    const float scale = 0.08838834764831845f;
    const int w = F.wave;
    __syncthreads();
    for (int i = F.tid; i < 1024; i += 512) relbs[i] = relb[i];
    if (F.tid < 32) relbs[1024 + F.tid] = -INFINITY;
    if (F.tid < 128) blut[F.tid] = (unsigned char)t5_bucket(F.tid);
    int u = blockIdx.x;
    if (u >= T) return;
    int idc[16]; int bid; v4u R[16]; v4u Qr[2];
    {
        const int cc = F.lane & 31, r = F.lane & 31, hf = F.lane >> 5;
        const int t = u % SEQ, b = u / SEQ;
        const int* ip = idxi + (size_t)u * TOPK + 32 * w + hf;
#pragma unroll
        for (int k = 0; k < 16; ++k) idc[k] = ip[2 * k];
        const bf16* kb = ckv + (size_t)b * SEQ * A_KVR + cc * 8;
#pragma unroll
        for (int k = 0; k < 16; ++k) R[k] = *(const v4u*)(kb + (size_t)idc[k] * A_KVR);
        if (F.tid < 256) { const int id = idxi[(size_t)u * TOPK + F.tid]; const int d = t - id; bks[F.tid] = (F.tid <= t) ? (unsigned char)t5_bucket(d > 0 ? d : 0) : (unsigned char)32; }
        const int u2 = (u + F.G < T) ? u + F.G : u;
        const int* ip2 = idxi + (size_t)u2 * TOPK + 32 * w + hf;
#pragma unroll
        for (int k = 0; k < 16; ++k) idc[k] = ip2[2 * k];
        bid = (F.tid < 256) ? idxi[(size_t)u2 * TOPK + F.tid] : -1;
        { const v4u* qp = (const v4u*)(qa_olat + (size_t)u * A_HEADS * A_KVR);
#pragma unroll
          for (int j = 0; j < 2; ++j) { const int id = 2 * w + j, head = 8 * (id & 3) + (F.lane & 7), pos = 8 * (id >> 2) + (F.lane >> 3); Qr[j] = qp[head * 32 + pos]; } }
    }
    unsigned wro[16], qwo[2], trb[2];
    { const unsigned r0 = F.lane & 31, hf0 = F.lane >> 5; const unsigned c0 = (r0 & 15u) ^ (4u * hf0);
#pragma unroll
      for (int k = 0; k < 16; ++k) wro[k] = (r0 >> 4) * 65536u + 256u * (32u * w + hf0) + 512u * k + 16u * (c0 ^ (unsigned)(8 * (k & 1) + ((k >> 1) & 3)));
#pragma unroll
      for (int j = 0; j < 2; ++j) { const int id = 2 * w + j, head = 8 * (id & 3) + (F.lane & 7), pos = 8 * (id >> 2) + (F.lane >> 3); qwo[j] = (pos >> 1) * 1024 + ((pos & 1) * 32 + head) * 16; }
      trb[0] = tr_base_perm((unsigned)F.lane, (unsigned)(w & 3), 0u); trb[1] = tr_base_perm((unsigned)F.lane, (unsigned)(w & 3), 1u); }
    unsigned rdo[16];
    { const unsigned r0 = F.lane & 31, hf0 = F.lane >> 5, row = 32u * w + r0, xr = ((row & 3u) << 2) | ((row >> 2) & 3u);
#pragma unroll
      for (int ks = 0; ks < 16; ++ks) rdo[ks] = 256u * row + (ks >> 3) * 65536u + 16u * ((unsigned)(2 * (ks & 7) + hf0) ^ xr); }
    for (int it = 0; u < T; u += F.G, ++it) {
        const int un = u + F.G, unn = u + 2 * F.G, par = it & 1;
        LDS_BARRIER();
        const int l2 = relane(F.lane), r = l2 & 31, hf = l2 >> 5;
        {
#pragma unroll
          for (int k = 0; k < 16; ++k) *(LAS v4u*)(KV + wro[k]) = R[k]; }
        *(LAS v4u*)(PF + qwo[0]) = Qr[0]; *(LAS v4u*)(PF + qwo[1]) = Qr[1];
        LDS_BARRIER();
        const int tid1 = w * 64 + l2;
        const int unb = (un < T) ? un : u; const int bn = unb / SEQ, tn = unb % SEQ;
        const bf16* kbn = ckv + (size_t)bn * SEQ * A_KVR + r * 8;
        f32x16 acc;
#pragma unroll
        for (int i = 0; i < 16; ++i) acc[i] = 0.f;
        {
#pragma unroll
          for (int ks = 0; ks < 16; ++ks) { const bf16x8 a = *(const LAS bf16x8*)(KV + rdo[ks]);
              acc = __builtin_amdgcn_mfma_f32_32x32x16_bf16(a, *(const LAS bf16x8*)(PF + ks * 1024 + l2 * 16), acc, 0, 0, 0);
              R[ks] = *(const v4u*)(kbn + (size_t)idc[ks] * A_KVR); } }
        if (tid1 < 256) { int d = tn - bid; d = d < 0 ? 0 : (d > 127 ? 127 : d); bks[(par ^ 1) * 256 + tid1] = (tid1 <= tn) ? blut[d] : (unsigned char)32; }
        { const v4u* qp = (const v4u*)(qa_olat + (size_t)unb * A_HEADS * A_KVR);
#pragma unroll
          for (int j = 0; j < 2; ++j) { const int id = 2 * w + j, head = 8 * (id & 3) + (l2 & 7), pos = 8 * (id >> 2) + (l2 >> 3); Qr[j] = qp[head * 32 + pos]; } }
        float lg[16]; float m = -INFINITY;
#pragma unroll
        for (int g = 0; g < 4; ++g) { const unsigned b4 = *(const LAS unsigned*)(bks + par * 256 + 32 * w + 8 * g + 4 * hf);
#pragma unroll
            for (int j = 0; j < 4; ++j) { const unsigned bk = (b4 >> (8 * j)) & 255u; const int i = 4 * g + j;
                lg[i] = acc[i] * scale + relbs[bk * 32 + r]; m = fmaxf(m, lg[i]); } }
        m = fmaxf(m, shx(m, 32, l2));
        if (hf == 0) wmax[r * 8 + w] = m;
        LDS_BARRIER();
        { const f32x4 m0 = *(const LAS f32x4*)(wmax + r * 8), m1 = *(const LAS f32x4*)(wmax + r * 8 + 4);
          m = fmaxf(fmaxf(fmaxf(m0.x, m0.y), fmaxf(m0.z, m0.w)), fmaxf(fmaxf(m1.x, m1.y), fmaxf(m1.z, m1.w))); }
        float s = 0.f;
#pragma unroll
        for (int i = 0; i < 16; ++i) { lg[i] = __expf(lg[i] - m); s += lg[i]; }
        s += shx(s, 32, l2);
        if (hf == 0) wsum[r * 8 + w] = s;
#pragma unroll
        for (int s2 = 0; s2 < 2; ++s2) { v4u pk; pk.x = pk2(lg[8 * s2 + 0], lg[8 * s2 + 1]); pk.y = pk2(lg[8 * s2 + 2], lg[8 * s2 + 3]); pk.z = pk2(lg[8 * s2 + 4], lg[8 * s2 + 5]); pk.w = pk2(lg[8 * s2 + 6], lg[8 * s2 + 7]);
            *(LAS v4u*)(PF + (2 * w + s2) * 1024 + l2 * 16) = pk; }
        LDS_BARRIER();
        const int l3 = relane(F.lane), r3 = l3 & 31, hf3 = l3 >> 5;
        if (hf3 == 0) { const f32x4 s0 = *(const LAS f32x4*)(wsum + r3 * 8), s1 = *(const LAS f32x4*)(wsum + r3 * 8 + 4);
            invw[w * 32 + r3] = 1.0f / (((s0.x + s0.y) + (s0.z + s0.w)) + ((s1.x + s1.y) + (s1.z + s1.w))); }
        f32x16 o;
#pragma unroll
        for (int i = 0; i < 16; ++i) o[i] = 0.f;
        LAS unsigned char* img = KV + (w >> 2) * 65536;
        const int unc = (unn < T) ? unn : u;
        const int* ip2 = idxi + (size_t)unc * TOPK + 32 * w + hf3;
        const unsigned tb0 = trb[0], tb1 = trb[1];
#pragma unroll
        for (int ks = 0; ks < 16; ++ks) { const bf16x8 a = *(const LAS bf16x8*)(PF + ks * 1024 + l3 * 16);
            const bf16x8 bb = tr_frag_at(img, tb0, tb1, (unsigned)ks);
            o = __builtin_amdgcn_mfma_f32_32x32x16_bf16(a, bb, o, 0, 0, 0);
            idc[ks] = ip2[2 * ks]; }
        if (w * 64 + l3 < 256) bid = idxi[(size_t)unc * TOPK + w * 64 + l3];
        bf16* op = qa_olat + ((size_t)u * A_HEADS + 4 * hf3) * A_KVR + 32 * w + r3;
#pragma unroll
        for (int g = 0; g < 4; ++g) { const f32x4 iv = *(const LAS f32x4*)(invw + w * 32 + 8 * g + 4 * hf3);
            op[(8 * g + 0) * A_KVR] = (bf16)f2bf(o[4 * g + 0] * iv.x); op[(8 * g + 1) * A_KVR] = (bf16)f2bf(o[4 * g + 1] * iv.y);
            op[(8 * g + 2) * A_KVR] = (bf16)f2bf(o[4 * g + 2] * iv.z); op[(8 * g + 3) * A_KVR] = (bf16)f2bf(o[4 * g + 3] * iv.w); }
    }
}

__device__ __forceinline__ void ph_sb_attn(Frame& F, const bf16* qkv, bf16* o_out, unsigned* qctr) {
    LAS unsigned char* img = F.lds + F.wave * 8192;
    LAS unsigned char* qimg = F.lds + 65536 + F.wave * 8192;
    const int r = F.lane & 31, hf = F.lane >> 5;
    const float scale = 0.08838834764831845f;
    constexpr int NTASK8 = BATCH * B_HEADS * (SEQ / 32) / 8;
    const int myx = (int)(xb_xcc_id() & 7u);
    for (int qi = 0; qi < 8; ++qi) { const int qsel = (myx + qi) & 7;
    for (;;) {
        int task = 0;
        if (F.lane == 0) task = (int)__hip_atomic_fetch_add(qctr + 64 * qsel, 1u, __ATOMIC_RELAXED, __HIP_MEMORY_SCOPE_AGENT);
        task = __builtin_amdgcn_readfirstlane(task);
        if (task >= NTASK8) break;
        task += qsel * NTASK8;
        const int qt = task & 127, bh = task >> 7, h = bh & 15, b = bh >> 4, t0 = qt * 32;
        v4u Kr[8], Vr[8];
#pragma unroll
        for (int k = 0; k < 8; ++k) { const int n = F.lane + 64 * k; *(LAS v4u*)(qimg + offb(n >> 4, n & 15)) = *(const v4u*)(qkv + (size_t)(b * SEQ + t0 + (n >> 4)) * B_INC + h * B_HD + (n & 15) * 8); }
        {
#pragma unroll
          for (int k = 0; k < 8; ++k) { const int n = F.lane + 64 * k; const bf16* rp = qkv + (size_t)(b * SEQ + qt * 32 + (n >> 4)) * B_INC + h * B_HD + (n & 15) * 8; Kr[k] = *(const v4u*)(rp + DM); Vr[k] = *(const v4u*)(rp + 2 * DM); } }
        f32x16 o[4];
#pragma unroll
        for (int dt = 0; dt < 4; ++dt)
#pragma unroll
            for (int i = 0; i < 16; ++i) o[dt][i] = 0.f;
        float Rc = 1.f;
        for (int kt = qt; kt >= 0; --kt) {
            const int ll = relane(F.lane), r = ll & 31, hf = ll >> 5;
#pragma unroll
            for (int k = 0; k < 8; ++k) { const int n = ll + 64 * k; *(LAS v4u*)(img + offb(n >> 4, n & 15)) = Kr[k]; }
            f32x16 acc;
#pragma unroll
            for (int i = 0; i < 16; ++i) acc[i] = 0.f;
#pragma unroll
            for (int ks = 0; ks < 8; ++ks) acc = __builtin_amdgcn_mfma_f32_32x32x16_bf16(*(const LAS bf16x8*)(img + offb(r, 2 * ks + hf)), *(const LAS bf16x8*)(qimg + offb(r, 2 * ks + hf)), acc, 0, 0, 0);
            asm volatile("s_waitcnt lgkmcnt(0)" ::: "memory");
#pragma unroll
            for (int k = 0; k < 8; ++k) { const int n = ll + 64 * k; *(LAS v4u*)(img + offb(n >> 4, n & 15)) = Vr[k]; }
            float be[16], om[16];
            const bool diag = (kt == qt);
#pragma unroll
            for (int i = 0; i < 16; ++i) { const float z = fminf(acc[i] * scale, 80.f);
                const float e = __expf(z), rr = __builtin_amdgcn_rcpf(1.0f + e);
                be[i] = e * rr; om[i] = rr; }
            if (diag) {
#pragma unroll
                for (int i = 0; i < 16; ++i) { const int kap = 8 * (i >> 2) + 4 * hf + (i & 3); if (kap >= r) { be[i] = 0.f; om[i] = 1.f; } } }
            float sfx[16], Gt[4], Go[4];
#pragma unroll
            for (int g = 0; g < 4; ++g) { sfx[4 * g + 3] = 1.f; sfx[4 * g + 2] = om[4 * g + 3]; sfx[4 * g + 1] = sfx[4 * g + 2] * om[4 * g + 2]; sfx[4 * g + 0] = sfx[4 * g + 1] * om[4 * g + 1]; Gt[g] = sfx[4 * g + 0] * om[4 * g + 0]; }
#pragma unroll
            for (int g = 0; g < 4; ++g) Go[g] = shx(Gt[g], 32, ll);
            float SP[4]; SP[3] = 1.f; SP[2] = Gt[3] * Go[3]; SP[1] = SP[2] * (Gt[2] * Go[2]); SP[0] = SP[1] * (Gt[1] * Go[1]);
            float wgt[16];
#pragma unroll
            for (int g = 0; g < 4; ++g) { const float Rg = Rc * SP[g] * (hf == 0 ? Go[g] : 1.f);
#pragma unroll
                for (int j = 0; j < 4; ++j) wgt[4 * g + j] = be[4 * g + j] * (Rg * sfx[4 * g + j]); }
            Rc = Rc * (SP[0] * (Gt[0] * Go[0]));
            if (kt > 0) {
#pragma unroll
                for (int k = 0; k < 8; ++k) { const int n = F.lane + 64 * k; const bf16* rp = qkv + (size_t)(b * SEQ + (kt - 1) * 32 + (n >> 4)) * B_INC + h * B_HD + (n & 15) * 8; Kr[k] = *(const v4u*)(rp + DM); Vr[k] = *(const v4u*)(rp + 2 * DM); }
            }
            asm volatile("s_waitcnt lgkmcnt(0)" ::: "memory");
#pragma unroll
            for (int s2 = 0; s2 < 2; ++s2) {
                v4u pk; pk.x = pk2(wgt[8 * s2 + 0], wgt[8 * s2 + 1]); pk.y = pk2(wgt[8 * s2 + 2], wgt[8 * s2 + 3]); pk.z = pk2(wgt[8 * s2 + 4], wgt[8 * s2 + 5]); pk.w = pk2(wgt[8 * s2 + 6], wgt[8 * s2 + 7]);
                const bf16x8 pa = __builtin_bit_cast(bf16x8, pk);
#pragma unroll
                for (int dt = 0; dt < 4; ++dt) { const bf16x8 vb = tr_frag_at(img, tr_base_perm((unsigned)ll, (unsigned)dt, 0u), tr_base_perm((unsigned)ll, (unsigned)dt, 1u), (unsigned)s2);
                    o[dt] = __builtin_amdgcn_mfma_f32_32x32x16_bf16(pa, vb, o[dt], 0, 0, 0); }
            }
            if (__ballot(Rc >= 0x1p-40f) == 0ull) break;
        }
#pragma unroll
        for (int dt = 0; dt < 4; ++dt)
#pragma unroll
            for (int i = 0; i < 16; ++i) { const int qrow = 8 * (i >> 2) + 4 * hf + (i & 3);
                o_out[(size_t)(b * SEQ + t0 + qrow) * DM + h * B_HD + 32 * dt + r] = (bf16)f2bf(o[dt][i]); }
    }
    }
}

constexpr int PH_LAYER0 = 3, PH_PER_LAYER = 16, PH_END = PH_LAYER0 + DEPTH * PH_PER_LAYER;
typedef pg8::bf16_t gb16;
__device__ __forceinline__ bool relaunder(Frame& F) { int l_; asm volatile("v_mbcnt_lo_u32_b32 %0, -1, 0\n\tv_mbcnt_hi_u32_b32 %0, -1, %0" : "=v"(l_)); F.lane = l_; F.tid = F.wave * 64 + l_; return true; }
template <class Epi> __device__ __forceinline__ void run_gemm(Frame& F, const bf16* A, const bf16* Bt, int N, int K, int lda, int ldb, int acs, const Epi& E) {
    pg8::Gemm g{(const gb16*)A, (const gb16*)Bt, T, N, K, lda, ldb, acs}; pg8::StaticOrder S; S.init(T, N, F.G, (F.G == 256) ? (int)((blockIdx.x & 31) * 8 + (blockIdx.x >> 5)) : (int)blockIdx.x);
    pg8::gemm_phase<Epi, pg8::StaticOrder, true, true>(F.lds, g, S, E, F.tid);
}
__global__ void __launch_bounds__(NWAVES * 64, 2) fwd_kernel(Args args) {
    extern __shared__ __attribute__((aligned(16))) unsigned char lds_raw[];
    Frame F;
    F.lds = (LAS unsigned char*)lds_raw;
    F.tid = threadIdx.x; F.lane = F.tid & 63; F.wave = __builtin_amdgcn_readfirstlane(F.tid >> 6); F.G = gridDim.x;
    F.ap = (const CAS Args*)__builtin_amdgcn_kernarg_segment_ptr();
    F.out = args.out; F.ws = args.ws;
    volatile LAS unsigned* MISC = (volatile LAS unsigned*)(F.lds + MISC_OFF);
    if (F.tid < 64) MISC[F.tid] = 0u;
    __syncthreads();
    const int lo = args.ph_lo, hi = args.ph_hi;
    XcdBarrier bar; bar.bar = (unsigned*)(F.ws + WS_CTL) + CW_BAR; bar.x = 0; bar.st = nullptr;
    if (hi - lo > 1) { bar = xcd_barrier_post((unsigned*)(F.ws + WS_CTL) + CW_BAR, MISC + 8); xcd_barrier<true>(bar); }
#define IN(k) (lo <= (k) && (k) < hi && relaunder(F))
#define INR(k) (lo <= (k) && (k) < hi)
#define GRID_BAR() do { XcdBarrier b2_ = bar; b2_.x = (unsigned)__builtin_amdgcn_readfirstlane((int)bar.x); asm volatile("" : "+s"(b2_.bar), "+s"(b2_.x)); xcd_barrier<false>(b2_); } while (0)
#define SEAM(k) do { if (INR((k) + 1)) GRID_BAR(); } while (0)

    float* mod = WSP(float, WS_MOD);
    const float* normg = F.inp(IN_NORMG);
    bf16* Hb = WSP(bf16, WS_H);
    if (IN(0)) { ph_prologue(F); SEAM(0); }
    if (IN(1)) { ph_modreduce(F); SEAM(1); }
    if (IN(2)) { ph_post(F, nullptr, F.inp(IN_X), true, nullptr, false, nullptr, nullptr, Hb, normg + 0 * DM, mod + 0 * DM, mod + 1 * DM); SEAM(2); }

    for (int L = 0; L < DEPTH; ++L) {
        const int pb = PH_LAYER0 + PH_PER_LAYER * L, j = L >> 1;
        const float* modL = mod + (size_t)L * BATCH * MODW;
        const float* ng = normg + (size_t)L * 4 * DM;
        const bool lastL = (L == DEPTH - 1);
        bf16* XB = (bf16*)((unsigned char*)F.out + 128 * MiB); bf16* XL = WSP(bf16, WS_P + 128 * MiB);
        if ((L & 1) == 0) {
            float* proj = WSP(float, WS_P); bf16* qidx = WSP(bf16, WS_P + 128 * MiB); bf16* ob = WSP(bf16, WS_P);
            bf16* big = WSP(bf16, WS_BIG);
            bf16* qlat = WSP(bf16, WS_QLAT); bf16* ckv = WSP(bf16, WS_CKV); bf16* kidx = WSP(bf16, WS_KIDX); float* widx = WSP(float, WS_WIDX); int* idxb = WSP(int, WS_IDX);
            if (IN(pb + 0)) { pg8::EpiF32 E{proj, A_INP}; run_gemm(F, Hb, WSP(bf16, WS_WAIN) + (size_t)j * A_INP * DM, A_INP, DM, DM, DM, 0, E); SEAM(pb + 0); }
            if (IN(pb + 1)) { ph_dsa_norm(F, proj, F.inp(IN_AQN) + j * A_QR, F.inp(IN_AKVN) + j * A_KVR, F.inp(IN_AIKN) + j * IDX_D, qlat, ckv, kidx, widx); SEAM(pb + 1); }
            if (IN(pb + 2)) { pg8::EpiBf16<0> E{(gb16*)big, 8192, (gb16*)qidx, 2048, 8192}; run_gemm(F, qlat, WSP(bf16, WS_WQC) + (size_t)j * 10240 * 512, 10240, A_QR, A_QR, A_QR, 0, E); SEAM(pb + 2); }
            if (IN(pb + 3)) { ph_indexer(F, qidx, kidx, widx, idxb); SEAM(pb + 3); }
            if (IN(pb + 4)) { ph_sparse_attn(F, big, ckv, idxb, F.inp(IN_RELB)); SEAM(pb + 4); }
            if (IN(pb + 5)) { pg8::EpiBf16<0> E{(gb16*)ob, 4096, (gb16*)ob, 4096, 1 << 30}; run_gemm(F, big, WSP(bf16, WS_WUV) + (size_t)j * 4096 * 512, 4096, 512, 8192, 512, 512, E); SEAM(pb + 5); }
            if (IN(pb + 6)) { pg8::EpiBf16<0> E{(gb16*)big, DM, (gb16*)big, DM, 1 << 30}; run_gemm(F, ob, WSP(bf16, WS_WAOUT) + (size_t)j * DM * 4096, DM, 4096, 4096, 4096, 0, E); SEAM(pb + 6); }
        } else {
            bf16* qkv = WSP(bf16, WS_BIG); bf16* ob = WSP(bf16, WS_P); bf16* big = WSP(bf16, WS_BIG);
            if (IN(pb + 0)) { pg8::EpiBf16<0> E{(gb16*)qkv, B_INC, (gb16*)qkv, B_INC, 1 << 30}; run_gemm(F, Hb, WSP(bf16, WS_WBIN) + (size_t)j * B_INC * DM, B_INC, DM, DM, DM, 0, E); SEAM(pb + 0); }
            if (IN(pb + 1)) { ph_sb_attn(F, qkv, ob, (unsigned*)(F.ws + WS_CTL) + CW_SBQ + 512 * j); SEAM(pb + 1); }
            if (IN(pb + 2)) { pg8::EpiBf16<0> E{(gb16*)big, DM, (gb16*)big, DM, 1 << 30}; run_gemm(F, ob, WSP(bf16, WS_WBOUT) + (size_t)j * DM * DM, DM, DM, DM, DM, 0, E); if (INR(pb + 7)) GRID_BAR(); }
        }
        if (IN(pb + 7)) { ph_post(F, WSP(bf16, WS_BIG), (L == 0) ? (const void*)F.inp(IN_X) : (const void*)XB, L == 0, lastL ? (void*)XL : (void*)XB, false, modL + 2 * DM, ng + 1 * DM, Hb, ng + 2 * DM, modL + 3 * DM, modL + 4 * DM); SEAM(pb + 7); }
        if (IN(pb + 8)) { pg8::EpiBf16<1> E{(gb16*)WSP(bf16, WS_BIG), DFF, (gb16*)WSP(bf16, WS_BIG), DFF, 1 << 30}; run_gemm(F, Hb, WSP(bf16, WS_WM1) + (size_t)L * DFF * DM, DFF, DM, DM, DM, 0, E); SEAM(pb + 8); }
        if (IN(pb + 9)) { pg8::EpiBf16<0> E{(gb16*)WSP(bf16, WS_P), DM, (gb16*)WSP(bf16, WS_P), DM, 1 << 30}; run_gemm(F, WSP(bf16, WS_BIG), WSP(bf16, WS_WM2) + (size_t)L * DM * DFF, DM, DFF, DFF, DFF, 0, E); SEAM(pb + 9); }
        if (IN(pb + 10)) {
            const float* modN = mod + (size_t)(L + 1) * BATCH * MODW; const float* ngN = normg + (size_t)(L + 1) * 4 * DM;
            ph_post(F, WSP(bf16, WS_P), lastL ? (const void*)XL : (const void*)XB, false, lastL ? (void*)F.out : (void*)XB, lastL, modL + 5 * DM, ng + 3 * DM, lastL ? nullptr : Hb, ngN, modN + 0 * DM, modN + 1 * DM);
            if (!lastL && INR(pb + PH_PER_LAYER)) GRID_BAR();
        }
    }
#undef IN
#undef INR
#undef GRID_BAR
#undef SEAM
}

extern "C" void kernel_launch(void* const* d_in, const int* in_sizes, int n_in, void* d_out, int out_size, void* d_ws, size_t ws_size, hipStream_t stream) {
    static int grid = 0;
    if (grid == 0) {
        if (n_in != N_IN || out_size != T * DM || ws_size < WS_END) { fprintf(stderr, "kernel_launch: unexpected problem: n_in %d out %d ws %zu (need %zu); nothing launched\n", n_in, out_size, ws_size, (size_t)WS_END); grid = -1; return; }
        int dev = 0, cus = 0, per_cu = 0;
        if (hipGetDevice(&dev) != hipSuccess || hipDeviceGetAttribute(&cus, hipDeviceAttributeMultiprocessorCount, dev) != hipSuccess) { grid = -1; return; }
        if (hipFuncSetAttribute((const void*)fwd_kernel, hipFuncAttributeMaxDynamicSharedMemorySize, LDS_BYTES) != hipSuccess) { fprintf(stderr, "kernel_launch: hipFuncSetAttribute(%d B LDS) failed\n", LDS_BYTES); grid = -1; return; }
        if (hipOccupancyMaxActiveBlocksPerMultiprocessor(&per_cu, (const void*)fwd_kernel, NWAVES * 64, LDS_BYTES) != hipSuccess || per_cu < 1) { fprintf(stderr, "kernel_launch: occupancy query says %d workgroups per CU; nothing launched\n", per_cu); (void)hipGetLastError(); grid = -1; return; }
        grid = cus * (per_cu < 1 ? per_cu : 1);
    }
    if (grid < 0) return;
    (void)hipMemsetAsync((char*)d_ws + WS_CTL, 0, CTL_ZERO_BYTES, stream);
    Args a{};
    for (int i = 0; i < N_IN; ++i) a.in[i] = (const float*)d_in[i];
    a.out = (float*)d_out; a.ws = (unsigned char*)d_ws;
#if ONE_LAUNCH
    a.ph_lo = 0; a.ph_hi = PH_END;
    hipLaunchKernelGGL(fwd_kernel, dim3(grid), dim3(NWAVES * 64), LDS_BYTES, stream, a);
#else
    for (int p = 0; p < PH_END; ++p) {
        if (p >= PH_LAYER0) { const int L = (p - PH_LAYER0) / PH_PER_LAYER, r = (p - PH_LAYER0) % PH_PER_LAYER;
            if (r > 10) continue; if ((L & 1) && r >= 3 && r <= 6) continue; }
        a.ph_lo = p; a.ph_hi = p + 1;
        hipLaunchKernelGGL(fwd_kernel, dim3(grid), dim3(NWAVES * 64), LDS_BYTES, stream, a);
    }
#endif
}
```
